# Optimizing an MI355X kernel written in HIP

```python
import math
import jax, jax.numpy as jnp
from jax import lax
import numpy as np

D_MODEL = 2048
BATCH = 4
SEQ = 8192
DEPTH = 4
DEC_BATCH = 2
DEC_SEQ = 8192
PAST_LEN = 128

HEAD_DIM = 128
A_HEADS = 8
A_KV = 2
B_HEADS = 8
B_KV = 2
C_WIDTH = 1024
C_BLOCKS = 8
C_BLOCK_W = C_WIDTH // C_BLOCKS
CONV_W = 4
LRU_C = 8.0
MIX_W = 1024
N_BRANCH = 3
FF = 4 * D_MODEL
WINDOW = 128
Q_BLOCK = 128
GRID_W = 64
ROPE_THETA = 10000.0
EPS = 1e-6

SPLIT_SIZES = (A_HEADS * HEAD_DIM, A_KV * HEAD_DIM, A_KV * HEAD_DIM,
               B_HEADS * HEAD_DIM, B_KV * HEAD_DIM, B_KV * HEAD_DIM,
               C_WIDTH, C_WIDTH, N_BRANCH * D_MODEL)
IN_W = 1024 + 256 + 256 + 1024 + 256 + 256 + 1024 + 1024 + 3 * 2048

kernel_name = "hybrid_gated_parallel_encoder"


def _rms_norm(x, g):
    xf = x.astype(jnp.float32)
    y = xf * lax.rsqrt(jnp.mean(jnp.square(xf), axis=-1, keepdims=True) + EPS)
    return (y * g.astype(jnp.float32)).astype(x.dtype)


def _rope_angles_1d(s):
    t = jnp.arange(s, dtype=jnp.float32)
    inv = ROPE_THETA ** (-jnp.arange(0, HEAD_DIM, 2, dtype=jnp.float32) / HEAD_DIM)
    return t[:, None] * inv[None, :]


def _rope_angles_axial(s):
    rows = s // GRID_W
    row = jnp.repeat(jnp.arange(rows, dtype=jnp.float32), GRID_W)
    col = jnp.tile(jnp.arange(GRID_W, dtype=jnp.float32), rows)
    half = HEAD_DIM // 2
    inv = ROPE_THETA ** (-jnp.arange(0, half, 2, dtype=jnp.float32) / half)
    return jnp.concatenate([row[:, None] * inv[None, :], col[:, None] * inv[None, :]], axis=-1)


def _apply_rope(x, ang):
    cos = jnp.cos(ang)[None, :, None, :]
    sin = jnp.sin(ang)[None, :, None, :]
    x1, x2 = jnp.split(x.astype(jnp.float32), 2, axis=-1)
    return jnp.concatenate([x1 * cos - x2 * sin, x2 * cos + x1 * sin], axis=-1).astype(x.dtype)


def _global_attention(q, k, v):
    b, s, h, d = q.shape
    kvh = k.shape[2]
    g = h // kvh
    nb = s // Q_BLOCK
    scale = d ** -0.5
    qb = q.reshape(b, nb, Q_BLOCK, kvh, g, d).transpose(1, 0, 2, 3, 4, 5)

    def block(qi):
        sc = jnp.einsum('bqhgd,bkhd->bhgqk', qi, k, preferred_element_type=jnp.float32) * scale
        p = jax.nn.softmax(sc, axis=-1)
        return jnp.einsum('bhgqk,bkhd->bqhgd', p.astype(v.dtype), v)

    o = lax.map(block, qb)
    return o.transpose(1, 0, 2, 3, 4, 5).reshape(b, s, h * d)


def _window_attention(q, k, v, sink):
    b, s, h, d = q.shape
    kvh = k.shape[2]
    g = h // kvh
    nb = s // Q_BLOCK
    scale = d ** -0.5
    pad = ((0, 0), (Q_BLOCK, Q_BLOCK), (0, 0), (0, 0))
    kp = jnp.pad(k, pad)
    vp = jnp.pad(v, pad)

    def bands(t):
        return jnp.concatenate(
            [t[:, o * Q_BLOCK: o * Q_BLOCK + s].reshape(b, nb, Q_BLOCK, kvh, d) for o in range(3)], axis=2)

    kb = bands(kp)
    vb = bands(vp)
    qb = q.reshape(b, nb, Q_BLOCK, kvh, g, d)
    sc = jnp.einsum('bnqhgd,bnkhd->bnhgqk', qb, kb, preferred_element_type=jnp.float32) * scale
    blk = jnp.arange(nb)[:, None, None] * Q_BLOCK
    qpos = blk + jnp.arange(Q_BLOCK)[None, :, None]
    kpos = blk - Q_BLOCK + jnp.arange(3 * Q_BLOCK)[None, None, :]
    valid = (jnp.abs(qpos - kpos) <= WINDOW) & (kpos >= 0) & (kpos < s)
    sc = jnp.where(valid[None, :, None, None], sc, -jnp.inf)
    sk = sink.astype(jnp.float32).reshape(kvh, g)[None, None, :, :, None, None]
    m = jnp.maximum(jnp.max(sc, axis=-1, keepdims=True), sk)
    e = jnp.exp(sc - m)
    p = e / (jnp.sum(e, axis=-1, keepdims=True) + jnp.exp(sk - m))
    o = jnp.einsum('bnhgqk,bnkhd->bnqhgd', p.astype(v.dtype), vb)
    return o.reshape(b, s, h * d)


def _lru_combine(c1, c2):
    a1, b1 = c1
    a2, b2 = c2
    return a1 * a2, a2 * b1 + b2


def _rglru_branch(xc, yc, conv_w, conv_b, gate_r_w, gate_r_b, gate_i_w, gate_i_b, lru_lambda):
    b, s, c = xc.shape
    left = CONV_W // 2
    xp = jnp.pad(xc, ((0, 0), (left, CONV_W - 1 - left), (0, 0)))
    u = conv_b
    for j in range(CONV_W):
        u = u + xp[:, j:j + s] * conv_w[j]
    ub = u.reshape(b, s, C_BLOCKS, C_BLOCK_W)
    uf = u.astype(jnp.float32)

    def direction(dd, reverse):
        r = jax.nn.sigmoid((jnp.einsum('bsnc,nce->bsne', ub, gate_r_w[dd]).reshape(b, s, c)
                            + gate_r_b[dd]).astype(jnp.float32))
        i = jax.nn.sigmoid((jnp.einsum('bsnc,nce->bsne', ub, gate_i_w[dd]).reshape(b, s, c)
                            + gate_i_b[dd]).astype(jnp.float32))
        log_a = LRU_C * r * jax.nn.log_sigmoid(lru_lambda[dd].astype(jnp.float32))
        a = jnp.exp(log_a)
        drive = jnp.sqrt(-jnp.expm1(2.0 * log_a)) * (i * uf)
        _, hs = lax.associative_scan(_lru_combine, (a, drive), axis=1, reverse=reverse)
        return hs

    hsum = direction(0, False) + direction(1, True)
    return (hsum * jax.nn.gelu(yc.astype(jnp.float32), approximate=True)).astype(xc.dtype)


def _mixer(h, p):
    b, s, _ = h.shape
    proj = h @ p['w_in']
    parts = []
    off = 0
    for sz in SPLIT_SIZES:
        parts.append(proj[..., off:off + sz])
        off += sz
    qa, ka, va, qb, kb, vb, xc, yc, gates = parts

    ang_ax = _rope_angles_axial(s)
    qa = _apply_rope(_rms_norm(qa.reshape(b, s, A_HEADS, HEAD_DIM), p['q_norm_a']), ang_ax)
    ka = _apply_rope(_rms_norm(ka.reshape(b, s, A_KV, HEAD_DIM), p['k_norm_a']), ang_ax)
    oa = _global_attention(qa, ka, va.reshape(b, s, A_KV, HEAD_DIM))

    ang_1d = _rope_angles_1d(s)
    qb = _apply_rope(qb.reshape(b, s, B_HEADS, HEAD_DIM), ang_1d)
    kb = _apply_rope(kb.reshape(b, s, B_KV, HEAD_DIM), ang_1d)
    ob = _window_attention(qb, kb, vb.reshape(b, s, B_KV, HEAD_DIM), p['sink_b'])

    oc = _rglru_branch(xc, yc, p['conv_w'], p['conv_b'], p['gate_r_w'], p['gate_r_b'],
                       p['gate_i_w'], p['gate_i_b'], p['lru_lambda'])

    g = jax.nn.sigmoid(gates.astype(jnp.float32)).astype(h.dtype).reshape(b, s, N_BRANCH, D_MODEL)
    wb = p['w_branch']
    merged = (g[:, :, 0] * (oa @ wb[0]) + g[:, :, 1] * (ob @ wb[1]) + g[:, :, 2] * (oc @ wb[2]))
    return merged @ p['w_out']


def _mlp(h, w_in, w_out):
    return jnp.square(jax.nn.relu(h @ w_in)) @ w_out


def _trunk(x, layers):
    for p in layers:
        x = x + _rms_norm(_mixer(_rms_norm(x, p['norm_mix_pre']), p), p['norm_mix_post'])
        x = x + _rms_norm(_mlp(_rms_norm(x, p['norm_ffn_pre']), p['w_ffn_in'], p['w_ffn_out']),
                          p['norm_ffn_post'])
    return x


def setup_inputs(seed: int = 0) -> dict:
    key = jax.random.key(seed)
    ks = jax.random.split(key, 24)
    f32 = jnp.float32
    nrm = lambda k, shape, scale: jax.random.normal(k, shape, f32) * scale
    gain = lambda k, shape: 1.0 + 0.05 * jax.random.normal(k, shape, f32)
    a_c = jax.random.uniform(ks[14], (DEPTH, 2, C_WIDTH), f32, 0.9, 0.999)
    a0 = a_c ** (1.0 / LRU_C)
    lru_lambda = jnp.log(a0) - jnp.log1p(-a0)
    return {
        'x_prompt': jax.random.normal(ks[0], (BATCH, SEQ, D_MODEL), f32),
        'x_sample': jax.random.normal(ks[1], (DEC_BATCH, DEC_SEQ, D_MODEL), f32),
        'norm_mix_pre': gain(ks[2], (DEPTH, D_MODEL)),
        'norm_mix_post': gain(ks[3], (DEPTH, D_MODEL)),
        'norm_ffn_pre': gain(ks[4], (DEPTH, D_MODEL)),
        'norm_ffn_post': gain(ks[5], (DEPTH, D_MODEL)),
        'w_in': nrm(ks[6], (DEPTH, D_MODEL, IN_W), D_MODEL ** -0.5),
        'q_norm_a': gain(ks[7], (DEPTH, HEAD_DIM)),
        'k_norm_a': gain(ks[8], (DEPTH, HEAD_DIM)),
        'sink_b': nrm(ks[9], (DEPTH, B_HEADS), 0.5),
        'conv_w': nrm(ks[10], (DEPTH, CONV_W, C_WIDTH), CONV_W ** -0.5),
        'conv_b': nrm(ks[11], (DEPTH, C_WIDTH), 0.01),
        'gate_r_w': nrm(ks[12], (DEPTH, 2, C_BLOCKS, C_BLOCK_W, C_BLOCK_W), C_BLOCK_W ** -0.5),
        'gate_r_b': nrm(ks[13], (DEPTH, 2, C_WIDTH), 0.01),
        'gate_i_w': nrm(ks[15], (DEPTH, 2, C_BLOCKS, C_BLOCK_W, C_BLOCK_W), C_BLOCK_W ** -0.5),
        'gate_i_b': nrm(ks[16], (DEPTH, 2, C_WIDTH), 0.01),
        'lru_lambda': lru_lambda,
        'w_branch': nrm(ks[17], (DEPTH, N_BRANCH, MIX_W, D_MODEL), MIX_W ** -0.5),
        'w_out': nrm(ks[18], (DEPTH, D_MODEL, D_MODEL), D_MODEL ** -0.5),
        'w_ffn_in': nrm(ks[19], (DEPTH, D_MODEL, FF), D_MODEL ** -0.5),
        'w_ffn_out': nrm(ks[20], (DEPTH, FF, D_MODEL), FF ** -0.5),
    }


def reference(x_prompt, x_sample, norm_mix_pre, norm_mix_post, norm_ffn_pre, norm_ffn_post, w_in,
              q_norm_a, k_norm_a, sink_b, conv_w, conv_b, gate_r_w, gate_r_b, gate_i_w, gate_i_b,
              lru_lambda, w_branch, w_out, w_ffn_in, w_ffn_out):
    layers = [dict(norm_mix_pre=norm_mix_pre[l], norm_mix_post=norm_mix_post[l],
                   norm_ffn_pre=norm_ffn_pre[l], norm_ffn_post=norm_ffn_post[l],
                   w_in=w_in[l], q_norm_a=q_norm_a[l], k_norm_a=k_norm_a[l], sink_b=sink_b[l],
                   conv_w=conv_w[l], conv_b=conv_b[l], gate_r_w=gate_r_w[l], gate_r_b=gate_r_b[l],
                   gate_i_w=gate_i_w[l], gate_i_b=gate_i_b[l], lru_lambda=lru_lambda[l],
                   w_branch=w_branch[l], w_out=w_out[l], w_ffn_in=w_ffn_in[l], w_ffn_out=w_ffn_out[l])
              for l in range(DEPTH)]
    y_prompt = _trunk(x_prompt, layers)
    y_sample = _trunk(x_sample, layers)
    return (y_prompt, y_sample)
```

```cpp
#include <hip/hip_runtime.h>
#include <cstdio>
#include <cstdint>

#ifndef PH_MASK
#define PH_MASK 0xFFF
#endif
#ifndef SUBMASK
#define SUBMASK 7
#endif
#ifndef SD_A
#define SD_A 2
#endif
#ifndef SD_B
#define SD_B 1
#endif
#ifndef MK_SINGLE
#define MK_SINGLE 0
#endif

#define LAS __attribute__((address_space(3)))
#define GAS __attribute__((address_space(1)))
#define CAS __attribute__((address_space(4)))
typedef unsigned short bf16;
typedef short bf16x8 __attribute__((ext_vector_type(8)));
typedef short s16x4 __attribute__((ext_vector_type(4)));
typedef float f32x4 __attribute__((ext_vector_type(4)));
typedef float f32x2 __attribute__((ext_vector_type(2)));
typedef float f32x16 __attribute__((ext_vector_type(16)));
typedef unsigned u32x4 __attribute__((ext_vector_type(4)));
typedef unsigned u32x2 __attribute__((ext_vector_type(2)));

constexpr int DM = 2048, SEQ = 8192, NTOK = 49152, TC = 16384, NCHUNK = 3, DEPTH = 4;
constexpr int INW = 11264, PWD = 5120, GWD = 6144, FFD = 8192, MWD = 1024, HD = 128;
constexpr int QA_OFF = 0, KA_OFF = 1024, VA_OFF = 1280, QB_OFF = 1536, KB_OFF = 2560, VB_OFF = 2816, XC_OFF = 3072, YC_OFF = 4096;
constexpr int NPROMPT_TOK = 32768;
constexpr float EPS = 1e-6f;
constexpr int LC = 32, NTCH = SEQ / LC;

constexpr size_t MiB = 1u << 20;
constexpr size_t WS_CTL = 0, CTL_ZERO_BYTES = 1 * MiB;
constexpr size_t WS_WIN = 2 * MiB;
constexpr size_t WS_WBR = 46 * MiB;
constexpr size_t WS_WOUT = 58 * MiB;
constexpr size_t WS_W1 = 66 * MiB;
constexpr size_t WS_W2 = 98 * MiB;
constexpr size_t WS_WG = 130 * MiB;
constexpr size_t WS_SUM = 131 * MiB;
constexpr size_t WS_CAR = 139 * MiB;
constexpr size_t WS_BRS = 143 * MiB;
constexpr size_t WS_H = 207 * MiB;
constexpr size_t WS_P = 271 * MiB;
constexpr size_t WS_G = 431 * MiB;
constexpr size_t WS_O = 623 * MiB;
constexpr size_t WS_END = 719 * MiB;
constexpr int CW_BAR = 4096;

constexpr int LDS_BYTES = 147456;
constexpr int MISC_OFF = 143360;

__device__ __forceinline__ unsigned cvt_pk_bf16(float lo, float hi) { unsigned r; asm volatile("v_cvt_pk_bf16_f32 %0, %1, %2" : "=v"(r) : "v"(lo), "v"(hi)); return r; }
__device__ __forceinline__ float bf_lo(unsigned w) { return __uint_as_float(w << 16); }
__device__ __forceinline__ float bf_hi(unsigned w) { return __uint_as_float(w & 0xffff0000u); }
__device__ __forceinline__ float bf2f(bf16 b) { return __uint_as_float(((unsigned)b) << 16); }
__device__ __forceinline__ float fast_sigmoid(float v) { return __builtin_amdgcn_rcpf(1.0f + __builtin_amdgcn_exp2f(-1.4426950408889634f * v)); }
__device__ __forceinline__ float wave_sum(float v, int lane) {
#pragma unroll
    for (int o = 1; o < 64; o <<= 1) v += __int_as_float(__builtin_amdgcn_ds_bpermute((lane ^ o) << 2, __float_as_int(v)));
    return v;
}

__device__ const double ROPE_F1[64] = {
1.59154943091895346e-01, 1.37822502603982849e-01, 1.19349370211248862e-01, 1.03352296618434064e-01, 8.94994016088910133e-02, 7.75032887553740585e-02, 6.71150830052272551e-02, 5.81192674418762462e-02,
5.03292121044697269e-02, 4.35833029420947638e-02, 3.77415888468699103e-02, 3.26828760272190911e-02, 2.83022152813622411e-02, 2.45087241866802648e-02, 2.12237020815031856e-02, 1.83789966569160986e-02,
1.59154943091895339e-02, 1.37822502603982842e-02, 1.19349370211248869e-02, 1.03352296618434060e-02, 8.94994016088910202e-03, 7.75032887553740654e-03, 6.71150830052272551e-03, 5.81192674418762427e-03,
5.03292121044697286e-03, 4.35833029420947656e-03, 3.77415888468699086e-03, 3.26828760272190893e-03, 2.83022152813622403e-03, 2.45087241866802661e-03, 2.12237020815031847e-03, 1.83789966569160995e-03,
1.59154943091895335e-03, 1.37822502603982846e-03, 1.19349370211248865e-03, 1.03352296618434069e-03, 8.94994016088910115e-04, 7.75032887553740654e-04, 6.71150830052272508e-04, 5.81192674418762427e-04,
5.03292121044697243e-04, 4.35833029420947678e-04, 3.77415888468699086e-04, 3.26828760272190871e-04, 2.83022152813622381e-04, 2.45087241866802661e-04, 2.12237020815031847e-04, 1.83789966569160984e-04,
1.59154943091895346e-04, 1.37822502603982835e-04, 1.19349370211248871e-04, 1.03352296618434063e-04, 8.94994016088910088e-05, 7.75032887553740654e-05, 6.71150830052272508e-05, 5.81192674418762400e-05,
5.03292121044697243e-05, 4.35833029420947644e-05, 3.77415888468699120e-05, 3.26828760272190871e-05, 2.83022152813622381e-05, 2.45087241866802641e-05, 2.12237020815031861e-05, 1.83789966569160984e-05 };
__device__ const double ROPE_FA[32] = {
1.59154943091895346e-01, 1.19349370211248862e-01, 8.94994016088910133e-02, 6.71150830052272551e-02, 5.03292121044697269e-02, 3.77415888468699103e-02, 2.83022152813622411e-02, 2.12237020815031856e-02,
1.59154943091895339e-02, 1.19349370211248869e-02, 8.94994016088910202e-03, 6.71150830052272551e-03, 5.03292121044697286e-03, 3.77415888468699086e-03, 2.83022152813622403e-03, 2.12237020815031847e-03,
1.59154943091895335e-03, 1.19349370211248865e-03, 8.94994016088910115e-04, 6.71150830052272508e-04, 5.03292121044697243e-04, 3.77415888468699086e-04, 2.83022152813622381e-04, 2.12237020815031847e-04,
1.59154943091895346e-04, 1.19349370211248871e-04, 8.94994016088910088e-05, 6.71150830052272508e-05, 5.03292121044697243e-05, 3.77415888468699120e-05, 2.83022152813622381e-05, 2.12237020815031861e-05 };

namespace pg8 {
typedef unsigned short bf16_t;
constexpr int BM = 256, BK = 64, HALF = 128, HTB = HALF * BK * 2, STAGE_BYTES = 8 * HTB, NXCD = 8, WGM = 8;
__host__ __device__ __forceinline__ int lds_byte(int r, int c) { const int st = (r >> 4) * 2 + (c >> 5), rr = r & 15, cc = c & 31, ob = rr * 64 + cc * 2; return st * 1024 + (ob ^ (((ob >> 9) & 1) << 5)); }
__host__ __device__ __forceinline__ void stage_rc(int b, int& R, int& C) { const int st = b / 1024, sb = b % 1024, swz = sb ^ (((sb >> 9) & 1) << 5); R = (st >> 1) * 16 + swz / 64; C = (st & 1) * 32 + (swz % 64) / 2; }
__host__ __device__ __forceinline__ int perm32(int rho) { const int n = rho >> 4, i = rho & 15; return 8 * (i >> 2) + 4 * n + (i & 3); }

struct Unit { int pm, pn, ka, kb, sub; };
struct Gemm { const bf16_t* A; const bf16_t* Bt; int K; };

struct StaticOrder {
    int nM, nN, nwg, G, c;
    __device__ void init(int M, int N, int G_, int c_) { nM = M / BM; nN = N / BM; nwg = nM * nN; G = G_; c = c_; }
    __device__ bool next(int i, Unit& u) const {
        const long L = (long)i * G + c; if (L >= nwg) return false;
        int wgid = (int)L; { const int q = nwg / NXCD, r = nwg % NXCD, xcd = wgid % NXCD, off = wgid / NXCD; wgid = (xcd < r ? xcd * (q + 1) : r * (q + 1) + (xcd - r) * q) + off; }
        const int nig = WGM * nN, gid = wgid / nig, fm = gid * WGM, gsz = (nM - fm) < WGM ? (nM - fm) : WGM;
        u.pm = fm + ((wgid % nig) % gsz); u.pn = (wgid % nig) / gsz; u.ka = u.pm; u.kb = u.pn; u.sub = 0; return true;
    }
};
struct BranchOrder {
    StaticOrder base; int npanel;
    __device__ bool next(int i, Unit& u) const {
        const int t = i / 3, s = i - 3 * t; if (!base.next(t, u)) return false;
        u.sub = s; u.ka = s * npanel + u.pm; u.kb = s * 8 + u.pn; return true;
    }
};

struct EpiIn {
    static constexpr bool PERM = true;
    bf16_t* P; bf16_t* G;
    __device__ __forceinline__ void operator()(const f32x4 (&acc)[2][2][4][2], const Unit& u, int wr, int wc, int fr_, int fq) const {
        int fr = fr_; asm volatile("" : "+v"(fr));
        const int row0 = u.pm * BM + wr * 64 + fr; const bool gate = u.pn >= 20;
        bf16_t* base = gate ? G : P; const int ldc = gate ? GWD : PWD; const int col0 = (gate ? u.pn - 20 : u.pn) * BM + wc * 32 + 8 * fq;
#pragma unroll
        for (int ai = 0; ai < 2; ++ai)
#pragma unroll
            for (int m = 0; m < 4; ++m) { bf16_t* rowp = base + (size_t)(row0 + ai * HALF + m * 16) * ldc + col0;
#pragma unroll
                for (int bj = 0; bj < 2; ++bj) { f32x4 v0 = acc[ai][bj][m][0], v1 = acc[ai][bj][m][1];
                    if (gate) {
#pragma unroll
                        for (int j = 0; j < 4; ++j) { v0[j] = fast_sigmoid(v0[j]); v1[j] = fast_sigmoid(v1[j]); } }
                    u32x4 w; w.x = cvt_pk_bf16(v0[0], v0[1]); w.y = cvt_pk_bf16(v0[2], v0[3]); w.z = cvt_pk_bf16(v1[0], v1[1]); w.w = cvt_pk_bf16(v1[2], v1[3]);
                    *(u32x4*)(rowp + bj * HALF) = w; } }
    }
};
struct EpiBr {
    static constexpr bool PERM = true;
    const bf16_t* G; bf16_t* OUT; float* scratch;
    __device__ __forceinline__ void operator()(const f32x4 (&acc)[2][2][4][2], const Unit& u, int wr, int wc, int fr_, int fq) const {
        int fr = fr_; asm volatile("" : "+v"(fr));
        const int row0 = u.pm * BM + wr * 64 + fr, col0 = u.pn * BM + wc * 32 + 8 * fq; const int sub = u.sub;
        GAS f32x4* sp = (GAS f32x4*)scratch + ((wr * 4 + wc) * 64 + fq * 16 + fr);
#pragma unroll
        for (int ai = 0; ai < 2; ++ai)
#pragma unroll
            for (int m = 0; m < 4; ++m) { const size_t row = (size_t)(row0 + ai * HALF + m * 16);
#pragma unroll
                for (int bj = 0; bj < 2; ++bj) { const int idx = (((ai * 4 + m) * 2 + bj) * 2) * 512;
                    const u32x4 gw = *(const u32x4*)(G + row * GWD + sub * DM + col0 + bj * HALF);
                    f32x4 v0 = acc[ai][bj][m][0] * (f32x4){bf_lo(gw.x), bf_hi(gw.x), bf_lo(gw.y), bf_hi(gw.y)};
                    f32x4 v1 = acc[ai][bj][m][1] * (f32x4){bf_lo(gw.z), bf_hi(gw.z), bf_lo(gw.w), bf_hi(gw.w)};
                    if (sub > 0) { v0 += sp[idx]; v1 += sp[idx + 512]; }
                    if (sub < 2) { sp[idx] = v0; sp[idx + 512] = v1; }
                    else { u32x4 w; w.x = cvt_pk_bf16(v0[0], v0[1]); w.y = cvt_pk_bf16(v0[2], v0[3]); w.z = cvt_pk_bf16(v1[0], v1[1]); w.w = cvt_pk_bf16(v1[2], v1[3]);
                        *(u32x4*)(OUT + row * DM + col0 + bj * HALF) = w; } }
                asm volatile("" ::: "memory"); }
    }
};
struct EpiF32 {
    static constexpr bool PERM = false;
    float* C; int ldc;
    __device__ __forceinline__ void operator()(const f32x4 (&acc)[2][2][4][2], const Unit& u, int wr, int wc, int fr_, int fq) const {
        int fr = fr_; asm volatile("" : "+v"(fr));
        const int row0 = u.pm * BM + wr * 64 + fr, col0 = u.pn * BM + wc * 32 + 4 * fq;
#pragma unroll
        for (int ai = 0; ai < 2; ++ai)
#pragma unroll
            for (int m = 0; m < 4; ++m) { float* rowp = C + (size_t)(row0 + ai * HALF + m * 16) * ldc + col0;
#pragma unroll
                for (int bj = 0; bj < 2; ++bj)
#pragma unroll
                    for (int n = 0; n < 2; ++n) *(f32x4*)(rowp + bj * HALF + n * 16) = acc[ai][bj][m][n]; }
    }
};
struct EpiRelu2 {
    static constexpr bool PERM = true;
    bf16_t* O; int ldc;
    __device__ __forceinline__ void operator()(const f32x4 (&acc)[2][2][4][2], const Unit& u, int wr, int wc, int fr_, int fq) const {
        int fr = fr_; asm volatile("" : "+v"(fr));
        const int row0 = u.pm * BM + wr * 64 + fr, col0 = u.pn * BM + wc * 32 + 8 * fq;
#pragma unroll
        for (int ai = 0; ai < 2; ++ai)
#pragma unroll
            for (int m = 0; m < 4; ++m) { bf16_t* rowp = O + (size_t)(row0 + ai * HALF + m * 16) * ldc + col0;
#pragma unroll
                for (int bj = 0; bj < 2; ++bj) { f32x4 v0 = acc[ai][bj][m][0], v1 = acc[ai][bj][m][1];
#pragma unroll
                    for (int j = 0; j < 4; ++j) { const float a = fmaxf(v0[j], 0.f), b = fmaxf(v1[j], 0.f); v0[j] = a * a; v1[j] = b * b; }
                    u32x4 w; w.x = cvt_pk_bf16(v0[0], v0[1]); w.y = cvt_pk_bf16(v0[2], v0[3]); w.z = cvt_pk_bf16(v1[0], v1[1]); w.w = cvt_pk_bf16(v1[2], v1[3]);
                    *(u32x4*)(rowp + bj * HALF) = w; } }
    }
};

template <class Epi, class Sched, bool ALIGN_EPI = true>
__device__ __forceinline__ void gemm_phase(LAS unsigned char* lds, const Gemm g, const Sched& S, const Epi& E) {
    int tid_ = threadIdx.x; asm volatile("" : "+v"(tid_));
    const int tid = tid_, wid = __builtin_amdgcn_readfirstlane(tid >> 6), lane = tid & 63, wr = wid >> 2, wc = wid & 3, fr = lane & 15, fq = lane >> 4;
    const int K = g.K, nt = K / BK;
    unsigned voffA[2], voffB[2];
#pragma unroll
    for (int i = 0; i < 2; ++i) { int R, C; stage_rc(tid * 16 + i * 8192, R, C); const int Rb = Epi::PERM ? ((R & ~31) + perm32(R & 31)) : R;
        voffA[i] = (unsigned)(R * K + C) * 2u; voffB[i] = (unsigned)(Rb * K + C) * 2u; }
    const size_t kstep = (size_t)(BK * 2);
    const size_t hstep = (size_t)HALF * K * 2;
    const size_t tstep = 2 * hstep;
    const unsigned ldsw = (unsigned)wid * 1024u;
    const int aoff = lds_byte(wr * 64 + fr, fq * 8), boff = lds_byte(wc * 32 + fr, fq * 8);
#define PG8_SA(b, h) (((b) * 2 + (h)) * HTB)
#define PG8_SB(b, h) ((4 + (b) * 2 + (h)) * HTB)
#define PG8_STAGE(bufoff, gbase, voff) do { _Pragma("unroll") for (int _i = 0; _i < 2; ++_i) \
        __builtin_amdgcn_global_load_lds((const unsigned*)((const char*)(gbase) + (voff)[_i]), (LAS unsigned*)(lds + (bufoff) + ldsw + _i * 8192), 16, 0, 0); } while (0)
#define PG8_LDA(dst, b, h) do { _Pragma("unroll") for (int m = 0; m < 4; ++m) _Pragma("unroll") for (int k = 0; k < 2; ++k) dst[m][k] = *(const LAS bf16x8*)(lds + PG8_SA(b, h) + aoff + m * 2048 + k * 1024); } while (0)
#define PG8_LDB(dst, b, h) do { _Pragma("unroll") for (int n = 0; n < 2; ++n) _Pragma("unroll") for (int k = 0; k < 2; ++k) dst[n][k] = *(const LAS bf16x8*)(lds + PG8_SB(b, h) + boff + n * 2048 + k * 1024); } while (0)
#define PG8_MMA(ai, bj, At, Bt) do { __builtin_amdgcn_s_setprio(1); _Pragma("unroll") for (int m = 0; m < 4; ++m) _Pragma("unroll") for (int n = 0; n < 2; ++n) _Pragma("unroll") for (int k = 0; k < 2; ++k) \
        acc[ai][bj][m][n] = __builtin_amdgcn_mfma_f32_16x16x32_bf16(Bt[n][k], At[m][k], acc[ai][bj][m][n], 0, 0, 0); __builtin_amdgcn_s_setprio(0); } while (0)
#define PG8_WAIT_V(n) asm volatile("s_waitcnt vmcnt(" #n ")" ::: "memory")
#define PG8_WAIT_L(n) asm volatile("s_waitcnt lgkmcnt(" #n ")" ::: "memory")
#define PG8_BAR __builtin_amdgcn_s_barrier()
#define PG8_SCHED __builtin_amdgcn_sched_barrier(0)
    Unit cur, nxt; int ui = 0;
    if (!S.next(0, cur)) return;
    f32x4 acc[2][2][4][2];
#pragma unroll
    for (int a = 0; a < 2; ++a)
#pragma unroll
        for (int b = 0; b < 2; ++b)
#pragma unroll
            for (int m = 0; m < 4; ++m)
#pragma unroll
                for (int n = 0; n < 2; ++n) acc[a][b][m][n] = (f32x4){0.f, 0.f, 0.f, 0.f};
    bf16x8 At[4][2], B0[2][2], B1[2][2];
    const char* cA = (const char*)g.A + (size_t)cur.ka * tstep; const char* cB = (const char*)g.Bt + (size_t)cur.kb * tstep;
    PG8_STAGE(PG8_SB(0, 0), cB, voffB); PG8_STAGE(PG8_SB(0, 1), cB + hstep, voffB); PG8_STAGE(PG8_SA(0, 0), cA, voffA); PG8_STAGE(PG8_SA(0, 1), cA + hstep, voffA);
    if (wr == 1) PG8_BAR;
    PG8_WAIT_V(2); PG8_BAR;
    PG8_STAGE(PG8_SB(1, 0), cB + kstep, voffB); PG8_STAGE(PG8_SA(1, 0), cA + kstep, voffA); PG8_STAGE(PG8_SB(1, 1), cB + hstep + kstep, voffB);
    PG8_WAIT_V(6); PG8_BAR;
    for (;;) {
        const bool has_next = S.next(ui + 1, nxt);
        const char* nA = has_next ? (const char*)g.A + (size_t)nxt.ka * tstep : cA; const char* nB = has_next ? (const char*)g.Bt + (size_t)nxt.kb * tstep : cB;
        for (int t = 0; t < nt; t += 2) {
            const bool last = (t == nt - 2);
            const char* a1 = cA + (size_t)(t + 1) * kstep;
            const char* a2 = last ? nA : cA + (size_t)(t + 2) * kstep; const char* b2 = last ? nB : cB + (size_t)(t + 2) * kstep;
            const char* a3 = a2 + kstep; const char* b3 = b2 + kstep;
            PG8_LDB(B0, 0, 0); PG8_LDB(B1, 0, 1); PG8_SCHED; PG8_LDA(At, 0, 0); PG8_STAGE(PG8_SA(1, 1), a1 + hstep, voffA);
            PG8_WAIT_V(8); PG8_WAIT_L(0); PG8_BAR; PG8_MMA(0, 0, At, B0); PG8_MMA(0, 1, At, B1); PG8_BAR; PG8_SCHED;
            PG8_LDA(At, 0, 1); PG8_STAGE(PG8_SB(0, 0), b2, voffB); PG8_STAGE(PG8_SB(0, 1), b2 + hstep, voffB); PG8_STAGE(PG8_SA(0, 0), a2, voffA);
            PG8_WAIT_V(8); PG8_WAIT_L(0); PG8_BAR; PG8_MMA(1, 0, At, B0); PG8_MMA(1, 1, At, B1); PG8_BAR; PG8_SCHED;
            PG8_LDB(B0, 1, 0); PG8_LDB(B1, 1, 1); PG8_SCHED; PG8_LDA(At, 1, 0); PG8_STAGE(PG8_SA(0, 1), a2 + hstep, voffA);
            PG8_WAIT_V(8); PG8_WAIT_L(0); PG8_BAR; PG8_MMA(0, 0, At, B0); PG8_MMA(0, 1, At, B1); PG8_BAR; PG8_SCHED;
            PG8_LDA(At, 1, 1); PG8_STAGE(PG8_SB(1, 0), b3, voffB); PG8_STAGE(PG8_SB(1, 1), b3 + hstep, voffB); PG8_STAGE(PG8_SA(1, 0), a3, voffA);
            PG8_WAIT_V(8); PG8_WAIT_L(0); PG8_BAR; PG8_MMA(1, 0, At, B0); PG8_MMA(1, 1, At, B1); PG8_BAR; PG8_SCHED;
        }
        if constexpr (ALIGN_EPI) { if (wr == 0) PG8_BAR; }
        E(acc, cur, wr, wc, fr, fq);
        if (!has_next) break;
#pragma unroll
        for (int a = 0; a < 2; ++a)
#pragma unroll
            for (int b = 0; b < 2; ++b)
#pragma unroll
                for (int m = 0; m < 4; ++m)
#pragma unroll
                    for (int n = 0; n < 2; ++n) acc[a][b][m][n] = (f32x4){0.f, 0.f, 0.f, 0.f};
        cur = nxt; cA = nA; cB = nB; ++ui;
        if constexpr (ALIGN_EPI) { if (wr == 1) PG8_BAR; }
    }
    PG8_WAIT_V(0);
    if constexpr (!ALIGN_EPI) { if (wr == 0) PG8_BAR; }
    PG8_BAR;
#undef PG8_SA
#undef PG8_SB
#undef PG8_STAGE
#undef PG8_LDA
#undef PG8_LDB
#undef PG8_MMA
#undef PG8_WAIT_V
#undef PG8_WAIT_L
#undef PG8_BAR
#undef PG8_SCHED
}
}

namespace att {
constexpr int D = 128, NW = 8, QBLK = 32, KVBLK = 64;
constexpr float SCALE = 0.088388347648318440f;
constexpr float THR = 8.f;
constexpr int LDQ = PWD, LDK = PWD, LDO = MWD;
constexpr int SHM_V = KVBLK * D * 2, SHM_K = KVBLK * D * 2;
constexpr int OST_PITCH = 272;
constexpr int OST_OFF = 2 * SHM_V + 2 * SHM_K + NW * 64 * 4;
constexpr int ATT_LDS = OST_OFF + NW * 32 * OST_PITCH;
#define KSWZ(row, colB) ((row) * 256 + ((colB) ^ (((row) & 7) << 4)))
#define SBAR() __builtin_amdgcn_sched_barrier(0)
__device__ __forceinline__ int crow(int r, int hi) { return (r & 3) + 8 * (r >> 2) + 4 * hi; }

template <bool MASKED>
__device__ __forceinline__ void partialSM(f32x16& p0, f32x16& p1, float& m_reg, float& mn, float& alpha, int mbase) {
  constexpr float C = SCALE * 1.4426950408889634f;
  if constexpr (MASKED) {
    const float ninf = -__builtin_inff();
#pragma unroll
    for (int r = 0; r < 16; ++r) { const int c = (r & 3) + 8 * (r >> 2);
      p0[r] = ((unsigned)(mbase - c) <= 256u) ? p0[r] : ninf;
      p1[r] = ((unsigned)(mbase - c - 32) <= 256u) ? p1[r] : ninf; }
  }
  float pmax = p0[0];
#pragma unroll
  for (int r = 1; r < 16; ++r) pmax = fmaxf(pmax, p0[r]);
#pragma unroll
  for (int r = 0; r < 16; ++r) pmax = fmaxf(pmax, p1[r]);
  { auto rr = __builtin_amdgcn_permlane32_swap(__float_as_uint(pmax), __float_as_uint(pmax), false, false);
    pmax = fmaxf(__uint_as_float(rr[0]), __uint_as_float(rr[1])); }
  if (__builtin_expect(__all(pmax - m_reg <= THR / SCALE), 1)) { mn = m_reg; alpha = 1.f; }
  else { mn = fmaxf(m_reg, pmax); alpha = __builtin_amdgcn_exp2f((m_reg - mn) * C); m_reg = mn; }
  float mnC = -mn * C;
#pragma unroll
  for (int r = 0; r < 16; ++r) p0[r] = fmaf(p0[r], C, mnC);
#pragma unroll
  for (int r = 0; r < 16; ++r) p1[r] = fmaf(p1[r], C, mnC);
#pragma unroll
  for (int r = 0; r < 16; ++r) p0[r] = __builtin_amdgcn_exp2f(p0[r]);
}
__device__ __forceinline__ void finishSM(f32x16& p0, f32x16& p1, float alpha, float& l_reg, bf16x8& pa0, bf16x8& pa1, bf16x8& pa2, bf16x8& pa3) {
#pragma unroll
  for (int r = 0; r < 16; ++r) p1[r] = __builtin_amdgcn_exp2f(p1[r]);
  float ps = 0;
#pragma unroll
  for (int r = 0; r < 16; ++r) ps += p0[r];
#pragma unroll
  for (int r = 0; r < 16; ++r) ps += p1[r];
  { auto rr = __builtin_amdgcn_permlane32_swap(__float_as_uint(ps), __float_as_uint(ps), false, false);
    ps = __uint_as_float(rr[0]) + __uint_as_float(rr[1]); }
  l_reg = l_reg * alpha + ps;
#define PK4(P, BASE, OUT) do { unsigned a0 = cvt_pk_bf16(P[BASE + 0], P[BASE + 1]), a1 = cvt_pk_bf16(P[BASE + 2], P[BASE + 3]);   \
    unsigned b0 = cvt_pk_bf16(P[BASE + 4], P[BASE + 5]), b1 = cvt_pk_bf16(P[BASE + 6], P[BASE + 7]);                              \
    auto r0 = __builtin_amdgcn_permlane32_swap(a0, b0, false, false); auto r1 = __builtin_amdgcn_permlane32_swap(a1, b1, false, false); \
    u32x4 w = {r0[0], r1[0], r0[1], r1[1]}; OUT = *reinterpret_cast<bf16x8*>(&w); } while (0)
  PK4(p0, 0, pa0); PK4(p0, 8, pa1); PK4(p1, 0, pa2); PK4(p1, 8, pa3);
#undef PK4
}
__device__ __forceinline__ void qkt(f32x16& p0, f32x16& p1, const bf16* Ks, const bf16x8* qr, int r32, int hi) {
  p0 = f32x16{}; p1 = f32x16{};
#pragma unroll
  for (int d0 = 0; d0 < 8; ++d0) { int cb = (d0 * 16 + hi * 8) * 2;
    bf16x8 b0 = *reinterpret_cast<const bf16x8*>((const char*)Ks + KSWZ(r32, cb));
    bf16x8 b1 = *reinterpret_cast<const bf16x8*>((const char*)Ks + KSWZ(32 + r32, cb));
    p0 = __builtin_amdgcn_mfma_f32_32x32x16_bf16(b0, qr[d0], p0, 0, 0, 0);
    p1 = __builtin_amdgcn_mfma_f32_32x32x16_bf16(b1, qr[d0], p1, 0, 0, 0); }
}
__device__ __forceinline__ int v_st(int k, int c) { const int kk = (k & ~0xC) | ((k & 4) << 1) | ((k & 8) >> 1); return ((kk >> 3) * 4 + (c >> 5)) * 512 + ((kk & 7) * 32 + (c & 31)) * 2; }
__device__ __forceinline__ int v_rd_base(int lane) { return ((lane & 3) << 3) | (((lane >> 2) & 3) << 6) | (((lane >> 4) & 1) << 5) | (((lane >> 5) & 1) << 8); }
constexpr int v_rd_off(int d0, int ks, int half) { return d0 * 512 + ks * 4096 + half * 2048; }
template <int OFF> __device__ __forceinline__ s16x4 tr_read(int vb) {
  s16x4 r; asm volatile("ds_read_b64_tr_b16 %0, %1 offset:%2" : "=&v"(r) : "v"(vb), "i"(OFF) : "memory"); return r;
}
template <int D0> __device__ __forceinline__ void pv_one(f32x16& od, int vb, bf16x8 pa0, bf16x8 pa1, bf16x8 pa2, bf16x8 pa3) {
  const s16x4 l0 = tr_read<v_rd_off(D0, 0, 0)>(vb), h0 = tr_read<v_rd_off(D0, 0, 1)>(vb), l1 = tr_read<v_rd_off(D0, 1, 0)>(vb), h1 = tr_read<v_rd_off(D0, 1, 1)>(vb);
  const s16x4 l2 = tr_read<v_rd_off(D0, 2, 0)>(vb), h2 = tr_read<v_rd_off(D0, 2, 1)>(vb), l3 = tr_read<v_rd_off(D0, 3, 0)>(vb), h3 = tr_read<v_rd_off(D0, 3, 1)>(vb);
  asm volatile("s_waitcnt lgkmcnt(0)" ::: "memory"); SBAR();
#define PK(L, H) (bf16x8){L[0], L[1], L[2], L[3], H[0], H[1], H[2], H[3]}
  od = __builtin_amdgcn_mfma_f32_32x32x16_bf16(pa0, PK(l0, h0), od, 0, 0, 0);
  od = __builtin_amdgcn_mfma_f32_32x32x16_bf16(pa1, PK(l1, h1), od, 0, 0, 0);
  od = __builtin_amdgcn_mfma_f32_32x32x16_bf16(pa2, PK(l2, h2), od, 0, 0, 0);
  od = __builtin_amdgcn_mfma_f32_32x32x16_bf16(pa3, PK(l3, h3), od, 0, 0, 0);
#undef PK
}
__device__ __forceinline__ void pv_d0(f32x16* o, int vb, bf16x8 pa0, bf16x8 pa1, bf16x8 pa2, bf16x8 pa3) {
  pv_one<0>(o[0], vb, pa0, pa1, pa2, pa3); pv_one<1>(o[1], vb, pa0, pa1, pa2, pa3); pv_one<2>(o[2], vb, pa0, pa1, pa2, pa3); pv_one<3>(o[3], vb, pa0, pa1, pa2, pa3);
}

template <int MODE, int SD>
__device__ __forceinline__ void attn_unit(const bf16* __restrict__ Qb, const bf16* __restrict__ Kh, const bf16* __restrict__ Vh, bf16* __restrict__ Ob, int NT, int dq0, float sink, char* lds) {
  int tid_ = threadIdx.x; asm volatile("" : "+v"(tid_));
  const int tid = tid_, wid = tid >> 6, lane = tid & 63, r32 = lane & 31, hi = lane >> 5;
  bf16* V_lds = (bf16*)lds; bf16* K_lds = (bf16*)(lds + 2 * SHM_V);
  float* ws = (float*)(lds + 2 * SHM_V + 2 * SHM_K) + wid * 64; float* li_l = ws; float* al_l = ws + 32;
  float m_reg = MODE ? sink * (1.0f / SCALE) : -1e30f, l_reg = MODE ? 1.0f : 0.0f; f32x16 o[4] = {}; bf16x8 qr[8];
  const bf16* Qw = Qb + (long)(wid * QBLK + r32) * LDQ + hi * 8;
#pragma unroll
  for (int d0 = 0; d0 < 8; ++d0) qr[d0] = *reinterpret_cast<const bf16x8*>(Qw + d0 * 16);
  const int sr = tid >> 4, sc = (tid & 15) * 8, vst0 = v_st(sr, sc), vst1 = v_st(32 + sr, sc);
  const int vb0 = (int)(uintptr_t)V_lds + v_rd_base(lane);
  const int mb0 = dq0 + wid * QBLK + r32 + 128 - 4 * hi;
  struct { bf16x8 vs0, vs1, ks0, ks1; } sr_[SD];
#define SLOAD(i, k0) do { sr_[i].vs0 = *reinterpret_cast<const bf16x8*>(&Vh[(long)((k0) + sr) * LDK + sc]); sr_[i].vs1 = *reinterpret_cast<const bf16x8*>(&Vh[(long)((k0) + 32 + sr) * LDK + sc]); \
    sr_[i].ks0 = *reinterpret_cast<const bf16x8*>(&Kh[(long)((k0) + sr) * LDK + sc]); sr_[i].ks1 = *reinterpret_cast<const bf16x8*>(&Kh[(long)((k0) + 32 + sr) * LDK + sc]); } while (0)
#define SWRITE(b, i) do { *(bf16x8*)((char*)V_lds + (b) * SHM_V + vst0) = sr_[i].vs0;          \
    *(bf16x8*)((char*)V_lds + (b) * SHM_V + vst1) = sr_[i].vs1; int kc = sc * 2;               \
    *(bf16x8*)((char*)K_lds + (b) * SHM_K + KSWZ(sr, kc)) = sr_[i].ks0;                       \
    *(bf16x8*)((char*)K_lds + (b) * SHM_K + KSWZ(32 + sr, kc)) = sr_[i].ks1; } while (0)
#define SWAIT() do { if constexpr (SD == 2) asm volatile("s_waitcnt vmcnt(4)" ::: "memory"); else asm volatile("s_waitcnt vmcnt(0)" ::: "memory"); } while (0)
#define RESC(a) do { if (__any((a) < 1.f)) { if (hi == 0) al_l[r32] = (a); asm volatile("s_waitcnt lgkmcnt(0)" ::: "memory"); \
    _Pragma("unroll") for (int d = 0; d < 4; ++d) _Pragma("unroll") for (int r = 0; r < 16; ++r) o[d][r] *= al_l[crow(r, hi)]; } } while (0)
#define PSM(P0, P1, MN, AL, J) partialSM<MODE != 0>(P0, P1, m_reg, MN, AL, mb0 - 64 * (J))
  f32x16 pA0, pA1, pB0, pB1; float mnA, mnB, alA, alB; bf16x8 pa0, pa1, pa2, pa3;
  constexpr int SE = 0, SO = SD - 1;
  SLOAD(SE, 0); asm volatile("s_waitcnt vmcnt(0)" ::: "memory"); SWRITE(0, SE); __syncthreads();
  qkt(pA0, pA1, K_lds, qr, r32, hi); PSM(pA0, pA1, mnA, alA, 0);
  SLOAD(SO, KVBLK); if constexpr (SD == 2) { if (2 < NT) SLOAD(SE, 2 * KVBLK); }
  SWAIT(); SWRITE(1, SO); __syncthreads();
  for (int j = 1; j + 1 < NT; j += 2) {
    SBAR(); qkt(pB0, pB1, (bf16*)((char*)K_lds + SHM_K), qr, r32, hi);
    finishSM(pA0, pA1, alA, l_reg, pa0, pa1, pa2, pa3); SBAR();
    SLOAD(SO, (j + SD) * KVBLK); SBAR();
    pv_d0(o, vb0, pa0, pa1, pa2, pa3); PSM(pB0, pB1, mnB, alB, j);
    __syncthreads(); SWAIT(); SWRITE(0, SE);
    RESC(alB); __syncthreads();
    SBAR(); qkt(pA0, pA1, K_lds, qr, r32, hi);
    finishSM(pB0, pB1, alB, l_reg, pa0, pa1, pa2, pa3); SBAR();
    if (SD == 1 || j + 3 < NT) SLOAD(SE, (j + 1 + SD) * KVBLK); SBAR();
    pv_d0(o, vb0 + (int)SHM_V, pa0, pa1, pa2, pa3); PSM(pA0, pA1, mnA, alA, j + 1);
    __syncthreads(); SWAIT(); SWRITE(1, SO);
    RESC(alA); __syncthreads();
  }
  SBAR(); qkt(pB0, pB1, (bf16*)((char*)K_lds + SHM_K), qr, r32, hi);
  finishSM(pA0, pA1, alA, l_reg, pa0, pa1, pa2, pa3); SBAR();
  pv_d0(o, vb0, pa0, pa1, pa2, pa3); PSM(pB0, pB1, mnB, alB, NT - 1);
  __syncthreads(); RESC(alB);
  finishSM(pB0, pB1, alB, l_reg, pa0, pa1, pa2, pa3); SBAR();
  pv_d0(o, vb0 + (int)SHM_V, pa0, pa1, pa2, pa3);
  if (hi == 0) li_l[r32] = l_reg; asm volatile("s_waitcnt lgkmcnt(0)" ::: "memory");
  float rli[16];
#pragma unroll
  for (int r = 0; r < 16; ++r) rli[r] = __builtin_amdgcn_rcpf(li_l[crow(r, hi)]);
  char* ost = lds + OST_OFF + wid * (32 * OST_PITCH);
#pragma unroll
  for (int r = 0; r < 16; ++r) { const int orow = crow(r, hi);
#pragma unroll
    for (int d0 = 0; d0 < 4; ++d0) { const float v = o[d0][r] * rli[r]; *(bf16*)(ost + orow * OST_PITCH + (d0 * 32 + r32) * 2) = (bf16)(cvt_pk_bf16(v, v) & 0xffffu); } }
  asm volatile("s_waitcnt lgkmcnt(0)" ::: "memory");
  bf16* Ow = Ob + (long)(wid * QBLK) * LDO;
#pragma unroll
  for (int i = 0; i < 8; ++i) { const int row = (lane >> 4) + 4 * i, cc = (lane & 15);
    const u32x4 w = *(const u32x4*)(ost + row * OST_PITCH + cc * 16);
    *(u32x4*)(Ow + (long)row * LDO + cc * 8) = w; }
  __syncthreads();
#undef SLOAD
#undef SWRITE
#undef SWAIT
#undef RESC
#undef PSM
}
}

#define XB_TMO      128
#define XB_XCNT(j)  (256  + 64 * (j))
#define XB_XSUB(j)  (1280 + 64 * (j))
#define XB_XGEN(j)  (2304 + 64 * (j))
#define XB_TOP      3328
#define XB_TOPGEN   3392
#define XCD_BAR_WORDS 3456
#define XB_SPIN_CAP (1u << 20)
__device__ __forceinline__ unsigned xb_ld(unsigned* p)              { return __hip_atomic_load(p, __ATOMIC_RELAXED, __HIP_MEMORY_SCOPE_AGENT); }
__device__ __forceinline__ unsigned xb_add(unsigned* p, unsigned v) { return __hip_atomic_fetch_add(p, v, __ATOMIC_RELAXED, __HIP_MEMORY_SCOPE_AGENT); }
__device__ __forceinline__ unsigned xb_xcc_id() { return (unsigned)__builtin_amdgcn_s_getreg((3 << 11) | 20) & 0xFu; }
#define XB_SPIN(cond, bar) do { unsigned _sp = 0; while (cond) { __builtin_amdgcn_s_sleep(1); \
    if ((++_sp & 255u) == 0u) { if (xb_ld(&(bar)[XB_TMO])) break; if (_sp > XB_SPIN_CAP) { atomicAdd(&(bar)[XB_TMO], 1u); break; } } } } while (0)
struct XcdBarrier { unsigned* bar; unsigned x; volatile LAS unsigned* st; };
__device__ __forceinline__ XcdBarrier xcd_barrier_post(unsigned* bar, volatile LAS unsigned* st) {
    XcdBarrier b; b.bar = bar; b.x = xb_xcc_id(); b.st = st;
    if (threadIdx.x == 0) (void)xb_add(&bar[XB_XCNT(b.x)], 1u);
    return b;
}
__device__ __forceinline__ void xcd_barrier_complete(unsigned* bar, unsigned x, unsigned& nloc, unsigned& nx) {
    const unsigned G = gridDim.x * gridDim.y * gridDim.z;
    unsigned sum, cnt, mine, sp = 0u;
    for (;;) {
        sum = 0u; cnt = 0u; mine = 0u;
#pragma unroll
        for (unsigned j = 0; j < 16; ++j) { const unsigned c = xb_ld(&bar[XB_XCNT(j)]); sum += c; cnt += (c > 0u) ? 1u : 0u; mine = (j == x) ? c : mine; }
        if (sum == G) break;
        __builtin_amdgcn_s_sleep(1);
        if ((++sp & 255u) == 0u) { if (xb_ld(&bar[XB_TMO])) break; if (sp > XB_SPIN_CAP) { atomicAdd(&bar[XB_TMO], 1u); break; } }
    }
    nloc = mine > 0u ? mine : 1u; nx = cnt > 0u ? cnt : 1u;
}
__device__ __forceinline__ void xcd_barrier(const XcdBarrier& b) {
    asm volatile("s_waitcnt vmcnt(0)" ::: "memory");
    __syncthreads();
    if (threadIdx.x == 0) {
        unsigned* bar = b.bar;
        __builtin_amdgcn_s_waitcnt(0);
        unsigned nloc = b.st[0], nx = b.st[1];
        if (nloc == 0u) { xcd_barrier_complete(bar, b.x, nloc, nx); b.st[0] = nloc; b.st[1] = nx; }
        const unsigned old = xb_add(&bar[XB_XSUB(b.x)], 1u);
        const unsigned gen = old / nloc;
        if (old + 1u == (gen + 1u) * nloc) {
            __builtin_amdgcn_fence(__ATOMIC_RELEASE, "agent");
            asm volatile("s_waitcnt vmcnt(0)" ::: "memory");
            const unsigned og = xb_add(&bar[XB_TOP], 1u);
            const unsigned tg = og / nx;
            if (og + 1u == (tg + 1u) * nx) xb_add(&bar[XB_TOPGEN], 1u);
            else XB_SPIN(xb_ld(&bar[XB_TOPGEN]) == tg, bar);
            __builtin_amdgcn_fence(__ATOMIC_ACQUIRE, "agent");
            xb_add(&bar[XB_XGEN(b.x)], 1u);
            asm volatile("s_waitcnt vmcnt(0)" ::: "memory");
        } else {
            XB_SPIN(xb_ld(&bar[XB_XGEN(b.x)]) == gen, bar);
            __builtin_amdgcn_fence(__ATOMIC_ACQUIRE, "agent");
            asm volatile("s_waitcnt vmcnt(0)" ::: "memory");
        }
    }
    __syncthreads();
}

__device__ __forceinline__ void transpose_item(const float* W, int K, int N, bf16* WT, LAS float* scr, int item, int lane) {
    const int nblk = N / 32, kb = item / nblk, nb = item % nblk, k0 = 64 * kb, n0 = 32 * nb;
#pragma unroll 8
    for (int i = 0; i < 32; ++i) { const int kk = 2 * i + (lane >> 5); scr[kk * 33 + (lane & 31)] = W[(size_t)(k0 + kk) * N + n0 + (lane & 31)]; }
    asm volatile("s_waitcnt lgkmcnt(0)" ::: "memory");
    const int c = lane & 7;
#pragma unroll
    for (int j = 0; j < 4; ++j) { const int n = (lane >> 3) + 8 * j; const LAS float* s = scr + (8 * c) * 33 + n;
        u32x4 o; o.x = cvt_pk_bf16(s[0 * 33], s[1 * 33]); o.y = cvt_pk_bf16(s[2 * 33], s[3 * 33]); o.z = cvt_pk_bf16(s[4 * 33], s[5 * 33]); o.w = cvt_pk_bf16(s[6 * 33], s[7 * 33]);
        *(u32x4*)(WT + (size_t)(n0 + n) * K + k0 + 8 * c) = o; }
    asm volatile("s_waitcnt lgkmcnt(0)" ::: "memory");
}

struct Args { const float* in[21]; float* out; unsigned char* ws; int lo, hi; };

__device__ __forceinline__ const float* x_in_row(const float* xp, const float* xs, int row) {
    return row < NPROMPT_TOK ? xp + (size_t)row * DM : xs + (size_t)(row - NPROMPT_TOK) * DM;
}

__device__ __forceinline__ void phase_weights(const CAS Args* a, unsigned char* ws, int l, LAS unsigned char* lds, int gw, int NGW, int wave, int lane) {
    LAS float* scr = (LAS float*)(lds + wave * 16384);
    constexpr int I_IN = (DM / 64) * (INW / 32), I_BR = (MWD / 64) * (DM / 32), I_OUT = (DM / 64) * (DM / 32), I_F1 = (DM / 64) * (FFD / 32), I_F2 = (FFD / 64) * (DM / 32), I_G = 32 * 8;
    constexpr int NITEMS = I_IN + 3 * I_BR + I_OUT + I_F1 + I_F2 + I_G;
    for (int it = gw; it < NITEMS; it += NGW) {
        int r = it;
        if (r < I_IN) { transpose_item(a->in[6] + (size_t)l * DM * INW, DM, INW, (bf16*)(ws + WS_WIN), scr, r, lane); continue; } r -= I_IN;
        if (r < 3 * I_BR) { const int b = r / I_BR; transpose_item(a->in[17] + ((size_t)l * 3 + b) * MWD * DM, MWD, DM, (bf16*)(ws + WS_WBR) + (size_t)b * DM * MWD, scr, r - b * I_BR, lane); continue; } r -= 3 * I_BR;
        if (r < I_OUT) { transpose_item(a->in[18] + (size_t)l * DM * DM, DM, DM, (bf16*)(ws + WS_WOUT), scr, r, lane); continue; } r -= I_OUT;
        if (r < I_F1) { transpose_item(a->in[19] + (size_t)l * DM * FFD, DM, FFD, (bf16*)(ws + WS_W1), scr, r, lane); continue; } r -= I_F1;
        if (r < I_F2) { transpose_item(a->in[20] + (size_t)l * FFD * DM, FFD, DM, (bf16*)(ws + WS_W2), scr, r, lane); continue; } r -= I_F2;
        { const int mi = r >> 3, sub = r & 7;
          const int gate = mi >> 4, dd = (mi >> 3) & 1, blk = mi & 7;
          const float* src = (gate ? a->in[14] : a->in[12]) + (((size_t)l * 2 + dd) * 8 + blk) * 16384;
          transpose_item(src, 128, 128, (bf16*)(ws + WS_WG) + ((size_t)(dd * 2 + gate) * 8 + blk) * 16384, scr, sub, lane); }
    }
}

__device__ __forceinline__ void norm_row_to_bf16(const float* xrow, const float* g, bf16* orow, int lane) {
    const f32x4* xr = (const f32x4*)xrow + lane; const f32x4* gr = (const f32x4*)g + lane;
    f32x4 v[8]; float s = 0.f;
#pragma unroll
    for (int j = 0; j < 8; ++j) { v[j] = xr[64 * j]; s += (v[j].x * v[j].x + v[j].y * v[j].y) + (v[j].z * v[j].z + v[j].w * v[j].w); }
    const float rstd = 1.0f / sqrtf(wave_sum(s, lane) * (1.0f / DM) + EPS);
    u32x2* o8 = (u32x2*)orow + lane;
#pragma unroll
    for (int j = 0; j < 8; ++j) { const f32x4 gg = gr[64 * j]; u32x2 w; w.x = cvt_pk_bf16(v[j].x * rstd * gg.x, v[j].y * rstd * gg.y); w.y = cvt_pk_bf16(v[j].z * rstd * gg.z, v[j].w * rstd * gg.w); o8[64 * j] = w; }
}
template <bool SECOND>
__device__ __forceinline__ void resid_norm_row(const float* yrow, const float* xold, float* xout, const float* g1, const float* g2, bf16* hrow, int lane) {
    const f32x4* yr = (const f32x4*)yrow + lane; const f32x4* xr = (const f32x4*)xold + lane; const f32x4* g1r = (const f32x4*)g1 + lane;
    f32x4 v[8]; float s = 0.f;
#pragma unroll
    for (int j = 0; j < 8; ++j) { v[j] = yr[64 * j]; s += (v[j].x * v[j].x + v[j].y * v[j].y) + (v[j].z * v[j].z + v[j].w * v[j].w); }
    const float rstd = 1.0f / sqrtf(wave_sum(s, lane) * (1.0f / DM) + EPS);
    float s2 = 0.f;
#pragma unroll
    for (int j = 0; j < 8; ++j) { const f32x4 gg = g1r[64 * j]; const f32x4 xo = xr[64 * j]; v[j] = xo + v[j] * rstd * gg; ((f32x4*)xout + lane)[64 * j] = v[j];
        s2 += (v[j].x * v[j].x + v[j].y * v[j].y) + (v[j].z * v[j].z + v[j].w * v[j].w); }
    if constexpr (SECOND) {
        const float rstd2 = 1.0f / sqrtf(wave_sum(s2, lane) * (1.0f / DM) + EPS);
        const f32x4* g2r = (const f32x4*)g2 + lane; u32x2* o8 = (u32x2*)hrow + lane;
#pragma unroll
        for (int j = 0; j < 8; ++j) { const f32x4 gg = g2r[64 * j]; u32x2 w; w.x = cvt_pk_bf16(v[j].x * rstd2 * gg.x, v[j].y * rstd2 * gg.y); w.y = cvt_pk_bf16(v[j].z * rstd2 * gg.z, v[j].w * rstd2 * gg.w); o8[64 * j] = w; }
    }
}

__device__ __forceinline__ void rope_token(bf16* prow, int pos, const float* qn, const float* kn, int lane) {
    const double reva = (double)(lane < 32 ? (pos >> 6) : (pos & 63)) * ROPE_FA[lane & 31];
    const double rev1 = (double)pos * ROPE_F1[lane];
    const float fa = (float)(reva - __builtin_floor(reva)), f1 = (float)(rev1 - __builtin_floor(rev1));
    const float ca = __builtin_amdgcn_cosf(fa), sa = __builtin_amdgcn_sinf(fa), c1 = __builtin_amdgcn_cosf(f1), s1 = __builtin_amdgcn_sinf(f1);
    const float qg1 = qn[lane], qg2 = qn[64 + lane], kg1 = kn[lane], kg2 = kn[64 + lane];
#pragma unroll
    for (int h = 0; h < 10; ++h) {
        bf16* p = prow + (h < 8 ? QA_OFF + h * HD : KA_OFF + (h - 8) * HD);
        const float x1 = bf2f(p[lane]), x2 = bf2f(p[64 + lane]);
        const float rstd = 1.0f / sqrtf(wave_sum(x1 * x1 + x2 * x2, lane) * (1.0f / HD) + EPS);
        const float y1 = x1 * rstd * (h < 8 ? qg1 : kg1), y2 = x2 * rstd * (h < 8 ? qg2 : kg2);
        const float o1 = y1 * ca - y2 * sa, o2 = y2 * ca + y1 * sa;
        p[lane] = (bf16)(cvt_pk_bf16(o1, o1) & 0xffffu); p[64 + lane] = (bf16)(cvt_pk_bf16(o2, o2) & 0xffffu);
    }
#pragma unroll
    for (int h = 0; h < 10; ++h) {
        bf16* p = prow + (h < 8 ? QB_OFF + h * HD : KB_OFF + (h - 8) * HD);
        const float x1 = bf2f(p[lane]), x2 = bf2f(p[64 + lane]);
        const float o1 = x1 * c1 - x2 * s1, o2 = x2 * c1 + x1 * s1;
        p[lane] = (bf16)(cvt_pk_bf16(o1, o1) & 0xffffu); p[64 + lane] = (bf16)(cvt_pk_bf16(o2, o2) & 0xffffu);
    }
}

struct CParams { const float* conv_w; const float* conv_b; const float* gate_r_b; const float* gate_i_b; const float* lam; const bf16* WG; };
template <int PASS>
__device__ __forceinline__ void c_unit(LAS unsigned char* lds, const bf16* P, bf16* OC, const CParams& cp, f32x2* SUM, const float* CAR, int seq, int tc, int nb) {
    constexpr int UP = 136;
    LAS bf16* U = (LAS bf16*)lds;
    LAS float* AD = (LAS float*)(lds + 16384);
    int tid_ = threadIdx.x; asm volatile("" : "+v"(tid_));
    const int tid = tid_, wave = tid >> 6, lane = tid & 63;
    {
        const int t = tid >> 4, c8 = (tid & 15) * 8, cg = nb * 128 + c8, ts = tc * LC + t;
        float u8[8];
        { const f32x4 b0 = *(const f32x4*)(cp.conv_b + cg), b1 = *(const f32x4*)(cp.conv_b + cg + 4); u8[0] = b0.x; u8[1] = b0.y; u8[2] = b0.z; u8[3] = b0.w; u8[4] = b1.x; u8[5] = b1.y; u8[6] = b1.z; u8[7] = b1.w; }
#pragma unroll
        for (int j = 0; j < 4; ++j) { const int tt = ts - 2 + j;
            if (tt >= 0 && tt < SEQ) {
                const u32x4 xw = *(const u32x4*)(P + (size_t)(seq * SEQ + tt) * PWD + XC_OFF + cg);
                const f32x4 w0 = *(const f32x4*)(cp.conv_w + j * MWD + cg), w1 = *(const f32x4*)(cp.conv_w + j * MWD + cg + 4);
                u8[0] += bf_lo(xw.x) * w0.x; u8[1] += bf_hi(xw.x) * w0.y; u8[2] += bf_lo(xw.y) * w0.z; u8[3] += bf_hi(xw.y) * w0.w;
                u8[4] += bf_lo(xw.z) * w1.x; u8[5] += bf_hi(xw.z) * w1.y; u8[6] += bf_lo(xw.w) * w1.z; u8[7] += bf_hi(xw.w) * w1.w; } }
        u32x4 w; w.x = cvt_pk_bf16(u8[0], u8[1]); w.y = cvt_pk_bf16(u8[2], u8[3]); w.z = cvt_pk_bf16(u8[4], u8[5]); w.w = cvt_pk_bf16(u8[6], u8[7]);
        *(LAS u32x4*)(U + t * UP + c8) = w;
    }
    __syncthreads();
    {
        const int dd = wave >> 2, q = wave & 3, r = lane & 31, h = lane >> 5;
        const bf16* wrp = cp.WG + ((size_t)((dd * 2 + 0) * 8 + nb) * 128 + 32 * q + r) * 128 + 8 * h;
        const bf16* wip = cp.WG + ((size_t)((dd * 2 + 1) * 8 + nb) * 128 + 32 * q + r) * 128 + 8 * h;
        f32x16 accr = {}, acci = {};
#pragma unroll
        for (int ks = 0; ks < 8; ++ks) {
            const bf16x8 af = *(const LAS bf16x8*)(U + r * UP + 16 * ks + 8 * h);
            const bf16x8 br = *(const bf16x8*)(wrp + 16 * ks), bi = *(const bf16x8*)(wip + 16 * ks);
            accr = __builtin_amdgcn_mfma_f32_32x32x16_bf16(af, br, accr, 0, 0, 0);
            acci = __builtin_amdgcn_mfma_f32_32x32x16_bf16(af, bi, acci, 0, 0, 0);
        }
        const int ch = 32 * q + r, cg = nb * 128 + ch;
        const float rb = cp.gate_r_b[dd * MWD + cg], ib = cp.gate_i_b[dd * MWD + cg], lam = cp.lam[dd * MWD + cg];
        const float el = __builtin_amdgcn_exp2f(-1.4426950408889634f * lam);
        const float ls8 = -8.0f * (lam > 3.0f ? el * (1.0f - el * (0.5f - el * (1.0f / 3.0f))) : 0.6931471805599453f * __builtin_amdgcn_logf(1.0f + el));
        LAS float* pa = AD + (dd * 2 + 0) * (32 * 128) + ch; LAS float* pd = AD + (dd * 2 + 1) * (32 * 128) + ch;
#pragma unroll
        for (int reg = 0; reg < 16; ++reg) {
            const int tt = (reg & 3) + 8 * (reg >> 2) + 4 * h;
            const float rr = fast_sigmoid(accr[reg] + rb), ii = fast_sigmoid(acci[reg] + ib);
            const float la = ls8 * rr;
            const float av = __builtin_amdgcn_exp2f(1.4426950408889634f * la);
            const float x2 = 2.0f * la;
            const float om = fabsf(x2) < 0.25f ? -x2 * (1.0f + x2 * (0.5f + x2 * ((1.0f / 6.0f) + x2 * ((1.0f / 24.0f) + x2 * ((1.0f / 120.0f) + x2 * (1.0f / 720.0f)))))) : 1.0f - av * av;
            const float uf = bf2f(U[tt * UP + ch]);
            pa[tt * 128] = av; pd[tt * 128] = sqrtf(om) * (ii * uf);
        }
    }
    __syncthreads();
    if (tid < 256) {
        const int dd = tid >> 7, ch = tid & 127, cg = nb * 128 + ch;
        LAS float* pa = AD + (dd * 2 + 0) * (32 * 128) + ch; LAS float* pd = AD + (dd * 2 + 1) * (32 * 128) + ch;
        const size_t si = ((size_t)(seq * NTCH + tc) * 2 + dd) * MWD + cg;
        if constexpr (PASS == 1) {
            float hh = 0.f, pp = 1.f;
#pragma unroll 8
            for (int s = 0; s < LC; ++s) { const int t = dd ? LC - 1 - s : s; const float av = pa[t * 128], dv = pd[t * 128]; hh = av * hh + dv; pp *= av; }
            SUM[si] = (f32x2){pp, hh};
        } else {
            float hh = CAR[si];
#pragma unroll 8
            for (int s = 0; s < LC; ++s) { const int t = dd ? LC - 1 - s : s; const float av = pa[t * 128], dv = pd[t * 128]; hh = av * hh + dv; pa[t * 128] = hh; }
        }
    }
    if constexpr (PASS == 3) {
        __syncthreads();
        const int t = tid >> 4, c8 = (tid & 15) * 8, cg = nb * 128 + c8; const size_t row = (size_t)(seq * SEQ + tc * LC + t);
        const u32x4 yw = *(const u32x4*)(P + row * PWD + YC_OFF + cg);
        const float y[8] = {bf_lo(yw.x), bf_hi(yw.x), bf_lo(yw.y), bf_hi(yw.y), bf_lo(yw.z), bf_hi(yw.z), bf_lo(yw.w), bf_hi(yw.w)};
        const LAS float* hf = AD + t * 128 + c8; const LAS float* hb = AD + 2 * (32 * 128) + t * 128 + c8;
        float o[8];
#pragma unroll
        for (int j = 0; j < 8; ++j) { const float z = 0.7978845608028654f * (y[j] + 0.044715f * y[j] * y[j] * y[j]);
            const float ge = y[j] * fast_sigmoid(2.0f * z);
            o[j] = (hf[j] + hb[j]) * ge; }
        u32x4 w; w.x = cvt_pk_bf16(o[0], o[1]); w.y = cvt_pk_bf16(o[2], o[3]); w.z = cvt_pk_bf16(o[4], o[5]); w.w = cvt_pk_bf16(o[6], o[7]);
        *(u32x4*)(OC + row * MWD + cg) = w;
    }
    __syncthreads();
}

__device__ __forceinline__ void phase_c2(LAS unsigned char* lds, const f32x2* SUM, float* CAR, int G, int bx) {
    int tid_ = threadIdx.x; asm volatile("" : "+v"(tid_));
    const int tid = tid_, seg = tid >> 6, lane = tid & 63;
    LAS f32x2* SEG = (LAS f32x2*)lds;
    for (int lgi = bx; lgi < 64; lgi += G) {
        const int seq = lgi >> 5, dd = (lgi >> 4) & 1, cg = (lgi & 15) * 64 + lane;
        const long step = dd ? -(long)(2 * MWD) : (long)(2 * MWD);
        const int tc0 = dd ? NTCH - 1 - seg * 32 : seg * 32;
        const f32x2* sp = SUM + ((size_t)(seq * NTCH + tc0) * 2 + dd) * MWD + cg;
        float* cp = CAR + ((size_t)(seq * NTCH + tc0) * 2 + dd) * MWD + cg;
        float pp = 1.f, hh = 0.f;
#pragma unroll 8
        for (int k = 0; k < 32; ++k) { const f32x2 s = sp[k * step]; hh = s.x * hh + s.y; pp *= s.x; }
        SEG[seg * 64 + lane] = (f32x2){pp, hh};
        __syncthreads();
        float carry = 0.f;
        for (int sg = 0; sg < seg; ++sg) { const f32x2 v = SEG[sg * 64 + lane]; carry = v.x * carry + v.y; }
#pragma unroll 8
        for (int k = 0; k < 32; ++k) { const f32x2 s = sp[k * step]; cp[k * step] = carry; carry = s.x * carry + s.y; }
        __syncthreads();
    }
}

__global__ void __launch_bounds__(512, 2) mk_fwd(Args args) {
    extern __shared__ __attribute__((aligned(16))) unsigned char lds_raw[];
    LAS unsigned char* lds = (LAS unsigned char*)lds_raw;
    {
        volatile LAS unsigned* MISC = (volatile LAS unsigned*)(lds + MISC_OFF);
        for (int u = threadIdx.x; u < (LDS_BYTES - MISC_OFF) / 4; u += 512) MISC[u] = 0u;
        __syncthreads();
    }
#if MK_SINGLE
    XcdBarrier bar = xcd_barrier_post((unsigned*)(args.ws + WS_CTL) + CW_BAR, (volatile LAS unsigned*)(lds + MISC_OFF) + 8);
#define GRID_BAR() xcd_barrier(bar)
#else
#define GRID_BAR() do {} while (0)
#endif
    const int lo = args.lo, hi = args.hi;
    int step = 0;
#define RUN(k) (lo <= (k) && (k) < hi)
#define SEAM(k) do { if (RUN((k) + 1)) GRID_BAR(); } while (0)
#define PHASE_ENTER() int tid = threadIdx.x; asm volatile("" : "+v"(tid)); int bx = blockIdx.x; asm volatile("" : "+s"(bx)); int G = gridDim.x; asm volatile("" : "+s"(G)); const int NGW = G * 8; (void)NGW; \
    const int lane = tid & 63, wave = __builtin_amdgcn_readfirstlane(tid >> 6), gw = bx * 8 + wave; \
    const CAS Args* ap = (const CAS Args*)__builtin_amdgcn_kernarg_segment_ptr(); asm volatile("" : "+s"(ap)); \
    unsigned char* ws = ap->ws; float* out = ap->out; (void)lane; (void)gw; (void)out; \
    bf16* const H = (bf16*)(ws + WS_H); bf16* const P = (bf16*)(ws + WS_P); float* const Y = (float*)(ws + WS_P); bf16* const GT = (bf16*)(ws + WS_G); bf16* const O = (bf16*)(ws + WS_O); bf16* const HID = (bf16*)(ws + WS_G); \
    (void)H; (void)P; (void)Y; (void)GT; (void)O; (void)HID

    for (int l = 0; l < DEPTH; ++l) {
        { const int k = step++; if (RUN(k) && ((PH_MASK >> 0) & 1)) { PHASE_ENTER(); phase_weights(ap, ws, l, lds, gw, NGW, wave, lane); SEAM(k); } }
        for (int c = 0; c < NCHUNK; ++c) {
            const int row0 = c * TC;
            { const int k = step++; if (RUN(k) && ((PH_MASK >> 1) & 1)) { PHASE_ENTER();
                const float* g = ap->in[2] + (size_t)l * DM;
                for (int m = gw; m < TC; m += NGW) { const int row = row0 + m; const float* xr = (l == 0) ? x_in_row(ap->in[0], ap->in[1], row) : out + (size_t)row * DM; norm_row_to_bf16(xr, g, H + (size_t)m * DM, lane); }
                SEAM(k); } }
            { const int k = step++; if (RUN(k) && ((PH_MASK >> 2) & 1)) { PHASE_ENTER();
                pg8::Gemm g{H, (bf16*)(ws + WS_WIN), DM}; pg8::StaticOrder S; S.init(TC, INW, G, bx); pg8::EpiIn E{P, GT};
                pg8::gemm_phase<pg8::EpiIn, pg8::StaticOrder>(lds, g, S, E);
                SEAM(k); } }
            { const int k = step++; if (RUN(k) && ((PH_MASK >> 3) & 1)) { PHASE_ENTER();
                const float* qn = ap->in[7] + (size_t)l * HD; const float* kn = ap->in[8] + (size_t)l * HD;
                for (int m = gw; m < TC; m += NGW) rope_token(P + (size_t)m * PWD, m & (SEQ - 1), qn, kn, lane);
                CParams cp{ap->in[10] + (size_t)l * 4 * MWD, ap->in[11] + (size_t)l * MWD, ap->in[13] + (size_t)l * 2 * MWD, ap->in[15] + (size_t)l * 2 * MWD, ap->in[16] + (size_t)l * 2 * MWD, (bf16*)(ws + WS_WG)};
                for (int u = bx; u < 2 * NTCH * 8; u += G) { const int nb = u & 7, tc = (u >> 3) & (NTCH - 1), seq = u >> 11; c_unit<1>(lds, P, nullptr, cp, (f32x2*)(ws + WS_SUM), (float*)(ws + WS_CAR), seq, tc, nb); }
                SEAM(k); } }
            { const int k = step++; if (RUN(k) && ((PH_MASK >> 4) & 1)) { PHASE_ENTER(); phase_c2(lds, (f32x2*)(ws + WS_SUM), (float*)(ws + WS_CAR), G, bx); SEAM(k); } }
            { const int k = step++; if (RUN(k) && ((PH_MASK >> 5) & 1)) {
                if (SUBMASK & 1) { PHASE_ENTER(); const int xcd = bx & 7, rank = bx >> 3, nrank = G >> 3; for (int i = rank; i < 64; i += nrank) {
                    const int seq = xcd >> 2, kvh = (xcd >> 1) & 1, head = kvh * 4 + (xcd & 1) * 2 + (i >> 5), qb = i & 31;
                    const bf16* Qb = P + (size_t)(seq * SEQ + qb * 256) * PWD + QA_OFF + head * HD;
                    const bf16* Kh = P + (size_t)(seq * SEQ) * PWD + KA_OFF + kvh * HD; const bf16* Vh = P + (size_t)(seq * SEQ) * PWD + VA_OFF + kvh * HD;
                    att::attn_unit<0, SD_A>(Qb, Kh, Vh, O + (size_t)(seq * SEQ + qb * 256) * MWD + head * HD, SEQ / 64, 0, 0.f, (char*)lds_raw);
                } }
                if (SUBMASK & 2) { PHASE_ENTER(); const int xcd = bx & 7, rank = bx >> 3, nrank = G >> 3; for (int i = rank; i < 64; i += nrank) {
                    const int seq = xcd >> 2, kvh = (xcd >> 1) & 1, head = kvh * 4 + (xcd & 1) * 2 + (i >> 5), qb = i & 31;
                    const int k0 = (qb == 0) ? 0 : qb * 256 - 128, k1 = (qb == 31) ? SEQ : qb * 256 + 384;
                    const bf16* Qb = P + (size_t)(seq * SEQ + qb * 256) * PWD + QB_OFF + head * HD;
                    const bf16* Kh = P + (size_t)(seq * SEQ + k0) * PWD + KB_OFF + kvh * HD; const bf16* Vh = P + (size_t)(seq * SEQ + k0) * PWD + VB_OFF + kvh * HD;
                    att::attn_unit<1, SD_B>(Qb, Kh, Vh, O + (size_t)TC * MWD + (size_t)(seq * SEQ + qb * 256) * MWD + head * HD, (k1 - k0) / 64, qb * 256 - k0, ap->in[9][l * 8 + head], (char*)lds_raw);
                } }
                if (SUBMASK & 4) { PHASE_ENTER();
                CParams cp{ap->in[10] + (size_t)l * 4 * MWD, ap->in[11] + (size_t)l * MWD, ap->in[13] + (size_t)l * 2 * MWD, ap->in[15] + (size_t)l * 2 * MWD, ap->in[16] + (size_t)l * 2 * MWD, (bf16*)(ws + WS_WG)};
                for (int u = bx; u < 2 * NTCH * 8; u += G) { const int nb = u & 7, tc = (u >> 3) & (NTCH - 1), seq = u >> 11; c_unit<3>(lds, P, O + (size_t)2 * TC * MWD, cp, (f32x2*)(ws + WS_SUM), (float*)(ws + WS_CAR), seq, tc, nb); } }
                SEAM(k); } }
            { const int k = step++; if (RUN(k) && ((PH_MASK >> 6) & 1)) { PHASE_ENTER();
                pg8::Gemm g{O, (bf16*)(ws + WS_WBR), MWD}; pg8::BranchOrder S; S.base.init(TC, DM, G, bx); S.npanel = TC / 256;
                pg8::EpiBr E{GT, H, (float*)(ws + WS_BRS) + (size_t)bx * 65536};
                pg8::gemm_phase<pg8::EpiBr, pg8::BranchOrder>(lds, g, S, E);
                SEAM(k); } }
            { const int k = step++; if (RUN(k) && ((PH_MASK >> 7) & 1)) { PHASE_ENTER();
                pg8::Gemm g{H, (bf16*)(ws + WS_WOUT), DM}; pg8::StaticOrder S; S.init(TC, DM, G, bx); pg8::EpiF32 E{Y, DM};
                pg8::gemm_phase<pg8::EpiF32, pg8::StaticOrder>(lds, g, S, E);
                SEAM(k); } }
            { const int k = step++; if (RUN(k) && ((PH_MASK >> 8) & 1)) { PHASE_ENTER();
                const float* g1 = ap->in[3] + (size_t)l * DM; const float* g2 = ap->in[4] + (size_t)l * DM;
                for (int m = gw; m < TC; m += NGW) { const int row = row0 + m; const float* xo = (l == 0) ? x_in_row(ap->in[0], ap->in[1], row) : out + (size_t)row * DM;
                    resid_norm_row<true>(Y + (size_t)m * DM, xo, out + (size_t)row * DM, g1, g2, H + (size_t)m * DM, lane); }
                SEAM(k); } }
            { const int k = step++; if (RUN(k) && ((PH_MASK >> 9) & 1)) { PHASE_ENTER();
                pg8::Gemm g{H, (bf16*)(ws + WS_W1), DM}; pg8::StaticOrder S; S.init(TC, FFD, G, bx); pg8::EpiRelu2 E{HID, FFD};
                pg8::gemm_phase<pg8::EpiRelu2, pg8::StaticOrder>(lds, g, S, E);
                SEAM(k); } }
            { const int k = step++; if (RUN(k) && ((PH_MASK >> 10) & 1)) { PHASE_ENTER();
                pg8::Gemm g{HID, (bf16*)(ws + WS_W2), FFD}; pg8::StaticOrder S; S.init(TC, DM, G, bx); pg8::EpiF32 E{Y, DM};
                pg8::gemm_phase<pg8::EpiF32, pg8::StaticOrder>(lds, g, S, E);
                SEAM(k); } }
            { const int k = step++; if (RUN(k) && ((PH_MASK >> 11) & 1)) { PHASE_ENTER();
                const float* g1 = ap->in[5] + (size_t)l * DM;
                for (int m = gw; m < TC; m += NGW) { const int row = row0 + m; resid_norm_row<false>(Y + (size_t)m * DM, out + (size_t)row * DM, out + (size_t)row * DM, g1, nullptr, nullptr, lane); }
                SEAM(k); } }
        }
    }
#undef RUN
#undef SEAM
}
constexpr int NSTEPS = DEPTH * (1 + NCHUNK * 11);

extern "C" void kernel_launch(void* const* d_in, const int* in_sizes, int n_in, void* d_out, int out_size, void* d_ws, size_t ws_size, hipStream_t stream) {
    static int grid = 0;
    if (grid == 0) {
        if (n_in != 21 || out_size != NTOK * DM || ws_size < WS_END) { fprintf(stderr, "kernel_launch: unexpected shapes (n_in %d out %d ws %zu)\n", n_in, out_size, ws_size); grid = -1; return; }
        int dev = 0, cus = 0, per_cu = 0;
        if (hipGetDevice(&dev) != hipSuccess || hipDeviceGetAttribute(&cus, hipDeviceAttributeMultiprocessorCount, dev) != hipSuccess) { grid = -1; return; }
        if (hipFuncSetAttribute((const void*)mk_fwd, hipFuncAttributeMaxDynamicSharedMemorySize, LDS_BYTES) != hipSuccess) { fprintf(stderr, "kernel_launch: hipFuncSetAttribute failed\n"); grid = -1; return; }
        if (hipOccupancyMaxActiveBlocksPerMultiprocessor(&per_cu, (const void*)mk_fwd, 512, LDS_BYTES) != hipSuccess || per_cu < 1) { fprintf(stderr, "kernel_launch: occupancy query says %d\n", per_cu); }
        (void)hipGetLastError();
        grid = cus;
    }
    if (grid < 0) return;
    if (hipMemsetAsync((char*)d_ws + WS_CTL, 0, CTL_ZERO_BYTES, stream) != hipSuccess) return;
    Args a{};
    for (int i = 0; i < 21; ++i) a.in[i] = (const float*)d_in[i];
    a.out = (float*)d_out; a.ws = (unsigned char*)d_ws;
#if MK_SINGLE
    a.lo = 0; a.hi = NSTEPS;
    hipLaunchKernelGGL(mk_fwd, dim3(grid), dim3(512), LDS_BYTES, stream, a);
#else
    for (int s = 0; s < NSTEPS; ++s) { a.lo = s; a.hi = s + 1; hipLaunchKernelGGL(mk_fwd, dim3(grid), dim3(512), LDS_BYTES, stream, a); }
#endif
    const hipError_t le = hipPeekAtLastError();
    if (le != hipSuccess) fprintf(stderr, "kernel_launch: launch failed: %s\n", hipGetErrorName(le));
}
```

```cpp
#include <hip/hip_runtime.h>
#include <cstdio>
#include <cstdint>

#ifndef PH_MASK
#define PH_MASK 0xFFF
#endif
#ifndef SUBMASK
#define SUBMASK 7
#endif
#ifndef SD_A
#define SD_A 2
#endif
#ifndef SD_B
#define SD_B 1
#endif
#ifndef MK_SINGLE
#define MK_SINGLE 1
#endif

#define LAS __attribute__((address_space(3)))
#define GAS __attribute__((address_space(1)))
#define CAS __attribute__((address_space(4)))
typedef unsigned short bf16;
typedef short bf16x8 __attribute__((ext_vector_type(8)));
typedef short s16x4 __attribute__((ext_vector_type(4)));
typedef float f32x4 __attribute__((ext_vector_type(4)));
typedef float f32x2 __attribute__((ext_vector_type(2)));
typedef float f32x16 __attribute__((ext_vector_type(16)));
typedef unsigned u32x4 __attribute__((ext_vector_type(4)));
typedef unsigned u32x2 __attribute__((ext_vector_type(2)));

constexpr int DM = 2048, SEQ = 8192, NTOK = 49152, TC = 16384, NCHUNK = 3, DEPTH = 4;
constexpr int INW = 11264, PWD = 5120, GWD = 6144, FFD = 8192, MWD = 1024, HD = 128;
constexpr int QA_OFF = 0, KA_OFF = 1024, VA_OFF = 1280, QB_OFF = 1536, KB_OFF = 2560, VB_OFF = 2816, XC_OFF = 3072, YC_OFF = 4096;
constexpr int NPROMPT_TOK = 32768;
constexpr float EPS = 1e-6f;
constexpr int LC = 32, NTCH = SEQ / LC;

constexpr size_t MiB = 1u << 20;
constexpr size_t WS_CTL = 0, CTL_ZERO_BYTES = 1 * MiB;
constexpr size_t WS_WIN = 2 * MiB;
constexpr size_t WS_WBR = 46 * MiB;
constexpr size_t WS_WOUT = 58 * MiB;
constexpr size_t WS_W1 = 66 * MiB;
constexpr size_t WS_W2 = 98 * MiB;
constexpr size_t WS_WG = 130 * MiB;
constexpr size_t WS_SUM = 131 * MiB;
constexpr size_t WS_CAR = 139 * MiB;
constexpr size_t WS_BRS = 143 * MiB;
constexpr size_t WS_H = 207 * MiB;
constexpr size_t WS_P = 271 * MiB;
constexpr size_t WS_G = 431 * MiB;
constexpr size_t WS_O = 623 * MiB;
constexpr size_t WS_END = 719 * MiB;
constexpr int CW_BAR = 4096;

constexpr int LDS_BYTES = 147456;
constexpr int MISC_OFF = 143360;

__device__ __forceinline__ unsigned cvt_pk_bf16(float lo, float hi) { unsigned r; asm volatile("v_cvt_pk_bf16_f32 %0, %1, %2" : "=v"(r) : "v"(lo), "v"(hi)); return r; }
__device__ __forceinline__ float bf_lo(unsigned w) { return __uint_as_float(w << 16); }
__device__ __forceinline__ float bf_hi(unsigned w) { return __uint_as_float(w & 0xffff0000u); }
__device__ __forceinline__ float bf2f(bf16 b) { return __uint_as_float(((unsigned)b) << 16); }
__device__ __forceinline__ float fast_sigmoid(float v) { return __builtin_amdgcn_rcpf(1.0f + __builtin_amdgcn_exp2f(-1.4426950408889634f * v)); }
__device__ __forceinline__ float wave_sum(float v, int lane) {
#pragma unroll
    for (int o = 1; o < 64; o <<= 1) v += __int_as_float(__builtin_amdgcn_ds_bpermute((lane ^ o) << 2, __float_as_int(v)));
    return v;
}

__device__ const double ROPE_F1[64] = {
1.59154943091895346e-01, 1.37822502603982849e-01, 1.19349370211248862e-01, 1.03352296618434064e-01, 8.94994016088910133e-02, 7.75032887553740585e-02, 6.71150830052272551e-02, 5.81192674418762462e-02,
5.03292121044697269e-02, 4.35833029420947638e-02, 3.77415888468699103e-02, 3.26828760272190911e-02, 2.83022152813622411e-02, 2.45087241866802648e-02, 2.12237020815031856e-02, 1.83789966569160986e-02,
1.59154943091895339e-02, 1.37822502603982842e-02, 1.19349370211248869e-02, 1.03352296618434060e-02, 8.94994016088910202e-03, 7.75032887553740654e-03, 6.71150830052272551e-03, 5.81192674418762427e-03,
5.03292121044697286e-03, 4.35833029420947656e-03, 3.77415888468699086e-03, 3.26828760272190893e-03, 2.83022152813622403e-03, 2.45087241866802661e-03, 2.12237020815031847e-03, 1.83789966569160995e-03,
1.59154943091895335e-03, 1.37822502603982846e-03, 1.19349370211248865e-03, 1.03352296618434069e-03, 8.94994016088910115e-04, 7.75032887553740654e-04, 6.71150830052272508e-04, 5.81192674418762427e-04,
5.03292121044697243e-04, 4.35833029420947678e-04, 3.77415888468699086e-04, 3.26828760272190871e-04, 2.83022152813622381e-04, 2.45087241866802661e-04, 2.12237020815031847e-04, 1.83789966569160984e-04,
1.59154943091895346e-04, 1.37822502603982835e-04, 1.19349370211248871e-04, 1.03352296618434063e-04, 8.94994016088910088e-05, 7.75032887553740654e-05, 6.71150830052272508e-05, 5.81192674418762400e-05,
5.03292121044697243e-05, 4.35833029420947644e-05, 3.77415888468699120e-05, 3.26828760272190871e-05, 2.83022152813622381e-05, 2.45087241866802641e-05, 2.12237020815031861e-05, 1.83789966569160984e-05 };
__device__ const double ROPE_FA[32] = {
1.59154943091895346e-01, 1.19349370211248862e-01, 8.94994016088910133e-02, 6.71150830052272551e-02, 5.03292121044697269e-02, 3.77415888468699103e-02, 2.83022152813622411e-02, 2.12237020815031856e-02,
1.59154943091895339e-02, 1.19349370211248869e-02, 8.94994016088910202e-03, 6.71150830052272551e-03, 5.03292121044697286e-03, 3.77415888468699086e-03, 2.83022152813622403e-03, 2.12237020815031847e-03,
1.59154943091895335e-03, 1.19349370211248865e-03, 8.94994016088910115e-04, 6.71150830052272508e-04, 5.03292121044697243e-04, 3.77415888468699086e-04, 2.83022152813622381e-04, 2.12237020815031847e-04,
1.59154943091895346e-04, 1.19349370211248871e-04, 8.94994016088910088e-05, 6.71150830052272508e-05, 5.03292121044697243e-05, 3.77415888468699120e-05, 2.83022152813622381e-05, 2.12237020815031861e-05 };

namespace pg8 {
typedef unsigned short bf16_t;
constexpr int BM = 256, BK = 64, HALF = 128, HTB = HALF * BK * 2, STAGE_BYTES = 8 * HTB, NXCD = 8, WGM = 8;
__host__ __device__ __forceinline__ int lds_byte(int r, int c) { const int st = (r >> 4) * 2 + (c >> 5), rr = r & 15, cc = c & 31, ob = rr * 64 + cc * 2; return st * 1024 + (ob ^ (((ob >> 9) & 1) << 5)); }
__host__ __device__ __forceinline__ void stage_rc(int b, int& R, int& C) { const int st = b / 1024, sb = b % 1024, swz = sb ^ (((sb >> 9) & 1) << 5); R = (st >> 1) * 16 + swz / 64; C = (st & 1) * 32 + (swz % 64) / 2; }
__host__ __device__ __forceinline__ int perm32(int rho) { const int n = rho >> 4, i = rho & 15; return 8 * (i >> 2) + 4 * n + (i & 3); }

struct Unit { int pm, pn, ka, kb, sub; };
struct Gemm { const bf16_t* A; const bf16_t* Bt; int K; };

struct StaticOrder {
    int nM, nN, nwg, G, c;
    __device__ void init(int M, int N, int G_, int c_) { nM = M / BM; nN = N / BM; nwg = nM * nN; G = G_; c = c_; }
    __device__ bool next(int i, Unit& u) const {
        const long L = (long)i * G + c; if (L >= nwg) return false;
        int wgid = (int)L; { const int q = nwg / NXCD, r = nwg % NXCD, xcd = wgid % NXCD, off = wgid / NXCD; wgid = (xcd < r ? xcd * (q + 1) : r * (q + 1) + (xcd - r) * q) + off; }
        const int nig = WGM * nN, gid = wgid / nig, fm = gid * WGM, gsz = (nM - fm) < WGM ? (nM - fm) : WGM;
        u.pm = fm + ((wgid % nig) % gsz); u.pn = (wgid % nig) / gsz; u.ka = u.pm; u.kb = u.pn; u.sub = 0; return true;
    }
};
struct BranchOrder {
    StaticOrder base; int npanel;
    __device__ bool next(int i, Unit& u) const {
        const int t = i / 3, s = i - 3 * t; if (!base.next(t, u)) return false;
        u.sub = s; u.ka = s * npanel + u.pm; u.kb = s * 8 + u.pn; return true;
    }
};

struct EpiIn {
    static constexpr bool PERM = true;
    bf16_t* P; bf16_t* G;
    __device__ __forceinline__ void operator()(const f32x4 (&acc)[2][2][4][2], const Unit& u, int wr, int wc, int fr_, int fq) const {
        int fr = fr_; asm volatile("" : "+v"(fr));
        const int row0 = u.pm * BM + wr * 64 + fr; const bool gate = u.pn >= 20;
        bf16_t* base = gate ? G : P; const int ldc = gate ? GWD : PWD; const int col0 = (gate ? u.pn - 20 : u.pn) * BM + wc * 32 + 8 * fq;
#pragma unroll
        for (int ai = 0; ai < 2; ++ai)
#pragma unroll
            for (int m = 0; m < 4; ++m) { bf16_t* rowp = base + (size_t)(row0 + ai * HALF + m * 16) * ldc + col0;
#pragma unroll
                for (int bj = 0; bj < 2; ++bj) { f32x4 v0 = acc[ai][bj][m][0], v1 = acc[ai][bj][m][1];
                    if (gate) {
#pragma unroll
                        for (int j = 0; j < 4; ++j) { v0[j] = fast_sigmoid(v0[j]); v1[j] = fast_sigmoid(v1[j]); } }
                    u32x4 w; w.x = cvt_pk_bf16(v0[0], v0[1]); w.y = cvt_pk_bf16(v0[2], v0[3]); w.z = cvt_pk_bf16(v1[0], v1[1]); w.w = cvt_pk_bf16(v1[2], v1[3]);
                    *(u32x4*)(rowp + bj * HALF) = w; } }
    }
};
struct EpiBr {
    static constexpr bool PERM = true;
    const bf16_t* G; bf16_t* OUT; float* scratch;
    __device__ __forceinline__ void operator()(const f32x4 (&acc)[2][2][4][2], const Unit& u, int wr, int wc, int fr_, int fq) const {
        int fr = fr_; asm volatile("" : "+v"(fr));
        const int row0 = u.pm * BM + wr * 64 + fr, col0 = u.pn * BM + wc * 32 + 8 * fq; const int sub = u.sub;
        GAS f32x4* sp = (GAS f32x4*)scratch + ((wr * 4 + wc) * 64 + fq * 16 + fr);
#pragma unroll
        for (int ai = 0; ai < 2; ++ai)
#pragma unroll
            for (int m = 0; m < 4; ++m) { const size_t row = (size_t)(row0 + ai * HALF + m * 16);
#pragma unroll
                for (int bj = 0; bj < 2; ++bj) { const int idx = (((ai * 4 + m) * 2 + bj) * 2) * 512;
                    const u32x4 gw = *(const u32x4*)(G + row * GWD + sub * DM + col0 + bj * HALF);
                    f32x4 v0 = acc[ai][bj][m][0] * (f32x4){bf_lo(gw.x), bf_hi(gw.x), bf_lo(gw.y), bf_hi(gw.y)};
                    f32x4 v1 = acc[ai][bj][m][1] * (f32x4){bf_lo(gw.z), bf_hi(gw.z), bf_lo(gw.w), bf_hi(gw.w)};
                    if (sub > 0) { v0 += sp[idx]; v1 += sp[idx + 512]; }
                    if (sub < 2) { sp[idx] = v0; sp[idx + 512] = v1; }
                    else { u32x4 w; w.x = cvt_pk_bf16(v0[0], v0[1]); w.y = cvt_pk_bf16(v0[2], v0[3]); w.z = cvt_pk_bf16(v1[0], v1[1]); w.w = cvt_pk_bf16(v1[2], v1[3]);
                        *(u32x4*)(OUT + row * DM + col0 + bj * HALF) = w; } }
                asm volatile("" ::: "memory"); }
    }
};
struct EpiF32 {
    static constexpr bool PERM = false;
    float* C; int ldc;
    __device__ __forceinline__ void operator()(const f32x4 (&acc)[2][2][4][2], const Unit& u, int wr, int wc, int fr_, int fq) const {
        int fr = fr_; asm volatile("" : "+v"(fr));
        const int row0 = u.pm * BM + wr * 64 + fr, col0 = u.pn * BM + wc * 32 + 4 * fq;
#pragma unroll
        for (int ai = 0; ai < 2; ++ai)
#pragma unroll
            for (int m = 0; m < 4; ++m) { float* rowp = C + (size_t)(row0 + ai * HALF + m * 16) * ldc + col0;
#pragma unroll
                for (int bj = 0; bj < 2; ++bj)
#pragma unroll
                    for (int n = 0; n < 2; ++n) *(f32x4*)(rowp + bj * HALF + n * 16) = acc[ai][bj][m][n]; }
    }
};
struct EpiRelu2 {
    static constexpr bool PERM = true;
    bf16_t* O; int ldc;
    __device__ __forceinline__ void operator()(const f32x4 (&acc)[2][2][4][2], const Unit& u, int wr, int wc, int fr_, int fq) const {
        int fr = fr_; asm volatile("" : "+v"(fr));
        const int row0 = u.pm * BM + wr * 64 + fr, col0 = u.pn * BM + wc * 32 + 8 * fq;
#pragma unroll
        for (int ai = 0; ai < 2; ++ai)
#pragma unroll
            for (int m = 0; m < 4; ++m) { bf16_t* rowp = O + (size_t)(row0 + ai * HALF + m * 16) * ldc + col0;
#pragma unroll
                for (int bj = 0; bj < 2; ++bj) { f32x4 v0 = acc[ai][bj][m][0], v1 = acc[ai][bj][m][1];
#pragma unroll
                    for (int j = 0; j < 4; ++j) { const float a = fmaxf(v0[j], 0.f), b = fmaxf(v1[j], 0.f); v0[j] = a * a; v1[j] = b * b; }
                    u32x4 w; w.x = cvt_pk_bf16(v0[0], v0[1]); w.y = cvt_pk_bf16(v0[2], v0[3]); w.z = cvt_pk_bf16(v1[0], v1[1]); w.w = cvt_pk_bf16(v1[2], v1[3]);
                    *(u32x4*)(rowp + bj * HALF) = w; } }
    }
};

template <class Epi, class Sched, bool ALIGN_EPI = true>
__device__ __forceinline__ void gemm_phase(LAS unsigned char* lds, const Gemm g, const Sched& S, const Epi& E) {
    int tid_ = threadIdx.x; asm volatile("" : "+v"(tid_));
    const int tid = tid_, wid = __builtin_amdgcn_readfirstlane(tid >> 6), lane = tid & 63, wr = wid >> 2, wc = wid & 3, fr = lane & 15, fq = lane >> 4;
    const int K = g.K, nt = K / BK;
    unsigned voffA[2], voffB[2];
#pragma unroll
    for (int i = 0; i < 2; ++i) { int R, C; stage_rc(tid * 16 + i * 8192, R, C); const int Rb = Epi::PERM ? ((R & ~31) + perm32(R & 31)) : R;
        voffA[i] = (unsigned)(R * K + C) * 2u; voffB[i] = (unsigned)(Rb * K + C) * 2u; }
    const size_t kstep = (size_t)(BK * 2);
    const size_t hstep = (size_t)HALF * K * 2;
    const size_t tstep = 2 * hstep;
    const unsigned ldsw = (unsigned)wid * 1024u;
    const int aoff = lds_byte(wr * 64 + fr, fq * 8), boff = lds_byte(wc * 32 + fr, fq * 8);
#define PG8_SA(b, h) (((b) * 2 + (h)) * HTB)
#define PG8_SB(b, h) ((4 + (b) * 2 + (h)) * HTB)
#define PG8_STAGE(bufoff, gbase, voff) do { _Pragma("unroll") for (int _i = 0; _i < 2; ++_i) \
        __builtin_amdgcn_global_load_lds((const unsigned*)((const char*)(gbase) + (voff)[_i]), (LAS unsigned*)(lds + (bufoff) + ldsw + _i * 8192), 16, 0, 0); } while (0)
#define PG8_LDA(dst, b, h) do { _Pragma("unroll") for (int m = 0; m < 4; ++m) _Pragma("unroll") for (int k = 0; k < 2; ++k) dst[m][k] = *(const LAS bf16x8*)(lds + PG8_SA(b, h) + aoff + m * 2048 + k * 1024); } while (0)
#define PG8_LDB(dst, b, h) do { _Pragma("unroll") for (int n = 0; n < 2; ++n) _Pragma("unroll") for (int k = 0; k < 2; ++k) dst[n][k] = *(const LAS bf16x8*)(lds + PG8_SB(b, h) + boff + n * 2048 + k * 1024); } while (0)
#define PG8_MMA(ai, bj, At, Bt) do { __builtin_amdgcn_s_setprio(1); _Pragma("unroll") for (int m = 0; m < 4; ++m) _Pragma("unroll") for (int n = 0; n < 2; ++n) _Pragma("unroll") for (int k = 0; k < 2; ++k) \
        acc[ai][bj][m][n] = __builtin_amdgcn_mfma_f32_16x16x32_bf16(Bt[n][k], At[m][k], acc[ai][bj][m][n], 0, 0, 0); __builtin_amdgcn_s_setprio(0); } while (0)
#define PG8_WAIT_V(n) asm volatile("s_waitcnt vmcnt(" #n ")" ::: "memory")
#define PG8_WAIT_L(n) asm volatile("s_waitcnt lgkmcnt(" #n ")" ::: "memory")
#define PG8_BAR __builtin_amdgcn_s_barrier()
#define PG8_SCHED __builtin_amdgcn_sched_barrier(0)
    Unit cur, nxt; int ui = 0;
    if (!S.next(0, cur)) return;
    f32x4 acc[2][2][4][2];
#pragma unroll
    for (int a = 0; a < 2; ++a)
#pragma unroll
        for (int b = 0; b < 2; ++b)
#pragma unroll
            for (int m = 0; m < 4; ++m)
#pragma unroll
                for (int n = 0; n < 2; ++n) acc[a][b][m][n] = (f32x4){0.f, 0.f, 0.f, 0.f};
    bf16x8 At[4][2], B0[2][2], B1[2][2];
    const char* cA = (const char*)g.A + (size_t)cur.ka * tstep; const char* cB = (const char*)g.Bt + (size_t)cur.kb * tstep;
    PG8_STAGE(PG8_SB(0, 0), cB, voffB); PG8_STAGE(PG8_SB(0, 1), cB + hstep, voffB); PG8_STAGE(PG8_SA(0, 0), cA, voffA); PG8_STAGE(PG8_SA(0, 1), cA + hstep, voffA);
    if (wr == 1) PG8_BAR;
    PG8_WAIT_V(2); PG8_BAR;
    PG8_STAGE(PG8_SB(1, 0), cB + kstep, voffB); PG8_STAGE(PG8_SA(1, 0), cA + kstep, voffA); PG8_STAGE(PG8_SB(1, 1), cB + hstep + kstep, voffB);
    PG8_WAIT_V(6); PG8_BAR;
    for (;;) {
        const bool has_next = S.next(ui + 1, nxt);
        const char* nA = has_next ? (const char*)g.A + (size_t)nxt.ka * tstep : cA; const char* nB = has_next ? (const char*)g.Bt + (size_t)nxt.kb * tstep : cB;
        for (int t = 0; t < nt; t += 2) {
            const bool last = (t == nt - 2);
            const char* a1 = cA + (size_t)(t + 1) * kstep;
            const char* a2 = last ? nA : cA + (size_t)(t + 2) * kstep; const char* b2 = last ? nB : cB + (size_t)(t + 2) * kstep;
            const char* a3 = a2 + kstep; const char* b3 = b2 + kstep;
            PG8_LDB(B0, 0, 0); PG8_LDB(B1, 0, 1); PG8_SCHED; PG8_LDA(At, 0, 0); PG8_STAGE(PG8_SA(1, 1), a1 + hstep, voffA);
            PG8_WAIT_V(8); PG8_WAIT_L(0); PG8_BAR; PG8_MMA(0, 0, At, B0); PG8_MMA(0, 1, At, B1); PG8_BAR; PG8_SCHED;
            PG8_LDA(At, 0, 1); PG8_STAGE(PG8_SB(0, 0), b2, voffB); PG8_STAGE(PG8_SB(0, 1), b2 + hstep, voffB); PG8_STAGE(PG8_SA(0, 0), a2, voffA);
            PG8_WAIT_V(8); PG8_WAIT_L(0); PG8_BAR; PG8_MMA(1, 0, At, B0); PG8_MMA(1, 1, At, B1); PG8_BAR; PG8_SCHED;
            PG8_LDB(B0, 1, 0); PG8_LDB(B1, 1, 1); PG8_SCHED; PG8_LDA(At, 1, 0); PG8_STAGE(PG8_SA(0, 1), a2 + hstep, voffA);
            PG8_WAIT_V(8); PG8_WAIT_L(0); PG8_BAR; PG8_MMA(0, 0, At, B0); PG8_MMA(0, 1, At, B1); PG8_BAR; PG8_SCHED;
            PG8_LDA(At, 1, 1); PG8_STAGE(PG8_SB(1, 0), b3, voffB); PG8_STAGE(PG8_SB(1, 1), b3 + hstep, voffB); PG8_STAGE(PG8_SA(1, 0), a3, voffA);
            PG8_WAIT_V(8); PG8_WAIT_L(0); PG8_BAR; PG8_MMA(1, 0, At, B0); PG8_MMA(1, 1, At, B1); PG8_BAR; PG8_SCHED;
        }
        if constexpr (ALIGN_EPI) { if (wr == 0) PG8_BAR; }
        E(acc, cur, wr, wc, fr, fq);
        if (!has_next) break;
#pragma unroll
        for (int a = 0; a < 2; ++a)
#pragma unroll
            for (int b = 0; b < 2; ++b)
#pragma unroll
                for (int m = 0; m < 4; ++m)
#pragma unroll
                    for (int n = 0; n < 2; ++n) acc[a][b][m][n] = (f32x4){0.f, 0.f, 0.f, 0.f};
        cur = nxt; cA = nA; cB = nB; ++ui;
        if constexpr (ALIGN_EPI) { if (wr == 1) PG8_BAR; }
    }
    PG8_WAIT_V(0);
    if constexpr (!ALIGN_EPI) { if (wr == 0) PG8_BAR; }
    PG8_BAR;
#undef PG8_SA
#undef PG8_SB
#undef PG8_STAGE
#undef PG8_LDA
#undef PG8_LDB
#undef PG8_MMA
#undef PG8_WAIT_V
#undef PG8_WAIT_L
#undef PG8_BAR
#undef PG8_SCHED
}
}

namespace att {
constexpr int D = 128, NW = 8, QBLK = 32, KVBLK = 64;
constexpr float SCALE = 0.088388347648318440f;
constexpr float THR = 8.f;
constexpr int LDQ = PWD, LDK = PWD, LDO = MWD;
constexpr int SHM_V = KVBLK * D * 2, SHM_K = KVBLK * D * 2;
constexpr int OST_PITCH = 272;
constexpr int OST_OFF = 2 * SHM_V + 2 * SHM_K + NW * 64 * 4;
constexpr int ATT_LDS = OST_OFF + NW * 32 * OST_PITCH;
#define KSWZ(row, colB) ((row) * 256 + ((colB) ^ (((row) & 7) << 4)))
#define SBAR() __builtin_amdgcn_sched_barrier(0)
__device__ __forceinline__ int crow(int r, int hi) { return (r & 3) + 8 * (r >> 2) + 4 * hi; }

template <bool MASKED>
__device__ __forceinline__ void partialSM(f32x16& p0, f32x16& p1, float& m_reg, float& mn, float& alpha, int mbase) {
  constexpr float C = SCALE * 1.4426950408889634f;
  if constexpr (MASKED) {
    const float ninf = -__builtin_inff();
#pragma unroll
    for (int r = 0; r < 16; ++r) { const int c = (r & 3) + 8 * (r >> 2);
      p0[r] = ((unsigned)(mbase - c) <= 256u) ? p0[r] : ninf;
      p1[r] = ((unsigned)(mbase - c - 32) <= 256u) ? p1[r] : ninf; }
  }
  float pmax = p0[0];
#pragma unroll
  for (int r = 1; r < 16; ++r) pmax = fmaxf(pmax, p0[r]);
#pragma unroll
  for (int r = 0; r < 16; ++r) pmax = fmaxf(pmax, p1[r]);
  { auto rr = __builtin_amdgcn_permlane32_swap(__float_as_uint(pmax), __float_as_uint(pmax), false, false);
    pmax = fmaxf(__uint_as_float(rr[0]), __uint_as_float(rr[1])); }
  if (__builtin_expect(__all(pmax - m_reg <= THR / SCALE), 1)) { mn = m_reg; alpha = 1.f; }
  else { mn = fmaxf(m_reg, pmax); alpha = __builtin_amdgcn_exp2f((m_reg - mn) * C); m_reg = mn; }
  float mnC = -mn * C;
#pragma unroll
  for (int r = 0; r < 16; ++r) p0[r] = fmaf(p0[r], C, mnC);
#pragma unroll
  for (int r = 0; r < 16; ++r) p1[r] = fmaf(p1[r], C, mnC);
#pragma unroll
  for (int r = 0; r < 16; ++r) p0[r] = __builtin_amdgcn_exp2f(p0[r]);
}
__device__ __forceinline__ void finishSM(f32x16& p0, f32x16& p1, float alpha, float& l_reg, bf16x8& pa0, bf16x8& pa1, bf16x8& pa2, bf16x8& pa3) {
#pragma unroll
  for (int r = 0; r < 16; ++r) p1[r] = __builtin_amdgcn_exp2f(p1[r]);
  float ps = 0;
#pragma unroll
  for (int r = 0; r < 16; ++r) ps += p0[r];
#pragma unroll
  for (int r = 0; r < 16; ++r) ps += p1[r];
  { auto rr = __builtin_amdgcn_permlane32_swap(__float_as_uint(ps), __float_as_uint(ps), false, false);
    ps = __uint_as_float(rr[0]) + __uint_as_float(rr[1]); }
  l_reg = l_reg * alpha + ps;
#define PK4(P, BASE, OUT) do { unsigned a0 = cvt_pk_bf16(P[BASE + 0], P[BASE + 1]), a1 = cvt_pk_bf16(P[BASE + 2], P[BASE + 3]);   \
    unsigned b0 = cvt_pk_bf16(P[BASE + 4], P[BASE + 5]), b1 = cvt_pk_bf16(P[BASE + 6], P[BASE + 7]);                              \
    auto r0 = __builtin_amdgcn_permlane32_swap(a0, b0, false, false); auto r1 = __builtin_amdgcn_permlane32_swap(a1, b1, false, false); \
    u32x4 w = {r0[0], r1[0], r0[1], r1[1]}; OUT = *reinterpret_cast<bf16x8*>(&w); } while (0)
  PK4(p0, 0, pa0); PK4(p0, 8, pa1); PK4(p1, 0, pa2); PK4(p1, 8, pa3);
#undef PK4
}
__device__ __forceinline__ void qkt(f32x16& p0, f32x16& p1, const bf16* Ks, const bf16x8* qr, int r32, int hi) {
  p0 = f32x16{}; p1 = f32x16{};
#pragma unroll
  for (int d0 = 0; d0 < 8; ++d0) { int cb = (d0 * 16 + hi * 8) * 2;
    bf16x8 b0 = *reinterpret_cast<const bf16x8*>((const char*)Ks + KSWZ(r32, cb));
    bf16x8 b1 = *reinterpret_cast<const bf16x8*>((const char*)Ks + KSWZ(32 + r32, cb));
    p0 = __builtin_amdgcn_mfma_f32_32x32x16_bf16(b0, qr[d0], p0, 0, 0, 0);
    p1 = __builtin_amdgcn_mfma_f32_32x32x16_bf16(b1, qr[d0], p1, 0, 0, 0); }
}
__device__ __forceinline__ int v_st(int k, int c) { const int kk = (k & ~0xC) | ((k & 4) << 1) | ((k & 8) >> 1); return ((kk >> 3) * 4 + (c >> 5)) * 512 + ((kk & 7) * 32 + (c & 31)) * 2; }
__device__ __forceinline__ int v_rd_base(int lane) { return ((lane & 3) << 3) | (((lane >> 2) & 3) << 6) | (((lane >> 4) & 1) << 5) | (((lane >> 5) & 1) << 8); }
constexpr int v_rd_off(int d0, int ks, int half) { return d0 * 512 + ks * 4096 + half * 2048; }
template <int OFF> __device__ __forceinline__ s16x4 tr_read(int vb) {
  s16x4 r; asm volatile("ds_read_b64_tr_b16 %0, %1 offset:%2" : "=&v"(r) : "v"(vb), "i"(OFF) : "memory"); return r;
}
template <int D0> __device__ __forceinline__ void pv_one(f32x16& od, int vb, bf16x8 pa0, bf16x8 pa1, bf16x8 pa2, bf16x8 pa3) {
  const s16x4 l0 = tr_read<v_rd_off(D0, 0, 0)>(vb), h0 = tr_read<v_rd_off(D0, 0, 1)>(vb), l1 = tr_read<v_rd_off(D0, 1, 0)>(vb), h1 = tr_read<v_rd_off(D0, 1, 1)>(vb);
  const s16x4 l2 = tr_read<v_rd_off(D0, 2, 0)>(vb), h2 = tr_read<v_rd_off(D0, 2, 1)>(vb), l3 = tr_read<v_rd_off(D0, 3, 0)>(vb), h3 = tr_read<v_rd_off(D0, 3, 1)>(vb);
  asm volatile("s_waitcnt lgkmcnt(0)" ::: "memory"); SBAR();
#define PK(L, H) (bf16x8){L[0], L[1], L[2], L[3], H[0], H[1], H[2], H[3]}
  od = __builtin_amdgcn_mfma_f32_32x32x16_bf16(pa0, PK(l0, h0), od, 0, 0, 0);
  od = __builtin_amdgcn_mfma_f32_32x32x16_bf16(pa1, PK(l1, h1), od, 0, 0, 0);
  od = __builtin_amdgcn_mfma_f32_32x32x16_bf16(pa2, PK(l2, h2), od, 0, 0, 0);
  od = __builtin_amdgcn_mfma_f32_32x32x16_bf16(pa3, PK(l3, h3), od, 0, 0, 0);
#undef PK
}
__device__ __forceinline__ void pv_d0(f32x16* o, int vb, bf16x8 pa0, bf16x8 pa1, bf16x8 pa2, bf16x8 pa3) {
  pv_one<0>(o[0], vb, pa0, pa1, pa2, pa3); pv_one<1>(o[1], vb, pa0, pa1, pa2, pa3); pv_one<2>(o[2], vb, pa0, pa1, pa2, pa3); pv_one<3>(o[3], vb, pa0, pa1, pa2, pa3);
}

template <int MODE, int SD>
__device__ __forceinline__ void attn_unit(const bf16* __restrict__ Qb, const bf16* __restrict__ Kh, const bf16* __restrict__ Vh, bf16* __restrict__ Ob, int NT, int dq0, float sink, char* lds) {
  int tid_ = threadIdx.x; asm volatile("" : "+v"(tid_));
  const int tid = tid_, wid = tid >> 6, lane = tid & 63, r32 = lane & 31, hi = lane >> 5;
  bf16* V_lds = (bf16*)lds; bf16* K_lds = (bf16*)(lds + 2 * SHM_V);
  float* ws = (float*)(lds + 2 * SHM_V + 2 * SHM_K) + wid * 64; float* li_l = ws; float* al_l = ws + 32;
  float m_reg = MODE ? sink * (1.0f / SCALE) : -1e30f, l_reg = MODE ? 1.0f : 0.0f; f32x16 o[4] = {}; bf16x8 qr[8];
  const bf16* Qw = Qb + (long)(wid * QBLK + r32) * LDQ + hi * 8;
#pragma unroll
  for (int d0 = 0; d0 < 8; ++d0) qr[d0] = *reinterpret_cast<const bf16x8*>(Qw + d0 * 16);
  const int sr = tid >> 4, sc = (tid & 15) * 8, vst0 = v_st(sr, sc), vst1 = v_st(32 + sr, sc);
  const int vb0 = (int)(uintptr_t)V_lds + v_rd_base(lane);
  const int mb0 = dq0 + wid * QBLK + r32 + 128 - 4 * hi;
  struct { bf16x8 vs0, vs1, ks0, ks1; } sr_[SD];
#define SLOAD(i, k0) do { sr_[i].vs0 = *reinterpret_cast<const bf16x8*>(&Vh[(long)((k0) + sr) * LDK + sc]); sr_[i].vs1 = *reinterpret_cast<const bf16x8*>(&Vh[(long)((k0) + 32 + sr) * LDK + sc]); \
    sr_[i].ks0 = *reinterpret_cast<const bf16x8*>(&Kh[(long)((k0) + sr) * LDK + sc]); sr_[i].ks1 = *reinterpret_cast<const bf16x8*>(&Kh[(long)((k0) + 32 + sr) * LDK + sc]); } while (0)
#define SWRITE(b, i) do { *(bf16x8*)((char*)V_lds + (b) * SHM_V + vst0) = sr_[i].vs0;          \
    *(bf16x8*)((char*)V_lds + (b) * SHM_V + vst1) = sr_[i].vs1; int kc = sc * 2;               \
    *(bf16x8*)((char*)K_lds + (b) * SHM_K + KSWZ(sr, kc)) = sr_[i].ks0;                       \
    *(bf16x8*)((char*)K_lds + (b) * SHM_K + KSWZ(32 + sr, kc)) = sr_[i].ks1; } while (0)
#define SWAIT() do { if constexpr (SD == 2) asm volatile("s_waitcnt vmcnt(4)" ::: "memory"); else asm volatile("s_waitcnt vmcnt(0)" ::: "memory"); } while (0)
#define RESC(a) do { if (__any((a) < 1.f)) { if (hi == 0) al_l[r32] = (a); asm volatile("s_waitcnt lgkmcnt(0)" ::: "memory"); \
    _Pragma("unroll") for (int d = 0; d < 4; ++d) _Pragma("unroll") for (int r = 0; r < 16; ++r) o[d][r] *= al_l[crow(r, hi)]; } } while (0)
#define PSM(P0, P1, MN, AL, J) partialSM<MODE != 0>(P0, P1, m_reg, MN, AL, mb0 - 64 * (J))
  f32x16 pA0, pA1, pB0, pB1; float mnA, mnB, alA, alB; bf16x8 pa0, pa1, pa2, pa3;
  constexpr int SE = 0, SO = SD - 1;
  SLOAD(SE, 0); asm volatile("s_waitcnt vmcnt(0)" ::: "memory"); SWRITE(0, SE); __syncthreads();
  qkt(pA0, pA1, K_lds, qr, r32, hi); PSM(pA0, pA1, mnA, alA, 0);
  SLOAD(SO, KVBLK); if constexpr (SD == 2) { if (2 < NT) SLOAD(SE, 2 * KVBLK); }
  SWAIT(); SWRITE(1, SO); __syncthreads();
  for (int j = 1; j + 1 < NT; j += 2) {
    SBAR(); qkt(pB0, pB1, (bf16*)((char*)K_lds + SHM_K), qr, r32, hi);
    finishSM(pA0, pA1, alA, l_reg, pa0, pa1, pa2, pa3); SBAR();
    SLOAD(SO, (j + SD) * KVBLK); SBAR();
    pv_d0(o, vb0, pa0, pa1, pa2, pa3); PSM(pB0, pB1, mnB, alB, j);
    __syncthreads(); SWAIT(); SWRITE(0, SE);
    RESC(alB); __syncthreads();
    SBAR(); qkt(pA0, pA1, K_lds, qr, r32, hi);
    finishSM(pB0, pB1, alB, l_reg, pa0, pa1, pa2, pa3); SBAR();
    if (SD == 1 || j + 3 < NT) SLOAD(SE, (j + 1 + SD) * KVBLK); SBAR();
    pv_d0(o, vb0 + (int)SHM_V, pa0, pa1, pa2, pa3); PSM(pA0, pA1, mnA, alA, j + 1);
    __syncthreads(); SWAIT(); SWRITE(1, SO);
    RESC(alA); __syncthreads();
  }
  SBAR(); qkt(pB0, pB1, (bf16*)((char*)K_lds + SHM_K), qr, r32, hi);
  finishSM(pA0, pA1, alA, l_reg, pa0, pa1, pa2, pa3); SBAR();
  pv_d0(o, vb0, pa0, pa1, pa2, pa3); PSM(pB0, pB1, mnB, alB, NT - 1);
  __syncthreads(); RESC(alB);
  finishSM(pB0, pB1, alB, l_reg, pa0, pa1, pa2, pa3); SBAR();
  pv_d0(o, vb0 + (int)SHM_V, pa0, pa1, pa2, pa3);
  if (hi == 0) li_l[r32] = l_reg; asm volatile("s_waitcnt lgkmcnt(0)" ::: "memory");
  float rli[16];
#pragma unroll
  for (int r = 0; r < 16; ++r) rli[r] = __builtin_amdgcn_rcpf(li_l[crow(r, hi)]);
  char* ost = lds + OST_OFF + wid * (32 * OST_PITCH);
#pragma unroll
  for (int r = 0; r < 16; ++r) { const int orow = crow(r, hi);
#pragma unroll
    for (int d0 = 0; d0 < 4; ++d0) { const float v = o[d0][r] * rli[r]; *(bf16*)(ost + orow * OST_PITCH + (d0 * 32 + r32) * 2) = (bf16)(cvt_pk_bf16(v, v) & 0xffffu); } }
  asm volatile("s_waitcnt lgkmcnt(0)" ::: "memory");
  bf16* Ow = Ob + (long)(wid * QBLK) * LDO;
#pragma unroll
  for (int i = 0; i < 8; ++i) { const int row = (lane >> 4) + 4 * i, cc = (lane & 15);
    const u32x4 w = *(const u32x4*)(ost + row * OST_PITCH + cc * 16);
    *(u32x4*)(Ow + (long)row * LDO + cc * 8) = w; }
  __syncthreads();
#undef SLOAD
#undef SWRITE
#undef SWAIT
#undef RESC
#undef PSM
}
}

#define XB_TMO      128
#define XB_XCNT(j)  (256  + 64 * (j))
#define XB_XSUB(j)  (1280 + 64 * (j))
#define XB_XGEN(j)  (2304 + 64 * (j))
#define XB_TOP      3328
#define XB_TOPGEN   3392
#define XCD_BAR_WORDS 3456
#define XB_SPIN_CAP (1u << 20)
__device__ __forceinline__ unsigned xb_ld(unsigned* p)              { return __hip_atomic_load(p, __ATOMIC_RELAXED, __HIP_MEMORY_SCOPE_AGENT); }
__device__ __forceinline__ unsigned xb_add(unsigned* p, unsigned v) { return __hip_atomic_fetch_add(p, v, __ATOMIC_RELAXED, __HIP_MEMORY_SCOPE_AGENT); }
__device__ __forceinline__ unsigned xb_xcc_id() { return (unsigned)__builtin_amdgcn_s_getreg((3 << 11) | 20) & 0xFu; }
#define XB_SPIN(cond, bar) do { unsigned _sp = 0; while (cond) { __builtin_amdgcn_s_sleep(1); \
    if ((++_sp & 255u) == 0u) { if (xb_ld(&(bar)[XB_TMO])) break; if (_sp > XB_SPIN_CAP) { atomicAdd(&(bar)[XB_TMO], 1u); break; } } } } while (0)
struct XcdBarrier { unsigned* bar; unsigned x; volatile LAS unsigned* st; };
__device__ __forceinline__ XcdBarrier xcd_barrier_post(unsigned* bar, volatile LAS unsigned* st) {
    XcdBarrier b; b.bar = bar; b.x = xb_xcc_id(); b.st = st;
    if (threadIdx.x == 0) (void)xb_add(&bar[XB_XCNT(b.x)], 1u);
    return b;
}
__device__ __forceinline__ void xcd_barrier_complete(unsigned* bar, unsigned x, unsigned& nloc, unsigned& nx) {
    const unsigned G = gridDim.x * gridDim.y * gridDim.z;
    unsigned sum, cnt, mine, sp = 0u;
    for (;;) {
        sum = 0u; cnt = 0u; mine = 0u;
#pragma unroll
        for (unsigned j = 0; j < 16; ++j) { const unsigned c = xb_ld(&bar[XB_XCNT(j)]); sum += c; cnt += (c > 0u) ? 1u : 0u; mine = (j == x) ? c : mine; }
        if (sum == G) break;
        __builtin_amdgcn_s_sleep(1);
        if ((++sp & 255u) == 0u) { if (xb_ld(&bar[XB_TMO])) break; if (sp > XB_SPIN_CAP) { atomicAdd(&bar[XB_TMO], 1u); break; } }
    }
    nloc = mine > 0u ? mine : 1u; nx = cnt > 0u ? cnt : 1u;
}
__device__ __forceinline__ void xcd_barrier(const XcdBarrier& b) {
    asm volatile("s_waitcnt vmcnt(0)" ::: "memory");
    __syncthreads();
    if (threadIdx.x == 0) {
        unsigned* bar = b.bar;
        __builtin_amdgcn_s_waitcnt(0);
        unsigned nloc = b.st[0], nx = b.st[1];
        if (nloc == 0u) { xcd_barrier_complete(bar, b.x, nloc, nx); b.st[0] = nloc; b.st[1] = nx; }
        const unsigned old = xb_add(&bar[XB_XSUB(b.x)], 1u);
        const unsigned gen = old / nloc;
        if (old + 1u == (gen + 1u) * nloc) {
            __builtin_amdgcn_fence(__ATOMIC_RELEASE, "agent");
            asm volatile("s_waitcnt vmcnt(0)" ::: "memory");
            const unsigned og = xb_add(&bar[XB_TOP], 1u);
            const unsigned tg = og / nx;
            if (og + 1u == (tg + 1u) * nx) xb_add(&bar[XB_TOPGEN], 1u);
            else XB_SPIN(xb_ld(&bar[XB_TOPGEN]) == tg, bar);
            __builtin_amdgcn_fence(__ATOMIC_ACQUIRE, "agent");
            xb_add(&bar[XB_XGEN(b.x)], 1u);
            asm volatile("s_waitcnt vmcnt(0)" ::: "memory");
        } else {
            XB_SPIN(xb_ld(&bar[XB_XGEN(b.x)]) == gen, bar);
            __builtin_amdgcn_fence(__ATOMIC_ACQUIRE, "agent");
            asm volatile("s_waitcnt vmcnt(0)" ::: "memory");
        }
    }
    __syncthreads();
}

__device__ __forceinline__ void transpose_item(const float* W, int K, int N, bf16* WT, LAS float* scr, int item, int lane) {
    const int nblk = N / 32, kb = item / nblk, nb = item % nblk, k0 = 64 * kb, n0 = 32 * nb;
#pragma unroll 8
    for (int i = 0; i < 32; ++i) { const int kk = 2 * i + (lane >> 5); scr[kk * 33 + (lane & 31)] = W[(size_t)(k0 + kk) * N + n0 + (lane & 31)]; }
    asm volatile("s_waitcnt lgkmcnt(0)" ::: "memory");
    const int c = lane & 7;
#pragma unroll
    for (int j = 0; j < 4; ++j) { const int n = (lane >> 3) + 8 * j; const LAS float* s = scr + (8 * c) * 33 + n;
        u32x4 o; o.x = cvt_pk_bf16(s[0 * 33], s[1 * 33]); o.y = cvt_pk_bf16(s[2 * 33], s[3 * 33]); o.z = cvt_pk_bf16(s[4 * 33], s[5 * 33]); o.w = cvt_pk_bf16(s[6 * 33], s[7 * 33]);
        *(u32x4*)(WT + (size_t)(n0 + n) * K + k0 + 8 * c) = o; }
    asm volatile("s_waitcnt lgkmcnt(0)" ::: "memory");
}

struct Args { const float* in[21]; float* out; unsigned char* ws; int lo, hi; };

__device__ __forceinline__ const float* x_in_row(const float* xp, const float* xs, int row) {
    return row < NPROMPT_TOK ? xp + (size_t)row * DM : xs + (size_t)(row - NPROMPT_TOK) * DM;
}

__device__ __forceinline__ void phase_weights(const CAS Args* a, unsigned char* ws, int l, LAS unsigned char* lds, int gw, int NGW, int wave, int lane) {
    LAS float* scr = (LAS float*)(lds + wave * 16384);
    constexpr int I_IN = (DM / 64) * (INW / 32), I_BR = (MWD / 64) * (DM / 32), I_OUT = (DM / 64) * (DM / 32), I_F1 = (DM / 64) * (FFD / 32), I_F2 = (FFD / 64) * (DM / 32), I_G = 32 * 8;
    constexpr int NITEMS = I_IN + 3 * I_BR + I_OUT + I_F1 + I_F2 + I_G;
    for (int it = gw; it < NITEMS; it += NGW) {
        int r = it;
        if (r < I_IN) { transpose_item(a->in[6] + (size_t)l * DM * INW, DM, INW, (bf16*)(ws + WS_WIN), scr, r, lane); continue; } r -= I_IN;
        if (r < 3 * I_BR) { const int b = r / I_BR; transpose_item(a->in[17] + ((size_t)l * 3 + b) * MWD * DM, MWD, DM, (bf16*)(ws + WS_WBR) + (size_t)b * DM * MWD, scr, r - b * I_BR, lane); continue; } r -= 3 * I_BR;
        if (r < I_OUT) { transpose_item(a->in[18] + (size_t)l * DM * DM, DM, DM, (bf16*)(ws + WS_WOUT), scr, r, lane); continue; } r -= I_OUT;
        if (r < I_F1) { transpose_item(a->in[19] + (size_t)l * DM * FFD, DM, FFD, (bf16*)(ws + WS_W1), scr, r, lane); continue; } r -= I_F1;
        if (r < I_F2) { transpose_item(a->in[20] + (size_t)l * FFD * DM, FFD, DM, (bf16*)(ws + WS_W2), scr, r, lane); continue; } r -= I_F2;
        { const int mi = r >> 3, sub = r & 7;
          const int gate = mi >> 4, dd = (mi >> 3) & 1, blk = mi & 7;
          const float* src = (gate ? a->in[14] : a->in[12]) + (((size_t)l * 2 + dd) * 8 + blk) * 16384;
          transpose_item(src, 128, 128, (bf16*)(ws + WS_WG) + ((size_t)(dd * 2 + gate) * 8 + blk) * 16384, scr, sub, lane); }
    }
}

__device__ __forceinline__ void norm_row_to_bf16(const float* xrow, const float* g, bf16* orow, int lane) {
    const f32x4* xr = (const f32x4*)xrow + lane; const f32x4* gr = (const f32x4*)g + lane;
    f32x4 v[8]; float s = 0.f;
#pragma unroll
    for (int j = 0; j < 8; ++j) { v[j] = xr[64 * j]; s += (v[j].x * v[j].x + v[j].y * v[j].y) + (v[j].z * v[j].z + v[j].w * v[j].w); }
    const float rstd = 1.0f / sqrtf(wave_sum(s, lane) * (1.0f / DM) + EPS);
    u32x2* o8 = (u32x2*)orow + lane;
#pragma unroll
    for (int j = 0; j < 8; ++j) { const f32x4 gg = gr[64 * j]; u32x2 w; w.x = cvt_pk_bf16(v[j].x * rstd * gg.x, v[j].y * rstd * gg.y); w.y = cvt_pk_bf16(v[j].z * rstd * gg.z, v[j].w * rstd * gg.w); o8[64 * j] = w; }
}
template <bool SECOND>
__device__ __forceinline__ void resid_norm_row(const float* yrow, const float* xold, float* xout, const float* g1, const float* g2, bf16* hrow, int lane) {
    const f32x4* yr = (const f32x4*)yrow + lane; const f32x4* xr = (const f32x4*)xold + lane; const f32x4* g1r = (const f32x4*)g1 + lane;
    f32x4 v[8]; float s = 0.f;
#pragma unroll
    for (int j = 0; j < 8; ++j) { v[j] = yr[64 * j]; s += (v[j].x * v[j].x + v[j].y * v[j].y) + (v[j].z * v[j].z + v[j].w * v[j].w); }
    const float rstd = 1.0f / sqrtf(wave_sum(s, lane) * (1.0f / DM) + EPS);
    float s2 = 0.f;
#pragma unroll
    for (int j = 0; j < 8; ++j) { const f32x4 gg = g1r[64 * j]; const f32x4 xo = xr[64 * j]; v[j] = xo + v[j] * rstd * gg; ((f32x4*)xout + lane)[64 * j] = v[j];
        s2 += (v[j].x * v[j].x + v[j].y * v[j].y) + (v[j].z * v[j].z + v[j].w * v[j].w); }
    if constexpr (SECOND) {
        const float rstd2 = 1.0f / sqrtf(wave_sum(s2, lane) * (1.0f / DM) + EPS);
        const f32x4* g2r = (const f32x4*)g2 + lane; u32x2* o8 = (u32x2*)hrow + lane;
#pragma unroll
        for (int j = 0; j < 8; ++j) { const f32x4 gg = g2r[64 * j]; u32x2 w; w.x = cvt_pk_bf16(v[j].x * rstd2 * gg.x, v[j].y * rstd2 * gg.y); w.y = cvt_pk_bf16(v[j].z * rstd2 * gg.z, v[j].w * rstd2 * gg.w); o8[64 * j] = w; }
    }
}

__device__ __forceinline__ void rope_token(bf16* prow, int pos, const float* qn, const float* kn, int lane) {
    const double reva = (double)(lane < 32 ? (pos >> 6) : (pos & 63)) * ROPE_FA[lane & 31];
    const double rev1 = (double)pos * ROPE_F1[lane];
    const float fa = (float)(reva - __builtin_floor(reva)), f1 = (float)(rev1 - __builtin_floor(rev1));
    const float ca = __builtin_amdgcn_cosf(fa), sa = __builtin_amdgcn_sinf(fa), c1 = __builtin_amdgcn_cosf(f1), s1 = __builtin_amdgcn_sinf(f1);
    const float qg1 = qn[lane], qg2 = qn[64 + lane], kg1 = kn[lane], kg2 = kn[64 + lane];
#pragma unroll
    for (int h = 0; h < 10; ++h) {
        bf16* p = prow + (h < 8 ? QA_OFF + h * HD : KA_OFF + (h - 8) * HD);
        const float x1 = bf2f(p[lane]), x2 = bf2f(p[64 + lane]);
        const float rstd = 1.0f / sqrtf(wave_sum(x1 * x1 + x2 * x2, lane) * (1.0f / HD) + EPS);
        const float y1 = x1 * rstd * (h < 8 ? qg1 : kg1), y2 = x2 * rstd * (h < 8 ? qg2 : kg2);
        const float o1 = y1 * ca - y2 * sa, o2 = y2 * ca + y1 * sa;
        p[lane] = (bf16)(cvt_pk_bf16(o1, o1) & 0xffffu); p[64 + lane] = (bf16)(cvt_pk_bf16(o2, o2) & 0xffffu);
    }
#pragma unroll
    for (int h = 0; h < 10; ++h) {
        bf16* p = prow + (h < 8 ? QB_OFF + h * HD : KB_OFF + (h - 8) * HD);
        const float x1 = bf2f(p[lane]), x2 = bf2f(p[64 + lane]);
        const float o1 = x1 * c1 - x2 * s1, o2 = x2 * c1 + x1 * s1;
        p[lane] = (bf16)(cvt_pk_bf16(o1, o1) & 0xffffu); p[64 + lane] = (bf16)(cvt_pk_bf16(o2, o2) & 0xffffu);
    }
}

struct CParams { const float* conv_w; const float* conv_b; const float* gate_r_b; const float* gate_i_b; const float* lam; const bf16* WG; };
template <int PASS>
__device__ __forceinline__ void c_unit(LAS unsigned char* lds, const bf16* P, bf16* OC, const CParams& cp, f32x2* SUM, const float* CAR, int seq, int tc, int nb) {
    constexpr int UP = 136;
    LAS bf16* U = (LAS bf16*)lds;
    LAS float* AD = (LAS float*)(lds + 16384);
    int tid_ = threadIdx.x; asm volatile("" : "+v"(tid_));
    const int tid = tid_, wave = tid >> 6, lane = tid & 63;
    {
        const int t = tid >> 4, c8 = (tid & 15) * 8, cg = nb * 128 + c8, ts = tc * LC + t;
        float u8[8];
        { const f32x4 b0 = *(const f32x4*)(cp.conv_b + cg), b1 = *(const f32x4*)(cp.conv_b + cg + 4); u8[0] = b0.x; u8[1] = b0.y; u8[2] = b0.z; u8[3] = b0.w; u8[4] = b1.x; u8[5] = b1.y; u8[6] = b1.z; u8[7] = b1.w; }
#pragma unroll
        for (int j = 0; j < 4; ++j) { const int tt = ts - 2 + j;
            if (tt >= 0 && tt < SEQ) {
                const u32x4 xw = *(const u32x4*)(P + (size_t)(seq * SEQ + tt) * PWD + XC_OFF + cg);
                const f32x4 w0 = *(const f32x4*)(cp.conv_w + j * MWD + cg), w1 = *(const f32x4*)(cp.conv_w + j * MWD + cg + 4);
                u8[0] += bf_lo(xw.x) * w0.x; u8[1] += bf_hi(xw.x) * w0.y; u8[2] += bf_lo(xw.y) * w0.z; u8[3] += bf_hi(xw.y) * w0.w;
                u8[4] += bf_lo(xw.z) * w1.x; u8[5] += bf_hi(xw.z) * w1.y; u8[6] += bf_lo(xw.w) * w1.z; u8[7] += bf_hi(xw.w) * w1.w; } }
        u32x4 w; w.x = cvt_pk_bf16(u8[0], u8[1]); w.y = cvt_pk_bf16(u8[2], u8[3]); w.z = cvt_pk_bf16(u8[4], u8[5]); w.w = cvt_pk_bf16(u8[6], u8[7]);
        *(LAS u32x4*)(U + t * UP + c8) = w;
    }
    __syncthreads();
    {
        const int dd = wave >> 2, q = wave & 3, r = lane & 31, h = lane >> 5;
        const bf16* wrp = cp.WG + ((size_t)((dd * 2 + 0) * 8 + nb) * 128 + 32 * q + r) * 128 + 8 * h;
        const bf16* wip = cp.WG + ((size_t)((dd * 2 + 1) * 8 + nb) * 128 + 32 * q + r) * 128 + 8 * h;
        f32x16 accr = {}, acci = {};
#pragma unroll
        for (int ks = 0; ks < 8; ++ks) {
            const bf16x8 af = *(const LAS bf16x8*)(U + r * UP + 16 * ks + 8 * h);
            const bf16x8 br = *(const bf16x8*)(wrp + 16 * ks), bi = *(const bf16x8*)(wip + 16 * ks);
            accr = __builtin_amdgcn_mfma_f32_32x32x16_bf16(af, br, accr, 0, 0, 0);
            acci = __builtin_amdgcn_mfma_f32_32x32x16_bf16(af, bi, acci, 0, 0, 0);
        }
        const int ch = 32 * q + r, cg = nb * 128 + ch;
        const float rb = cp.gate_r_b[dd * MWD + cg], ib = cp.gate_i_b[dd * MWD + cg], lam = cp.lam[dd * MWD + cg];
        const float el = __builtin_amdgcn_exp2f(-1.4426950408889634f * lam);
        const float ls8 = -8.0f * (lam > 3.0f ? el * (1.0f - el * (0.5f - el * (1.0f / 3.0f))) : 0.6931471805599453f * __builtin_amdgcn_logf(1.0f + el));
        LAS float* pa = AD + (dd * 2 + 0) * (32 * 128) + ch; LAS float* pd = AD + (dd * 2 + 1) * (32 * 128) + ch;
#pragma unroll
        for (int reg = 0; reg < 16; ++reg) {
            const int tt = (reg & 3) + 8 * (reg >> 2) + 4 * h;
            const float rr = fast_sigmoid(accr[reg] + rb), ii = fast_sigmoid(acci[reg] + ib);
            const float la = ls8 * rr;
            const float av = __builtin_amdgcn_exp2f(1.4426950408889634f * la);
            const float x2 = 2.0f * la;
            const float om = fabsf(x2) < 0.25f ? -x2 * (1.0f + x2 * (0.5f + x2 * ((1.0f / 6.0f) + x2 * ((1.0f / 24.0f) + x2 * ((1.0f / 120.0f) + x2 * (1.0f / 720.0f)))))) : 1.0f - av * av;
            const float uf = bf2f(U[tt * UP + ch]);
            pa[tt * 128] = av; pd[tt * 128] = sqrtf(om) * (ii * uf);
        }
    }
    __syncthreads();
    if (tid < 256) {
        const int dd = tid >> 7, ch = tid & 127, cg = nb * 128 + ch;
        LAS float* pa = AD + (dd * 2 + 0) * (32 * 128) + ch; LAS float* pd = AD + (dd * 2 + 1) * (32 * 128) + ch;
        const size_t si = ((size_t)(seq * NTCH + tc) * 2 + dd) * MWD + cg;
        if constexpr (PASS == 1) {
            float hh = 0.f, pp = 1.f;
#pragma unroll 8
            for (int s = 0; s < LC; ++s) { const int t = dd ? LC - 1 - s : s; const float av = pa[t * 128], dv = pd[t * 128]; hh = av * hh + dv; pp *= av; }
            SUM[si] = (f32x2){pp, hh};
        } else {
            float hh = CAR[si];
#pragma unroll 8
            for (int s = 0; s < LC; ++s) { const int t = dd ? LC - 1 - s : s; const float av = pa[t * 128], dv = pd[t * 128]; hh = av * hh + dv; pa[t * 128] = hh; }
        }
    }
    if constexpr (PASS == 3) {
        __syncthreads();
        const int t = tid >> 4, c8 = (tid & 15) * 8, cg = nb * 128 + c8; const size_t row = (size_t)(seq * SEQ + tc * LC + t);
        const u32x4 yw = *(const u32x4*)(P + row * PWD + YC_OFF + cg);
        const float y[8] = {bf_lo(yw.x), bf_hi(yw.x), bf_lo(yw.y), bf_hi(yw.y), bf_lo(yw.z), bf_hi(yw.z), bf_lo(yw.w), bf_hi(yw.w)};
        const LAS float* hf = AD + t * 128 + c8; const LAS float* hb = AD + 2 * (32 * 128) + t * 128 + c8;
        float o[8];
#pragma unroll
        for (int j = 0; j < 8; ++j) { const float z = 0.7978845608028654f * (y[j] + 0.044715f * y[j] * y[j] * y[j]);
            const float ge = y[j] * fast_sigmoid(2.0f * z);
            o[j] = (hf[j] + hb[j]) * ge; }
        u32x4 w; w.x = cvt_pk_bf16(o[0], o[1]); w.y = cvt_pk_bf16(o[2], o[3]); w.z = cvt_pk_bf16(o[4], o[5]); w.w = cvt_pk_bf16(o[6], o[7]);
        *(u32x4*)(OC + row * MWD + cg) = w;
    }
    __syncthreads();
}

__device__ __forceinline__ void phase_c2(LAS unsigned char* lds, const f32x2* SUM, float* CAR, int G, int bx) {
    int tid_ = threadIdx.x; asm volatile("" : "+v"(tid_));
    const int tid = tid_, seg = tid >> 6, lane = tid & 63;
    LAS f32x2* SEG = (LAS f32x2*)lds;
    for (int lgi = bx; lgi < 64; lgi += G) {
        const int seq = lgi >> 5, dd = (lgi >> 4) & 1, cg = (lgi & 15) * 64 + lane;
        const long step = dd ? -(long)(2 * MWD) : (long)(2 * MWD);
        const int tc0 = dd ? NTCH - 1 - seg * 32 : seg * 32;
        const f32x2* sp = SUM + ((size_t)(seq * NTCH + tc0) * 2 + dd) * MWD + cg;
        float* cp = CAR + ((size_t)(seq * NTCH + tc0) * 2 + dd) * MWD + cg;
        float pp = 1.f, hh = 0.f;
#pragma unroll 8
        for (int k = 0; k < 32; ++k) { const f32x2 s = sp[k * step]; hh = s.x * hh + s.y; pp *= s.x; }
        SEG[seg * 64 + lane] = (f32x2){pp, hh};
        __syncthreads();
        float carry = 0.f;
        for (int sg = 0; sg < seg; ++sg) { const f32x2 v = SEG[sg * 64 + lane]; carry = v.x * carry + v.y; }
#pragma unroll 8
        for (int k = 0; k < 32; ++k) { const f32x2 s = sp[k * step]; cp[k * step] = carry; carry = s.x * carry + s.y; }
        __syncthreads();
    }
}

__global__ void __launch_bounds__(512, 2) mk_fwd(Args args) {
    extern __shared__ __attribute__((aligned(16))) unsigned char lds_raw[];
    LAS unsigned char* lds = (LAS unsigned char*)lds_raw;
    {
        volatile LAS unsigned* MISC = (volatile LAS unsigned*)(lds + MISC_OFF);
        for (int u = threadIdx.x; u < (LDS_BYTES - MISC_OFF) / 4; u += 512) MISC[u] = 0u;
        __syncthreads();
    }
#if MK_SINGLE
    XcdBarrier bar = xcd_barrier_post((unsigned*)(args.ws + WS_CTL) + CW_BAR, (volatile LAS unsigned*)(lds + MISC_OFF) + 8);
#define GRID_BAR() xcd_barrier(bar)
#else
#define GRID_BAR() do {} while (0)
#endif
    const int lo = args.lo, hi = args.hi;
    int step = 0;
#define RUN(k) (lo <= (k) && (k) < hi)
#define SEAM(k) do { if (RUN((k) + 1)) GRID_BAR(); } while (0)
#define PHASE_ENTER() int tid = threadIdx.x; asm volatile("" : "+v"(tid)); int bx = blockIdx.x; asm volatile("" : "+s"(bx)); int G = gridDim.x; asm volatile("" : "+s"(G)); const int NGW = G * 8; (void)NGW; \
    const int lane = tid & 63, wave = __builtin_amdgcn_readfirstlane(tid >> 6), gw = bx * 8 + wave; \
    const CAS Args* ap = (const CAS Args*)__builtin_amdgcn_kernarg_segment_ptr(); asm volatile("" : "+s"(ap)); \
    unsigned char* ws = ap->ws; float* out = ap->out; (void)lane; (void)gw; (void)out; \
    bf16* const H = (bf16*)(ws + WS_H); bf16* const P = (bf16*)(ws + WS_P); float* const Y = (float*)(ws + WS_P); bf16* const GT = (bf16*)(ws + WS_G); bf16* const O = (bf16*)(ws + WS_O); bf16* const HID = (bf16*)(ws + WS_G); \
    (void)H; (void)P; (void)Y; (void)GT; (void)O; (void)HID

    for (int l = 0; l < DEPTH; ++l) {
        { const int k = step++; if (RUN(k) && ((PH_MASK >> 0) & 1)) { PHASE_ENTER(); phase_weights(ap, ws, l, lds, gw, NGW, wave, lane); SEAM(k); } }
        for (int c = 0; c < NCHUNK; ++c) {
            const int row0 = c * TC;
            { const int k = step++; if (RUN(k) && ((PH_MASK >> 1) & 1)) { PHASE_ENTER();
                const float* g = ap->in[2] + (size_t)l * DM;
                for (int m = gw; m < TC; m += NGW) { const int row = row0 + m; const float* xr = (l == 0) ? x_in_row(ap->in[0], ap->in[1], row) : out + (size_t)row * DM; norm_row_to_bf16(xr, g, H + (size_t)m * DM, lane); }
                SEAM(k); } }
            { const int k = step++; if (RUN(k) && ((PH_MASK >> 2) & 1)) { PHASE_ENTER();
                pg8::Gemm g{H, (bf16*)(ws + WS_WIN), DM}; pg8::StaticOrder S; S.init(TC, INW, G, bx); pg8::EpiIn E{P, GT};
                pg8::gemm_phase<pg8::EpiIn, pg8::StaticOrder>(lds, g, S, E);
                SEAM(k); } }
            { const int k = step++; if (RUN(k) && ((PH_MASK >> 3) & 1)) { PHASE_ENTER();
                const float* qn = ap->in[7] + (size_t)l * HD; const float* kn = ap->in[8] + (size_t)l * HD;
                for (int m = gw; m < TC; m += NGW) rope_token(P + (size_t)m * PWD, m & (SEQ - 1), qn, kn, lane);
                CParams cp{ap->in[10] + (size_t)l * 4 * MWD, ap->in[11] + (size_t)l * MWD, ap->in[13] + (size_t)l * 2 * MWD, ap->in[15] + (size_t)l * 2 * MWD, ap->in[16] + (size_t)l * 2 * MWD, (bf16*)(ws + WS_WG)};
                for (int u = bx; u < 2 * NTCH * 8; u += G) { const int nb = u & 7, tc = (u >> 3) & (NTCH - 1), seq = u >> 11; c_unit<1>(lds, P, nullptr, cp, (f32x2*)(ws + WS_SUM), (float*)(ws + WS_CAR), seq, tc, nb); }
                SEAM(k); } }
            { const int k = step++; if (RUN(k) && ((PH_MASK >> 4) & 1)) { PHASE_ENTER(); phase_c2(lds, (f32x2*)(ws + WS_SUM), (float*)(ws + WS_CAR), G, bx); SEAM(k); } }
            { const int k = step++; if (RUN(k) && ((PH_MASK >> 5) & 1)) {
                if (SUBMASK & 1) { PHASE_ENTER(); const int xcd = bx & 7, rank = bx >> 3, nrank = G >> 3; for (int i = rank; i < 64; i += nrank) {
                    const int seq = xcd >> 2, kvh = (xcd >> 1) & 1, head = kvh * 4 + (xcd & 1) * 2 + (i >> 5), qb = i & 31;
                    const bf16* Qb = P + (size_t)(seq * SEQ + qb * 256) * PWD + QA_OFF + head * HD;
                    const bf16* Kh = P + (size_t)(seq * SEQ) * PWD + KA_OFF + kvh * HD; const bf16* Vh = P + (size_t)(seq * SEQ) * PWD + VA_OFF + kvh * HD;
                    att::attn_unit<0, SD_A>(Qb, Kh, Vh, O + (size_t)(seq * SEQ + qb * 256) * MWD + head * HD, SEQ / 64, 0, 0.f, (char*)lds_raw);
                } }
                if (SUBMASK & 2) { PHASE_ENTER(); const int xcd = bx & 7, rank = bx >> 3, nrank = G >> 3; for (int i = rank; i < 64; i += nrank) {
                    const int seq = xcd >> 2, kvh = (xcd >> 1) & 1, head = kvh * 4 + (xcd & 1) * 2 + (i >> 5), qb = i & 31;
                    const int k0 = (qb == 0) ? 0 : qb * 256 - 128, k1 = (qb == 31) ? SEQ : qb * 256 + 384;
                    const bf16* Qb = P + (size_t)(seq * SEQ + qb * 256) * PWD + QB_OFF + head * HD;
                    const bf16* Kh = P + (size_t)(seq * SEQ + k0) * PWD + KB_OFF + kvh * HD; const bf16* Vh = P + (size_t)(seq * SEQ + k0) * PWD + VB_OFF + kvh * HD;
                    att::attn_unit<1, SD_B>(Qb, Kh, Vh, O + (size_t)TC * MWD + (size_t)(seq * SEQ + qb * 256) * MWD + head * HD, (k1 - k0) / 64, qb * 256 - k0, ap->in[9][l * 8 + head], (char*)lds_raw);
                } }
                if (SUBMASK & 4) { PHASE_ENTER();
                CParams cp{ap->in[10] + (size_t)l * 4 * MWD, ap->in[11] + (size_t)l * MWD, ap->in[13] + (size_t)l * 2 * MWD, ap->in[15] + (size_t)l * 2 * MWD, ap->in[16] + (size_t)l * 2 * MWD, (bf16*)(ws + WS_WG)};
                for (int u = bx; u < 2 * NTCH * 8; u += G) { const int nb = u & 7, tc = (u >> 3) & (NTCH - 1), seq = u >> 11; c_unit<3>(lds, P, O + (size_t)2 * TC * MWD, cp, (f32x2*)(ws + WS_SUM), (float*)(ws + WS_CAR), seq, tc, nb); } }
                SEAM(k); } }
            { const int k = step++; if (RUN(k) && ((PH_MASK >> 6) & 1)) { PHASE_ENTER();
                pg8::Gemm g{O, (bf16*)(ws + WS_WBR), MWD}; pg8::BranchOrder S; S.base.init(TC, DM, G, bx); S.npanel = TC / 256;
                pg8::EpiBr E{GT, H, (float*)(ws + WS_BRS) + (size_t)bx * 65536};
                pg8::gemm_phase<pg8::EpiBr, pg8::BranchOrder>(lds, g, S, E);
                SEAM(k); } }
            { const int k = step++; if (RUN(k) && ((PH_MASK >> 7) & 1)) { PHASE_ENTER();
                pg8::Gemm g{H, (bf16*)(ws + WS_WOUT), DM}; pg8::StaticOrder S; S.init(TC, DM, G, bx); pg8::EpiF32 E{Y, DM};
                pg8::gemm_phase<pg8::EpiF32, pg8::StaticOrder>(lds, g, S, E);
                SEAM(k); } }
            { const int k = step++; if (RUN(k) && ((PH_MASK >> 8) & 1)) { PHASE_ENTER();
                const float* g1 = ap->in[3] + (size_t)l * DM; const float* g2 = ap->in[4] + (size_t)l * DM;
                for (int m = gw; m < TC; m += NGW) { const int row = row0 + m; const float* xo = (l == 0) ? x_in_row(ap->in[0], ap->in[1], row) : out + (size_t)row * DM;
                    resid_norm_row<true>(Y + (size_t)m * DM, xo, out + (size_t)row * DM, g1, g2, H + (size_t)m * DM, lane); }
                SEAM(k); } }
            { const int k = step++; if (RUN(k) && ((PH_MASK >> 9) & 1)) { PHASE_ENTER();
                pg8::Gemm g{H, (bf16*)(ws + WS_W1), DM}; pg8::StaticOrder S; S.init(TC, FFD, G, bx); pg8::EpiRelu2 E{HID, FFD};
                pg8::gemm_phase<pg8::EpiRelu2, pg8::StaticOrder>(lds, g, S, E);
                SEAM(k); } }
            { const int k = step++; if (RUN(k) && ((PH_MASK >> 10) & 1)) { PHASE_ENTER();
                pg8::Gemm g{HID, (bf16*)(ws + WS_W2), FFD}; pg8::StaticOrder S; S.init(TC, DM, G, bx); pg8::EpiF32 E{Y, DM};
                pg8::gemm_phase<pg8::EpiF32, pg8::StaticOrder>(lds, g, S, E);
                SEAM(k); } }
            { const int k = step++; if (RUN(k) && ((PH_MASK >> 11) & 1)) { PHASE_ENTER();
                const float* g1 = ap->in[5] + (size_t)l * DM;
                for (int m = gw; m < TC; m += NGW) { const int row = row0 + m; resid_norm_row<false>(Y + (size_t)m * DM, out + (size_t)row * DM, out + (size_t)row * DM, g1, nullptr, nullptr, lane); }
                SEAM(k); } }
        }
    }
#undef RUN
#undef SEAM
}
constexpr int NSTEPS = DEPTH * (1 + NCHUNK * 11);

extern "C" void kernel_launch(void* const* d_in, const int* in_sizes, int n_in, void* d_out, int out_size, void* d_ws, size_t ws_size, hipStream_t stream) {
    static int grid = 0;
    if (grid == 0) {
        if (n_in != 21 || out_size != NTOK * DM || ws_size < WS_END) { fprintf(stderr, "kernel_launch: unexpected shapes (n_in %d out %d ws %zu)\n", n_in, out_size, ws_size); grid = -1; return; }
        int dev = 0, cus = 0, per_cu = 0;
        if (hipGetDevice(&dev) != hipSuccess || hipDeviceGetAttribute(&cus, hipDeviceAttributeMultiprocessorCount, dev) != hipSuccess) { grid = -1; return; }
        if (hipFuncSetAttribute((const void*)mk_fwd, hipFuncAttributeMaxDynamicSharedMemorySize, LDS_BYTES) != hipSuccess) { fprintf(stderr, "kernel_launch: hipFuncSetAttribute failed\n"); grid = -1; return; }
        if (hipOccupancyMaxActiveBlocksPerMultiprocessor(&per_cu, (const void*)mk_fwd, 512, LDS_BYTES) != hipSuccess || per_cu < 1) { fprintf(stderr, "kernel_launch: occupancy query says %d\n", per_cu); }
        (void)hipGetLastError();
        grid = cus;
    }
    if (grid < 0) return;
    if (hipMemsetAsync((char*)d_ws + WS_CTL, 0, CTL_ZERO_BYTES, stream) != hipSuccess) return;
    Args a{};
    for (int i = 0; i < 21; ++i) a.in[i] = (const float*)d_in[i];
    a.out = (float*)d_out; a.ws = (unsigned char*)d_ws;
#if MK_SINGLE
    a.lo = 0; a.hi = NSTEPS;
    hipLaunchKernelGGL(mk_fwd, dim3(grid), dim3(512), LDS_BYTES, stream, a);
#else
    for (int s = 0; s < NSTEPS; ++s) { a.lo = s; a.hi = s + 1; hipLaunchKernelGGL(mk_fwd, dim3(grid), dim3(512), LDS_BYTES, stream, a); }
#endif
    const hipError_t le = hipPeekAtLastError();
    if (le != hipSuccess) fprintf(stderr, "kernel_launch: launch failed: %s\n", hipGetErrorName(le));
}
```

```cpp
#include <hip/hip_runtime.h>
#include <cstdio>
#include <cstdint>

#ifndef PH_MASK
#define PH_MASK 0xFFF
#endif
#ifndef SUBMASK
#define SUBMASK 7
#endif
#ifndef SD_A
#define SD_A 2
#endif
#ifndef SD_B
#define SD_B 1
#endif
#ifndef DUP_MASK
#define DUP_MASK 0
#endif
#define NREP(i) (1 + ((DUP_MASK >> (i)) & 1))
#ifndef MK_SINGLE
#define MK_SINGLE 1
#endif

#define LAS __attribute__((address_space(3)))
#define GAS __attribute__((address_space(1)))
#define CAS __attribute__((address_space(4)))
typedef unsigned short bf16;
typedef short bf16x8 __attribute__((ext_vector_type(8)));
typedef short s16x4 __attribute__((ext_vector_type(4)));
typedef float f32x4 __attribute__((ext_vector_type(4)));
typedef float f32x2 __attribute__((ext_vector_type(2)));
typedef float f32x16 __attribute__((ext_vector_type(16)));
typedef unsigned u32x4 __attribute__((ext_vector_type(4)));
typedef unsigned u32x2 __attribute__((ext_vector_type(2)));

constexpr int DM = 2048, SEQ = 8192, NTOK = 49152, TC = 16384, NCHUNK = 3, DEPTH = 4;
constexpr int INW = 11264, PWD = 5120, GWD = 6144, FFD = 8192, MWD = 1024, HD = 128;
constexpr int QA_OFF = 0, KA_OFF = 1024, VA_OFF = 1280, QB_OFF = 1536, KB_OFF = 2560, VB_OFF = 2816, XC_OFF = 3072, YC_OFF = 4096;
constexpr int NPROMPT_TOK = 32768;
constexpr float EPS = 1e-6f;
constexpr int LC = 32, NTCH = SEQ / LC;

constexpr size_t MiB = 1u << 20;
constexpr size_t WS_CTL = 0, CTL_ZERO_BYTES = 1 * MiB;
constexpr size_t WS_WIN = 2 * MiB;
constexpr size_t WS_WBR = 46 * MiB;
constexpr size_t WS_WOUT = 58 * MiB;
constexpr size_t WS_W1 = 66 * MiB;
constexpr size_t WS_W2 = 98 * MiB;
constexpr size_t WS_WG = 130 * MiB;
constexpr size_t WS_SUM = 131 * MiB;
constexpr size_t WS_CAR = 139 * MiB;
constexpr size_t WS_BRS = 143 * MiB;
constexpr size_t WS_H = 727 * MiB;
constexpr size_t WS_P = 271 * MiB;
constexpr size_t WS_G = 431 * MiB;
constexpr size_t WS_O = 623 * MiB;
constexpr size_t WS_TAB1 = 719 * MiB;
constexpr size_t WS_TABA = 723 * MiB;
constexpr size_t WS_END = 919 * MiB;
constexpr int CW_BAR = 4096;

constexpr int LDS_BYTES = 147456;
constexpr int MISC_OFF = 143360;

__device__ __forceinline__ unsigned cvt_pk_bf16(float lo, float hi) { unsigned r; asm volatile("v_cvt_pk_bf16_f32 %0, %1, %2" : "=v"(r) : "v"(lo), "v"(hi)); return r; }
__device__ __forceinline__ float bf_lo(unsigned w) { return __uint_as_float(w << 16); }
__device__ __forceinline__ float bf_hi(unsigned w) { return __uint_as_float(w & 0xffff0000u); }
__device__ __forceinline__ float bf2f(bf16 b) { return __uint_as_float(((unsigned)b) << 16); }
__device__ __forceinline__ float fast_sigmoid(float v) { return __builtin_amdgcn_rcpf(1.0f + __builtin_amdgcn_exp2f(-1.4426950408889634f * v)); }
__device__ __forceinline__ float wave_sum(float v, int lane) {
#pragma unroll
    for (int o = 1; o < 64; o <<= 1) v += __int_as_float(__builtin_amdgcn_ds_bpermute((lane ^ o) << 2, __float_as_int(v)));
    return v;
}

__device__ const double ROPE_F1[64] = {
1.59154943091895346e-01, 1.37822502603982849e-01, 1.19349370211248862e-01, 1.03352296618434064e-01, 8.94994016088910133e-02, 7.75032887553740585e-02, 6.71150830052272551e-02, 5.81192674418762462e-02,
5.03292121044697269e-02, 4.35833029420947638e-02, 3.77415888468699103e-02, 3.26828760272190911e-02, 2.83022152813622411e-02, 2.45087241866802648e-02, 2.12237020815031856e-02, 1.83789966569160986e-02,
1.59154943091895339e-02, 1.37822502603982842e-02, 1.19349370211248869e-02, 1.03352296618434060e-02, 8.94994016088910202e-03, 7.75032887553740654e-03, 6.71150830052272551e-03, 5.81192674418762427e-03,
5.03292121044697286e-03, 4.35833029420947656e-03, 3.77415888468699086e-03, 3.26828760272190893e-03, 2.83022152813622403e-03, 2.45087241866802661e-03, 2.12237020815031847e-03, 1.83789966569160995e-03,
1.59154943091895335e-03, 1.37822502603982846e-03, 1.19349370211248865e-03, 1.03352296618434069e-03, 8.94994016088910115e-04, 7.75032887553740654e-04, 6.71150830052272508e-04, 5.81192674418762427e-04,
5.03292121044697243e-04, 4.35833029420947678e-04, 3.77415888468699086e-04, 3.26828760272190871e-04, 2.83022152813622381e-04, 2.45087241866802661e-04, 2.12237020815031847e-04, 1.83789966569160984e-04,
1.59154943091895346e-04, 1.37822502603982835e-04, 1.19349370211248871e-04, 1.03352296618434063e-04, 8.94994016088910088e-05, 7.75032887553740654e-05, 6.71150830052272508e-05, 5.81192674418762400e-05,
5.03292121044697243e-05, 4.35833029420947644e-05, 3.77415888468699120e-05, 3.26828760272190871e-05, 2.83022152813622381e-05, 2.45087241866802641e-05, 2.12237020815031861e-05, 1.83789966569160984e-05 };
__device__ const double ROPE_FA[32] = {
1.59154943091895346e-01, 1.19349370211248862e-01, 8.94994016088910133e-02, 6.71150830052272551e-02, 5.03292121044697269e-02, 3.77415888468699103e-02, 2.83022152813622411e-02, 2.12237020815031856e-02,
1.59154943091895339e-02, 1.19349370211248869e-02, 8.94994016088910202e-03, 6.71150830052272551e-03, 5.03292121044697286e-03, 3.77415888468699086e-03, 2.83022152813622403e-03, 2.12237020815031847e-03,
1.59154943091895335e-03, 1.19349370211248865e-03, 8.94994016088910115e-04, 6.71150830052272508e-04, 5.03292121044697243e-04, 3.77415888468699086e-04, 2.83022152813622381e-04, 2.12237020815031847e-04,
1.59154943091895346e-04, 1.19349370211248871e-04, 8.94994016088910088e-05, 6.71150830052272508e-05, 5.03292121044697243e-05, 3.77415888468699120e-05, 2.83022152813622381e-05, 2.12237020815031861e-05 };

namespace pg8 {
typedef unsigned short bf16_t;
constexpr int BM = 256, BK = 64, HALF = 128, HTB = HALF * BK * 2, STAGE_BYTES = 8 * HTB, NXCD = 8, WGM = 8;
__host__ __device__ __forceinline__ int lds_byte(int r, int c) { const int st = (r >> 4) * 2 + (c >> 5), rr = r & 15, cc = c & 31, ob = rr * 64 + cc * 2; return st * 1024 + (ob ^ (((ob >> 9) & 1) << 5)); }
__host__ __device__ __forceinline__ void stage_rc(int b, int& R, int& C) { const int st = b / 1024, sb = b % 1024, swz = sb ^ (((sb >> 9) & 1) << 5); R = (st >> 1) * 16 + swz / 64; C = (st & 1) * 32 + (swz % 64) / 2; }
__host__ __device__ __forceinline__ int perm32(int rho) { const int n = rho >> 4, i = rho & 15; return 8 * (i >> 2) + 4 * n + (i & 3); }

struct Unit { int pm, pn, ka, kb, sub; };
struct Gemm { const bf16_t* A; const bf16_t* Bt; int K; };

struct StaticOrder {
    int nM, nN, nwg, G, c;
    __device__ void init(int M, int N, int G_, int c_) { nM = M / BM; nN = N / BM; nwg = nM * nN; G = G_; c = c_; }
    __device__ bool next(int i, Unit& u) const {
        const long L = (long)i * G + c; if (L >= nwg) return false;
        int wgid = (int)L; { const int q = nwg / NXCD, r = nwg % NXCD, xcd = wgid % NXCD, off = wgid / NXCD; wgid = (xcd < r ? xcd * (q + 1) : r * (q + 1) + (xcd - r) * q) + off; }
        const int nig = WGM * nN, gid = wgid / nig, fm = gid * WGM, gsz = (nM - fm) < WGM ? (nM - fm) : WGM;
        u.pm = fm + ((wgid % nig) % gsz); u.pn = (wgid % nig) / gsz; u.ka = u.pm; u.kb = u.pn; u.sub = 0; return true;
    }
};
struct BranchOrder {
    StaticOrder base; int npanel;
    __device__ bool next(int i, Unit& u) const {
        const int t = i / 3, s = i - 3 * t; if (!base.next(t, u)) return false;
        u.sub = s; u.ka = s * npanel + u.pm; u.kb = s * 8 + u.pn; return true;
    }
};

struct EpiIn {
    static constexpr bool PERM = true;
    bf16_t* P; bf16_t* G;
    __device__ __forceinline__ void operator()(const f32x4 (&acc)[2][2][4][2], const Unit& u, int wr, int wc, int fr_, int fq) const {
        int fr = fr_; asm volatile("" : "+v"(fr));
        const int row0 = u.pm * BM + wr * 64 + fr; const bool gate = u.pn >= 20;
        bf16_t* base = gate ? G : P; const int ldc = gate ? GWD : PWD; const int col0 = (gate ? u.pn - 20 : u.pn) * BM + wc * 32 + 8 * fq;
#pragma unroll
        for (int ai = 0; ai < 2; ++ai)
#pragma unroll
            for (int m = 0; m < 4; ++m) { bf16_t* rowp = base + (size_t)(row0 + ai * HALF + m * 16) * ldc + col0;
#pragma unroll
                for (int bj = 0; bj < 2; ++bj) { f32x4 v0 = acc[ai][bj][m][0], v1 = acc[ai][bj][m][1];
                    if (gate) {
#pragma unroll
                        for (int j = 0; j < 4; ++j) { v0[j] = fast_sigmoid(v0[j]); v1[j] = fast_sigmoid(v1[j]); } }
                    u32x4 w; w.x = cvt_pk_bf16(v0[0], v0[1]); w.y = cvt_pk_bf16(v0[2], v0[3]); w.z = cvt_pk_bf16(v1[0], v1[1]); w.w = cvt_pk_bf16(v1[2], v1[3]);
                    *(u32x4*)(rowp + bj * HALF) = w; } }
    }
};
struct EpiBr {
    static constexpr bool PERM = true;
    const bf16_t* G; bf16_t* OUT; float* scratch;
    __device__ __forceinline__ void operator()(const f32x4 (&acc)[2][2][4][2], const Unit& u, int wr, int wc, int fr_, int fq) const {
        int fr = fr_; asm volatile("" : "+v"(fr));
        const int row0 = u.pm * BM + wr * 64 + fr, col0 = u.pn * BM + wc * 32 + 8 * fq; const int sub = u.sub;
        GAS f32x4* sp = (GAS f32x4*)scratch + ((wr * 4 + wc) * 64 + fq * 16 + fr);
#pragma unroll
        for (int ai = 0; ai < 2; ++ai)
#pragma unroll
            for (int m = 0; m < 4; ++m) { const size_t row = (size_t)(row0 + ai * HALF + m * 16);
#pragma unroll
                for (int bj = 0; bj < 2; ++bj) { const int idx = (((ai * 4 + m) * 2 + bj) * 2) * 512;
                    const u32x4 gw = *(const u32x4*)(G + row * GWD + sub * DM + col0 + bj * HALF);
                    f32x4 v0 = acc[ai][bj][m][0] * (f32x4){bf_lo(gw.x), bf_hi(gw.x), bf_lo(gw.y), bf_hi(gw.y)};
                    f32x4 v1 = acc[ai][bj][m][1] * (f32x4){bf_lo(gw.z), bf_hi(gw.z), bf_lo(gw.w), bf_hi(gw.w)};
                    if (sub > 0) { v0 += sp[idx]; v1 += sp[idx + 512]; }
                    if (sub < 2) { sp[idx] = v0; sp[idx + 512] = v1; }
                    else { u32x4 w; w.x = cvt_pk_bf16(v0[0], v0[1]); w.y = cvt_pk_bf16(v0[2], v0[3]); w.z = cvt_pk_bf16(v1[0], v1[1]); w.w = cvt_pk_bf16(v1[2], v1[3]);
                        *(u32x4*)(OUT + row * DM + col0 + bj * HALF) = w; } }
                asm volatile("" ::: "memory"); }
    }
};
struct EpiF32 {
    static constexpr bool PERM = false;
    float* C; int ldc;
    __device__ __forceinline__ void operator()(const f32x4 (&acc)[2][2][4][2], const Unit& u, int wr, int wc, int fr_, int fq) const {
        int fr = fr_; asm volatile("" : "+v"(fr));
        const int row0 = u.pm * BM + wr * 64 + fr, col0 = u.pn * BM + wc * 32 + 4 * fq;
#pragma unroll
        for (int ai = 0; ai < 2; ++ai)
#pragma unroll
            for (int m = 0; m < 4; ++m) { float* rowp = C + (size_t)(row0 + ai * HALF + m * 16) * ldc + col0;
#pragma unroll
                for (int bj = 0; bj < 2; ++bj)
#pragma unroll
                    for (int n = 0; n < 2; ++n) *(f32x4*)(rowp + bj * HALF + n * 16) = acc[ai][bj][m][n]; }
    }
};
struct EpiRelu2 {
    static constexpr bool PERM = true;
    bf16_t* O; int ldc;
    __device__ __forceinline__ void operator()(const f32x4 (&acc)[2][2][4][2], const Unit& u, int wr, int wc, int fr_, int fq) const {
        int fr = fr_; asm volatile("" : "+v"(fr));
        const int row0 = u.pm * BM + wr * 64 + fr, col0 = u.pn * BM + wc * 32 + 8 * fq;
#pragma unroll
        for (int ai = 0; ai < 2; ++ai)
#pragma unroll
            for (int m = 0; m < 4; ++m) { bf16_t* rowp = O + (size_t)(row0 + ai * HALF + m * 16) * ldc + col0;
#pragma unroll
                for (int bj = 0; bj < 2; ++bj) { f32x4 v0 = acc[ai][bj][m][0], v1 = acc[ai][bj][m][1];
#pragma unroll
                    for (int j = 0; j < 4; ++j) { const float a = fmaxf(v0[j], 0.f), b = fmaxf(v1[j], 0.f); v0[j] = a * a; v1[j] = b * b; }
                    u32x4 w; w.x = cvt_pk_bf16(v0[0], v0[1]); w.y = cvt_pk_bf16(v0[2], v0[3]); w.z = cvt_pk_bf16(v1[0], v1[1]); w.w = cvt_pk_bf16(v1[2], v1[3]);
                    *(u32x4*)(rowp + bj * HALF) = w; } }
    }
};

template <class Epi, class Sched, bool ALIGN_EPI = true>
__device__ __forceinline__ void gemm_phase(LAS unsigned char* lds, const Gemm g, const Sched& S, const Epi& E) {
    int tid_ = threadIdx.x; asm volatile("" : "+v"(tid_));
    const int tid = tid_, wid = __builtin_amdgcn_readfirstlane(tid >> 6), lane = tid & 63, wr = wid >> 2, wc = wid & 3, fr = lane & 15, fq = lane >> 4;
    const int K = g.K, nt = K / BK;
    unsigned voffA[2], voffB[2];
#pragma unroll
    for (int i = 0; i < 2; ++i) { int R, C; stage_rc(tid * 16 + i * 8192, R, C); const int Rb = Epi::PERM ? ((R & ~31) + perm32(R & 31)) : R;
        voffA[i] = (unsigned)(R * K + C) * 2u; voffB[i] = (unsigned)(Rb * K + C) * 2u; }
    const size_t kstep = (size_t)(BK * 2);
    const size_t hstep = (size_t)HALF * K * 2;
    const size_t tstep = 2 * hstep;
    const unsigned ldsw = (unsigned)wid * 1024u;
    const int aoff = lds_byte(wr * 64 + fr, fq * 8), boff = lds_byte(wc * 32 + fr, fq * 8);
#define PG8_SA(b, h) (((b) * 2 + (h)) * HTB)
#define PG8_SB(b, h) ((4 + (b) * 2 + (h)) * HTB)
#define PG8_STAGE(bufoff, gbase, voff) do { _Pragma("unroll") for (int _i = 0; _i < 2; ++_i) \
        __builtin_amdgcn_global_load_lds((const unsigned*)((const char*)(gbase) + (voff)[_i]), (LAS unsigned*)(lds + (bufoff) + ldsw + _i * 8192), 16, 0, 0); } while (0)
#define PG8_LDA(dst, b, h) do { _Pragma("unroll") for (int m = 0; m < 4; ++m) _Pragma("unroll") for (int k = 0; k < 2; ++k) dst[m][k] = *(const LAS bf16x8*)(lds + PG8_SA(b, h) + aoff + m * 2048 + k * 1024); } while (0)
#define PG8_LDB(dst, b, h) do { _Pragma("unroll") for (int n = 0; n < 2; ++n) _Pragma("unroll") for (int k = 0; k < 2; ++k) dst[n][k] = *(const LAS bf16x8*)(lds + PG8_SB(b, h) + boff + n * 2048 + k * 1024); } while (0)
#define PG8_MMA(ai, bj, At, Bt) do { __builtin_amdgcn_s_setprio(1); _Pragma("unroll") for (int m = 0; m < 4; ++m) _Pragma("unroll") for (int n = 0; n < 2; ++n) _Pragma("unroll") for (int k = 0; k < 2; ++k) \
        acc[ai][bj][m][n] = __builtin_amdgcn_mfma_f32_16x16x32_bf16(Bt[n][k], At[m][k], acc[ai][bj][m][n], 0, 0, 0); __builtin_amdgcn_s_setprio(0); } while (0)
#define PG8_WAIT_V(n) asm volatile("s_waitcnt vmcnt(" #n ")" ::: "memory")
#define PG8_WAIT_L(n) asm volatile("s_waitcnt lgkmcnt(" #n ")" ::: "memory")
#define PG8_BAR __builtin_amdgcn_s_barrier()
#define PG8_SCHED __builtin_amdgcn_sched_barrier(0)
    Unit cur, nxt; int ui = 0;
    if (!S.next(0, cur)) return;
    f32x4 acc[2][2][4][2];
#pragma unroll
    for (int a = 0; a < 2; ++a)
#pragma unroll
        for (int b = 0; b < 2; ++b)
#pragma unroll
            for (int m = 0; m < 4; ++m)
#pragma unroll
                for (int n = 0; n < 2; ++n) acc[a][b][m][n] = (f32x4){0.f, 0.f, 0.f, 0.f};
    bf16x8 At[4][2], B0[2][2], B1[2][2];
    const char* cA = (const char*)g.A + (size_t)cur.ka * tstep; const char* cB = (const char*)g.Bt + (size_t)cur.kb * tstep;
    PG8_STAGE(PG8_SB(0, 0), cB, voffB); PG8_STAGE(PG8_SB(0, 1), cB + hstep, voffB); PG8_STAGE(PG8_SA(0, 0), cA, voffA); PG8_STAGE(PG8_SA(0, 1), cA + hstep, voffA);
    if (wr == 1) PG8_BAR;
    PG8_WAIT_V(2); PG8_BAR;
    PG8_STAGE(PG8_SB(1, 0), cB + kstep, voffB); PG8_STAGE(PG8_SA(1, 0), cA + kstep, voffA); PG8_STAGE(PG8_SB(1, 1), cB + hstep + kstep, voffB);
    PG8_WAIT_V(6); PG8_BAR;
    for (;;) {
        const bool has_next = S.next(ui + 1, nxt);
        const char* nA = has_next ? (const char*)g.A + (size_t)nxt.ka * tstep : cA; const char* nB = has_next ? (const char*)g.Bt + (size_t)nxt.kb * tstep : cB;
        for (int t = 0; t < nt; t += 2) {
            const bool last = (t == nt - 2);
            const char* a1 = cA + (size_t)(t + 1) * kstep;
            const char* a2 = last ? nA : cA + (size_t)(t + 2) * kstep; const char* b2 = last ? nB : cB + (size_t)(t + 2) * kstep;
            const char* a3 = a2 + kstep; const char* b3 = b2 + kstep;
            PG8_LDB(B0, 0, 0); PG8_LDB(B1, 0, 1); PG8_SCHED; PG8_LDA(At, 0, 0); PG8_STAGE(PG8_SA(1, 1), a1 + hstep, voffA);
            PG8_WAIT_V(8); PG8_WAIT_L(0); PG8_BAR; PG8_MMA(0, 0, At, B0); PG8_MMA(0, 1, At, B1); PG8_BAR; PG8_SCHED;
            PG8_LDA(At, 0, 1); PG8_STAGE(PG8_SB(0, 0), b2, voffB); PG8_STAGE(PG8_SB(0, 1), b2 + hstep, voffB); PG8_STAGE(PG8_SA(0, 0), a2, voffA);
            PG8_WAIT_V(8); PG8_WAIT_L(0); PG8_BAR; PG8_MMA(1, 0, At, B0); PG8_MMA(1, 1, At, B1); PG8_BAR; PG8_SCHED;
            PG8_LDB(B0, 1, 0); PG8_LDB(B1, 1, 1); PG8_SCHED; PG8_LDA(At, 1, 0); PG8_STAGE(PG8_SA(0, 1), a2 + hstep, voffA);
            PG8_WAIT_V(8); PG8_WAIT_L(0); PG8_BAR; PG8_MMA(0, 0, At, B0); PG8_MMA(0, 1, At, B1); PG8_BAR; PG8_SCHED;
            PG8_LDA(At, 1, 1); PG8_STAGE(PG8_SB(1, 0), b3, voffB); PG8_STAGE(PG8_SB(1, 1), b3 + hstep, voffB); PG8_STAGE(PG8_SA(1, 0), a3, voffA);
            PG8_WAIT_V(8); PG8_WAIT_L(0); PG8_BAR; PG8_MMA(1, 0, At, B0); PG8_MMA(1, 1, At, B1); PG8_BAR; PG8_SCHED;
        }
        if constexpr (ALIGN_EPI) { if (wr == 0) PG8_BAR; }
        E(acc, cur, wr, wc, fr, fq);
        if (!has_next) break;
#pragma unroll
        for (int a = 0; a < 2; ++a)
#pragma unroll
            for (int b = 0; b < 2; ++b)
#pragma unroll
                for (int m = 0; m < 4; ++m)
#pragma unroll
                    for (int n = 0; n < 2; ++n) acc[a][b][m][n] = (f32x4){0.f, 0.f, 0.f, 0.f};
        cur = nxt; cA = nA; cB = nB; ++ui;
        if constexpr (ALIGN_EPI) { if (wr == 1) PG8_BAR; }
    }
    PG8_WAIT_V(0);
    if constexpr (!ALIGN_EPI) { if (wr == 0) PG8_BAR; }
    PG8_BAR;
#undef PG8_SA
#undef PG8_SB
#undef PG8_STAGE
#undef PG8_LDA
#undef PG8_LDB
#undef PG8_MMA
#undef PG8_WAIT_V
#undef PG8_WAIT_L
#undef PG8_BAR
#undef PG8_SCHED
}
}

namespace att {
constexpr int D = 128, NW = 8, QBLK = 32, KVBLK = 64;
constexpr float SCALE = 0.088388347648318440f;
constexpr float THR = 8.f;
constexpr int LDQ = PWD, LDK = PWD, LDO = MWD;
constexpr int SHM_V = KVBLK * D * 2, SHM_K = KVBLK * D * 2;
constexpr int OST_PITCH = 272;
constexpr int OST_OFF = 2 * SHM_V + 2 * SHM_K + NW * 64 * 4;
constexpr int ATT_LDS = OST_OFF + NW * 32 * OST_PITCH;
#define KSWZ(row, colB) ((row) * 256 + ((colB) ^ (((row) & 7) << 4)))
#define SBAR() __builtin_amdgcn_sched_barrier(0)
__device__ __forceinline__ int crow(int r, int hi) { return (r & 3) + 8 * (r >> 2) + 4 * hi; }

template <bool MASKED>
__device__ __forceinline__ void partialSM(f32x16& p0, f32x16& p1, float& m_reg, float& mn, float& alpha, int mbase) {
  constexpr float C = SCALE * 1.4426950408889634f;
  if constexpr (MASKED) {
    const float ninf = -__builtin_inff();
#pragma unroll
    for (int r = 0; r < 16; ++r) { const int c = (r & 3) + 8 * (r >> 2);
      p0[r] = ((unsigned)(mbase - c) <= 256u) ? p0[r] : ninf;
      p1[r] = ((unsigned)(mbase - c - 32) <= 256u) ? p1[r] : ninf; }
  }
  float pmax = p0[0];
#pragma unroll
  for (int r = 1; r < 16; ++r) pmax = fmaxf(pmax, p0[r]);
#pragma unroll
  for (int r = 0; r < 16; ++r) pmax = fmaxf(pmax, p1[r]);
  { auto rr = __builtin_amdgcn_permlane32_swap(__float_as_uint(pmax), __float_as_uint(pmax), false, false);
    pmax = fmaxf(__uint_as_float(rr[0]), __uint_as_float(rr[1])); }
  if (__builtin_expect(__all(pmax - m_reg <= THR / SCALE), 1)) { mn = m_reg; alpha = 1.f; }
  else { mn = fmaxf(m_reg, pmax); alpha = __builtin_amdgcn_exp2f((m_reg - mn) * C); m_reg = mn; }
  float mnC = -mn * C;
#pragma unroll
  for (int r = 0; r < 16; ++r) p0[r] = fmaf(p0[r], C, mnC);
#pragma unroll
  for (int r = 0; r < 16; ++r) p1[r] = fmaf(p1[r], C, mnC);
#pragma unroll
  for (int r = 0; r < 16; ++r) p0[r] = __builtin_amdgcn_exp2f(p0[r]);
}
__device__ __forceinline__ void finishSM(f32x16& p0, f32x16& p1, float alpha, float& l_reg, bf16x8& pa0, bf16x8& pa1, bf16x8& pa2, bf16x8& pa3) {
#pragma unroll
  for (int r = 0; r < 16; ++r) p1[r] = __builtin_amdgcn_exp2f(p1[r]);
  float ps = 0;
#pragma unroll
  for (int r = 0; r < 16; ++r) ps += p0[r];
#pragma unroll
  for (int r = 0; r < 16; ++r) ps += p1[r];
  { auto rr = __builtin_amdgcn_permlane32_swap(__float_as_uint(ps), __float_as_uint(ps), false, false);
    ps = __uint_as_float(rr[0]) + __uint_as_float(rr[1]); }
  l_reg = l_reg * alpha + ps;
#define PK4(P, BASE, OUT) do { unsigned a0 = cvt_pk_bf16(P[BASE + 0], P[BASE + 1]), a1 = cvt_pk_bf16(P[BASE + 2], P[BASE + 3]);   \
    unsigned b0 = cvt_pk_bf16(P[BASE + 4], P[BASE + 5]), b1 = cvt_pk_bf16(P[BASE + 6], P[BASE + 7]);                              \
    auto r0 = __builtin_amdgcn_permlane32_swap(a0, b0, false, false); auto r1 = __builtin_amdgcn_permlane32_swap(a1, b1, false, false); \
    u32x4 w = {r0[0], r1[0], r0[1], r1[1]}; OUT = *reinterpret_cast<bf16x8*>(&w); } while (0)
  PK4(p0, 0, pa0); PK4(p0, 8, pa1); PK4(p1, 0, pa2); PK4(p1, 8, pa3);
#undef PK4
}
__device__ __forceinline__ void qkt(f32x16& p0, f32x16& p1, const bf16* Ks, const bf16x8* qr, int r32, int hi) {
  p0 = f32x16{}; p1 = f32x16{};
#pragma unroll
  for (int d0 = 0; d0 < 8; ++d0) { int cb = (d0 * 16 + hi * 8) * 2;
    bf16x8 b0 = *reinterpret_cast<const bf16x8*>((const char*)Ks + KSWZ(r32, cb));
    bf16x8 b1 = *reinterpret_cast<const bf16x8*>((const char*)Ks + KSWZ(32 + r32, cb));
    p0 = __builtin_amdgcn_mfma_f32_32x32x16_bf16(b0, qr[d0], p0, 0, 0, 0);
    p1 = __builtin_amdgcn_mfma_f32_32x32x16_bf16(b1, qr[d0], p1, 0, 0, 0); }
}
__device__ __forceinline__ int v_st(int k, int c) { const int kk = (k & ~0xC) | ((k & 4) << 1) | ((k & 8) >> 1); return ((kk >> 3) * 4 + (c >> 5)) * 512 + ((kk & 7) * 32 + (c & 31)) * 2; }
__device__ __forceinline__ int v_rd_base(int lane) { return ((lane & 3) << 3) | (((lane >> 2) & 3) << 6) | (((lane >> 4) & 1) << 5) | (((lane >> 5) & 1) << 8); }
constexpr int v_rd_off(int d0, int ks, int half) { return d0 * 512 + ks * 4096 + half * 2048; }
template <int OFF> __device__ __forceinline__ s16x4 tr_read(int vb) {
  s16x4 r; asm volatile("ds_read_b64_tr_b16 %0, %1 offset:%2" : "=&v"(r) : "v"(vb), "i"(OFF) : "memory"); return r;
}
template <int D0> __device__ __forceinline__ void pv_one(f32x16& od, int vb, bf16x8 pa0, bf16x8 pa1, bf16x8 pa2, bf16x8 pa3) {
  const s16x4 l0 = tr_read<v_rd_off(D0, 0, 0)>(vb), h0 = tr_read<v_rd_off(D0, 0, 1)>(vb), l1 = tr_read<v_rd_off(D0, 1, 0)>(vb), h1 = tr_read<v_rd_off(D0, 1, 1)>(vb);
  const s16x4 l2 = tr_read<v_rd_off(D0, 2, 0)>(vb), h2 = tr_read<v_rd_off(D0, 2, 1)>(vb), l3 = tr_read<v_rd_off(D0, 3, 0)>(vb), h3 = tr_read<v_rd_off(D0, 3, 1)>(vb);
  asm volatile("s_waitcnt lgkmcnt(0)" ::: "memory"); SBAR();
#define PK(L, H) (bf16x8){L[0], L[1], L[2], L[3], H[0], H[1], H[2], H[3]}
  od = __builtin_amdgcn_mfma_f32_32x32x16_bf16(pa0, PK(l0, h0), od, 0, 0, 0);
  od = __builtin_amdgcn_mfma_f32_32x32x16_bf16(pa1, PK(l1, h1), od, 0, 0, 0);
  od = __builtin_amdgcn_mfma_f32_32x32x16_bf16(pa2, PK(l2, h2), od, 0, 0, 0);
  od = __builtin_amdgcn_mfma_f32_32x32x16_bf16(pa3, PK(l3, h3), od, 0, 0, 0);
#undef PK
}
__device__ __forceinline__ void pv_d0(f32x16* o, int vb, bf16x8 pa0, bf16x8 pa1, bf16x8 pa2, bf16x8 pa3) {
  pv_one<0>(o[0], vb, pa0, pa1, pa2, pa3); pv_one<1>(o[1], vb, pa0, pa1, pa2, pa3); pv_one<2>(o[2], vb, pa0, pa1, pa2, pa3); pv_one<3>(o[3], vb, pa0, pa1, pa2, pa3);
}

template <int MODE, int SD>
__device__ __forceinline__ void attn_unit(const bf16* __restrict__ Qb, const bf16* __restrict__ Kh, const bf16* __restrict__ Vh, bf16* __restrict__ Ob, int NT, int dq0, float sink, char* lds,
                                          const f32x2* __restrict__ tab  , const float* __restrict__ gq  ) {
  int tid_ = threadIdx.x; asm volatile("" : "+v"(tid_));
  const int tid = tid_, wid = tid >> 6, lane = tid & 63, r32 = lane & 31, hi = lane >> 5;
  bf16* V_lds = (bf16*)lds; bf16* K_lds = (bf16*)(lds + 2 * SHM_V);
  float* ws = (float*)(lds + 2 * SHM_V + 2 * SHM_K) + wid * 64; float* li_l = ws; float* al_l = ws + 32;
  float m_reg = MODE ? sink * (1.0f / SCALE) : -1e30f, l_reg = MODE ? 1.0f : 0.0f; f32x16 o[4] = {}; bf16x8 qr[8];
  const bf16* Qw = Qb + (long)(wid * QBLK + r32) * LDQ + hi * 8;
#pragma unroll
  for (int d0 = 0; d0 < 8; ++d0) qr[d0] = *reinterpret_cast<const bf16x8*>(Qw + d0 * 16);
  {
    float rstd = 1.f;
    if constexpr (MODE == 0) {
      float ss = 0.f;
#pragma unroll
      for (int d0 = 0; d0 < 8; ++d0) { const u32x4 w = *reinterpret_cast<const u32x4*>(&qr[d0]);
        const float a0 = bf_lo(w.x), a1 = bf_hi(w.x), a2 = bf_lo(w.y), a3 = bf_hi(w.y), a4 = bf_lo(w.z), a5 = bf_hi(w.z), a6 = bf_lo(w.w), a7 = bf_hi(w.w);
        ss += (a0 * a0 + a1 * a1) + (a2 * a2 + a3 * a3) + (a4 * a4 + a5 * a5) + (a6 * a6 + a7 * a7); }
      { auto rr = __builtin_amdgcn_permlane32_swap(__float_as_uint(ss), __float_as_uint(ss), false, false); ss = __uint_as_float(rr[0]) + __uint_as_float(rr[1]); }
      rstd = 1.0f / sqrtf(ss * (1.0f / D) + EPS);
    }
    const f32x4* tp = (const f32x4*)(tab + (wid * QBLK + r32) * 64 + hi * 8);
#pragma unroll
    for (int d0 = 0; d0 < 4; ++d0) {
      const u32x4 w1 = *reinterpret_cast<const u32x4*>(&qr[d0]), w2 = *reinterpret_cast<const u32x4*>(&qr[d0 + 4]);
      float x1[8] = {bf_lo(w1.x), bf_hi(w1.x), bf_lo(w1.y), bf_hi(w1.y), bf_lo(w1.z), bf_hi(w1.z), bf_lo(w1.w), bf_hi(w1.w)};
      float x2[8] = {bf_lo(w2.x), bf_hi(w2.x), bf_lo(w2.y), bf_hi(w2.y), bf_lo(w2.z), bf_hi(w2.z), bf_lo(w2.w), bf_hi(w2.w)};
      if constexpr (MODE == 0) {
        const f32x4 g1a = *(const f32x4*)(gq + d0 * 16 + hi * 8), g1b = *(const f32x4*)(gq + d0 * 16 + hi * 8 + 4), g2a = *(const f32x4*)(gq + 64 + d0 * 16 + hi * 8), g2b = *(const f32x4*)(gq + 64 + d0 * 16 + hi * 8 + 4);
        const float g1[8] = {g1a.x, g1a.y, g1a.z, g1a.w, g1b.x, g1b.y, g1b.z, g1b.w}, g2[8] = {g2a.x, g2a.y, g2a.z, g2a.w, g2b.x, g2b.y, g2b.z, g2b.w};
#pragma unroll
        for (int e = 0; e < 8; ++e) { x1[e] = x1[e] * rstd * g1[e]; x2[e] = x2[e] * rstd * g2[e]; }
      }
      float o1[8], o2[8];
#pragma unroll
      for (int e2 = 0; e2 < 4; ++e2) { const f32x4 cs = tp[d0 * 8 + e2];
        o1[2 * e2] = x1[2 * e2] * cs.x - x2[2 * e2] * cs.y; o2[2 * e2] = x2[2 * e2] * cs.x + x1[2 * e2] * cs.y;
        o1[2 * e2 + 1] = x1[2 * e2 + 1] * cs.z - x2[2 * e2 + 1] * cs.w; o2[2 * e2 + 1] = x2[2 * e2 + 1] * cs.z + x1[2 * e2 + 1] * cs.w; }
      u32x4 p1, p2; p1.x = cvt_pk_bf16(o1[0], o1[1]); p1.y = cvt_pk_bf16(o1[2], o1[3]); p1.z = cvt_pk_bf16(o1[4], o1[5]); p1.w = cvt_pk_bf16(o1[6], o1[7]);
      p2.x = cvt_pk_bf16(o2[0], o2[1]); p2.y = cvt_pk_bf16(o2[2], o2[3]); p2.z = cvt_pk_bf16(o2[4], o2[5]); p2.w = cvt_pk_bf16(o2[6], o2[7]);
      qr[d0] = *reinterpret_cast<bf16x8*>(&p1); qr[d0 + 4] = *reinterpret_cast<bf16x8*>(&p2);
    }
  }
  const int sr = tid >> 4, sc = (tid & 15) * 8, vst0 = v_st(sr, sc), vst1 = v_st(32 + sr, sc);
  const int vb0 = (int)(uintptr_t)V_lds + v_rd_base(lane);
  const int mb0 = dq0 + wid * QBLK + r32 + 128 - 4 * hi;
  struct { bf16x8 vs0, vs1, ks0, ks1; } sr_[SD];
#define SLOAD(i, k0) do { sr_[i].vs0 = *reinterpret_cast<const bf16x8*>(&Vh[(long)((k0) + sr) * LDK + sc]); sr_[i].vs1 = *reinterpret_cast<const bf16x8*>(&Vh[(long)((k0) + 32 + sr) * LDK + sc]); \
    sr_[i].ks0 = *reinterpret_cast<const bf16x8*>(&Kh[(long)((k0) + sr) * LDK + sc]); sr_[i].ks1 = *reinterpret_cast<const bf16x8*>(&Kh[(long)((k0) + 32 + sr) * LDK + sc]); } while (0)
#define SWRITE(b, i) do { *(bf16x8*)((char*)V_lds + (b) * SHM_V + vst0) = sr_[i].vs0;          \
    *(bf16x8*)((char*)V_lds + (b) * SHM_V + vst1) = sr_[i].vs1; int kc = sc * 2;               \
    *(bf16x8*)((char*)K_lds + (b) * SHM_K + KSWZ(sr, kc)) = sr_[i].ks0;                       \
    *(bf16x8*)((char*)K_lds + (b) * SHM_K + KSWZ(32 + sr, kc)) = sr_[i].ks1; } while (0)
#define SWAIT() do { if constexpr (SD == 2) asm volatile("s_waitcnt vmcnt(4)" ::: "memory"); else asm volatile("s_waitcnt vmcnt(0)" ::: "memory"); } while (0)
#define RESC(a) do { if (__any((a) < 1.f)) { if (hi == 0) al_l[r32] = (a); asm volatile("s_waitcnt lgkmcnt(0)" ::: "memory"); \
    _Pragma("unroll") for (int d = 0; d < 4; ++d) _Pragma("unroll") for (int r = 0; r < 16; ++r) o[d][r] *= al_l[crow(r, hi)]; } } while (0)
#define PSM(P0, P1, MN, AL, J) partialSM<MODE != 0>(P0, P1, m_reg, MN, AL, mb0 - 64 * (J))
  f32x16 pA0, pA1, pB0, pB1; float mnA, mnB, alA, alB; bf16x8 pa0, pa1, pa2, pa3;
  constexpr int SE = 0, SO = SD - 1;
  SLOAD(SE, 0); asm volatile("s_waitcnt vmcnt(0)" ::: "memory"); SWRITE(0, SE); __syncthreads();
  qkt(pA0, pA1, K_lds, qr, r32, hi); PSM(pA0, pA1, mnA, alA, 0);
  SLOAD(SO, KVBLK); if constexpr (SD == 2) { if (2 < NT) SLOAD(SE, 2 * KVBLK); }
  SWAIT(); SWRITE(1, SO); __syncthreads();
  for (int j = 1; j + 1 < NT; j += 2) {
    SBAR(); qkt(pB0, pB1, (bf16*)((char*)K_lds + SHM_K), qr, r32, hi);
    finishSM(pA0, pA1, alA, l_reg, pa0, pa1, pa2, pa3); SBAR();
    SLOAD(SO, (j + SD) * KVBLK); SBAR();
    pv_d0(o, vb0, pa0, pa1, pa2, pa3); PSM(pB0, pB1, mnB, alB, j);
    __syncthreads(); SWAIT(); SWRITE(0, SE);
    RESC(alB); __syncthreads();
    SBAR(); qkt(pA0, pA1, K_lds, qr, r32, hi);
    finishSM(pB0, pB1, alB, l_reg, pa0, pa1, pa2, pa3); SBAR();
    if (SD == 1 || j + 3 < NT) SLOAD(SE, (j + 1 + SD) * KVBLK); SBAR();
    pv_d0(o, vb0 + (int)SHM_V, pa0, pa1, pa2, pa3); PSM(pA0, pA1, mnA, alA, j + 1);
    __syncthreads(); SWAIT(); SWRITE(1, SO);
    RESC(alA); __syncthreads();
  }
  SBAR(); qkt(pB0, pB1, (bf16*)((char*)K_lds + SHM_K), qr, r32, hi);
  finishSM(pA0, pA1, alA, l_reg, pa0, pa1, pa2, pa3); SBAR();
  pv_d0(o, vb0, pa0, pa1, pa2, pa3); PSM(pB0, pB1, mnB, alB, NT - 1);
  __syncthreads(); RESC(alB);
  finishSM(pB0, pB1, alB, l_reg, pa0, pa1, pa2, pa3); SBAR();
  pv_d0(o, vb0 + (int)SHM_V, pa0, pa1, pa2, pa3);
  if (hi == 0) li_l[r32] = l_reg; asm volatile("s_waitcnt lgkmcnt(0)" ::: "memory");
  float rli[16];
#pragma unroll
  for (int r = 0; r < 16; ++r) rli[r] = __builtin_amdgcn_rcpf(li_l[crow(r, hi)]);
  char* ost = lds + OST_OFF + wid * (32 * OST_PITCH);
#pragma unroll
  for (int r = 0; r < 16; ++r) { const int orow = crow(r, hi);
#pragma unroll
    for (int d0 = 0; d0 < 4; ++d0) { const float v = o[d0][r] * rli[r]; *(bf16*)(ost + orow * OST_PITCH + (d0 * 32 + r32) * 2) = (bf16)(cvt_pk_bf16(v, v) & 0xffffu); } }
  asm volatile("s_waitcnt lgkmcnt(0)" ::: "memory");
  bf16* Ow = Ob + (long)(wid * QBLK) * LDO;
#pragma unroll
  for (int i = 0; i < 8; ++i) { const int row = (lane >> 4) + 4 * i, cc = (lane & 15);
    const u32x4 w = *(const u32x4*)(ost + row * OST_PITCH + cc * 16);
    *(u32x4*)(Ow + (long)row * LDO + cc * 8) = w; }
  __syncthreads();
#undef SLOAD
#undef SWRITE
#undef SWAIT
#undef RESC
#undef PSM
}
}

#define XB_TMO      128
#define XB_XCNT(j)  (256  + 64 * (j))
#define XB_XSUB(j)  (1280 + 64 * (j))
#define XB_XGEN(j)  (2304 + 64 * (j))
#define XB_TOP      3328
#define XB_TOPGEN   3392
#define XCD_BAR_WORDS 3456
#define XB_SPIN_CAP (1u << 20)
__device__ __forceinline__ unsigned xb_ld(unsigned* p)              { return __hip_atomic_load(p, __ATOMIC_RELAXED, __HIP_MEMORY_SCOPE_AGENT); }
__device__ __forceinline__ unsigned xb_add(unsigned* p, unsigned v) { return __hip_atomic_fetch_add(p, v, __ATOMIC_RELAXED, __HIP_MEMORY_SCOPE_AGENT); }
__device__ __forceinline__ unsigned xb_xcc_id() { return (unsigned)__builtin_amdgcn_s_getreg((3 << 11) | 20) & 0xFu; }
#define XB_SPIN(cond, bar) do { unsigned _sp = 0; while (cond) { __builtin_amdgcn_s_sleep(1); \
    if ((++_sp & 255u) == 0u) { if (xb_ld(&(bar)[XB_TMO])) break; if (_sp > XB_SPIN_CAP) { atomicAdd(&(bar)[XB_TMO], 1u); break; } } } } while (0)
struct XcdBarrier { unsigned* bar; unsigned x; volatile LAS unsigned* st; };
__device__ __forceinline__ XcdBarrier xcd_barrier_post(unsigned* bar, volatile LAS unsigned* st) {
    XcdBarrier b; b.bar = bar; b.x = xb_xcc_id(); b.st = st;
    if (threadIdx.x == 0) (void)xb_add(&bar[XB_XCNT(b.x)], 1u);
    return b;
}
__device__ __forceinline__ void xcd_barrier_complete(unsigned* bar, unsigned x, unsigned& nloc, unsigned& nx) {
    const unsigned G = gridDim.x * gridDim.y * gridDim.z;
    unsigned sum, cnt, mine, sp = 0u;
    for (;;) {
        sum = 0u; cnt = 0u; mine = 0u;
#pragma unroll
        for (unsigned j = 0; j < 16; ++j) { const unsigned c = xb_ld(&bar[XB_XCNT(j)]); sum += c; cnt += (c > 0u) ? 1u : 0u; mine = (j == x) ? c : mine; }
        if (sum == G) break;
        __builtin_amdgcn_s_sleep(1);
        if ((++sp & 255u) == 0u) { if (xb_ld(&bar[XB_TMO])) break; if (sp > XB_SPIN_CAP) { atomicAdd(&bar[XB_TMO], 1u); break; } }
    }
    nloc = mine > 0u ? mine : 1u; nx = cnt > 0u ? cnt : 1u;
}
__device__ __forceinline__ void xcd_barrier(const XcdBarrier& b) {
    asm volatile("s_waitcnt vmcnt(0)" ::: "memory");
    __syncthreads();
    if (threadIdx.x == 0) {
        unsigned* bar = b.bar;
        __builtin_amdgcn_s_waitcnt(0);
        unsigned nloc = b.st[0], nx = b.st[1];
        if (nloc == 0u) { xcd_barrier_complete(bar, b.x, nloc, nx); b.st[0] = nloc; b.st[1] = nx; }
        const unsigned old = xb_add(&bar[XB_XSUB(b.x)], 1u);
        const unsigned gen = old / nloc;
        if (old + 1u == (gen + 1u) * nloc) {
            __builtin_amdgcn_fence(__ATOMIC_RELEASE, "agent");
            asm volatile("s_waitcnt vmcnt(0)" ::: "memory");
            const unsigned og = xb_add(&bar[XB_TOP], 1u);
            const unsigned tg = og / nx;
            if (og + 1u == (tg + 1u) * nx) xb_add(&bar[XB_TOPGEN], 1u);
            else XB_SPIN(xb_ld(&bar[XB_TOPGEN]) == tg, bar);
            __builtin_amdgcn_fence(__ATOMIC_ACQUIRE, "agent");
            xb_add(&bar[XB_XGEN(b.x)], 1u);
            asm volatile("s_waitcnt vmcnt(0)" ::: "memory");
        } else {
            XB_SPIN(xb_ld(&bar[XB_XGEN(b.x)]) == gen, bar);
            __builtin_amdgcn_fence(__ATOMIC_ACQUIRE, "agent");
            asm volatile("s_waitcnt vmcnt(0)" ::: "memory");
        }
    }
    __syncthreads();
}

__device__ __forceinline__ void transpose_item(const float* W, int K, int N, bf16* WT, LAS float* scr, int item, int lane) {
    const int nblk = N / 32, kb = item / nblk, nb = item % nblk, k0 = 64 * kb, n0 = 32 * nb;
#pragma unroll 8
    for (int i = 0; i < 32; ++i) { const int kk = 2 * i + (lane >> 5); scr[kk * 33 + (lane & 31)] = W[(size_t)(k0 + kk) * N + n0 + (lane & 31)]; }
    asm volatile("s_waitcnt lgkmcnt(0)" ::: "memory");
    const int c = lane & 7;
#pragma unroll
    for (int j = 0; j < 4; ++j) { const int n = (lane >> 3) + 8 * j; const LAS float* s = scr + (8 * c) * 33 + n;
        u32x4 o; o.x = cvt_pk_bf16(s[0 * 33], s[1 * 33]); o.y = cvt_pk_bf16(s[2 * 33], s[3 * 33]); o.z = cvt_pk_bf16(s[4 * 33], s[5 * 33]); o.w = cvt_pk_bf16(s[6 * 33], s[7 * 33]);
        *(u32x4*)(WT + (size_t)(n0 + n) * K + k0 + 8 * c) = o; }
    asm volatile("s_waitcnt lgkmcnt(0)" ::: "memory");
}

struct Args { const float* in[21]; float* out; unsigned char* ws; int lo, hi; };

__device__ __forceinline__ const float* x_in_row(const float* xp, const float* xs, int row) {
    return row < NPROMPT_TOK ? xp + (size_t)row * DM : xs + (size_t)(row - NPROMPT_TOK) * DM;
}

__device__ __forceinline__ void phase_weights(const CAS Args* a, unsigned char* ws, int l, LAS unsigned char* lds, int gw, int NGW, int wave, int lane) {
    LAS float* scr = (LAS float*)(lds + wave * 16384);
    constexpr int I_IN = (DM / 64) * (INW / 32), I_BR = (MWD / 64) * (DM / 32), I_OUT = (DM / 64) * (DM / 32), I_F1 = (DM / 64) * (FFD / 32), I_F2 = (FFD / 64) * (DM / 32), I_G = 32 * 8;
    constexpr int NITEMS = I_IN + 3 * I_BR + I_OUT + I_F1 + I_F2 + I_G;
    for (int it = gw; it < NITEMS; it += NGW) {
        int r = it;
        if (r < I_IN) { transpose_item(a->in[6] + (size_t)l * DM * INW, DM, INW, (bf16*)(ws + WS_WIN), scr, r, lane); continue; } r -= I_IN;
        if (r < 3 * I_BR) { const int b = r / I_BR; transpose_item(a->in[17] + ((size_t)l * 3 + b) * MWD * DM, MWD, DM, (bf16*)(ws + WS_WBR) + (size_t)b * DM * MWD, scr, r - b * I_BR, lane); continue; } r -= 3 * I_BR;
        if (r < I_OUT) { transpose_item(a->in[18] + (size_t)l * DM * DM, DM, DM, (bf16*)(ws + WS_WOUT), scr, r, lane); continue; } r -= I_OUT;
        if (r < I_F1) { transpose_item(a->in[19] + (size_t)l * DM * FFD, DM, FFD, (bf16*)(ws + WS_W1), scr, r, lane); continue; } r -= I_F1;
        if (r < I_F2) { transpose_item(a->in[20] + (size_t)l * FFD * DM, FFD, DM, (bf16*)(ws + WS_W2), scr, r, lane); continue; } r -= I_F2;
        { const int mi = r >> 3, sub = r & 7;
          const int gate = mi >> 4, dd = (mi >> 3) & 1, blk = mi & 7;
          const float* src = (gate ? a->in[14] : a->in[12]) + (((size_t)l * 2 + dd) * 8 + blk) * 16384;
          transpose_item(src, 128, 128, (bf16*)(ws + WS_WG) + ((size_t)(dd * 2 + gate) * 8 + blk) * 16384, scr, sub, lane); }
    }
}

__device__ __forceinline__ void norm_row_to_bf16(const float* xrow, const float* g, bf16* orow, int lane) {
    const f32x4* xr = (const f32x4*)xrow + lane; const f32x4* gr = (const f32x4*)g + lane;
    f32x4 v[8]; float s = 0.f;
#pragma unroll
    for (int j = 0; j < 8; ++j) { v[j] = xr[64 * j]; s += (v[j].x * v[j].x + v[j].y * v[j].y) + (v[j].z * v[j].z + v[j].w * v[j].w); }
    const float rstd = 1.0f / sqrtf(wave_sum(s, lane) * (1.0f / DM) + EPS);
    u32x2* o8 = (u32x2*)orow + lane;
#pragma unroll
    for (int j = 0; j < 8; ++j) { const f32x4 gg = gr[64 * j]; u32x2 w; w.x = cvt_pk_bf16(v[j].x * rstd * gg.x, v[j].y * rstd * gg.y); w.y = cvt_pk_bf16(v[j].z * rstd * gg.z, v[j].w * rstd * gg.w); o8[64 * j] = w; }
}
template <bool SECOND>
__device__ __forceinline__ void resid_norm_row(const float* yrow, const float* xold, float* xout, const float* g1, const float* g2, bf16* hrow, int lane) {
    const f32x4* yr = (const f32x4*)yrow + lane; const f32x4* xr = (const f32x4*)xold + lane; const f32x4* g1r = (const f32x4*)g1 + lane;
    f32x4 v[8]; float s = 0.f;
#pragma unroll
    for (int j = 0; j < 8; ++j) { v[j] = yr[64 * j]; s += (v[j].x * v[j].x + v[j].y * v[j].y) + (v[j].z * v[j].z + v[j].w * v[j].w); }
    const float rstd = 1.0f / sqrtf(wave_sum(s, lane) * (1.0f / DM) + EPS);
    float s2 = 0.f;
#pragma unroll
    for (int j = 0; j < 8; ++j) { const f32x4 gg = g1r[64 * j]; const f32x4 xo = xr[64 * j]; v[j] = xo + v[j] * rstd * gg; ((f32x4*)xout + lane)[64 * j] = v[j];
        s2 += (v[j].x * v[j].x + v[j].y * v[j].y) + (v[j].z * v[j].z + v[j].w * v[j].w); }
    if constexpr (SECOND) {
        const float rstd2 = 1.0f / sqrtf(wave_sum(s2, lane) * (1.0f / DM) + EPS);
        const f32x4* g2r = (const f32x4*)g2 + lane; u32x2* o8 = (u32x2*)hrow + lane;
#pragma unroll
        for (int j = 0; j < 8; ++j) { const f32x4 gg = g2r[64 * j]; u32x2 w; w.x = cvt_pk_bf16(v[j].x * rstd2 * gg.x, v[j].y * rstd2 * gg.y); w.y = cvt_pk_bf16(v[j].z * rstd2 * gg.z, v[j].w * rstd2 * gg.w); o8[64 * j] = w; }
    }
}

__device__ __forceinline__ void krope_token(bf16* prow, const f32x2* taba, const f32x2* tab1, const float* kn, int lane) {
    const f32x2 csa = taba[lane], cs1 = tab1[lane];
    const float kg1 = kn[lane], kg2 = kn[64 + lane];
#pragma unroll
    for (int h = 0; h < 2; ++h) {
        bf16* p = prow + KA_OFF + h * HD;
        const float x1 = bf2f(p[lane]), x2 = bf2f(p[64 + lane]);
        const float rstd = 1.0f / sqrtf(wave_sum(x1 * x1 + x2 * x2, lane) * (1.0f / HD) + EPS);
        const float y1 = x1 * rstd * kg1, y2 = x2 * rstd * kg2;
        const float o1 = y1 * csa.x - y2 * csa.y, o2 = y2 * csa.x + y1 * csa.y;
        p[lane] = (bf16)(cvt_pk_bf16(o1, o1) & 0xffffu); p[64 + lane] = (bf16)(cvt_pk_bf16(o2, o2) & 0xffffu);
    }
#pragma unroll
    for (int h = 0; h < 2; ++h) {
        bf16* p = prow + KB_OFF + h * HD;
        const float x1 = bf2f(p[lane]), x2 = bf2f(p[64 + lane]);
        const float o1 = x1 * cs1.x - x2 * cs1.y, o2 = x2 * cs1.x + x1 * cs1.y;
        p[lane] = (bf16)(cvt_pk_bf16(o1, o1) & 0xffffu); p[64 + lane] = (bf16)(cvt_pk_bf16(o2, o2) & 0xffffu);
    }
}
__device__ __forceinline__ void rope_tables(f32x2* tab1, f32x2* taba, int gtid, int nthr) {
    for (int i = gtid; i < SEQ * 64; i += nthr) {
        const int pos = i >> 6, j = i & 63;
        const double rev1 = (double)pos * ROPE_F1[j];
        const double reva = (double)(j < 32 ? (pos >> 6) : (pos & 63)) * ROPE_FA[j & 31];
        const float f1 = (float)(rev1 - __builtin_floor(rev1)), fa = (float)(reva - __builtin_floor(reva));
        tab1[i] = (f32x2){__builtin_amdgcn_cosf(f1), __builtin_amdgcn_sinf(f1)};
        taba[i] = (f32x2){__builtin_amdgcn_cosf(fa), __builtin_amdgcn_sinf(fa)};
    }
}

struct CParams { const float* conv_w; const float* conv_b; const float* gate_r_b; const float* gate_i_b; const float* lam; const bf16* WG; };
template <int PASS>
__device__ __forceinline__ void c_unit(LAS unsigned char* lds, const bf16* P, bf16* OC, const CParams& cp, f32x2* SUM, const float* CAR, int seq, int tc, int nb) {
    constexpr int UP = 136;
    LAS bf16* U = (LAS bf16*)lds;
    LAS float* AD = (LAS float*)(lds + 16384);
    int tid_ = threadIdx.x; asm volatile("" : "+v"(tid_));
    const int tid = tid_, wave = tid >> 6, lane = tid & 63;
    {
        const int t = tid >> 4, c8 = (tid & 15) * 8, cg = nb * 128 + c8, ts = tc * LC + t;
        float u8[8];
        { const f32x4 b0 = *(const f32x4*)(cp.conv_b + cg), b1 = *(const f32x4*)(cp.conv_b + cg + 4); u8[0] = b0.x; u8[1] = b0.y; u8[2] = b0.z; u8[3] = b0.w; u8[4] = b1.x; u8[5] = b1.y; u8[6] = b1.z; u8[7] = b1.w; }
#pragma unroll
        for (int j = 0; j < 4; ++j) { const int tt = ts - 2 + j;
            if (tt >= 0 && tt < SEQ) {
                const u32x4 xw = *(const u32x4*)(P + (size_t)(seq * SEQ + tt) * PWD + XC_OFF + cg);
                const f32x4 w0 = *(const f32x4*)(cp.conv_w + j * MWD + cg), w1 = *(const f32x4*)(cp.conv_w + j * MWD + cg + 4);
                u8[0] += bf_lo(xw.x) * w0.x; u8[1] += bf_hi(xw.x) * w0.y; u8[2] += bf_lo(xw.y) * w0.z; u8[3] += bf_hi(xw.y) * w0.w;
                u8[4] += bf_lo(xw.z) * w1.x; u8[5] += bf_hi(xw.z) * w1.y; u8[6] += bf_lo(xw.w) * w1.z; u8[7] += bf_hi(xw.w) * w1.w; } }
        u32x4 w; w.x = cvt_pk_bf16(u8[0], u8[1]); w.y = cvt_pk_bf16(u8[2], u8[3]); w.z = cvt_pk_bf16(u8[4], u8[5]); w.w = cvt_pk_bf16(u8[6], u8[7]);
        *(LAS u32x4*)(U + t * UP + c8) = w;
    }
    __syncthreads();
    {
        const int dd = wave >> 2, q = wave & 3, r = lane & 31, h = lane >> 5;
        const bf16* wrp = cp.WG + ((size_t)((dd * 2 + 0) * 8 + nb) * 128 + 32 * q + r) * 128 + 8 * h;
        const bf16* wip = cp.WG + ((size_t)((dd * 2 + 1) * 8 + nb) * 128 + 32 * q + r) * 128 + 8 * h;
        f32x16 accr = {}, acci = {};
#pragma unroll
        for (int ks = 0; ks < 8; ++ks) {
            const bf16x8 af = *(const LAS bf16x8*)(U + r * UP + 16 * ks + 8 * h);
            const bf16x8 br = *(const bf16x8*)(wrp + 16 * ks), bi = *(const bf16x8*)(wip + 16 * ks);
            accr = __builtin_amdgcn_mfma_f32_32x32x16_bf16(af, br, accr, 0, 0, 0);
            acci = __builtin_amdgcn_mfma_f32_32x32x16_bf16(af, bi, acci, 0, 0, 0);
        }
        const int ch = 32 * q + r, cg = nb * 128 + ch;
        const float rb = cp.gate_r_b[dd * MWD + cg], ib = cp.gate_i_b[dd * MWD + cg], lam = cp.lam[dd * MWD + cg];
        const float el = __builtin_amdgcn_exp2f(-1.4426950408889634f * lam);
        const float ls8 = -8.0f * (lam > 3.0f ? el * (1.0f - el * (0.5f - el * (1.0f / 3.0f))) : 0.6931471805599453f * __builtin_amdgcn_logf(1.0f + el));
        LAS float* pa = AD + (dd * 2 + 0) * (32 * 128) + ch; LAS float* pd = AD + (dd * 2 + 1) * (32 * 128) + ch;
#pragma unroll
        for (int reg = 0; reg < 16; ++reg) {
            const int tt = (reg & 3) + 8 * (reg >> 2) + 4 * h;
            const float rr = fast_sigmoid(accr[reg] + rb), ii = fast_sigmoid(acci[reg] + ib);
            const float la = ls8 * rr;
            const float av = __builtin_amdgcn_exp2f(1.4426950408889634f * la);
            const float x2 = 2.0f * la;
            const float om = fabsf(x2) < 0.25f ? -x2 * (1.0f + x2 * (0.5f + x2 * ((1.0f / 6.0f) + x2 * ((1.0f / 24.0f) + x2 * ((1.0f / 120.0f) + x2 * (1.0f / 720.0f)))))) : 1.0f - av * av;
            const float uf = bf2f(U[tt * UP + ch]);
            pa[tt * 128] = av; pd[tt * 128] = sqrtf(om) * (ii * uf);
        }
    }
    __syncthreads();
    if (tid < 256) {
        const int dd = tid >> 7, ch = tid & 127, cg = nb * 128 + ch;
        LAS float* pa = AD + (dd * 2 + 0) * (32 * 128) + ch; LAS float* pd = AD + (dd * 2 + 1) * (32 * 128) + ch;
        const size_t si = ((size_t)(seq * NTCH + tc) * 2 + dd) * MWD + cg;
        if constexpr (PASS == 1) {
            float hh = 0.f, pp = 1.f;
#pragma unroll 8
            for (int s = 0; s < LC; ++s) { const int t = dd ? LC - 1 - s : s; const float av = pa[t * 128], dv = pd[t * 128]; hh = av * hh + dv; pp *= av; }
            SUM[si] = (f32x2){pp, hh};
        } else {
            float hh = CAR[si];
#pragma unroll 8
            for (int s = 0; s < LC; ++s) { const int t = dd ? LC - 1 - s : s; const float av = pa[t * 128], dv = pd[t * 128]; hh = av * hh + dv; pa[t * 128] = hh; }
        }
    }
    if constexpr (PASS == 3) {
        __syncthreads();
        const int t = tid >> 4, c8 = (tid & 15) * 8, cg = nb * 128 + c8; const size_t row = (size_t)(seq * SEQ + tc * LC + t);
        const u32x4 yw = *(const u32x4*)(P + row * PWD + YC_OFF + cg);
        const float y[8] = {bf_lo(yw.x), bf_hi(yw.x), bf_lo(yw.y), bf_hi(yw.y), bf_lo(yw.z), bf_hi(yw.z), bf_lo(yw.w), bf_hi(yw.w)};
        const LAS float* hf = AD + t * 128 + c8; const LAS float* hb = AD + 2 * (32 * 128) + t * 128 + c8;
        float o[8];
#pragma unroll
        for (int j = 0; j < 8; ++j) { const float z = 0.7978845608028654f * (y[j] + 0.044715f * y[j] * y[j] * y[j]);
            const float ge = y[j] * fast_sigmoid(2.0f * z);
            o[j] = (hf[j] + hb[j]) * ge; }
        u32x4 w; w.x = cvt_pk_bf16(o[0], o[1]); w.y = cvt_pk_bf16(o[2], o[3]); w.z = cvt_pk_bf16(o[4], o[5]); w.w = cvt_pk_bf16(o[6], o[7]);
        *(u32x4*)(OC + row * MWD + cg) = w;
    }
    __syncthreads();
}

__device__ __forceinline__ void phase_c2(LAS unsigned char* lds, const f32x2* SUM, float* CAR, int G, int bx) {
    int tid_ = threadIdx.x; asm volatile("" : "+v"(tid_));
    const int tid = tid_, seg = tid >> 6, lane = tid & 63;
    LAS f32x2* SEG = (LAS f32x2*)lds;
    for (int lgi = bx; lgi < 64; lgi += G) {
        const int seq = lgi >> 5, dd = (lgi >> 4) & 1, cg = (lgi & 15) * 64 + lane;
        const long step = dd ? -(long)(2 * MWD) : (long)(2 * MWD);
        const int tc0 = dd ? NTCH - 1 - seg * 32 : seg * 32;
        const f32x2* sp = SUM + ((size_t)(seq * NTCH + tc0) * 2 + dd) * MWD + cg;
        float* cp = CAR + ((size_t)(seq * NTCH + tc0) * 2 + dd) * MWD + cg;
        float pp = 1.f, hh = 0.f;
#pragma unroll 8
        for (int k = 0; k < 32; ++k) { const f32x2 s = sp[k * step]; hh = s.x * hh + s.y; pp *= s.x; }
        SEG[seg * 64 + lane] = (f32x2){pp, hh};
        __syncthreads();
        float carry = 0.f;
        for (int sg = 0; sg < seg; ++sg) { const f32x2 v = SEG[sg * 64 + lane]; carry = v.x * carry + v.y; }
#pragma unroll 8
        for (int k = 0; k < 32; ++k) { const f32x2 s = sp[k * step]; cp[k * step] = carry; carry = s.x * carry + s.y; }
        __syncthreads();
    }
}

__global__ void __launch_bounds__(512, 2) mk_fwd(Args args) {
    extern __shared__ __attribute__((aligned(16))) unsigned char lds_raw[];
    LAS unsigned char* lds = (LAS unsigned char*)lds_raw;
    {
        volatile LAS unsigned* MISC = (volatile LAS unsigned*)(lds + MISC_OFF);
        for (int u = threadIdx.x; u < (LDS_BYTES - MISC_OFF) / 4; u += 512) MISC[u] = 0u;
        __syncthreads();
    }
#if MK_SINGLE
    XcdBarrier bar = xcd_barrier_post((unsigned*)(args.ws + WS_CTL) + CW_BAR, (volatile LAS unsigned*)(lds + MISC_OFF) + 8);
#define GRID_BAR() xcd_barrier(bar)
#else
#define GRID_BAR() do {} while (0)
#endif
    const int lo = args.lo, hi = args.hi;
    int step = 0;
#define RUN(k) (lo <= (k) && (k) < hi)
#define SEAM(k) do { if (RUN((k) + 1)) GRID_BAR(); } while (0)
#define PHASE_ENTER() int tid = threadIdx.x; asm volatile("" : "+v"(tid)); int bx = blockIdx.x; asm volatile("" : "+s"(bx)); int G = gridDim.x; asm volatile("" : "+s"(G)); const int NGW = G * 8; (void)NGW; \
    const int lane = tid & 63, wave = __builtin_amdgcn_readfirstlane(tid >> 6), gw = bx * 8 + wave; \
    const CAS Args* ap = (const CAS Args*)__builtin_amdgcn_kernarg_segment_ptr(); asm volatile("" : "+s"(ap)); \
    unsigned char* ws = ap->ws; float* out = ap->out; (void)lane; (void)gw; (void)out; \
    bf16* const P = (bf16*)(ws + WS_P); float* const Y = (float*)(ws + WS_P); bf16* const GT = (bf16*)(ws + WS_G); bf16* const O = (bf16*)(ws + WS_O); bf16* const HID = (bf16*)(ws + WS_G); \
    (void)P; (void)Y; (void)GT; (void)O; (void)HID

    for (int l = 0; l < DEPTH; ++l) {
        { const int k = step++; if (RUN(k) && ((PH_MASK >> 0) & 1)) { PHASE_ENTER(); for (int rep_ = 0; rep_ < NREP(0); ++rep_) phase_weights(ap, ws, l, lds, gw, NGW, wave, lane);
            if (l == 0) {
                rope_tables((f32x2*)(ws + WS_TAB1), (f32x2*)(ws + WS_TABA), bx * 512 + tid, G * 512);
                const float* g = ap->in[2];
                for (int row = gw; row < NTOK; row += NGW) norm_row_to_bf16(x_in_row(ap->in[0], ap->in[1], row), g, (bf16*)(ws + WS_H) + (size_t)row * DM, lane); }
            SEAM(k); } }
        for (int c = 0; c < NCHUNK; ++c) {
            const int row0 = c * TC;
            #define HC ((bf16*)(ws + WS_H) + (size_t)c * TC * DM)
            { const int k = step++; if (RUN(k) && ((PH_MASK >> 2) & 1)) { PHASE_ENTER();
                pg8::Gemm g{HC, (bf16*)(ws + WS_WIN), DM}; pg8::StaticOrder S; S.init(TC, INW, G, bx); pg8::EpiIn E{P, GT};
                for (int rep_ = 0; rep_ < NREP(2); ++rep_) pg8::gemm_phase<pg8::EpiIn, pg8::StaticOrder>(lds, g, S, E);
                SEAM(k); } }
            { const int k = step++; if (RUN(k) && ((PH_MASK >> 3) & 1)) { PHASE_ENTER();
                const float* kn = ap->in[8] + (size_t)l * HD;
                for (int m = gw; m < TC; m += NGW) { const int pos = m & (SEQ - 1); krope_token(P + (size_t)m * PWD, (const f32x2*)(ws + WS_TABA) + pos * 64, (const f32x2*)(ws + WS_TAB1) + pos * 64, kn, lane); }
                CParams cp{ap->in[10] + (size_t)l * 4 * MWD, ap->in[11] + (size_t)l * MWD, ap->in[13] + (size_t)l * 2 * MWD, ap->in[15] + (size_t)l * 2 * MWD, ap->in[16] + (size_t)l * 2 * MWD, (bf16*)(ws + WS_WG)};
                for (int rep_ = 0; rep_ < NREP(3); ++rep_) for (int u = bx; u < 2 * NTCH * 8; u += G) { const int nb = u & 7, tc = (u >> 3) & (NTCH - 1), seq = u >> 11; c_unit<1>(lds, P, nullptr, cp, (f32x2*)(ws + WS_SUM), (float*)(ws + WS_CAR), seq, tc, nb); }
                SEAM(k); } }
            { const int k = step++; if (RUN(k) && ((PH_MASK >> 4) & 1)) { PHASE_ENTER(); for (int rep_ = 0; rep_ < NREP(4); ++rep_) phase_c2(lds, (f32x2*)(ws + WS_SUM), (float*)(ws + WS_CAR), G, bx); SEAM(k); } }
            { const int k = step++; if (RUN(k) && ((PH_MASK >> 5) & 1)) {
                if (SUBMASK & 1) { PHASE_ENTER(); const int xcd = bx & 7, rank = bx >> 3, nrank = G >> 3; for (int rep_ = 0; rep_ < NREP(12); ++rep_) for (int i = rank; i < 64; i += nrank) {
                    const int seq = xcd >> 2, kvh = (xcd >> 1) & 1, head = kvh * 4 + (xcd & 1) * 2 + (i >> 5), qb = i & 31;
                    const bf16* Qb = P + (size_t)(seq * SEQ + qb * 256) * PWD + QA_OFF + head * HD;
                    const bf16* Kh = P + (size_t)(seq * SEQ) * PWD + KA_OFF + kvh * HD; const bf16* Vh = P + (size_t)(seq * SEQ) * PWD + VA_OFF + kvh * HD;
                    att::attn_unit<0, SD_A>(Qb, Kh, Vh, O + (size_t)(seq * SEQ + qb * 256) * MWD + head * HD, SEQ / 64, 0, 0.f, (char*)lds_raw, (const f32x2*)(ws + WS_TABA) + qb * 256 * 64, ap->in[7] + (size_t)l * HD);
                } }
                if (SUBMASK & 2) { PHASE_ENTER(); const int xcd = bx & 7, rank = bx >> 3, nrank = G >> 3; for (int rep_ = 0; rep_ < NREP(13); ++rep_) for (int i = rank; i < 64; i += nrank) {
                    const int seq = xcd >> 2, kvh = (xcd >> 1) & 1, head = kvh * 4 + (xcd & 1) * 2 + (i >> 5), qb = i & 31;
                    const int k0 = (qb == 0) ? 0 : qb * 256 - 128, k1 = (qb == 31) ? SEQ : qb * 256 + 384;
                    const bf16* Qb = P + (size_t)(seq * SEQ + qb * 256) * PWD + QB_OFF + head * HD;
                    const bf16* Kh = P + (size_t)(seq * SEQ + k0) * PWD + KB_OFF + kvh * HD; const bf16* Vh = P + (size_t)(seq * SEQ + k0) * PWD + VB_OFF + kvh * HD;
                    att::attn_unit<1, SD_B>(Qb, Kh, Vh, O + (size_t)TC * MWD + (size_t)(seq * SEQ + qb * 256) * MWD + head * HD, (k1 - k0) / 64, qb * 256 - k0, ap->in[9][l * 8 + head], (char*)lds_raw, (const f32x2*)(ws + WS_TAB1) + qb * 256 * 64, nullptr);
                } }
                if (SUBMASK & 4) { PHASE_ENTER();
                CParams cp{ap->in[10] + (size_t)l * 4 * MWD, ap->in[11] + (size_t)l * MWD, ap->in[13] + (size_t)l * 2 * MWD, ap->in[15] + (size_t)l * 2 * MWD, ap->in[16] + (size_t)l * 2 * MWD, (bf16*)(ws + WS_WG)};
                for (int rep_ = 0; rep_ < NREP(14); ++rep_) for (int u = bx; u < 2 * NTCH * 8; u += G) { const int nb = u & 7, tc = (u >> 3) & (NTCH - 1), seq = u >> 11; c_unit<3>(lds, P, O + (size_t)2 * TC * MWD, cp, (f32x2*)(ws + WS_SUM), (float*)(ws + WS_CAR), seq, tc, nb); } }
                SEAM(k); } }
            { const int k = step++; if (RUN(k) && ((PH_MASK >> 6) & 1)) { PHASE_ENTER();
                pg8::Gemm g{O, (bf16*)(ws + WS_WBR), MWD}; pg8::BranchOrder S; S.base.init(TC, DM, G, bx); S.npanel = TC / 256;
                pg8::EpiBr E{GT, HC, (float*)(ws + WS_BRS) + (size_t)bx * 65536};
                for (int rep_ = 0; rep_ < NREP(6); ++rep_) pg8::gemm_phase<pg8::EpiBr, pg8::BranchOrder>(lds, g, S, E);
                SEAM(k); } }
            { const int k = step++; if (RUN(k) && ((PH_MASK >> 7) & 1)) { PHASE_ENTER();
                pg8::Gemm g{HC, (bf16*)(ws + WS_WOUT), DM}; pg8::StaticOrder S; S.init(TC, DM, G, bx); pg8::EpiF32 E{Y, DM};
                for (int rep_ = 0; rep_ < NREP(7); ++rep_) pg8::gemm_phase<pg8::EpiF32, pg8::StaticOrder>(lds, g, S, E);
                SEAM(k); } }
            { const int k = step++; if (RUN(k) && ((PH_MASK >> 8) & 1)) { PHASE_ENTER();
                const float* g1 = ap->in[3] + (size_t)l * DM; const float* g2 = ap->in[4] + (size_t)l * DM;
                for (int m = gw; m < TC; m += NGW) { const int row = row0 + m; const float* xo = (l == 0) ? x_in_row(ap->in[0], ap->in[1], row) : out + (size_t)row * DM;
                    resid_norm_row<true>(Y + (size_t)m * DM, xo, out + (size_t)row * DM, g1, g2, HC + (size_t)m * DM, lane); }
                SEAM(k); } }
            { const int k = step++; if (RUN(k) && ((PH_MASK >> 9) & 1)) { PHASE_ENTER();
                pg8::Gemm g{HC, (bf16*)(ws + WS_W1), DM}; pg8::StaticOrder S; S.init(TC, FFD, G, bx); pg8::EpiRelu2 E{HID, FFD};
                for (int rep_ = 0; rep_ < NREP(9); ++rep_) pg8::gemm_phase<pg8::EpiRelu2, pg8::StaticOrder>(lds, g, S, E);
                SEAM(k); } }
            { const int k = step++; if (RUN(k) && ((PH_MASK >> 10) & 1)) { PHASE_ENTER();
                pg8::Gemm g{HID, (bf16*)(ws + WS_W2), FFD}; pg8::StaticOrder S; S.init(TC, DM, G, bx); pg8::EpiF32 E{Y, DM};
                for (int rep_ = 0; rep_ < NREP(10); ++rep_) pg8::gemm_phase<pg8::EpiF32, pg8::StaticOrder>(lds, g, S, E);
                SEAM(k); } }
            { const int k = step++; if (RUN(k) && ((PH_MASK >> 11) & 1)) { PHASE_ENTER();
                const float* g1 = ap->in[5] + (size_t)l * DM;
                if (l + 1 < DEPTH) { const float* g2 = ap->in[2] + (size_t)(l + 1) * DM;
                    for (int m = gw; m < TC; m += NGW) { const int row = row0 + m; resid_norm_row<true>(Y + (size_t)m * DM, out + (size_t)row * DM, out + (size_t)row * DM, g1, g2, HC + (size_t)m * DM, lane); } }
                else { for (int m = gw; m < TC; m += NGW) { const int row = row0 + m; resid_norm_row<false>(Y + (size_t)m * DM, out + (size_t)row * DM, out + (size_t)row * DM, g1, nullptr, nullptr, lane); } }
                SEAM(k); } }
        }
    }
#undef RUN
#undef SEAM
}
constexpr int NSTEPS = DEPTH * (1 + NCHUNK * 10);

extern "C" void kernel_launch(void* const* d_in, const int* in_sizes, int n_in, void* d_out, int out_size, void* d_ws, size_t ws_size, hipStream_t stream) {
    static int grid = 0;
    if (grid == 0) {
        if (n_in != 21 || out_size != NTOK * DM || ws_size < WS_END) { fprintf(stderr, "kernel_launch: unexpected shapes (n_in %d out %d ws %zu)\n", n_in, out_size, ws_size); grid = -1; return; }
        int dev = 0, cus = 0, per_cu = 0;
        if (hipGetDevice(&dev) != hipSuccess || hipDeviceGetAttribute(&cus, hipDeviceAttributeMultiprocessorCount, dev) != hipSuccess) { grid = -1; return; }
        if (hipFuncSetAttribute((const void*)mk_fwd, hipFuncAttributeMaxDynamicSharedMemorySize, LDS_BYTES) != hipSuccess) { fprintf(stderr, "kernel_launch: hipFuncSetAttribute failed\n"); grid = -1; return; }
        if (hipOccupancyMaxActiveBlocksPerMultiprocessor(&per_cu, (const void*)mk_fwd, 512, LDS_BYTES) != hipSuccess || per_cu < 1) { fprintf(stderr, "kernel_launch: occupancy query says %d\n", per_cu); }
        (void)hipGetLastError();
        grid = cus;
    }
    if (grid < 0) return;
    if (hipMemsetAsync((char*)d_ws + WS_CTL, 0, CTL_ZERO_BYTES, stream) != hipSuccess) return;
    Args a{};
    for (int i = 0; i < 21; ++i) a.in[i] = (const float*)d_in[i];
    a.out = (float*)d_out; a.ws = (unsigned char*)d_ws;
#if MK_SINGLE
    a.lo = 0; a.hi = NSTEPS;
    hipLaunchKernelGGL(mk_fwd, dim3(grid), dim3(512), LDS_BYTES, stream, a);
#else
    for (int s = 0; s < NSTEPS; ++s) { a.lo = s; a.hi = s + 1; hipLaunchKernelGGL(mk_fwd, dim3(grid), dim3(512), LDS_BYTES, stream, a); }
#endif
    const hipError_t le = hipPeekAtLastError();
    if (le != hipSuccess) fprintf(stderr, "kernel_launch: launch failed: %s\n", hipGetErrorName(le));
}
```

```cpp
#include <hip/hip_runtime.h>
#include <cstdio>
#include <cstdint>

#ifndef PH_MASK
#define PH_MASK 0xFFF
#endif
#ifndef SUBMASK
#define SUBMASK 7
#endif
#ifndef SD_A
#define SD_A 2
#endif
#ifndef SD_B
#define SD_B 1
#endif
#ifndef DUP_MASK
#define DUP_MASK 0
#endif
#define NREP(i) (1 + ((DUP_MASK >> (i)) & 1))
#ifndef MK_SINGLE
#define MK_SINGLE 1
#endif

#define LAS __attribute__((address_space(3)))
#define GAS __attribute__((address_space(1)))
#define CAS __attribute__((address_space(4)))
typedef unsigned short bf16;
typedef short bf16x8 __attribute__((ext_vector_type(8)));
typedef short s16x4 __attribute__((ext_vector_type(4)));
typedef float f32x4 __attribute__((ext_vector_type(4)));
typedef float f32x2 __attribute__((ext_vector_type(2)));
typedef float f32x16 __attribute__((ext_vector_type(16)));
typedef unsigned u32x4 __attribute__((ext_vector_type(4)));
typedef unsigned u32x2 __attribute__((ext_vector_type(2)));

constexpr int DM = 2048, SEQ = 8192, NTOK = 49152, TC = 16384, NCHUNK = 3, DEPTH = 4;
constexpr int INW = 11264, PWD = 5120, GWD = 6144, FFD = 8192, MWD = 1024, HD = 128;
constexpr int QA_OFF = 0, KA_OFF = 1024, VA_OFF = 1280, QB_OFF = 1536, KB_OFF = 2560, VB_OFF = 2816, XC_OFF = 3072, YC_OFF = 4096;
constexpr int NPROMPT_TOK = 32768;
constexpr float EPS = 1e-6f;

constexpr size_t MiB = 1u << 20;
constexpr size_t WS_CTL = 0, CTL_ZERO_BYTES = 1 * MiB;
constexpr size_t WS_WIN = 2 * MiB;
constexpr size_t WS_WBR = 46 * MiB;
constexpr size_t WS_WOUT = 58 * MiB;
constexpr size_t WS_W1 = 66 * MiB;
constexpr size_t WS_W2 = 98 * MiB;
constexpr size_t WS_WG = 130 * MiB;
constexpr size_t WS_SUM = 131 * MiB;
constexpr size_t WS_CAR = 139 * MiB;
constexpr size_t WS_BRS = 143 * MiB;
constexpr size_t WS_H = 727 * MiB;
constexpr size_t WS_P = 271 * MiB;
constexpr size_t WS_G = 431 * MiB;
constexpr size_t WS_O = 623 * MiB;
constexpr size_t WS_TAB1 = 719 * MiB;
constexpr size_t WS_TABA = 723 * MiB;
constexpr size_t WS_END = 919 * MiB;
constexpr int CW_BAR = 4096;

constexpr int LDS_BYTES = 147456;
constexpr int MISC_OFF = 143360;

__device__ __forceinline__ unsigned cvt_pk_bf16(float lo, float hi) { unsigned r; asm volatile("v_cvt_pk_bf16_f32 %0, %1, %2" : "=v"(r) : "v"(lo), "v"(hi)); return r; }
__device__ __forceinline__ float bf_lo(unsigned w) { return __uint_as_float(w << 16); }
__device__ __forceinline__ float bf_hi(unsigned w) { return __uint_as_float(w & 0xffff0000u); }
__device__ __forceinline__ float bf2f(bf16 b) { return __uint_as_float(((unsigned)b) << 16); }
__device__ __forceinline__ float fast_sigmoid(float v) { return __builtin_amdgcn_rcpf(1.0f + __builtin_amdgcn_exp2f(-1.4426950408889634f * v)); }
__device__ __forceinline__ float wave_sum(float v, int lane) {
#pragma unroll
    for (int o = 1; o < 64; o <<= 1) v += __int_as_float(__builtin_amdgcn_ds_bpermute((lane ^ o) << 2, __float_as_int(v)));
    return v;
}

__device__ const double ROPE_F1[64] = {
1.59154943091895346e-01, 1.37822502603982849e-01, 1.19349370211248862e-01, 1.03352296618434064e-01, 8.94994016088910133e-02, 7.75032887553740585e-02, 6.71150830052272551e-02, 5.81192674418762462e-02,
5.03292121044697269e-02, 4.35833029420947638e-02, 3.77415888468699103e-02, 3.26828760272190911e-02, 2.83022152813622411e-02, 2.45087241866802648e-02, 2.12237020815031856e-02, 1.83789966569160986e-02,
1.59154943091895339e-02, 1.37822502603982842e-02, 1.19349370211248869e-02, 1.03352296618434060e-02, 8.94994016088910202e-03, 7.75032887553740654e-03, 6.71150830052272551e-03, 5.81192674418762427e-03,
5.03292121044697286e-03, 4.35833029420947656e-03, 3.77415888468699086e-03, 3.26828760272190893e-03, 2.83022152813622403e-03, 2.45087241866802661e-03, 2.12237020815031847e-03, 1.83789966569160995e-03,
1.59154943091895335e-03, 1.37822502603982846e-03, 1.19349370211248865e-03, 1.03352296618434069e-03, 8.94994016088910115e-04, 7.75032887553740654e-04, 6.71150830052272508e-04, 5.81192674418762427e-04,
5.03292121044697243e-04, 4.35833029420947678e-04, 3.77415888468699086e-04, 3.26828760272190871e-04, 2.83022152813622381e-04, 2.45087241866802661e-04, 2.12237020815031847e-04, 1.83789966569160984e-04,
1.59154943091895346e-04, 1.37822502603982835e-04, 1.19349370211248871e-04, 1.03352296618434063e-04, 8.94994016088910088e-05, 7.75032887553740654e-05, 6.71150830052272508e-05, 5.81192674418762400e-05,
5.03292121044697243e-05, 4.35833029420947644e-05, 3.77415888468699120e-05, 3.26828760272190871e-05, 2.83022152813622381e-05, 2.45087241866802641e-05, 2.12237020815031861e-05, 1.83789966569160984e-05 };
__device__ const double ROPE_FA[32] = {
1.59154943091895346e-01, 1.19349370211248862e-01, 8.94994016088910133e-02, 6.71150830052272551e-02, 5.03292121044697269e-02, 3.77415888468699103e-02, 2.83022152813622411e-02, 2.12237020815031856e-02,
1.59154943091895339e-02, 1.19349370211248869e-02, 8.94994016088910202e-03, 6.71150830052272551e-03, 5.03292121044697286e-03, 3.77415888468699086e-03, 2.83022152813622403e-03, 2.12237020815031847e-03,
1.59154943091895335e-03, 1.19349370211248865e-03, 8.94994016088910115e-04, 6.71150830052272508e-04, 5.03292121044697243e-04, 3.77415888468699086e-04, 2.83022152813622381e-04, 2.12237020815031847e-04,
1.59154943091895346e-04, 1.19349370211248871e-04, 8.94994016088910088e-05, 6.71150830052272508e-05, 5.03292121044697243e-05, 3.77415888468699120e-05, 2.83022152813622381e-05, 2.12237020815031861e-05 };

namespace pg8 {
typedef unsigned short bf16_t;
constexpr int BM = 256, BK = 64, HALF = 128, HTB = HALF * BK * 2, STAGE_BYTES = 8 * HTB, NXCD = 8, WGM = 8;
__host__ __device__ __forceinline__ int lds_byte(int r, int c) { const int st = (r >> 4) * 2 + (c >> 5), rr = r & 15, cc = c & 31, ob = rr * 64 + cc * 2; return st * 1024 + (ob ^ (((ob >> 9) & 1) << 5)); }
__host__ __device__ __forceinline__ void stage_rc(int b, int& R, int& C) { const int st = b / 1024, sb = b % 1024, swz = sb ^ (((sb >> 9) & 1) << 5); R = (st >> 1) * 16 + swz / 64; C = (st & 1) * 32 + (swz % 64) / 2; }
__host__ __device__ __forceinline__ int perm32(int rho) { const int n = rho >> 4, i = rho & 15; return 8 * (i >> 2) + 4 * n + (i & 3); }

struct Unit { int pm, pn, ka, kb, sub; };
struct Gemm { const bf16_t* A; const bf16_t* Bt; int K; };

struct StaticOrder {
    int nM, nN, nwg, G, c;
    __device__ void init(int M, int N, int G_, int c_) { nM = M / BM; nN = N / BM; nwg = nM * nN; G = G_; c = c_; }
    __device__ bool next(int i, Unit& u) const {
        const long L = (long)i * G + c; if (L >= nwg) return false;
        int wgid = (int)L; { const int q = nwg / NXCD, r = nwg % NXCD, xcd = wgid % NXCD, off = wgid / NXCD; wgid = (xcd < r ? xcd * (q + 1) : r * (q + 1) + (xcd - r) * q) + off; }
        const int nig = WGM * nN, gid = wgid / nig, fm = gid * WGM, gsz = (nM - fm) < WGM ? (nM - fm) : WGM;
        u.pm = fm + ((wgid % nig) % gsz); u.pn = (wgid % nig) / gsz; u.ka = u.pm; u.kb = u.pn; u.sub = 0; return true;
    }
};
struct BranchOrder {
    StaticOrder base; int npanel;
    __device__ bool next(int i, Unit& u) const {
        const int t = i / 3, s = i - 3 * t; if (!base.next(t, u)) return false;
        u.sub = s; u.ka = s * npanel + u.pm; u.kb = s * 8 + u.pn; return true;
    }
};

struct EpiIn {
    static constexpr bool PERM = true;
    bf16_t* P; bf16_t* G;
    __device__ __forceinline__ void operator()(const f32x4 (&acc)[2][2][4][2], const Unit& u, int wr, int wc, int fr_, int fq) const {
        int fr = fr_; asm volatile("" : "+v"(fr));
        const int row0 = u.pm * BM + wr * 64 + fr; const bool gate = u.pn >= 20;
        bf16_t* base = gate ? G : P; const int ldc = gate ? GWD : PWD; const int col0 = (gate ? u.pn - 20 : u.pn) * BM + wc * 32 + 8 * fq;
#pragma unroll
        for (int ai = 0; ai < 2; ++ai)
#pragma unroll
            for (int m = 0; m < 4; ++m) { bf16_t* rowp = base + (size_t)(row0 + ai * HALF + m * 16) * ldc + col0;
#pragma unroll
                for (int bj = 0; bj < 2; ++bj) { f32x4 v0 = acc[ai][bj][m][0], v1 = acc[ai][bj][m][1];
                    if (gate) {
#pragma unroll
                        for (int j = 0; j < 4; ++j) { v0[j] = fast_sigmoid(v0[j]); v1[j] = fast_sigmoid(v1[j]); } }
                    u32x4 w; w.x = cvt_pk_bf16(v0[0], v0[1]); w.y = cvt_pk_bf16(v0[2], v0[3]); w.z = cvt_pk_bf16(v1[0], v1[1]); w.w = cvt_pk_bf16(v1[2], v1[3]);
                    *(u32x4*)(rowp + bj * HALF) = w; } }
    }
};
struct EpiBr {
    static constexpr bool PERM = true;
    const bf16_t* G; bf16_t* OUT; float* scratch;
    __device__ __forceinline__ void operator()(const f32x4 (&acc)[2][2][4][2], const Unit& u, int wr, int wc, int fr_, int fq) const {
        int fr = fr_; asm volatile("" : "+v"(fr));
        const int row0 = u.pm * BM + wr * 64 + fr, col0 = u.pn * BM + wc * 32 + 8 * fq; const int sub = u.sub;
        GAS f32x4* sp = (GAS f32x4*)scratch + ((wr * 4 + wc) * 64 + fq * 16 + fr);
#pragma unroll
        for (int ai = 0; ai < 2; ++ai)
#pragma unroll
            for (int m = 0; m < 4; ++m) { const size_t row = (size_t)(row0 + ai * HALF + m * 16);
#pragma unroll
                for (int bj = 0; bj < 2; ++bj) { const int idx = (((ai * 4 + m) * 2 + bj) * 2) * 512;
                    const u32x4 gw = *(const u32x4*)(G + row * GWD + sub * DM + col0 + bj * HALF);
                    f32x4 v0 = acc[ai][bj][m][0] * (f32x4){bf_lo(gw.x), bf_hi(gw.x), bf_lo(gw.y), bf_hi(gw.y)};
                    f32x4 v1 = acc[ai][bj][m][1] * (f32x4){bf_lo(gw.z), bf_hi(gw.z), bf_lo(gw.w), bf_hi(gw.w)};
                    if (sub > 0) { v0 += sp[idx]; v1 += sp[idx + 512]; }
                    if (sub < 2) { sp[idx] = v0; sp[idx + 512] = v1; }
                    else { u32x4 w; w.x = cvt_pk_bf16(v0[0], v0[1]); w.y = cvt_pk_bf16(v0[2], v0[3]); w.z = cvt_pk_bf16(v1[0], v1[1]); w.w = cvt_pk_bf16(v1[2], v1[3]);
                        *(u32x4*)(OUT + row * DM + col0 + bj * HALF) = w; } }
                asm volatile("" ::: "memory"); }
    }
};
struct EpiF32 {
    static constexpr bool PERM = false;
    float* C; int ldc;
    __device__ __forceinline__ void operator()(const f32x4 (&acc)[2][2][4][2], const Unit& u, int wr, int wc, int fr_, int fq) const {
        int fr = fr_; asm volatile("" : "+v"(fr));
        const int row0 = u.pm * BM + wr * 64 + fr, col0 = u.pn * BM + wc * 32 + 4 * fq;
#pragma unroll
        for (int ai = 0; ai < 2; ++ai)
#pragma unroll
            for (int m = 0; m < 4; ++m) { float* rowp = C + (size_t)(row0 + ai * HALF + m * 16) * ldc + col0;
#pragma unroll
                for (int bj = 0; bj < 2; ++bj)
#pragma unroll
                    for (int n = 0; n < 2; ++n) *(f32x4*)(rowp + bj * HALF + n * 16) = acc[ai][bj][m][n]; }
    }
};
struct EpiRelu2 {
    static constexpr bool PERM = true;
    bf16_t* O; int ldc;
    __device__ __forceinline__ void operator()(const f32x4 (&acc)[2][2][4][2], const Unit& u, int wr, int wc, int fr_, int fq) const {
        int fr = fr_; asm volatile("" : "+v"(fr));
        const int row0 = u.pm * BM + wr * 64 + fr, col0 = u.pn * BM + wc * 32 + 8 * fq;
#pragma unroll
        for (int ai = 0; ai < 2; ++ai)
#pragma unroll
            for (int m = 0; m < 4; ++m) { bf16_t* rowp = O + (size_t)(row0 + ai * HALF + m * 16) * ldc + col0;
#pragma unroll
                for (int bj = 0; bj < 2; ++bj) { f32x4 v0 = acc[ai][bj][m][0], v1 = acc[ai][bj][m][1];
#pragma unroll
                    for (int j = 0; j < 4; ++j) { const float a = fmaxf(v0[j], 0.f), b = fmaxf(v1[j], 0.f); v0[j] = a * a; v1[j] = b * b; }
                    u32x4 w; w.x = cvt_pk_bf16(v0[0], v0[1]); w.y = cvt_pk_bf16(v0[2], v0[3]); w.z = cvt_pk_bf16(v1[0], v1[1]); w.w = cvt_pk_bf16(v1[2], v1[3]);
                    *(u32x4*)(rowp + bj * HALF) = w; } }
    }
};

template <class Epi, class Sched, bool ALIGN_EPI = true>
__device__ __forceinline__ void gemm_phase(LAS unsigned char* lds, const Gemm g, const Sched& S, const Epi& E) {
    int tid_ = threadIdx.x; asm volatile("" : "+v"(tid_));
    const int tid = tid_, wid = __builtin_amdgcn_readfirstlane(tid >> 6), lane = tid & 63, wr = wid >> 2, wc = wid & 3, fr = lane & 15, fq = lane >> 4;
    const int K = g.K, nt = K / BK;
    unsigned voffA[2], voffB[2];
#pragma unroll
    for (int i = 0; i < 2; ++i) { int R, C; stage_rc(tid * 16 + i * 8192, R, C); const int Rb = Epi::PERM ? ((R & ~31) + perm32(R & 31)) : R;
        voffA[i] = (unsigned)(R * K + C) * 2u; voffB[i] = (unsigned)(Rb * K + C) * 2u; }
    const size_t kstep = (size_t)(BK * 2);
    const size_t hstep = (size_t)HALF * K * 2;
    const size_t tstep = 2 * hstep;
    const unsigned ldsw = (unsigned)wid * 1024u;
    const int aoff = lds_byte(wr * 64 + fr, fq * 8), boff = lds_byte(wc * 32 + fr, fq * 8);
#define PG8_SA(b, h) (((b) * 2 + (h)) * HTB)
#define PG8_SB(b, h) ((4 + (b) * 2 + (h)) * HTB)
#define PG8_STAGE(bufoff, gbase, voff) do { _Pragma("unroll") for (int _i = 0; _i < 2; ++_i) \
        __builtin_amdgcn_global_load_lds((const unsigned*)((const char*)(gbase) + (voff)[_i]), (LAS unsigned*)(lds + (bufoff) + ldsw + _i * 8192), 16, 0, 0); } while (0)
#define PG8_LDA(dst, b, h) do { _Pragma("unroll") for (int m = 0; m < 4; ++m) _Pragma("unroll") for (int k = 0; k < 2; ++k) dst[m][k] = *(const LAS bf16x8*)(lds + PG8_SA(b, h) + aoff + m * 2048 + k * 1024); } while (0)
#define PG8_LDB(dst, b, h) do { _Pragma("unroll") for (int n = 0; n < 2; ++n) _Pragma("unroll") for (int k = 0; k < 2; ++k) dst[n][k] = *(const LAS bf16x8*)(lds + PG8_SB(b, h) + boff + n * 2048 + k * 1024); } while (0)
#define PG8_MMA(ai, bj, At, Bt) do { __builtin_amdgcn_s_setprio(1); _Pragma("unroll") for (int m = 0; m < 4; ++m) _Pragma("unroll") for (int n = 0; n < 2; ++n) _Pragma("unroll") for (int k = 0; k < 2; ++k) \
        acc[ai][bj][m][n] = __builtin_amdgcn_mfma_f32_16x16x32_bf16(Bt[n][k], At[m][k], acc[ai][bj][m][n], 0, 0, 0); __builtin_amdgcn_s_setprio(0); } while (0)
#define PG8_WAIT_V(n) asm volatile("s_waitcnt vmcnt(" #n ")" ::: "memory")
#define PG8_WAIT_L(n) asm volatile("s_waitcnt lgkmcnt(" #n ")" ::: "memory")
#define PG8_BAR __builtin_amdgcn_s_barrier()
#define PG8_SCHED __builtin_amdgcn_sched_barrier(0)
    Unit cur, nxt; int ui = 0;
    if (!S.next(0, cur)) return;
    f32x4 acc[2][2][4][2];
#pragma unroll
    for (int a = 0; a < 2; ++a)
#pragma unroll
        for (int b = 0; b < 2; ++b)
#pragma unroll
            for (int m = 0; m < 4; ++m)
#pragma unroll
                for (int n = 0; n < 2; ++n) acc[a][b][m][n] = (f32x4){0.f, 0.f, 0.f, 0.f};
    bf16x8 At[4][2], B0[2][2], B1[2][2];
    const char* cA = (const char*)g.A + (size_t)cur.ka * tstep; const char* cB = (const char*)g.Bt + (size_t)cur.kb * tstep;
    PG8_STAGE(PG8_SB(0, 0), cB, voffB); PG8_STAGE(PG8_SB(0, 1), cB + hstep, voffB); PG8_STAGE(PG8_SA(0, 0), cA, voffA); PG8_STAGE(PG8_SA(0, 1), cA + hstep, voffA);
    if (wr == 1) PG8_BAR;
    PG8_WAIT_V(2); PG8_BAR;
    PG8_STAGE(PG8_SB(1, 0), cB + kstep, voffB); PG8_STAGE(PG8_SA(1, 0), cA + kstep, voffA); PG8_STAGE(PG8_SB(1, 1), cB + hstep + kstep, voffB);
    PG8_WAIT_V(6); PG8_BAR;
    for (;;) {
        const bool has_next = S.next(ui + 1, nxt);
        const char* nA = has_next ? (const char*)g.A + (size_t)nxt.ka * tstep : cA; const char* nB = has_next ? (const char*)g.Bt + (size_t)nxt.kb * tstep : cB;
        for (int t = 0; t < nt; t += 2) {
            const bool last = (t == nt - 2);
            const char* a1 = cA + (size_t)(t + 1) * kstep;
            const char* a2 = last ? nA : cA + (size_t)(t + 2) * kstep; const char* b2 = last ? nB : cB + (size_t)(t + 2) * kstep;
            const char* a3 = a2 + kstep; const char* b3 = b2 + kstep;
            PG8_LDB(B0, 0, 0); PG8_LDB(B1, 0, 1); PG8_SCHED; PG8_LDA(At, 0, 0); PG8_STAGE(PG8_SA(1, 1), a1 + hstep, voffA);
            PG8_WAIT_V(8); PG8_WAIT_L(0); PG8_BAR; PG8_MMA(0, 0, At, B0); PG8_MMA(0, 1, At, B1); PG8_BAR; PG8_SCHED;
            PG8_LDA(At, 0, 1); PG8_STAGE(PG8_SB(0, 0), b2, voffB); PG8_STAGE(PG8_SB(0, 1), b2 + hstep, voffB); PG8_STAGE(PG8_SA(0, 0), a2, voffA);
            PG8_WAIT_V(8); PG8_WAIT_L(0); PG8_BAR; PG8_MMA(1, 0, At, B0); PG8_MMA(1, 1, At, B1); PG8_BAR; PG8_SCHED;
            PG8_LDB(B0, 1, 0); PG8_LDB(B1, 1, 1); PG8_SCHED; PG8_LDA(At, 1, 0); PG8_STAGE(PG8_SA(0, 1), a2 + hstep, voffA);
            PG8_WAIT_V(8); PG8_WAIT_L(0); PG8_BAR; PG8_MMA(0, 0, At, B0); PG8_MMA(0, 1, At, B1); PG8_BAR; PG8_SCHED;
            PG8_LDA(At, 1, 1); PG8_STAGE(PG8_SB(1, 0), b3, voffB); PG8_STAGE(PG8_SB(1, 1), b3 + hstep, voffB); PG8_STAGE(PG8_SA(1, 0), a3, voffA);
            PG8_WAIT_V(8); PG8_WAIT_L(0); PG8_BAR; PG8_MMA(1, 0, At, B0); PG8_MMA(1, 1, At, B1); PG8_BAR; PG8_SCHED;
        }
        if constexpr (ALIGN_EPI) { if (wr == 0) PG8_BAR; }
        E(acc, cur, wr, wc, fr, fq);
        if (!has_next) break;
#pragma unroll
        for (int a = 0; a < 2; ++a)
#pragma unroll
            for (int b = 0; b < 2; ++b)
#pragma unroll
                for (int m = 0; m < 4; ++m)
#pragma unroll
                    for (int n = 0; n < 2; ++n) acc[a][b][m][n] = (f32x4){0.f, 0.f, 0.f, 0.f};
        cur = nxt; cA = nA; cB = nB; ++ui;
        if constexpr (ALIGN_EPI) { if (wr == 1) PG8_BAR; }
    }
    PG8_WAIT_V(0);
    if constexpr (!ALIGN_EPI) { if (wr == 0) PG8_BAR; }
    PG8_BAR;
#undef PG8_SA
#undef PG8_SB
#undef PG8_STAGE
#undef PG8_LDA
#undef PG8_LDB
#undef PG8_MMA
#undef PG8_WAIT_V
#undef PG8_WAIT_L
#undef PG8_BAR
#undef PG8_SCHED
}
}

namespace att {
constexpr int D = 128, NW = 8, QBLK = 32, KVBLK = 64;
constexpr float SCALE = 0.088388347648318440f;
constexpr float THR = 8.f;
constexpr int LDQ = PWD, LDK = PWD, LDO = MWD;
constexpr int SHM_V = KVBLK * D * 2, SHM_K = KVBLK * D * 2;
constexpr int OST_PITCH = 272;
constexpr int OST_OFF = 2 * SHM_V + 2 * SHM_K + NW * 64 * 4;
constexpr int ATT_LDS = OST_OFF + NW * 32 * OST_PITCH;
#define KSWZ(row, colB) ((row) * 256 + ((colB) ^ (((row) & 7) << 4)))
#define SBAR() __builtin_amdgcn_sched_barrier(0)
__device__ __forceinline__ int crow(int r, int hi) { return (r & 3) + 8 * (r >> 2) + 4 * hi; }

template <bool MASKED>
__device__ __forceinline__ void partialSM(f32x16& p0, f32x16& p1, float& m_reg, float& mn, float& alpha, int mbase) {
  constexpr float C = SCALE * 1.4426950408889634f;
  if constexpr (MASKED) {
    const float ninf = -__builtin_inff();
#pragma unroll
    for (int r = 0; r < 16; ++r) { const int c = (r & 3) + 8 * (r >> 2);
      p0[r] = ((unsigned)(mbase - c) <= 256u) ? p0[r] : ninf;
      p1[r] = ((unsigned)(mbase - c - 32) <= 256u) ? p1[r] : ninf; }
  }
  float pmax = p0[0];
#pragma unroll
  for (int r = 1; r < 16; ++r) pmax = fmaxf(pmax, p0[r]);
#pragma unroll
  for (int r = 0; r < 16; ++r) pmax = fmaxf(pmax, p1[r]);
  { auto rr = __builtin_amdgcn_permlane32_swap(__float_as_uint(pmax), __float_as_uint(pmax), false, false);
    pmax = fmaxf(__uint_as_float(rr[0]), __uint_as_float(rr[1])); }
  if (__builtin_expect(__all(pmax - m_reg <= THR / SCALE), 1)) { mn = m_reg; alpha = 1.f; }
  else { mn = fmaxf(m_reg, pmax); alpha = __builtin_amdgcn_exp2f((m_reg - mn) * C); m_reg = mn; }
  float mnC = -mn * C;
#pragma unroll
  for (int r = 0; r < 16; ++r) p0[r] = fmaf(p0[r], C, mnC);
#pragma unroll
  for (int r = 0; r < 16; ++r) p1[r] = fmaf(p1[r], C, mnC);
#pragma unroll
  for (int r = 0; r < 16; ++r) p0[r] = __builtin_amdgcn_exp2f(p0[r]);
}
__device__ __forceinline__ void finishSM(f32x16& p0, f32x16& p1, float alpha, float& l_reg, bf16x8& pa0, bf16x8& pa1, bf16x8& pa2, bf16x8& pa3) {
#pragma unroll
  for (int r = 0; r < 16; ++r) p1[r] = __builtin_amdgcn_exp2f(p1[r]);
  float ps = 0;
#pragma unroll
  for (int r = 0; r < 16; ++r) ps += p0[r];
#pragma unroll
  for (int r = 0; r < 16; ++r) ps += p1[r];
  { auto rr = __builtin_amdgcn_permlane32_swap(__float_as_uint(ps), __float_as_uint(ps), false, false);
    ps = __uint_as_float(rr[0]) + __uint_as_float(rr[1]); }
  l_reg = l_reg * alpha + ps;
#define PK4(P, BASE, OUT) do { unsigned a0 = cvt_pk_bf16(P[BASE + 0], P[BASE + 1]), a1 = cvt_pk_bf16(P[BASE + 2], P[BASE + 3]);   \
    unsigned b0 = cvt_pk_bf16(P[BASE + 4], P[BASE + 5]), b1 = cvt_pk_bf16(P[BASE + 6], P[BASE + 7]);                              \
    auto r0 = __builtin_amdgcn_permlane32_swap(a0, b0, false, false); auto r1 = __builtin_amdgcn_permlane32_swap(a1, b1, false, false); \
    u32x4 w = {r0[0], r1[0], r0[1], r1[1]}; OUT = *reinterpret_cast<bf16x8*>(&w); } while (0)
  PK4(p0, 0, pa0); PK4(p0, 8, pa1); PK4(p1, 0, pa2); PK4(p1, 8, pa3);
#undef PK4
}
__device__ __forceinline__ void qkt(f32x16& p0, f32x16& p1, const bf16* Ks, const bf16x8* qr, int r32, int hi) {
  p0 = f32x16{}; p1 = f32x16{};
#pragma unroll
  for (int d0 = 0; d0 < 8; ++d0) { int cb = (d0 * 16 + hi * 8) * 2;
    bf16x8 b0 = *reinterpret_cast<const bf16x8*>((const char*)Ks + KSWZ(r32, cb));
    bf16x8 b1 = *reinterpret_cast<const bf16x8*>((const char*)Ks + KSWZ(32 + r32, cb));
    p0 = __builtin_amdgcn_mfma_f32_32x32x16_bf16(b0, qr[d0], p0, 0, 0, 0);
    p1 = __builtin_amdgcn_mfma_f32_32x32x16_bf16(b1, qr[d0], p1, 0, 0, 0); }
}
__device__ __forceinline__ int v_st(int k, int c) { const int kk = (k & ~0xC) | ((k & 4) << 1) | ((k & 8) >> 1); return ((kk >> 3) * 4 + (c >> 5)) * 512 + ((kk & 7) * 32 + (c & 31)) * 2; }
__device__ __forceinline__ int v_rd_base(int lane) { return ((lane & 3) << 3) | (((lane >> 2) & 3) << 6) | (((lane >> 4) & 1) << 5) | (((lane >> 5) & 1) << 8); }
constexpr int v_rd_off(int d0, int ks, int half) { return d0 * 512 + ks * 4096 + half * 2048; }
template <int OFF> __device__ __forceinline__ s16x4 tr_read(int vb) {
  s16x4 r; asm volatile("ds_read_b64_tr_b16 %0, %1 offset:%2" : "=&v"(r) : "v"(vb), "i"(OFF) : "memory"); return r;
}
template <int D0> __device__ __forceinline__ void pv_one(f32x16& od, int vb, bf16x8 pa0, bf16x8 pa1, bf16x8 pa2, bf16x8 pa3) {
  const s16x4 l0 = tr_read<v_rd_off(D0, 0, 0)>(vb), h0 = tr_read<v_rd_off(D0, 0, 1)>(vb), l1 = tr_read<v_rd_off(D0, 1, 0)>(vb), h1 = tr_read<v_rd_off(D0, 1, 1)>(vb);
  const s16x4 l2 = tr_read<v_rd_off(D0, 2, 0)>(vb), h2 = tr_read<v_rd_off(D0, 2, 1)>(vb), l3 = tr_read<v_rd_off(D0, 3, 0)>(vb), h3 = tr_read<v_rd_off(D0, 3, 1)>(vb);
  asm volatile("s_waitcnt lgkmcnt(0)" ::: "memory"); SBAR();
#define PK(L, H) (bf16x8){L[0], L[1], L[2], L[3], H[0], H[1], H[2], H[3]}
  od = __builtin_amdgcn_mfma_f32_32x32x16_bf16(pa0, PK(l0, h0), od, 0, 0, 0);
  od = __builtin_amdgcn_mfma_f32_32x32x16_bf16(pa1, PK(l1, h1), od, 0, 0, 0);
  od = __builtin_amdgcn_mfma_f32_32x32x16_bf16(pa2, PK(l2, h2), od, 0, 0, 0);
  od = __builtin_amdgcn_mfma_f32_32x32x16_bf16(pa3, PK(l3, h3), od, 0, 0, 0);
#undef PK
}
__device__ __forceinline__ void pv_d0(f32x16* o, int vb, bf16x8 pa0, bf16x8 pa1, bf16x8 pa2, bf16x8 pa3) {
  pv_one<0>(o[0], vb, pa0, pa1, pa2, pa3); pv_one<1>(o[1], vb, pa0, pa1, pa2, pa3); pv_one<2>(o[2], vb, pa0, pa1, pa2, pa3); pv_one<3>(o[3], vb, pa0, pa1, pa2, pa3);
}

template <int MODE, int SD>
__device__ __forceinline__ void attn_unit(const bf16* __restrict__ Qb, const bf16* __restrict__ Kh, const bf16* __restrict__ Vh, bf16* __restrict__ Ob, int NT, int dq0, float sink, char* lds,
                                          const f32x2* __restrict__ tab  , const float* __restrict__ gq  ) {
  int tid_ = threadIdx.x; asm volatile("" : "+v"(tid_));
  const int tid = tid_, wid = tid >> 6, lane = tid & 63, r32 = lane & 31, hi = lane >> 5;
  bf16* V_lds = (bf16*)lds; bf16* K_lds = (bf16*)(lds + 2 * SHM_V);
  float* ws = (float*)(lds + 2 * SHM_V + 2 * SHM_K) + wid * 64; float* li_l = ws; float* al_l = ws + 32;
  float m_reg = MODE ? sink * (1.0f / SCALE) : -1e30f, l_reg = MODE ? 1.0f : 0.0f; f32x16 o[4] = {}; bf16x8 qr[8];
  const bf16* Qw = Qb + (long)(wid * QBLK + r32) * LDQ + hi * 8;
#pragma unroll
  for (int d0 = 0; d0 < 8; ++d0) qr[d0] = *reinterpret_cast<const bf16x8*>(Qw + d0 * 16);
  {
    float rstd = 1.f;
    if constexpr (MODE == 0) {
      float ss = 0.f;
#pragma unroll
      for (int d0 = 0; d0 < 8; ++d0) { const u32x4 w = *reinterpret_cast<const u32x4*>(&qr[d0]);
        const float a0 = bf_lo(w.x), a1 = bf_hi(w.x), a2 = bf_lo(w.y), a3 = bf_hi(w.y), a4 = bf_lo(w.z), a5 = bf_hi(w.z), a6 = bf_lo(w.w), a7 = bf_hi(w.w);
        ss += (a0 * a0 + a1 * a1) + (a2 * a2 + a3 * a3) + (a4 * a4 + a5 * a5) + (a6 * a6 + a7 * a7); }
      { auto rr = __builtin_amdgcn_permlane32_swap(__float_as_uint(ss), __float_as_uint(ss), false, false); ss = __uint_as_float(rr[0]) + __uint_as_float(rr[1]); }
      rstd = 1.0f / sqrtf(ss * (1.0f / D) + EPS);
    }
    const f32x4* tp = (const f32x4*)(tab + (wid * QBLK + r32) * 64 + hi * 8);
#pragma unroll
    for (int d0 = 0; d0 < 4; ++d0) {
      const u32x4 w1 = *reinterpret_cast<const u32x4*>(&qr[d0]), w2 = *reinterpret_cast<const u32x4*>(&qr[d0 + 4]);
      float x1[8] = {bf_lo(w1.x), bf_hi(w1.x), bf_lo(w1.y), bf_hi(w1.y), bf_lo(w1.z), bf_hi(w1.z), bf_lo(w1.w), bf_hi(w1.w)};
      float x2[8] = {bf_lo(w2.x), bf_hi(w2.x), bf_lo(w2.y), bf_hi(w2.y), bf_lo(w2.z), bf_hi(w2.z), bf_lo(w2.w), bf_hi(w2.w)};
      if constexpr (MODE == 0) {
        const f32x4 g1a = *(const f32x4*)(gq + d0 * 16 + hi * 8), g1b = *(const f32x4*)(gq + d0 * 16 + hi * 8 + 4), g2a = *(const f32x4*)(gq + 64 + d0 * 16 + hi * 8), g2b = *(const f32x4*)(gq + 64 + d0 * 16 + hi * 8 + 4);
        const float g1[8] = {g1a.x, g1a.y, g1a.z, g1a.w, g1b.x, g1b.y, g1b.z, g1b.w}, g2[8] = {g2a.x, g2a.y, g2a.z, g2a.w, g2b.x, g2b.y, g2b.z, g2b.w};
#pragma unroll
        for (int e = 0; e < 8; ++e) { x1[e] = x1[e] * rstd * g1[e]; x2[e] = x2[e] * rstd * g2[e]; }
      }
      float o1[8], o2[8];
#pragma unroll
      for (int e2 = 0; e2 < 4; ++e2) { const f32x4 cs = tp[d0 * 8 + e2];
        o1[2 * e2] = x1[2 * e2] * cs.x - x2[2 * e2] * cs.y; o2[2 * e2] = x2[2 * e2] * cs.x + x1[2 * e2] * cs.y;
        o1[2 * e2 + 1] = x1[2 * e2 + 1] * cs.z - x2[2 * e2 + 1] * cs.w; o2[2 * e2 + 1] = x2[2 * e2 + 1] * cs.z + x1[2 * e2 + 1] * cs.w; }
      u32x4 p1, p2; p1.x = cvt_pk_bf16(o1[0], o1[1]); p1.y = cvt_pk_bf16(o1[2], o1[3]); p1.z = cvt_pk_bf16(o1[4], o1[5]); p1.w = cvt_pk_bf16(o1[6], o1[7]);
      p2.x = cvt_pk_bf16(o2[0], o2[1]); p2.y = cvt_pk_bf16(o2[2], o2[3]); p2.z = cvt_pk_bf16(o2[4], o2[5]); p2.w = cvt_pk_bf16(o2[6], o2[7]);
      qr[d0] = *reinterpret_cast<bf16x8*>(&p1); qr[d0 + 4] = *reinterpret_cast<bf16x8*>(&p2);
    }
  }
  const int sr = tid >> 4, sc = (tid & 15) * 8, vst0 = v_st(sr, sc), vst1 = v_st(32 + sr, sc);
  const int vb0 = (int)(uintptr_t)V_lds + v_rd_base(lane);
  const int mb0 = dq0 + wid * QBLK + r32 + 128 - 4 * hi;
  struct { bf16x8 vs0, vs1, ks0, ks1; } sr_[SD];
#define SLOAD(i, k0) do { sr_[i].vs0 = *reinterpret_cast<const bf16x8*>(&Vh[(long)((k0) + sr) * LDK + sc]); sr_[i].vs1 = *reinterpret_cast<const bf16x8*>(&Vh[(long)((k0) + 32 + sr) * LDK + sc]); \
    sr_[i].ks0 = *reinterpret_cast<const bf16x8*>(&Kh[(long)((k0) + sr) * LDK + sc]); sr_[i].ks1 = *reinterpret_cast<const bf16x8*>(&Kh[(long)((k0) + 32 + sr) * LDK + sc]); } while (0)
#define SWRITE(b, i) do { *(bf16x8*)((char*)V_lds + (b) * SHM_V + vst0) = sr_[i].vs0;          \
    *(bf16x8*)((char*)V_lds + (b) * SHM_V + vst1) = sr_[i].vs1; int kc = sc * 2;               \
    *(bf16x8*)((char*)K_lds + (b) * SHM_K + KSWZ(sr, kc)) = sr_[i].ks0;                       \
    *(bf16x8*)((char*)K_lds + (b) * SHM_K + KSWZ(32 + sr, kc)) = sr_[i].ks1; } while (0)
#define SWAIT() do { if constexpr (SD == 2) asm volatile("s_waitcnt vmcnt(4)" ::: "memory"); else asm volatile("s_waitcnt vmcnt(0)" ::: "memory"); } while (0)
#define RESC(a) do { if (__any((a) < 1.f)) { if (hi == 0) al_l[r32] = (a); asm volatile("s_waitcnt lgkmcnt(0)" ::: "memory"); \
    _Pragma("unroll") for (int d = 0; d < 4; ++d) _Pragma("unroll") for (int r = 0; r < 16; ++r) o[d][r] *= al_l[crow(r, hi)]; } } while (0)
#define PSM(P0, P1, MN, AL, J) partialSM<MODE != 0>(P0, P1, m_reg, MN, AL, mb0 - 64 * (J))
  f32x16 pA0, pA1, pB0, pB1; float mnA, mnB, alA, alB; bf16x8 pa0, pa1, pa2, pa3;
  constexpr int SE = 0, SO = SD - 1;
  SLOAD(SE, 0); asm volatile("s_waitcnt vmcnt(0)" ::: "memory"); SWRITE(0, SE); __syncthreads();
  qkt(pA0, pA1, K_lds, qr, r32, hi); PSM(pA0, pA1, mnA, alA, 0);
  SLOAD(SO, KVBLK); if constexpr (SD == 2) { if (2 < NT) SLOAD(SE, 2 * KVBLK); }
  SWAIT(); SWRITE(1, SO); __syncthreads();
  for (int j = 1; j + 1 < NT; j += 2) {
    SBAR(); qkt(pB0, pB1, (bf16*)((char*)K_lds + SHM_K), qr, r32, hi);
    finishSM(pA0, pA1, alA, l_reg, pa0, pa1, pa2, pa3); SBAR();
    SLOAD(SO, (j + SD) * KVBLK); SBAR();
    pv_d0(o, vb0, pa0, pa1, pa2, pa3); PSM(pB0, pB1, mnB, alB, j);
    __syncthreads(); SWAIT(); SWRITE(0, SE);
    RESC(alB); __syncthreads();
    SBAR(); qkt(pA0, pA1, K_lds, qr, r32, hi);
    finishSM(pB0, pB1, alB, l_reg, pa0, pa1, pa2, pa3); SBAR();
    if (SD == 1 || j + 3 < NT) SLOAD(SE, (j + 1 + SD) * KVBLK); SBAR();
    pv_d0(o, vb0 + (int)SHM_V, pa0, pa1, pa2, pa3); PSM(pA0, pA1, mnA, alA, j + 1);
    __syncthreads(); SWAIT(); SWRITE(1, SO);
    RESC(alA); __syncthreads();
  }
  SBAR(); qkt(pB0, pB1, (bf16*)((char*)K_lds + SHM_K), qr, r32, hi);
  finishSM(pA0, pA1, alA, l_reg, pa0, pa1, pa2, pa3); SBAR();
  pv_d0(o, vb0, pa0, pa1, pa2, pa3); PSM(pB0, pB1, mnB, alB, NT - 1);
  __syncthreads(); RESC(alB);
  finishSM(pB0, pB1, alB, l_reg, pa0, pa1, pa2, pa3); SBAR();
  pv_d0(o, vb0 + (int)SHM_V, pa0, pa1, pa2, pa3);
  if (hi == 0) li_l[r32] = l_reg; asm volatile("s_waitcnt lgkmcnt(0)" ::: "memory");
  float rli[16];
#pragma unroll
  for (int r = 0; r < 16; ++r) rli[r] = __builtin_amdgcn_rcpf(li_l[crow(r, hi)]);
  char* ost = lds + OST_OFF + wid * (32 * OST_PITCH);
#pragma unroll
  for (int r = 0; r < 16; ++r) { const int orow = crow(r, hi);
#pragma unroll
    for (int d0 = 0; d0 < 4; ++d0) { const float v = o[d0][r] * rli[r]; *(bf16*)(ost + orow * OST_PITCH + (d0 * 32 + r32) * 2) = (bf16)(cvt_pk_bf16(v, v) & 0xffffu); } }
  asm volatile("s_waitcnt lgkmcnt(0)" ::: "memory");
  bf16* Ow = Ob + (long)(wid * QBLK) * LDO;
#pragma unroll
  for (int i = 0; i < 8; ++i) { const int row = (lane >> 4) + 4 * i, cc = (lane & 15);
    const u32x4 w = *(const u32x4*)(ost + row * OST_PITCH + cc * 16);
    *(u32x4*)(Ow + (long)row * LDO + cc * 8) = w; }
  __syncthreads();
#undef SLOAD
#undef SWRITE
#undef SWAIT
#undef RESC
#undef PSM
}
}

#define XB_TMO      128
#define XB_XCNT(j)  (256  + 64 * (j))
#define XB_XSUB(j)  (1280 + 64 * (j))
#define XB_XGEN(j)  (2304 + 64 * (j))
#define XB_TOP      3328
#define XB_TOPGEN   3392
#define XCD_BAR_WORDS 3456
#define XB_SPIN_CAP (1u << 20)
__device__ __forceinline__ unsigned xb_ld(unsigned* p)              { return __hip_atomic_load(p, __ATOMIC_RELAXED, __HIP_MEMORY_SCOPE_AGENT); }
__device__ __forceinline__ unsigned xb_add(unsigned* p, unsigned v) { return __hip_atomic_fetch_add(p, v, __ATOMIC_RELAXED, __HIP_MEMORY_SCOPE_AGENT); }
__device__ __forceinline__ unsigned xb_xcc_id() { return (unsigned)__builtin_amdgcn_s_getreg((3 << 11) | 20) & 0xFu; }
#define XB_SPIN(cond, bar) do { unsigned _sp = 0; while (cond) { __builtin_amdgcn_s_sleep(1); \
    if ((++_sp & 255u) == 0u) { if (xb_ld(&(bar)[XB_TMO])) break; if (_sp > XB_SPIN_CAP) { atomicAdd(&(bar)[XB_TMO], 1u); break; } } } } while (0)
struct XcdBarrier { unsigned* bar; unsigned x; volatile LAS unsigned* st; };
__device__ __forceinline__ XcdBarrier xcd_barrier_post(unsigned* bar, volatile LAS unsigned* st) {
    XcdBarrier b; b.bar = bar; b.x = xb_xcc_id(); b.st = st;
    if (threadIdx.x == 0) (void)xb_add(&bar[XB_XCNT(b.x)], 1u);
    return b;
}
__device__ __forceinline__ void xcd_barrier_complete(unsigned* bar, unsigned x, unsigned& nloc, unsigned& nx) {
    const unsigned G = gridDim.x * gridDim.y * gridDim.z;
    unsigned sum, cnt, mine, sp = 0u;
    for (;;) {
        sum = 0u; cnt = 0u; mine = 0u;
#pragma unroll
        for (unsigned j = 0; j < 16; ++j) { const unsigned c = xb_ld(&bar[XB_XCNT(j)]); sum += c; cnt += (c > 0u) ? 1u : 0u; mine = (j == x) ? c : mine; }
        if (sum == G) break;
        __builtin_amdgcn_s_sleep(1);
        if ((++sp & 255u) == 0u) { if (xb_ld(&bar[XB_TMO])) break; if (sp > XB_SPIN_CAP) { atomicAdd(&bar[XB_TMO], 1u); break; } }
    }
    nloc = mine > 0u ? mine : 1u; nx = cnt > 0u ? cnt : 1u;
}
__device__ __forceinline__ void xcd_barrier(const XcdBarrier& b) {
    asm volatile("s_waitcnt vmcnt(0)" ::: "memory");
    __syncthreads();
    if (threadIdx.x == 0) {
        unsigned* bar = b.bar;
        __builtin_amdgcn_s_waitcnt(0);
        unsigned nloc = b.st[0], nx = b.st[1];
        if (nloc == 0u) { xcd_barrier_complete(bar, b.x, nloc, nx); b.st[0] = nloc; b.st[1] = nx; }
        const unsigned old = xb_add(&bar[XB_XSUB(b.x)], 1u);
        const unsigned gen = old / nloc;
        if (old + 1u == (gen + 1u) * nloc) {
            __builtin_amdgcn_fence(__ATOMIC_RELEASE, "agent");
            asm volatile("s_waitcnt vmcnt(0)" ::: "memory");
            const unsigned og = xb_add(&bar[XB_TOP], 1u);
            const unsigned tg = og / nx;
            if (og + 1u == (tg + 1u) * nx) xb_add(&bar[XB_TOPGEN], 1u);
            else XB_SPIN(xb_ld(&bar[XB_TOPGEN]) == tg, bar);
            __builtin_amdgcn_fence(__ATOMIC_ACQUIRE, "agent");
            xb_add(&bar[XB_XGEN(b.x)], 1u);
            asm volatile("s_waitcnt vmcnt(0)" ::: "memory");
        } else {
            XB_SPIN(xb_ld(&bar[XB_XGEN(b.x)]) == gen, bar);
            __builtin_amdgcn_fence(__ATOMIC_ACQUIRE, "agent");
            asm volatile("s_waitcnt vmcnt(0)" ::: "memory");
        }
    }
    __syncthreads();
}

__device__ __forceinline__ void transpose_item(const float* W, int K, int N, bf16* WT, LAS float* scr, int item, int lane) {
    const int nblk = N / 32, kb = item / nblk, nb = item % nblk, k0 = 64 * kb, n0 = 32 * nb;
#pragma unroll 8
    for (int i = 0; i < 32; ++i) { const int kk = 2 * i + (lane >> 5); scr[kk * 33 + (lane & 31)] = W[(size_t)(k0 + kk) * N + n0 + (lane & 31)]; }
    asm volatile("s_waitcnt lgkmcnt(0)" ::: "memory");
    const int c = lane & 7;
#pragma unroll
    for (int j = 0; j < 4; ++j) { const int n = (lane >> 3) + 8 * j; const LAS float* s = scr + (8 * c) * 33 + n;
        u32x4 o; o.x = cvt_pk_bf16(s[0 * 33], s[1 * 33]); o.y = cvt_pk_bf16(s[2 * 33], s[3 * 33]); o.z = cvt_pk_bf16(s[4 * 33], s[5 * 33]); o.w = cvt_pk_bf16(s[6 * 33], s[7 * 33]);
        *(u32x4*)(WT + (size_t)(n0 + n) * K + k0 + 8 * c) = o; }
    asm volatile("s_waitcnt lgkmcnt(0)" ::: "memory");
}

struct Args { const float* in[21]; float* out; unsigned char* ws; int lo, hi; };

__device__ __forceinline__ const float* x_in_row(const float* xp, const float* xs, int row) {
    return row < NPROMPT_TOK ? xp + (size_t)row * DM : xs + (size_t)(row - NPROMPT_TOK) * DM;
}

__device__ __forceinline__ void phase_weights(const CAS Args* a, unsigned char* ws, int l, LAS unsigned char* lds, int gw, int NGW, int wave, int lane) {
    LAS float* scr = (LAS float*)(lds + wave * 16384);
    constexpr int I_IN = (DM / 64) * (INW / 32), I_BR = (MWD / 64) * (DM / 32), I_OUT = (DM / 64) * (DM / 32), I_F1 = (DM / 64) * (FFD / 32), I_F2 = (FFD / 64) * (DM / 32), I_G = 32 * 8;
    constexpr int NITEMS = I_IN + 3 * I_BR + I_OUT + I_F1 + I_F2 + I_G;
    for (int it = gw; it < NITEMS; it += NGW) {
        int r = it;
        if (r < I_IN) { transpose_item(a->in[6] + (size_t)l * DM * INW, DM, INW, (bf16*)(ws + WS_WIN), scr, r, lane); continue; } r -= I_IN;
        if (r < 3 * I_BR) { const int b = r / I_BR; transpose_item(a->in[17] + ((size_t)l * 3 + b) * MWD * DM, MWD, DM, (bf16*)(ws + WS_WBR) + (size_t)b * DM * MWD, scr, r - b * I_BR, lane); continue; } r -= 3 * I_BR;
        if (r < I_OUT) { transpose_item(a->in[18] + (size_t)l * DM * DM, DM, DM, (bf16*)(ws + WS_WOUT), scr, r, lane); continue; } r -= I_OUT;
        if (r < I_F1) { transpose_item(a->in[19] + (size_t)l * DM * FFD, DM, FFD, (bf16*)(ws + WS_W1), scr, r, lane); continue; } r -= I_F1;
        if (r < I_F2) { transpose_item(a->in[20] + (size_t)l * FFD * DM, FFD, DM, (bf16*)(ws + WS_W2), scr, r, lane); continue; } r -= I_F2;
        { const int mi = r >> 3, sub = r & 7;
          const int gate = mi >> 4, dd = (mi >> 3) & 1, blk = mi & 7;
          const float* src = (gate ? a->in[14] : a->in[12]) + (((size_t)l * 2 + dd) * 8 + blk) * 16384;
          transpose_item(src, 128, 128, (bf16*)(ws + WS_WG) + ((size_t)(dd * 2 + gate) * 8 + blk) * 16384, scr, sub, lane); }
    }
}

__device__ __forceinline__ void norm_row_to_bf16(const float* xrow, const float* g, bf16* orow, int lane) {
    const f32x4* xr = (const f32x4*)xrow + lane; const f32x4* gr = (const f32x4*)g + lane;
    f32x4 v[8]; float s = 0.f;
#pragma unroll
    for (int j = 0; j < 8; ++j) { v[j] = xr[64 * j]; s += (v[j].x * v[j].x + v[j].y * v[j].y) + (v[j].z * v[j].z + v[j].w * v[j].w); }
    const float rstd = 1.0f / sqrtf(wave_sum(s, lane) * (1.0f / DM) + EPS);
    u32x2* o8 = (u32x2*)orow + lane;
#pragma unroll
    for (int j = 0; j < 8; ++j) { const f32x4 gg = gr[64 * j]; u32x2 w; w.x = cvt_pk_bf16(v[j].x * rstd * gg.x, v[j].y * rstd * gg.y); w.y = cvt_pk_bf16(v[j].z * rstd * gg.z, v[j].w * rstd * gg.w); o8[64 * j] = w; }
}
template <bool SECOND>
__device__ __forceinline__ void resid_norm_row(const float* yrow, const float* xold, float* xout, const float* g1, const float* g2, bf16* hrow, int lane) {
    const f32x4* yr = (const f32x4*)yrow + lane; const f32x4* xr = (const f32x4*)xold + lane; const f32x4* g1r = (const f32x4*)g1 + lane;
    f32x4 v[8]; float s = 0.f;
#pragma unroll
    for (int j = 0; j < 8; ++j) { v[j] = yr[64 * j]; s += (v[j].x * v[j].x + v[j].y * v[j].y) + (v[j].z * v[j].z + v[j].w * v[j].w); }
    const float rstd = 1.0f / sqrtf(wave_sum(s, lane) * (1.0f / DM) + EPS);
    float s2 = 0.f;
#pragma unroll
    for (int j = 0; j < 8; ++j) { const f32x4 gg = g1r[64 * j]; const f32x4 xo = xr[64 * j]; v[j] = xo + v[j] * rstd * gg; ((f32x4*)xout + lane)[64 * j] = v[j];
        s2 += (v[j].x * v[j].x + v[j].y * v[j].y) + (v[j].z * v[j].z + v[j].w * v[j].w); }
    if constexpr (SECOND) {
        const float rstd2 = 1.0f / sqrtf(wave_sum(s2, lane) * (1.0f / DM) + EPS);
        const f32x4* g2r = (const f32x4*)g2 + lane; u32x2* o8 = (u32x2*)hrow + lane;
#pragma unroll
        for (int j = 0; j < 8; ++j) { const f32x4 gg = g2r[64 * j]; u32x2 w; w.x = cvt_pk_bf16(v[j].x * rstd2 * gg.x, v[j].y * rstd2 * gg.y); w.y = cvt_pk_bf16(v[j].z * rstd2 * gg.z, v[j].w * rstd2 * gg.w); o8[64 * j] = w; }
    }
}

__device__ __forceinline__ void krope_token(bf16* prow, const f32x2* taba, const f32x2* tab1, const float* kn, int lane) {
    const f32x2 csa = taba[lane], cs1 = tab1[lane];
    const float kg1 = kn[lane], kg2 = kn[64 + lane];
#pragma unroll
    for (int h = 0; h < 2; ++h) {
        bf16* p = prow + KA_OFF + h * HD;
        const float x1 = bf2f(p[lane]), x2 = bf2f(p[64 + lane]);
        const float rstd = 1.0f / sqrtf(wave_sum(x1 * x1 + x2 * x2, lane) * (1.0f / HD) + EPS);
        const float y1 = x1 * rstd * kg1, y2 = x2 * rstd * kg2;
        const float o1 = y1 * csa.x - y2 * csa.y, o2 = y2 * csa.x + y1 * csa.y;
        p[lane] = (bf16)(cvt_pk_bf16(o1, o1) & 0xffffu); p[64 + lane] = (bf16)(cvt_pk_bf16(o2, o2) & 0xffffu);
    }
#pragma unroll
    for (int h = 0; h < 2; ++h) {
        bf16* p = prow + KB_OFF + h * HD;
        const float x1 = bf2f(p[lane]), x2 = bf2f(p[64 + lane]);
        const float o1 = x1 * cs1.x - x2 * cs1.y, o2 = x2 * cs1.x + x1 * cs1.y;
        p[lane] = (bf16)(cvt_pk_bf16(o1, o1) & 0xffffu); p[64 + lane] = (bf16)(cvt_pk_bf16(o2, o2) & 0xffffu);
    }
}
__device__ __forceinline__ void rope_tables(f32x2* tab1, f32x2* taba, int gtid, int nthr) {
    for (int i = gtid; i < SEQ * 64; i += nthr) {
        const int pos = i >> 6, j = i & 63;
        const double rev1 = (double)pos * ROPE_F1[j];
        const double reva = (double)(j < 32 ? (pos >> 6) : (pos & 63)) * ROPE_FA[j & 31];
        const float f1 = (float)(rev1 - __builtin_floor(rev1)), fa = (float)(reva - __builtin_floor(reva));
        tab1[i] = (f32x2){__builtin_amdgcn_cosf(f1), __builtin_amdgcn_sinf(f1)};
        taba[i] = (f32x2){__builtin_amdgcn_cosf(fa), __builtin_amdgcn_sinf(fa)};
    }
}

struct CParams { const float* conv_w; const float* conv_b; const float* gate_r_b; const float* gate_i_b; const float* lam; const bf16* WG; };
constexpr int CSPAN = 512, NSPAN = SEQ / CSPAN;
template <int PASS, int DIR>
__device__ __forceinline__ void c_sweep(LAS unsigned char* lds, const bf16* P, bf16* OC, const CParams& cp, f32x2* SUM, int seq, int nb, int sp) {
    constexpr int UP = 136;
    LAS bf16* U = (LAS bf16*)lds;
    LAS float* AD = (LAS float*)(lds + 32768);
    int tid_ = threadIdx.x; asm volatile("" : "+v"(tid_));
    const int tid = tid_, wave = tid >> 6, lane = tid & 63;
    const int t0 = tid >> 4, c8 = (tid & 15) * 8, cg8 = nb * 128 + c8;
    LAS float* CW = (LAS float*)(lds + 32768 + 65536);
    for (int i = tid; i < 5 * 128; i += 512) CW[i] = (i < 512) ? cp.conv_w[(i >> 7) * MWD + nb * 128 + (i & 127)] : cp.conv_b[nb * 128 + (i & 127)];
    const int q = wave & 3, th = wave >> 2, r = lane & 31, h = lane >> 5;
    bf16x8 bfr[8], bfi[8];
    { const bf16* wrp = cp.WG + ((size_t)((DIR * 2 + 0) * 8 + nb) * 128 + 32 * q + r) * 128 + 8 * h;
      const bf16* wip = cp.WG + ((size_t)((DIR * 2 + 1) * 8 + nb) * 128 + 32 * q + r) * 128 + 8 * h;
#pragma unroll
      for (int ks = 0; ks < 8; ++ks) { bfr[ks] = *(const bf16x8*)(wrp + 16 * ks); bfi[ks] = *(const bf16x8*)(wip + 16 * ks); } }
    const int ch = 32 * q + r, cg = nb * 128 + ch;
    const float rb = cp.gate_r_b[DIR * MWD + cg], ib = cp.gate_i_b[DIR * MWD + cg], lam = cp.lam[DIR * MWD + cg];
    const float el = __builtin_amdgcn_exp2f(-1.4426950408889634f * lam);
    const float ls8 = -8.0f * (lam > 3.0f ? el * (1.0f - el * (0.5f - el * (1.0f / 3.0f))) : 0.6931471805599453f * __builtin_amdgcn_logf(1.0f + el));
    float hh = 0.f, pp = 1.f;
    if constexpr (PASS == 3) {
        if (tid < 128) {
            const f32x2* sb = SUM + ((size_t)(seq * NSPAN) * 2 + DIR) * MWD + nb * 128 + tid;
            if constexpr (DIR == 0) { for (int s = 0; s < sp; ++s) { const f32x2 v = sb[(size_t)s * 2 * MWD]; hh = v.x * hh + v.y; } }
            else { for (int s = NSPAN - 1; s > sp; --s) { const f32x2 v = sb[(size_t)s * 2 * MWD]; hh = v.x * hh + v.y; } }
        }
    }
    const size_t rowbase = (size_t)seq * SEQ + (size_t)sp * CSPAN;
    const int posbase = sp * CSPAN;
    u32x4 xw[2][4];
#define C_LOADX(tile) do { _Pragma("unroll") for (int hf = 0; hf < 2; ++hf) _Pragma("unroll") for (int j = 0; j < 4; ++j) { const int tt = posbase + (tile) * 64 + t0 + 32 * hf - 2 + j; \
        xw[hf][j] = (tt >= 0 && tt < SEQ) ? *(const u32x4*)(P + ((size_t)seq * SEQ + tt) * PWD + XC_OFF + cg8) : (u32x4){0u, 0u, 0u, 0u}; } } while (0)
    C_LOADX(DIR ? 7 : 0);
    __syncthreads();
    for (int it = 0; it < 8; ++it) {
        const int tile = DIR ? 7 - it : it;
#pragma unroll
        for (int hf = 0; hf < 2; ++hf) {
            float u8[8];
            { const f32x4 b0 = *(const LAS f32x4*)(CW + 512 + c8), b1 = *(const LAS f32x4*)(CW + 512 + c8 + 4); u8[0] = b0.x; u8[1] = b0.y; u8[2] = b0.z; u8[3] = b0.w; u8[4] = b1.x; u8[5] = b1.y; u8[6] = b1.z; u8[7] = b1.w; }
#pragma unroll
            for (int j = 0; j < 4; ++j) { const u32x4 x = xw[hf][j]; const f32x4 w0 = *(const LAS f32x4*)(CW + j * 128 + c8), w1 = *(const LAS f32x4*)(CW + j * 128 + c8 + 4);
                u8[0] += bf_lo(x.x) * w0.x; u8[1] += bf_hi(x.x) * w0.y; u8[2] += bf_lo(x.y) * w0.z; u8[3] += bf_hi(x.y) * w0.w;
                u8[4] += bf_lo(x.z) * w1.x; u8[5] += bf_hi(x.z) * w1.y; u8[6] += bf_lo(x.w) * w1.z; u8[7] += bf_hi(x.w) * w1.w; }
            u32x4 w; w.x = cvt_pk_bf16(u8[0], u8[1]); w.y = cvt_pk_bf16(u8[2], u8[3]); w.z = cvt_pk_bf16(u8[4], u8[5]); w.w = cvt_pk_bf16(u8[6], u8[7]);
            *(LAS u32x4*)(U + (t0 + 32 * hf) * UP + c8) = w;
        }
        if (it < 7) C_LOADX(DIR ? 6 - it : it + 1);
        __syncthreads();
        {
            f32x16 accr = {}, acci = {};
#pragma unroll
            for (int ks = 0; ks < 8; ++ks) {
                const bf16x8 af = *(const LAS bf16x8*)(U + (32 * th + r) * UP + 16 * ks + 8 * h);
                accr = __builtin_amdgcn_mfma_f32_32x32x16_bf16(af, bfr[ks], accr, 0, 0, 0);
                acci = __builtin_amdgcn_mfma_f32_32x32x16_bf16(af, bfi[ks], acci, 0, 0, 0);
            }
            LAS float* pa = AD + ch; LAS float* pd = AD + 64 * 128 + ch;
#pragma unroll
            for (int reg = 0; reg < 16; ++reg) {
                const int tt = 32 * th + (reg & 3) + 8 * (reg >> 2) + 4 * h;
                const float rr = fast_sigmoid(accr[reg] + rb), ii = fast_sigmoid(acci[reg] + ib);
                const float la = ls8 * rr;
                const float av = __builtin_amdgcn_exp2f(1.4426950408889634f * la);
                const float x2 = 2.0f * la;
                const float om = fabsf(x2) < 0.25f ? -x2 * (1.0f + x2 * (0.5f + x2 * ((1.0f / 6.0f) + x2 * ((1.0f / 24.0f) + x2 * ((1.0f / 120.0f) + x2 * (1.0f / 720.0f)))))) : 1.0f - av * av;
                const float uf = bf2f(U[tt * UP + ch]);
                pa[tt * 128] = av; pd[tt * 128] = sqrtf(om) * (ii * uf);
            }
        }
        u32x4 yw[2], ow[2];
        if constexpr (PASS == 3) {
#pragma unroll
            for (int hf = 0; hf < 2; ++hf) { const size_t row = rowbase + tile * 64 + t0 + 32 * hf; yw[hf] = *(const u32x4*)(P + row * PWD + YC_OFF + cg8);
                if constexpr (DIR == 1) ow[hf] = *(const u32x4*)(OC + row * MWD + cg8); }
        }
        __syncthreads();
        if (tid < 128) {
            LAS float* pa = AD + tid; LAS float* pd = AD + 64 * 128 + tid;
#pragma unroll 16
            for (int s = 0; s < 64; ++s) { const int t = DIR ? 63 - s : s; const float av = pa[t * 128], dv = pd[t * 128]; hh = av * hh + dv;
                if constexpr (PASS == 1) pp *= av; else pa[t * 128] = hh; }
        }
        if constexpr (PASS == 3) {
            __syncthreads();
#pragma unroll
            for (int hf = 0; hf < 2; ++hf) { const int t = t0 + 32 * hf; const size_t row = rowbase + tile * 64 + t;
                const u32x4 y4 = yw[hf];
                const float y[8] = {bf_lo(y4.x), bf_hi(y4.x), bf_lo(y4.y), bf_hi(y4.y), bf_lo(y4.z), bf_hi(y4.z), bf_lo(y4.w), bf_hi(y4.w)};
                const LAS float* hp = AD + t * 128 + c8;
                float o[8];
#pragma unroll
                for (int j = 0; j < 8; ++j) { const float z = 0.7978845608028654f * (y[j] + 0.044715f * y[j] * y[j] * y[j]);
                    o[j] = hp[j] * (y[j] * fast_sigmoid(2.0f * z)); }
                if constexpr (DIR == 1) { const u32x4 p4 = ow[hf]; o[0] += bf_lo(p4.x); o[1] += bf_hi(p4.x); o[2] += bf_lo(p4.y); o[3] += bf_hi(p4.y); o[4] += bf_lo(p4.z); o[5] += bf_hi(p4.z); o[6] += bf_lo(p4.w); o[7] += bf_hi(p4.w); }
                u32x4 w; w.x = cvt_pk_bf16(o[0], o[1]); w.y = cvt_pk_bf16(o[2], o[3]); w.z = cvt_pk_bf16(o[4], o[5]); w.w = cvt_pk_bf16(o[6], o[7]);
                *(u32x4*)(OC + row * MWD + cg8) = w; }
        }
    }
#undef C_LOADX
    if constexpr (PASS == 1) { if (tid < 128) SUM[((size_t)(seq * NSPAN + sp) * 2 + DIR) * MWD + nb * 128 + tid] = (f32x2){pp, hh}; }
    __syncthreads();
}

__global__ void __launch_bounds__(512, 2) mk_fwd(Args args) {
    extern __shared__ __attribute__((aligned(16))) unsigned char lds_raw[];
    LAS unsigned char* lds = (LAS unsigned char*)lds_raw;
    {
        volatile LAS unsigned* MISC = (volatile LAS unsigned*)(lds + MISC_OFF);
        for (int u = threadIdx.x; u < (LDS_BYTES - MISC_OFF) / 4; u += 512) MISC[u] = 0u;
        __syncthreads();
    }
#if MK_SINGLE
    XcdBarrier bar = xcd_barrier_post((unsigned*)(args.ws + WS_CTL) + CW_BAR, (volatile LAS unsigned*)(lds + MISC_OFF) + 8);
#define GRID_BAR() xcd_barrier(bar)
#else
#define GRID_BAR() do {} while (0)
#endif
    const int lo = args.lo, hi = args.hi;
    int step = 0;
#define RUN(k) (lo <= (k) && (k) < hi)
#define SEAM(k) do { if (RUN((k) + 1)) GRID_BAR(); } while (0)
#define PHASE_ENTER() int tid = threadIdx.x; asm volatile("" : "+v"(tid)); int bx = blockIdx.x; asm volatile("" : "+s"(bx)); int G = gridDim.x; asm volatile("" : "+s"(G)); const int NGW = G * 8; (void)NGW; \
    const int lane = tid & 63, wave = __builtin_amdgcn_readfirstlane(tid >> 6), gw = bx * 8 + wave; \
    const CAS Args* ap = (const CAS Args*)__builtin_amdgcn_kernarg_segment_ptr(); asm volatile("" : "+s"(ap)); \
    unsigned char* ws = ap->ws; float* out = ap->out; (void)lane; (void)gw; (void)out; \
    bf16* const P = (bf16*)(ws + WS_P); float* const Y = (float*)(ws + WS_P); bf16* const GT = (bf16*)(ws + WS_G); bf16* const O = (bf16*)(ws + WS_O); bf16* const HID = (bf16*)(ws + WS_G); \
    (void)P; (void)Y; (void)GT; (void)O; (void)HID

    for (int l = 0; l < DEPTH; ++l) {
        { const int k = step++; if (RUN(k) && ((PH_MASK >> 0) & 1)) { PHASE_ENTER(); for (int rep_ = 0; rep_ < NREP(0); ++rep_) phase_weights(ap, ws, l, lds, gw, NGW, wave, lane);
            if (l == 0) {
                rope_tables((f32x2*)(ws + WS_TAB1), (f32x2*)(ws + WS_TABA), bx * 512 + tid, G * 512);
                const float* g = ap->in[2];
                for (int row = gw; row < NTOK; row += NGW) norm_row_to_bf16(x_in_row(ap->in[0], ap->in[1], row), g, (bf16*)(ws + WS_H) + (size_t)row * DM, lane); }
            SEAM(k); } }
        for (int c = 0; c < NCHUNK; ++c) {
            const int row0 = c * TC;
            #define HC ((bf16*)(ws + WS_H) + (size_t)c * TC * DM)
            { const int k = step++; if (RUN(k) && ((PH_MASK >> 2) & 1)) { PHASE_ENTER();
                pg8::Gemm g{HC, (bf16*)(ws + WS_WIN), DM}; pg8::StaticOrder S; S.init(TC, INW, G, bx); pg8::EpiIn E{P, GT};
                for (int rep_ = 0; rep_ < NREP(2); ++rep_) pg8::gemm_phase<pg8::EpiIn, pg8::StaticOrder>(lds, g, S, E);
                SEAM(k); } }
            { const int k = step++; if (RUN(k) && ((PH_MASK >> 3) & 1)) { PHASE_ENTER();
                const float* kn = ap->in[8] + (size_t)l * HD;
                for (int m = gw; m < TC; m += NGW) { const int pos = m & (SEQ - 1); krope_token(P + (size_t)m * PWD, (const f32x2*)(ws + WS_TABA) + pos * 64, (const f32x2*)(ws + WS_TAB1) + pos * 64, kn, lane); }
                CParams cp{ap->in[10] + (size_t)l * 4 * MWD, ap->in[11] + (size_t)l * MWD, ap->in[13] + (size_t)l * 2 * MWD, ap->in[15] + (size_t)l * 2 * MWD, ap->in[16] + (size_t)l * 2 * MWD, (bf16*)(ws + WS_WG)};
                for (int rep_ = 0; rep_ < NREP(3); ++rep_) for (int u = bx; u < 2 * 8 * NSPAN; u += G) { const int sp = u & (NSPAN - 1), nb = (u >> 4) & 7, seq = u >> 7;
                    c_sweep<1, 0>(lds, P, nullptr, cp, (f32x2*)(ws + WS_SUM), seq, nb, sp); c_sweep<1, 1>(lds, P, nullptr, cp, (f32x2*)(ws + WS_SUM), seq, nb, sp); }
                SEAM(k); } }
            { const int k = step++; if (RUN(k) && ((PH_MASK >> 5) & 1)) {
                if (SUBMASK & 1) { PHASE_ENTER(); const int xcd = bx & 7, rank = bx >> 3, nrank = G >> 3; for (int rep_ = 0; rep_ < NREP(12); ++rep_) for (int i = rank; i < 64; i += nrank) {
                    const int seq = xcd >> 2, kvh = (xcd >> 1) & 1, head = kvh * 4 + (xcd & 1) * 2 + (i >> 5), qb = i & 31;
                    const bf16* Qb = P + (size_t)(seq * SEQ + qb * 256) * PWD + QA_OFF + head * HD;
                    const bf16* Kh = P + (size_t)(seq * SEQ) * PWD + KA_OFF + kvh * HD; const bf16* Vh = P + (size_t)(seq * SEQ) * PWD + VA_OFF + kvh * HD;
                    att::attn_unit<0, SD_A>(Qb, Kh, Vh, O + (size_t)(seq * SEQ + qb * 256) * MWD + head * HD, SEQ / 64, 0, 0.f, (char*)lds_raw, (const f32x2*)(ws + WS_TABA) + qb * 256 * 64, ap->in[7] + (size_t)l * HD);
                } }
                if (SUBMASK & 2) { PHASE_ENTER(); const int xcd = bx & 7, rank = bx >> 3, nrank = G >> 3; for (int rep_ = 0; rep_ < NREP(13); ++rep_) for (int i = rank; i < 64; i += nrank) {
                    const int seq = xcd >> 2, kvh = (xcd >> 1) & 1, head = kvh * 4 + (xcd & 1) * 2 + (i >> 5), qb = i & 31;
                    const int k0 = (qb == 0) ? 0 : qb * 256 - 128, k1 = (qb == 31) ? SEQ : qb * 256 + 384;
                    const bf16* Qb = P + (size_t)(seq * SEQ + qb * 256) * PWD + QB_OFF + head * HD;
                    const bf16* Kh = P + (size_t)(seq * SEQ + k0) * PWD + KB_OFF + kvh * HD; const bf16* Vh = P + (size_t)(seq * SEQ + k0) * PWD + VB_OFF + kvh * HD;
                    att::attn_unit<1, SD_B>(Qb, Kh, Vh, O + (size_t)TC * MWD + (size_t)(seq * SEQ + qb * 256) * MWD + head * HD, (k1 - k0) / 64, qb * 256 - k0, ap->in[9][l * 8 + head], (char*)lds_raw, (const f32x2*)(ws + WS_TAB1) + qb * 256 * 64, nullptr);
                } }
                if (SUBMASK & 4) { PHASE_ENTER();
                CParams cp{ap->in[10] + (size_t)l * 4 * MWD, ap->in[11] + (size_t)l * MWD, ap->in[13] + (size_t)l * 2 * MWD, ap->in[15] + (size_t)l * 2 * MWD, ap->in[16] + (size_t)l * 2 * MWD, (bf16*)(ws + WS_WG)};
                for (int rep_ = 0; rep_ < NREP(14); ++rep_) for (int u = bx; u < 2 * 8 * NSPAN; u += G) { const int sp = u & (NSPAN - 1), nb = (u >> 4) & 7, seq = u >> 7;
                    c_sweep<3, 0>(lds, P, O + (size_t)2 * TC * MWD, cp, (f32x2*)(ws + WS_SUM), seq, nb, sp); c_sweep<3, 1>(lds, P, O + (size_t)2 * TC * MWD, cp, (f32x2*)(ws + WS_SUM), seq, nb, sp); } }
                SEAM(k); } }
            { const int k = step++; if (RUN(k) && ((PH_MASK >> 6) & 1)) { PHASE_ENTER();
                pg8::Gemm g{O, (bf16*)(ws + WS_WBR), MWD}; pg8::BranchOrder S; S.base.init(TC, DM, G, bx); S.npanel = TC / 256;
                pg8::EpiBr E{GT, HC, (float*)(ws + WS_BRS) + (size_t)bx * 65536};
                for (int rep_ = 0; rep_ < NREP(6); ++rep_) pg8::gemm_phase<pg8::EpiBr, pg8::BranchOrder>(lds, g, S, E);
                SEAM(k); } }
            { const int k = step++; if (RUN(k) && ((PH_MASK >> 7) & 1)) { PHASE_ENTER();
                pg8::Gemm g{HC, (bf16*)(ws + WS_WOUT), DM}; pg8::StaticOrder S; S.init(TC, DM, G, bx); pg8::EpiF32 E{Y, DM};
                for (int rep_ = 0; rep_ < NREP(7); ++rep_) pg8::gemm_phase<pg8::EpiF32, pg8::StaticOrder>(lds, g, S, E);
                SEAM(k); } }
            { const int k = step++; if (RUN(k) && ((PH_MASK >> 8) & 1)) { PHASE_ENTER();
                const float* g1 = ap->in[3] + (size_t)l * DM; const float* g2 = ap->in[4] + (size_t)l * DM;
                for (int m = gw; m < TC; m += NGW) { const int row = row0 + m; const float* xo = (l == 0) ? x_in_row(ap->in[0], ap->in[1], row) : out + (size_t)row * DM;
                    resid_norm_row<true>(Y + (size_t)m * DM, xo, out + (size_t)row * DM, g1, g2, HC + (size_t)m * DM, lane); }
                SEAM(k); } }
            { const int k = step++; if (RUN(k) && ((PH_MASK >> 9) & 1)) { PHASE_ENTER();
                pg8::Gemm g{HC, (bf16*)(ws + WS_W1), DM}; pg8::StaticOrder S; S.init(TC, FFD, G, bx); pg8::EpiRelu2 E{HID, FFD};
                for (int rep_ = 0; rep_ < NREP(9); ++rep_) pg8::gemm_phase<pg8::EpiRelu2, pg8::StaticOrder>(lds, g, S, E);
                SEAM(k); } }
            { const int k = step++; if (RUN(k) && ((PH_MASK >> 10) & 1)) { PHASE_ENTER();
                pg8::Gemm g{HID, (bf16*)(ws + WS_W2), FFD}; pg8::StaticOrder S; S.init(TC, DM, G, bx); pg8::EpiF32 E{Y, DM};
                for (int rep_ = 0; rep_ < NREP(10); ++rep_) pg8::gemm_phase<pg8::EpiF32, pg8::StaticOrder>(lds, g, S, E);
                SEAM(k); } }
            { const int k = step++; if (RUN(k) && ((PH_MASK >> 11) & 1)) { PHASE_ENTER();
                const float* g1 = ap->in[5] + (size_t)l * DM;
                if (l + 1 < DEPTH) { const float* g2 = ap->in[2] + (size_t)(l + 1) * DM;
                    for (int m = gw; m < TC; m += NGW) { const int row = row0 + m; resid_norm_row<true>(Y + (size_t)m * DM, out + (size_t)row * DM, out + (size_t)row * DM, g1, g2, HC + (size_t)m * DM, lane); } }
                else { for (int m = gw; m < TC; m += NGW) { const int row = row0 + m; resid_norm_row<false>(Y + (size_t)m * DM, out + (size_t)row * DM, out + (size_t)row * DM, g1, nullptr, nullptr, lane); } }
                SEAM(k); } }
        }
    }
#undef RUN
#undef SEAM
}
constexpr int NSTEPS = DEPTH * (1 + NCHUNK * 9);

extern "C" void kernel_launch(void* const* d_in, const int* in_sizes, int n_in, void* d_out, int out_size, void* d_ws, size_t ws_size, hipStream_t stream) {
    static int grid = 0;
    if (grid == 0) {
        if (n_in != 21 || out_size != NTOK * DM || ws_size < WS_END) { fprintf(stderr, "kernel_launch: unexpected shapes (n_in %d out %d ws %zu)\n", n_in, out_size, ws_size); grid = -1; return; }
        int dev = 0, cus = 0, per_cu = 0;
        if (hipGetDevice(&dev) != hipSuccess || hipDeviceGetAttribute(&cus, hipDeviceAttributeMultiprocessorCount, dev) != hipSuccess) { grid = -1; return; }
        if (hipFuncSetAttribute((const void*)mk_fwd, hipFuncAttributeMaxDynamicSharedMemorySize, LDS_BYTES) != hipSuccess) { fprintf(stderr, "kernel_launch: hipFuncSetAttribute failed\n"); grid = -1; return; }
        if (hipOccupancyMaxActiveBlocksPerMultiprocessor(&per_cu, (const void*)mk_fwd, 512, LDS_BYTES) != hipSuccess || per_cu < 1) { fprintf(stderr, "kernel_launch: occupancy query says %d\n", per_cu); }
        (void)hipGetLastError();
        grid = cus;
    }
    if (grid < 0) return;
    if (hipMemsetAsync((char*)d_ws + WS_CTL, 0, CTL_ZERO_BYTES, stream) != hipSuccess) return;
    Args a{};
    for (int i = 0; i < 21; ++i) a.in[i] = (const float*)d_in[i];
    a.out = (float*)d_out; a.ws = (unsigned char*)d_ws;
#if MK_SINGLE
    a.lo = 0; a.hi = NSTEPS;
    hipLaunchKernelGGL(mk_fwd, dim3(grid), dim3(512), LDS_BYTES, stream, a);
#else
    for (int s = 0; s < NSTEPS; ++s) { a.lo = s; a.hi = s + 1; hipLaunchKernelGGL(mk_fwd, dim3(grid), dim3(512), LDS_BYTES, stream, a); }
#endif
    const hipError_t le = hipPeekAtLastError();
    if (le != hipSuccess) fprintf(stderr, "kernel_launch: launch failed: %s\n", hipGetErrorName(le));
}
```

```cpp
#include <hip/hip_runtime.h>
#include <cstdio>
#include <cstdint>

#ifndef PH_MASK
#define PH_MASK 0xFFF
#endif
#ifndef SUBMASK
#define SUBMASK 7
#endif
#ifndef SD_A
#define SD_A 2
#endif
#ifndef SD_B
#define SD_B 1
#endif
#ifndef DUP_MASK
#define DUP_MASK 0
#endif
#define NREP(i) (1 + ((DUP_MASK >> (i)) & 1))
#ifndef MK_SINGLE
#define MK_SINGLE 1
#endif

#define LAS __attribute__((address_space(3)))
#define GAS __attribute__((address_space(1)))
#define CAS __attribute__((address_space(4)))
typedef unsigned short bf16;
typedef short bf16x8 __attribute__((ext_vector_type(8)));
typedef short s16x4 __attribute__((ext_vector_type(4)));
typedef float f32x4 __attribute__((ext_vector_type(4)));
typedef float f32x2 __attribute__((ext_vector_type(2)));
typedef float f32x16 __attribute__((ext_vector_type(16)));
typedef unsigned u32x4 __attribute__((ext_vector_type(4)));
typedef unsigned u32x2 __attribute__((ext_vector_type(2)));

constexpr int DM = 2048, SEQ = 8192, NTOK = 49152, TC = 16384, NCHUNK = 3, DEPTH = 4;
constexpr int INW = 11264, PWD = 5120, GWD = 6144, FFD = 8192, MWD = 1024, HD = 128;
constexpr int QA_OFF = 0, KA_OFF = 1024, VA_OFF = 1280, QB_OFF = 1536, KB_OFF = 2560, VB_OFF = 2816, XC_OFF = 3072, YC_OFF = 4096;
constexpr int NPROMPT_TOK = 32768;
constexpr float EPS = 1e-6f;

constexpr size_t MiB = 1u << 20;
constexpr size_t WS_CTL = 0, CTL_ZERO_BYTES = 1 * MiB;
constexpr size_t WS_WIN = 2 * MiB;
constexpr size_t WS_WBR = 46 * MiB;
constexpr size_t WS_WOUT = 58 * MiB;
constexpr size_t WS_W1 = 66 * MiB;
constexpr size_t WS_W2 = 98 * MiB;
constexpr size_t WS_WG = 130 * MiB;
constexpr size_t WS_SUM = 131 * MiB;
constexpr size_t WS_CAR = 139 * MiB;
constexpr size_t WS_BRS = 143 * MiB;
constexpr size_t WS_XB = 727 * MiB;
constexpr size_t WS_RS = 919 * MiB;
constexpr size_t WS_P = 271 * MiB;
constexpr size_t WS_G = 431 * MiB;
constexpr size_t WS_O = 623 * MiB;
constexpr size_t WS_TAB1 = 719 * MiB;
constexpr size_t WS_TABA = 723 * MiB;
constexpr size_t WS_END = 920 * MiB;
constexpr int CW_BAR = 4096;

constexpr int LDS_BYTES = 147456;
constexpr int MISC_OFF = 143360;

__device__ __forceinline__ unsigned cvt_pk_bf16(float lo, float hi) { unsigned r; asm volatile("v_cvt_pk_bf16_f32 %0, %1, %2" : "=v"(r) : "v"(lo), "v"(hi)); return r; }
__device__ __forceinline__ float bf_lo(unsigned w) { return __uint_as_float(w << 16); }
__device__ __forceinline__ float bf_hi(unsigned w) { return __uint_as_float(w & 0xffff0000u); }
__device__ __forceinline__ float bf2f(bf16 b) { return __uint_as_float(((unsigned)b) << 16); }
__device__ __forceinline__ float fast_sigmoid(float v) { return __builtin_amdgcn_rcpf(1.0f + __builtin_amdgcn_exp2f(-1.4426950408889634f * v)); }
__device__ __forceinline__ float wave_sum(float v, int lane) {
#pragma unroll
    for (int o = 1; o < 64; o <<= 1) v += __int_as_float(__builtin_amdgcn_ds_bpermute((lane ^ o) << 2, __float_as_int(v)));
    return v;
}

__device__ const double ROPE_F1[64] = {
1.59154943091895346e-01, 1.37822502603982849e-01, 1.19349370211248862e-01, 1.03352296618434064e-01, 8.94994016088910133e-02, 7.75032887553740585e-02, 6.71150830052272551e-02, 5.81192674418762462e-02,
5.03292121044697269e-02, 4.35833029420947638e-02, 3.77415888468699103e-02, 3.26828760272190911e-02, 2.83022152813622411e-02, 2.45087241866802648e-02, 2.12237020815031856e-02, 1.83789966569160986e-02,
1.59154943091895339e-02, 1.37822502603982842e-02, 1.19349370211248869e-02, 1.03352296618434060e-02, 8.94994016088910202e-03, 7.75032887553740654e-03, 6.71150830052272551e-03, 5.81192674418762427e-03,
5.03292121044697286e-03, 4.35833029420947656e-03, 3.77415888468699086e-03, 3.26828760272190893e-03, 2.83022152813622403e-03, 2.45087241866802661e-03, 2.12237020815031847e-03, 1.83789966569160995e-03,
1.59154943091895335e-03, 1.37822502603982846e-03, 1.19349370211248865e-03, 1.03352296618434069e-03, 8.94994016088910115e-04, 7.75032887553740654e-04, 6.71150830052272508e-04, 5.81192674418762427e-04,
5.03292121044697243e-04, 4.35833029420947678e-04, 3.77415888468699086e-04, 3.26828760272190871e-04, 2.83022152813622381e-04, 2.45087241866802661e-04, 2.12237020815031847e-04, 1.83789966569160984e-04,
1.59154943091895346e-04, 1.37822502603982835e-04, 1.19349370211248871e-04, 1.03352296618434063e-04, 8.94994016088910088e-05, 7.75032887553740654e-05, 6.71150830052272508e-05, 5.81192674418762400e-05,
5.03292121044697243e-05, 4.35833029420947644e-05, 3.77415888468699120e-05, 3.26828760272190871e-05, 2.83022152813622381e-05, 2.45087241866802641e-05, 2.12237020815031861e-05, 1.83789966569160984e-05 };
__device__ const double ROPE_FA[32] = {
1.59154943091895346e-01, 1.19349370211248862e-01, 8.94994016088910133e-02, 6.71150830052272551e-02, 5.03292121044697269e-02, 3.77415888468699103e-02, 2.83022152813622411e-02, 2.12237020815031856e-02,
1.59154943091895339e-02, 1.19349370211248869e-02, 8.94994016088910202e-03, 6.71150830052272551e-03, 5.03292121044697286e-03, 3.77415888468699086e-03, 2.83022152813622403e-03, 2.12237020815031847e-03,
1.59154943091895335e-03, 1.19349370211248865e-03, 8.94994016088910115e-04, 6.71150830052272508e-04, 5.03292121044697243e-04, 3.77415888468699086e-04, 2.83022152813622381e-04, 2.12237020815031847e-04,
1.59154943091895346e-04, 1.19349370211248871e-04, 8.94994016088910088e-05, 6.71150830052272508e-05, 5.03292121044697243e-05, 3.77415888468699120e-05, 2.83022152813622381e-05, 2.12237020815031861e-05 };

namespace pg8 {
typedef unsigned short bf16_t;
constexpr int BM = 256, BK = 64, HALF = 128, HTB = HALF * BK * 2, STAGE_BYTES = 8 * HTB, NXCD = 8, WGM = 8;
__host__ __device__ __forceinline__ int lds_byte(int r, int c) { const int st = (r >> 4) * 2 + (c >> 5), rr = r & 15, cc = c & 31, ob = rr * 64 + cc * 2; return st * 1024 + (ob ^ (((ob >> 9) & 1) << 5)); }
__host__ __device__ __forceinline__ void stage_rc(int b, int& R, int& C) { const int st = b / 1024, sb = b % 1024, swz = sb ^ (((sb >> 9) & 1) << 5); R = (st >> 1) * 16 + swz / 64; C = (st & 1) * 32 + (swz % 64) / 2; }
__host__ __device__ __forceinline__ int perm32(int rho) { const int n = rho >> 4, i = rho & 15; return 8 * (i >> 2) + 4 * n + (i & 3); }

struct Unit { int pm, pn, ka, kb, sub; };
struct Gemm { const bf16_t* A; const bf16_t* Bt; int K; };

struct StaticOrder {
    int nM, nN, nwg, G, c;
    __device__ void init(int M, int N, int G_, int c_) { nM = M / BM; nN = N / BM; nwg = nM * nN; G = G_; c = c_; }
    __device__ bool next(int i, Unit& u) const {
        const long L = (long)i * G + c; if (L >= nwg) return false;
        int wgid = (int)L; { const int q = nwg / NXCD, r = nwg % NXCD, xcd = wgid % NXCD, off = wgid / NXCD; wgid = (xcd < r ? xcd * (q + 1) : r * (q + 1) + (xcd - r) * q) + off; }
        const int nig = WGM * nN, gid = wgid / nig, fm = gid * WGM, gsz = (nM - fm) < WGM ? (nM - fm) : WGM;
        u.pm = fm + ((wgid % nig) % gsz); u.pn = (wgid % nig) / gsz; u.ka = u.pm; u.kb = u.pn; u.sub = 0; return true;
    }
};
struct BranchOrder {
    StaticOrder base; int npanel;
    __device__ bool next(int i, Unit& u) const {
        const int t = i / 3, s = i - 3 * t; if (!base.next(t, u)) return false;
        u.sub = s; u.ka = s * npanel + u.pm; u.kb = s * 8 + u.pn; return true;
    }
};

struct EpiIn {
    static constexpr bool PERM = true;
    bf16_t* P; bf16_t* G; const float* rs;
    __device__ __forceinline__ void operator()(const f32x4 (&acc)[2][2][4][2], const Unit& u, int wr, int wc, int fr_, int fq) const {
        int fr = fr_; asm volatile("" : "+v"(fr));
        const int row0 = u.pm * BM + wr * 64 + fr; const bool gate = u.pn >= 20;
        bf16_t* base = gate ? G : P; const int ldc = gate ? GWD : PWD; const int col0 = (gate ? u.pn - 20 : u.pn) * BM + wc * 32 + 8 * fq;
#pragma unroll
        for (int ai = 0; ai < 2; ++ai)
#pragma unroll
            for (int m = 0; m < 4; ++m) { bf16_t* rowp = base + (size_t)(row0 + ai * HALF + m * 16) * ldc + col0; const float rsv = rs[row0 + ai * HALF + m * 16];
#pragma unroll
                for (int bj = 0; bj < 2; ++bj) { f32x4 v0 = acc[ai][bj][m][0] * rsv, v1 = acc[ai][bj][m][1] * rsv;
                    if (gate) {
#pragma unroll
                        for (int j = 0; j < 4; ++j) { v0[j] = fast_sigmoid(v0[j]); v1[j] = fast_sigmoid(v1[j]); } }
                    u32x4 w; w.x = cvt_pk_bf16(v0[0], v0[1]); w.y = cvt_pk_bf16(v0[2], v0[3]); w.z = cvt_pk_bf16(v1[0], v1[1]); w.w = cvt_pk_bf16(v1[2], v1[3]);
                    *(u32x4*)(rowp + bj * HALF) = w; } }
    }
};
struct EpiBr {
    static constexpr bool PERM = true;
    const bf16_t* G; bf16_t* OUT; float* scratch;
    __device__ __forceinline__ void operator()(const f32x4 (&acc)[2][2][4][2], const Unit& u, int wr, int wc, int fr_, int fq) const {
        int fr = fr_; asm volatile("" : "+v"(fr));
        const int row0 = u.pm * BM + wr * 64 + fr, col0 = u.pn * BM + wc * 32 + 8 * fq; const int sub = u.sub;
        GAS f32x4* sp = (GAS f32x4*)scratch + ((wr * 4 + wc) * 64 + fq * 16 + fr);
#pragma unroll
        for (int ai = 0; ai < 2; ++ai)
#pragma unroll
            for (int m = 0; m < 4; ++m) { const size_t row = (size_t)(row0 + ai * HALF + m * 16);
#pragma unroll
                for (int bj = 0; bj < 2; ++bj) { const int idx = (((ai * 4 + m) * 2 + bj) * 2) * 512;
                    const u32x4 gw = *(const u32x4*)(G + row * GWD + sub * DM + col0 + bj * HALF);
                    f32x4 v0 = acc[ai][bj][m][0] * (f32x4){bf_lo(gw.x), bf_hi(gw.x), bf_lo(gw.y), bf_hi(gw.y)};
                    f32x4 v1 = acc[ai][bj][m][1] * (f32x4){bf_lo(gw.z), bf_hi(gw.z), bf_lo(gw.w), bf_hi(gw.w)};
                    if (sub > 0) { v0 += sp[idx]; v1 += sp[idx + 512]; }
                    if (sub < 2) { sp[idx] = v0; sp[idx + 512] = v1; }
                    else { u32x4 w; w.x = cvt_pk_bf16(v0[0], v0[1]); w.y = cvt_pk_bf16(v0[2], v0[3]); w.z = cvt_pk_bf16(v1[0], v1[1]); w.w = cvt_pk_bf16(v1[2], v1[3]);
                        *(u32x4*)(OUT + row * DM + col0 + bj * HALF) = w; } }
                asm volatile("" ::: "memory"); }
    }
};
struct EpiBf16 {
    static constexpr bool PERM = true;
    bf16_t* O; int ldc;
    __device__ __forceinline__ void operator()(const f32x4 (&acc)[2][2][4][2], const Unit& u, int wr, int wc, int fr_, int fq) const {
        int fr = fr_; asm volatile("" : "+v"(fr));
        const int row0 = u.pm * BM + wr * 64 + fr, col0 = u.pn * BM + wc * 32 + 8 * fq;
#pragma unroll
        for (int ai = 0; ai < 2; ++ai)
#pragma unroll
            for (int m = 0; m < 4; ++m) { bf16_t* rowp = O + (size_t)(row0 + ai * HALF + m * 16) * ldc + col0;
#pragma unroll
                for (int bj = 0; bj < 2; ++bj) { const f32x4 v0 = acc[ai][bj][m][0], v1 = acc[ai][bj][m][1];
                    u32x4 w; w.x = cvt_pk_bf16(v0[0], v0[1]); w.y = cvt_pk_bf16(v0[2], v0[3]); w.z = cvt_pk_bf16(v1[0], v1[1]); w.w = cvt_pk_bf16(v1[2], v1[3]);
                    *(u32x4*)(rowp + bj * HALF) = w; } }
    }
};
struct EpiRelu2 {
    static constexpr bool PERM = true;
    bf16_t* O; int ldc; const float* rs;
    __device__ __forceinline__ void operator()(const f32x4 (&acc)[2][2][4][2], const Unit& u, int wr, int wc, int fr_, int fq) const {
        int fr = fr_; asm volatile("" : "+v"(fr));
        const int row0 = u.pm * BM + wr * 64 + fr, col0 = u.pn * BM + wc * 32 + 8 * fq;
#pragma unroll
        for (int ai = 0; ai < 2; ++ai)
#pragma unroll
            for (int m = 0; m < 4; ++m) { bf16_t* rowp = O + (size_t)(row0 + ai * HALF + m * 16) * ldc + col0; const float rsv = rs[row0 + ai * HALF + m * 16];
#pragma unroll
                for (int bj = 0; bj < 2; ++bj) { f32x4 v0 = acc[ai][bj][m][0], v1 = acc[ai][bj][m][1];
#pragma unroll
                    for (int j = 0; j < 4; ++j) { const float a = fmaxf(v0[j] * rsv, 0.f), b = fmaxf(v1[j] * rsv, 0.f); v0[j] = a * a; v1[j] = b * b; }
                    u32x4 w; w.x = cvt_pk_bf16(v0[0], v0[1]); w.y = cvt_pk_bf16(v0[2], v0[3]); w.z = cvt_pk_bf16(v1[0], v1[1]); w.w = cvt_pk_bf16(v1[2], v1[3]);
                    *(u32x4*)(rowp + bj * HALF) = w; } }
    }
};

template <class Epi, class Sched, bool ALIGN_EPI = true>
__device__ __forceinline__ void gemm_phase(LAS unsigned char* lds, const Gemm g, const Sched& S, const Epi& E) {
    int tid_ = threadIdx.x; asm volatile("" : "+v"(tid_));
    const int tid = tid_, wid = __builtin_amdgcn_readfirstlane(tid >> 6), lane = tid & 63, wr = wid >> 2, wc = wid & 3, fr = lane & 15, fq = lane >> 4;
    const int K = g.K, nt = K / BK;
    unsigned voffA[2], voffB[2];
#pragma unroll
    for (int i = 0; i < 2; ++i) { int R, C; stage_rc(tid * 16 + i * 8192, R, C); const int Rb = Epi::PERM ? ((R & ~31) + perm32(R & 31)) : R;
        voffA[i] = (unsigned)(R * K + C) * 2u; voffB[i] = (unsigned)(Rb * K + C) * 2u; }
    const size_t kstep = (size_t)(BK * 2);
    const size_t hstep = (size_t)HALF * K * 2;
    const size_t tstep = 2 * hstep;
    const unsigned ldsw = (unsigned)wid * 1024u;
    const int aoff = lds_byte(wr * 64 + fr, fq * 8), boff = lds_byte(wc * 32 + fr, fq * 8);
#define PG8_SA(b, h) (((b) * 2 + (h)) * HTB)
#define PG8_SB(b, h) ((4 + (b) * 2 + (h)) * HTB)
#define PG8_STAGE(bufoff, gbase, voff) do { _Pragma("unroll") for (int _i = 0; _i < 2; ++_i) \
        __builtin_amdgcn_global_load_lds((const unsigned*)((const char*)(gbase) + (voff)[_i]), (LAS unsigned*)(lds + (bufoff) + ldsw + _i * 8192), 16, 0, 0); } while (0)
#define PG8_LDA(dst, b, h) do { _Pragma("unroll") for (int m = 0; m < 4; ++m) _Pragma("unroll") for (int k = 0; k < 2; ++k) dst[m][k] = *(const LAS bf16x8*)(lds + PG8_SA(b, h) + aoff + m * 2048 + k * 1024); } while (0)
#define PG8_LDB(dst, b, h) do { _Pragma("unroll") for (int n = 0; n < 2; ++n) _Pragma("unroll") for (int k = 0; k < 2; ++k) dst[n][k] = *(const LAS bf16x8*)(lds + PG8_SB(b, h) + boff + n * 2048 + k * 1024); } while (0)
#define PG8_MMA(ai, bj, At, Bt) do { __builtin_amdgcn_s_setprio(1); _Pragma("unroll") for (int m = 0; m < 4; ++m) _Pragma("unroll") for (int n = 0; n < 2; ++n) _Pragma("unroll") for (int k = 0; k < 2; ++k) \
        acc[ai][bj][m][n] = __builtin_amdgcn_mfma_f32_16x16x32_bf16(Bt[n][k], At[m][k], acc[ai][bj][m][n], 0, 0, 0); __builtin_amdgcn_s_setprio(0); } while (0)
#define PG8_WAIT_V(n) asm volatile("s_waitcnt vmcnt(" #n ")" ::: "memory")
#define PG8_WAIT_L(n) asm volatile("s_waitcnt lgkmcnt(" #n ")" ::: "memory")
#define PG8_BAR __builtin_amdgcn_s_barrier()
#define PG8_SCHED __builtin_amdgcn_sched_barrier(0)
    Unit cur, nxt; int ui = 0;
    if (!S.next(0, cur)) return;
    f32x4 acc[2][2][4][2];
#pragma unroll
    for (int a = 0; a < 2; ++a)
#pragma unroll
        for (int b = 0; b < 2; ++b)
#pragma unroll
            for (int m = 0; m < 4; ++m)
#pragma unroll
                for (int n = 0; n < 2; ++n) acc[a][b][m][n] = (f32x4){0.f, 0.f, 0.f, 0.f};
    bf16x8 At[4][2], B0[2][2], B1[2][2];
    const char* cA = (const char*)g.A + (size_t)cur.ka * tstep; const char* cB = (const char*)g.Bt + (size_t)cur.kb * tstep;
    PG8_STAGE(PG8_SB(0, 0), cB, voffB); PG8_STAGE(PG8_SB(0, 1), cB + hstep, voffB); PG8_STAGE(PG8_SA(0, 0), cA, voffA); PG8_STAGE(PG8_SA(0, 1), cA + hstep, voffA);
    if (wr == 1) PG8_BAR;
    PG8_WAIT_V(2); PG8_BAR;
    PG8_STAGE(PG8_SB(1, 0), cB + kstep, voffB); PG8_STAGE(PG8_SA(1, 0), cA + kstep, voffA); PG8_STAGE(PG8_SB(1, 1), cB + hstep + kstep, voffB);
    PG8_WAIT_V(6); PG8_BAR;
    for (;;) {
        const bool has_next = S.next(ui + 1, nxt);
        const char* nA = has_next ? (const char*)g.A + (size_t)nxt.ka * tstep : cA; const char* nB = has_next ? (const char*)g.Bt + (size_t)nxt.kb * tstep : cB;
        for (int t = 0; t < nt; t += 2) {
            const bool last = (t == nt - 2);
            const char* a1 = cA + (size_t)(t + 1) * kstep;
            const char* a2 = last ? nA : cA + (size_t)(t + 2) * kstep; const char* b2 = last ? nB : cB + (size_t)(t + 2) * kstep;
            const char* a3 = a2 + kstep; const char* b3 = b2 + kstep;
            PG8_LDB(B0, 0, 0); PG8_LDB(B1, 0, 1); PG8_SCHED; PG8_LDA(At, 0, 0); PG8_STAGE(PG8_SA(1, 1), a1 + hstep, voffA);
            PG8_WAIT_V(8); PG8_WAIT_L(0); PG8_BAR; PG8_MMA(0, 0, At, B0); PG8_MMA(0, 1, At, B1); PG8_BAR; PG8_SCHED;
            PG8_LDA(At, 0, 1); PG8_STAGE(PG8_SB(0, 0), b2, voffB); PG8_STAGE(PG8_SB(0, 1), b2 + hstep, voffB); PG8_STAGE(PG8_SA(0, 0), a2, voffA);
            PG8_WAIT_V(8); PG8_WAIT_L(0); PG8_BAR; PG8_MMA(1, 0, At, B0); PG8_MMA(1, 1, At, B1); PG8_BAR; PG8_SCHED;
            PG8_LDB(B0, 1, 0); PG8_LDB(B1, 1, 1); PG8_SCHED; PG8_LDA(At, 1, 0); PG8_STAGE(PG8_SA(0, 1), a2 + hstep, voffA);
            PG8_WAIT_V(8); PG8_WAIT_L(0); PG8_BAR; PG8_MMA(0, 0, At, B0); PG8_MMA(0, 1, At, B1); PG8_BAR; PG8_SCHED;
            PG8_LDA(At, 1, 1); PG8_STAGE(PG8_SB(1, 0), b3, voffB); PG8_STAGE(PG8_SB(1, 1), b3 + hstep, voffB); PG8_STAGE(PG8_SA(1, 0), a3, voffA);
            PG8_WAIT_V(8); PG8_WAIT_L(0); PG8_BAR; PG8_MMA(1, 0, At, B0); PG8_MMA(1, 1, At, B1); PG8_BAR; PG8_SCHED;
        }
        if constexpr (ALIGN_EPI) { if (wr == 0) PG8_BAR; }
        E(acc, cur, wr, wc, fr, fq);
        if (!has_next) break;
#pragma unroll
        for (int a = 0; a < 2; ++a)
#pragma unroll
            for (int b = 0; b < 2; ++b)
#pragma unroll
                for (int m = 0; m < 4; ++m)
#pragma unroll
                    for (int n = 0; n < 2; ++n) acc[a][b][m][n] = (f32x4){0.f, 0.f, 0.f, 0.f};
        cur = nxt; cA = nA; cB = nB; ++ui;
        if constexpr (ALIGN_EPI) { if (wr == 1) PG8_BAR; }
    }
    PG8_WAIT_V(0);
    if constexpr (!ALIGN_EPI) { if (wr == 0) PG8_BAR; }
    PG8_BAR;
#undef PG8_SA
#undef PG8_SB
#undef PG8_STAGE
#undef PG8_LDA
#undef PG8_LDB
#undef PG8_MMA
#undef PG8_WAIT_V
#undef PG8_WAIT_L
#undef PG8_BAR
#undef PG8_SCHED
}
}

namespace att {
constexpr int D = 128, NW = 8, QBLK = 32, KVBLK = 64;
constexpr float SCALE = 0.088388347648318440f;
constexpr float THR = 8.f;
constexpr int LDQ = PWD, LDK = PWD, LDO = MWD;
constexpr int SHM_V = KVBLK * D * 2, SHM_K = KVBLK * D * 2;
constexpr int OST_PITCH = 272;
constexpr int OST_OFF = 2 * SHM_V + 2 * SHM_K + NW * 64 * 4;
constexpr int ATT_LDS = OST_OFF + NW * 32 * OST_PITCH;
#define KSWZ(row, colB) ((row) * 256 + ((colB) ^ (((row) & 7) << 4)))
#define SBAR() __builtin_amdgcn_sched_barrier(0)
__device__ __forceinline__ int crow(int r, int hi) { return (r & 3) + 8 * (r >> 2) + 4 * hi; }

template <bool MASKED>
__device__ __forceinline__ void partialSM(f32x16& p0, f32x16& p1, float& m_reg, float& mn, float& alpha, int mbase) {
  constexpr float C = SCALE * 1.4426950408889634f;
  if constexpr (MASKED) {
    const float ninf = -__builtin_inff();
#pragma unroll
    for (int r = 0; r < 16; ++r) { const int c = (r & 3) + 8 * (r >> 2);
      p0[r] = ((unsigned)(mbase - c) <= 256u) ? p0[r] : ninf;
      p1[r] = ((unsigned)(mbase - c - 32) <= 256u) ? p1[r] : ninf; }
  }
  float pmax = p0[0];
#pragma unroll
  for (int r = 1; r < 16; ++r) pmax = fmaxf(pmax, p0[r]);
#pragma unroll
  for (int r = 0; r < 16; ++r) pmax = fmaxf(pmax, p1[r]);
  { auto rr = __builtin_amdgcn_permlane32_swap(__float_as_uint(pmax), __float_as_uint(pmax), false, false);
    pmax = fmaxf(__uint_as_float(rr[0]), __uint_as_float(rr[1])); }
  if (__builtin_expect(__all(pmax - m_reg <= THR / SCALE), 1)) { mn = m_reg; alpha = 1.f; }
  else { mn = fmaxf(m_reg, pmax); alpha = __builtin_amdgcn_exp2f((m_reg - mn) * C); m_reg = mn; }
  float mnC = -mn * C;
#pragma unroll
  for (int r = 0; r < 16; ++r) p0[r] = fmaf(p0[r], C, mnC);
#pragma unroll
  for (int r = 0; r < 16; ++r) p1[r] = fmaf(p1[r], C, mnC);
#pragma unroll
  for (int r = 0; r < 16; ++r) p0[r] = __builtin_amdgcn_exp2f(p0[r]);
}
__device__ __forceinline__ void finishSM(f32x16& p0, f32x16& p1, float alpha, float& l_reg, bf16x8& pa0, bf16x8& pa1, bf16x8& pa2, bf16x8& pa3) {
#pragma unroll
  for (int r = 0; r < 16; ++r) p1[r] = __builtin_amdgcn_exp2f(p1[r]);
  float ps = 0;
#pragma unroll
  for (int r = 0; r < 16; ++r) ps += p0[r];
#pragma unroll
  for (int r = 0; r < 16; ++r) ps += p1[r];
  { auto rr = __builtin_amdgcn_permlane32_swap(__float_as_uint(ps), __float_as_uint(ps), false, false);
    ps = __uint_as_float(rr[0]) + __uint_as_float(rr[1]); }
  l_reg = l_reg * alpha + ps;
#define PK4(P, BASE, OUT) do { unsigned a0 = cvt_pk_bf16(P[BASE + 0], P[BASE + 1]), a1 = cvt_pk_bf16(P[BASE + 2], P[BASE + 3]);   \
    unsigned b0 = cvt_pk_bf16(P[BASE + 4], P[BASE + 5]), b1 = cvt_pk_bf16(P[BASE + 6], P[BASE + 7]);                              \
    auto r0 = __builtin_amdgcn_permlane32_swap(a0, b0, false, false); auto r1 = __builtin_amdgcn_permlane32_swap(a1, b1, false, false); \
    u32x4 w = {r0[0], r1[0], r0[1], r1[1]}; OUT = *reinterpret_cast<bf16x8*>(&w); } while (0)
  PK4(p0, 0, pa0); PK4(p0, 8, pa1); PK4(p1, 0, pa2); PK4(p1, 8, pa3);
#undef PK4
}
__device__ __forceinline__ void qkt(f32x16& p0, f32x16& p1, const bf16* Ks, const bf16x8* qr, int r32, int hi) {
  p0 = f32x16{}; p1 = f32x16{};
#pragma unroll
  for (int d0 = 0; d0 < 8; ++d0) { int cb = (d0 * 16 + hi * 8) * 2;
    bf16x8 b0 = *reinterpret_cast<const bf16x8*>((const char*)Ks + KSWZ(r32, cb));
    bf16x8 b1 = *reinterpret_cast<const bf16x8*>((const char*)Ks + KSWZ(32 + r32, cb));
    p0 = __builtin_amdgcn_mfma_f32_32x32x16_bf16(b0, qr[d0], p0, 0, 0, 0);
    p1 = __builtin_amdgcn_mfma_f32_32x32x16_bf16(b1, qr[d0], p1, 0, 0, 0); }
}
__device__ __forceinline__ int v_st(int k, int c) { const int kk = (k & ~0xC) | ((k & 4) << 1) | ((k & 8) >> 1); return ((kk >> 3) * 4 + (c >> 5)) * 512 + ((kk & 7) * 32 + (c & 31)) * 2; }
__device__ __forceinline__ int v_rd_base(int lane) { return ((lane & 3) << 3) | (((lane >> 2) & 3) << 6) | (((lane >> 4) & 1) << 5) | (((lane >> 5) & 1) << 8); }
constexpr int v_rd_off(int d0, int ks, int half) { return d0 * 512 + ks * 4096 + half * 2048; }
template <int OFF> __device__ __forceinline__ s16x4 tr_read(int vb) {
  s16x4 r; asm volatile("ds_read_b64_tr_b16 %0, %1 offset:%2" : "=&v"(r) : "v"(vb), "i"(OFF) : "memory"); return r;
}
template <int D0> __device__ __forceinline__ void pv_one(f32x16& od, int vb, bf16x8 pa0, bf16x8 pa1, bf16x8 pa2, bf16x8 pa3) {
  const s16x4 l0 = tr_read<v_rd_off(D0, 0, 0)>(vb), h0 = tr_read<v_rd_off(D0, 0, 1)>(vb), l1 = tr_read<v_rd_off(D0, 1, 0)>(vb), h1 = tr_read<v_rd_off(D0, 1, 1)>(vb);
  const s16x4 l2 = tr_read<v_rd_off(D0, 2, 0)>(vb), h2 = tr_read<v_rd_off(D0, 2, 1)>(vb), l3 = tr_read<v_rd_off(D0, 3, 0)>(vb), h3 = tr_read<v_rd_off(D0, 3, 1)>(vb);
  asm volatile("s_waitcnt lgkmcnt(0)" ::: "memory"); SBAR();
#define PK(L, H) (bf16x8){L[0], L[1], L[2], L[3], H[0], H[1], H[2], H[3]}
  od = __builtin_amdgcn_mfma_f32_32x32x16_bf16(pa0, PK(l0, h0), od, 0, 0, 0);
  od = __builtin_amdgcn_mfma_f32_32x32x16_bf16(pa1, PK(l1, h1), od, 0, 0, 0);
  od = __builtin_amdgcn_mfma_f32_32x32x16_bf16(pa2, PK(l2, h2), od, 0, 0, 0);
  od = __builtin_amdgcn_mfma_f32_32x32x16_bf16(pa3, PK(l3, h3), od, 0, 0, 0);
#undef PK
}
__device__ __forceinline__ void pv_d0(f32x16* o, int vb, bf16x8 pa0, bf16x8 pa1, bf16x8 pa2, bf16x8 pa3) {
  pv_one<0>(o[0], vb, pa0, pa1, pa2, pa3); pv_one<1>(o[1], vb, pa0, pa1, pa2, pa3); pv_one<2>(o[2], vb, pa0, pa1, pa2, pa3); pv_one<3>(o[3], vb, pa0, pa1, pa2, pa3);
}

template <int MODE, int SD>
__device__ __forceinline__ void attn_unit(const bf16* __restrict__ Qb, const bf16* __restrict__ Kh, const bf16* __restrict__ Vh, bf16* __restrict__ Ob, int NT, int dq0, float sink, char* lds,
                                          const f32x2* __restrict__ tab  , const float* __restrict__ gq  ) {
  int tid_ = threadIdx.x; asm volatile("" : "+v"(tid_));
  const int tid = tid_, wid = tid >> 6, lane = tid & 63, r32 = lane & 31, hi = lane >> 5;
  bf16* V_lds = (bf16*)lds; bf16* K_lds = (bf16*)(lds + 2 * SHM_V);
  float* ws = (float*)(lds + 2 * SHM_V + 2 * SHM_K) + wid * 64; float* li_l = ws; float* al_l = ws + 32;
  float m_reg = MODE ? sink * (1.0f / SCALE) : -1e30f, l_reg = MODE ? 1.0f : 0.0f; f32x16 o[4] = {}; bf16x8 qr[8];
  const bf16* Qw = Qb + (long)(wid * QBLK + r32) * LDQ + hi * 8;
#pragma unroll
  for (int d0 = 0; d0 < 8; ++d0) qr[d0] = *reinterpret_cast<const bf16x8*>(Qw + d0 * 16);
  {
    float rstd = 1.f;
    if constexpr (MODE == 0) {
      float ss = 0.f;
#pragma unroll
      for (int d0 = 0; d0 < 8; ++d0) { const u32x4 w = *reinterpret_cast<const u32x4*>(&qr[d0]);
        const float a0 = bf_lo(w.x), a1 = bf_hi(w.x), a2 = bf_lo(w.y), a3 = bf_hi(w.y), a4 = bf_lo(w.z), a5 = bf_hi(w.z), a6 = bf_lo(w.w), a7 = bf_hi(w.w);
        ss += (a0 * a0 + a1 * a1) + (a2 * a2 + a3 * a3) + (a4 * a4 + a5 * a5) + (a6 * a6 + a7 * a7); }
      { auto rr = __builtin_amdgcn_permlane32_swap(__float_as_uint(ss), __float_as_uint(ss), false, false); ss = __uint_as_float(rr[0]) + __uint_as_float(rr[1]); }
      rstd = 1.0f / sqrtf(ss * (1.0f / D) + EPS);
    }
    const f32x4* tp = (const f32x4*)(tab + (wid * QBLK + r32) * 64 + hi * 8);
#pragma unroll
    for (int d0 = 0; d0 < 4; ++d0) {
      const u32x4 w1 = *reinterpret_cast<const u32x4*>(&qr[d0]), w2 = *reinterpret_cast<const u32x4*>(&qr[d0 + 4]);
      float x1[8] = {bf_lo(w1.x), bf_hi(w1.x), bf_lo(w1.y), bf_hi(w1.y), bf_lo(w1.z), bf_hi(w1.z), bf_lo(w1.w), bf_hi(w1.w)};
      float x2[8] = {bf_lo(w2.x), bf_hi(w2.x), bf_lo(w2.y), bf_hi(w2.y), bf_lo(w2.z), bf_hi(w2.z), bf_lo(w2.w), bf_hi(w2.w)};
      if constexpr (MODE == 0) {
        const f32x4 g1a = *(const f32x4*)(gq + d0 * 16 + hi * 8), g1b = *(const f32x4*)(gq + d0 * 16 + hi * 8 + 4), g2a = *(const f32x4*)(gq + 64 + d0 * 16 + hi * 8), g2b = *(const f32x4*)(gq + 64 + d0 * 16 + hi * 8 + 4);
        const float g1[8] = {g1a.x, g1a.y, g1a.z, g1a.w, g1b.x, g1b.y, g1b.z, g1b.w}, g2[8] = {g2a.x, g2a.y, g2a.z, g2a.w, g2b.x, g2b.y, g2b.z, g2b.w};
#pragma unroll
        for (int e = 0; e < 8; ++e) { x1[e] = x1[e] * rstd * g1[e]; x2[e] = x2[e] * rstd * g2[e]; }
      }
      float o1[8], o2[8];
#pragma unroll
      for (int e2 = 0; e2 < 4; ++e2) { const f32x4 cs = tp[d0 * 8 + e2];
        o1[2 * e2] = x1[2 * e2] * cs.x - x2[2 * e2] * cs.y; o2[2 * e2] = x2[2 * e2] * cs.x + x1[2 * e2] * cs.y;
        o1[2 * e2 + 1] = x1[2 * e2 + 1] * cs.z - x2[2 * e2 + 1] * cs.w; o2[2 * e2 + 1] = x2[2 * e2 + 1] * cs.z + x1[2 * e2 + 1] * cs.w; }
      u32x4 p1, p2; p1.x = cvt_pk_bf16(o1[0], o1[1]); p1.y = cvt_pk_bf16(o1[2], o1[3]); p1.z = cvt_pk_bf16(o1[4], o1[5]); p1.w = cvt_pk_bf16(o1[6], o1[7]);
      p2.x = cvt_pk_bf16(o2[0], o2[1]); p2.y = cvt_pk_bf16(o2[2], o2[3]); p2.z = cvt_pk_bf16(o2[4], o2[5]); p2.w = cvt_pk_bf16(o2[6], o2[7]);
      qr[d0] = *reinterpret_cast<bf16x8*>(&p1); qr[d0 + 4] = *reinterpret_cast<bf16x8*>(&p2);
    }
  }
  const int sr = tid >> 4, sc = (tid & 15) * 8, vst0 = v_st(sr, sc), vst1 = v_st(32 + sr, sc);
  const int vb0 = (int)(uintptr_t)V_lds + v_rd_base(lane);
  const int mb0 = dq0 + wid * QBLK + r32 + 128 - 4 * hi;
  struct { bf16x8 vs0, vs1, ks0, ks1; } sr_[SD];
#define SLOAD(i, k0) do { sr_[i].vs0 = *reinterpret_cast<const bf16x8*>(&Vh[(long)((k0) + sr) * LDK + sc]); sr_[i].vs1 = *reinterpret_cast<const bf16x8*>(&Vh[(long)((k0) + 32 + sr) * LDK + sc]); \
    sr_[i].ks0 = *reinterpret_cast<const bf16x8*>(&Kh[(long)((k0) + sr) * LDK + sc]); sr_[i].ks1 = *reinterpret_cast<const bf16x8*>(&Kh[(long)((k0) + 32 + sr) * LDK + sc]); } while (0)
#define SWRITE(b, i) do { *(bf16x8*)((char*)V_lds + (b) * SHM_V + vst0) = sr_[i].vs0;          \
    *(bf16x8*)((char*)V_lds + (b) * SHM_V + vst1) = sr_[i].vs1; int kc = sc * 2;               \
    *(bf16x8*)((char*)K_lds + (b) * SHM_K + KSWZ(sr, kc)) = sr_[i].ks0;                       \
    *(bf16x8*)((char*)K_lds + (b) * SHM_K + KSWZ(32 + sr, kc)) = sr_[i].ks1; } while (0)
#define SWAIT() do { if constexpr (SD == 2) asm volatile("s_waitcnt vmcnt(4)" ::: "memory"); else asm volatile("s_waitcnt vmcnt(0)" ::: "memory"); } while (0)
#define RESC(a) do { if (__any((a) < 1.f)) { if (hi == 0) al_l[r32] = (a); asm volatile("s_waitcnt lgkmcnt(0)" ::: "memory"); \
    _Pragma("unroll") for (int d = 0; d < 4; ++d) _Pragma("unroll") for (int r = 0; r < 16; ++r) o[d][r] *= al_l[crow(r, hi)]; } } while (0)
#define PSM(P0, P1, MN, AL, J) partialSM<MODE != 0>(P0, P1, m_reg, MN, AL, mb0 - 64 * (J))
  f32x16 pA0, pA1, pB0, pB1; float mnA, mnB, alA, alB; bf16x8 pa0, pa1, pa2, pa3;
  constexpr int SE = 0, SO = SD - 1;
  SLOAD(SE, 0); asm volatile("s_waitcnt vmcnt(0)" ::: "memory"); SWRITE(0, SE); __syncthreads();
  qkt(pA0, pA1, K_lds, qr, r32, hi); PSM(pA0, pA1, mnA, alA, 0);
  SLOAD(SO, KVBLK); if constexpr (SD == 2) { if (2 < NT) SLOAD(SE, 2 * KVBLK); }
  SWAIT(); SWRITE(1, SO); __syncthreads();
  for (int j = 1; j + 1 < NT; j += 2) {
    SBAR(); qkt(pB0, pB1, (bf16*)((char*)K_lds + SHM_K), qr, r32, hi);
    finishSM(pA0, pA1, alA, l_reg, pa0, pa1, pa2, pa3); SBAR();
    SLOAD(SO, (j + SD) * KVBLK); SBAR();
    pv_d0(o, vb0, pa0, pa1, pa2, pa3); PSM(pB0, pB1, mnB, alB, j);
    __syncthreads(); SWAIT(); SWRITE(0, SE);
    RESC(alB); __syncthreads();
    SBAR(); qkt(pA0, pA1, K_lds, qr, r32, hi);
    finishSM(pB0, pB1, alB, l_reg, pa0, pa1, pa2, pa3); SBAR();
    if (SD == 1 || j + 3 < NT) SLOAD(SE, (j + 1 + SD) * KVBLK); SBAR();
    pv_d0(o, vb0 + (int)SHM_V, pa0, pa1, pa2, pa3); PSM(pA0, pA1, mnA, alA, j + 1);
    __syncthreads(); SWAIT(); SWRITE(1, SO);
    RESC(alA); __syncthreads();
  }
  SBAR(); qkt(pB0, pB1, (bf16*)((char*)K_lds + SHM_K), qr, r32, hi);
  finishSM(pA0, pA1, alA, l_reg, pa0, pa1, pa2, pa3); SBAR();
  pv_d0(o, vb0, pa0, pa1, pa2, pa3); PSM(pB0, pB1, mnB, alB, NT - 1);
  __syncthreads(); RESC(alB);
  finishSM(pB0, pB1, alB, l_reg, pa0, pa1, pa2, pa3); SBAR();
  pv_d0(o, vb0 + (int)SHM_V, pa0, pa1, pa2, pa3);
  if (hi == 0) li_l[r32] = l_reg; asm volatile("s_waitcnt lgkmcnt(0)" ::: "memory");
  float rli[16];
#pragma unroll
  for (int r = 0; r < 16; ++r) rli[r] = __builtin_amdgcn_rcpf(li_l[crow(r, hi)]);
  char* ost = lds + OST_OFF + wid * (32 * OST_PITCH);
#pragma unroll
  for (int r = 0; r < 16; ++r) { const int orow = crow(r, hi);
#pragma unroll
    for (int d0 = 0; d0 < 4; ++d0) { const float v = o[d0][r] * rli[r]; *(bf16*)(ost + orow * OST_PITCH + (d0 * 32 + r32) * 2) = (bf16)(cvt_pk_bf16(v, v) & 0xffffu); } }
  asm volatile("s_waitcnt lgkmcnt(0)" ::: "memory");
  bf16* Ow = Ob + (long)(wid * QBLK) * LDO;
#pragma unroll
  for (int i = 0; i < 8; ++i) { const int row = (lane >> 4) + 4 * i, cc = (lane & 15);
    const u32x4 w = *(const u32x4*)(ost + row * OST_PITCH + cc * 16);
    *(u32x4*)(Ow + (long)row * LDO + cc * 8) = w; }
  __syncthreads();
#undef SLOAD
#undef SWRITE
#undef SWAIT
#undef RESC
#undef PSM
}
}

#define XB_TMO      128
#define XB_XCNT(j)  (256  + 64 * (j))
#define XB_XSUB(j)  (1280 + 64 * (j))
#define XB_XGEN(j)  (2304 + 64 * (j))
#define XB_TOP      3328
#define XB_TOPGEN   3392
#define XCD_BAR_WORDS 3456
#define XB_SPIN_CAP (1u << 20)
__device__ __forceinline__ unsigned xb_ld(unsigned* p)              { return __hip_atomic_load(p, __ATOMIC_RELAXED, __HIP_MEMORY_SCOPE_AGENT); }
__device__ __forceinline__ unsigned xb_add(unsigned* p, unsigned v) { return __hip_atomic_fetch_add(p, v, __ATOMIC_RELAXED, __HIP_MEMORY_SCOPE_AGENT); }
__device__ __forceinline__ unsigned xb_xcc_id() { return (unsigned)__builtin_amdgcn_s_getreg((3 << 11) | 20) & 0xFu; }
#define XB_SPIN(cond, bar) do { unsigned _sp = 0; while (cond) { __builtin_amdgcn_s_sleep(1); \
    if ((++_sp & 255u) == 0u) { if (xb_ld(&(bar)[XB_TMO])) break; if (_sp > XB_SPIN_CAP) { atomicAdd(&(bar)[XB_TMO], 1u); break; } } } } while (0)
struct XcdBarrier { unsigned* bar; unsigned x; volatile LAS unsigned* st; };
__device__ __forceinline__ XcdBarrier xcd_barrier_post(unsigned* bar, volatile LAS unsigned* st) {
    XcdBarrier b; b.bar = bar; b.x = xb_xcc_id(); b.st = st;
    if (threadIdx.x == 0) (void)xb_add(&bar[XB_XCNT(b.x)], 1u);
    return b;
}
__device__ __forceinline__ void xcd_barrier_complete(unsigned* bar, unsigned x, unsigned& nloc, unsigned& nx) {
    const unsigned G = gridDim.x * gridDim.y * gridDim.z;
    unsigned sum, cnt, mine, sp = 0u;
    for (;;) {
        sum = 0u; cnt = 0u; mine = 0u;
#pragma unroll
        for (unsigned j = 0; j < 16; ++j) { const unsigned c = xb_ld(&bar[XB_XCNT(j)]); sum += c; cnt += (c > 0u) ? 1u : 0u; mine = (j == x) ? c : mine; }
        if (sum == G) break;
        __builtin_amdgcn_s_sleep(1);
        if ((++sp & 255u) == 0u) { if (xb_ld(&bar[XB_TMO])) break; if (sp > XB_SPIN_CAP) { atomicAdd(&bar[XB_TMO], 1u); break; } }
    }
    nloc = mine > 0u ? mine : 1u; nx = cnt > 0u ? cnt : 1u;
}
__device__ __forceinline__ void xcd_barrier(const XcdBarrier& b) {
    asm volatile("s_waitcnt vmcnt(0)" ::: "memory");
    __syncthreads();
    if (threadIdx.x == 0) {
        unsigned* bar = b.bar;
        __builtin_amdgcn_s_waitcnt(0);
        unsigned nloc = b.st[0], nx = b.st[1];
        if (nloc == 0u) { xcd_barrier_complete(bar, b.x, nloc, nx); b.st[0] = nloc; b.st[1] = nx; }
        const unsigned old = xb_add(&bar[XB_XSUB(b.x)], 1u);
        const unsigned gen = old / nloc;
        if (old + 1u == (gen + 1u) * nloc) {
            __builtin_amdgcn_fence(__ATOMIC_RELEASE, "agent");
            asm volatile("s_waitcnt vmcnt(0)" ::: "memory");
            const unsigned og = xb_add(&bar[XB_TOP], 1u);
            const unsigned tg = og / nx;
            if (og + 1u == (tg + 1u) * nx) xb_add(&bar[XB_TOPGEN], 1u);
            else XB_SPIN(xb_ld(&bar[XB_TOPGEN]) == tg, bar);
            __builtin_amdgcn_fence(__ATOMIC_ACQUIRE, "agent");
            xb_add(&bar[XB_XGEN(b.x)], 1u);
            asm volatile("s_waitcnt vmcnt(0)" ::: "memory");
        } else {
            XB_SPIN(xb_ld(&bar[XB_XGEN(b.x)]) == gen, bar);
            __builtin_amdgcn_fence(__ATOMIC_ACQUIRE, "agent");
            asm volatile("s_waitcnt vmcnt(0)" ::: "memory");
        }
    }
    __syncthreads();
}

__device__ __forceinline__ void transpose_item(const float* W, int K, int N, bf16* WT, LAS float* scr, int item, int lane, const float* gk = nullptr) {
    const int nblk = N / 32, kb = item / nblk, nb = item % nblk, k0 = 64 * kb, n0 = 32 * nb;
#pragma unroll 8
    for (int i = 0; i < 32; ++i) { const int kk = 2 * i + (lane >> 5); scr[kk * 33 + (lane & 31)] = W[(size_t)(k0 + kk) * N + n0 + (lane & 31)] * (gk ? gk[k0 + kk] : 1.0f); }
    asm volatile("s_waitcnt lgkmcnt(0)" ::: "memory");
    const int c = lane & 7;
#pragma unroll
    for (int j = 0; j < 4; ++j) { const int n = (lane >> 3) + 8 * j; const LAS float* s = scr + (8 * c) * 33 + n;
        u32x4 o; o.x = cvt_pk_bf16(s[0 * 33], s[1 * 33]); o.y = cvt_pk_bf16(s[2 * 33], s[3 * 33]); o.z = cvt_pk_bf16(s[4 * 33], s[5 * 33]); o.w = cvt_pk_bf16(s[6 * 33], s[7 * 33]);
        *(u32x4*)(WT + (size_t)(n0 + n) * K + k0 + 8 * c) = o; }
    asm volatile("s_waitcnt lgkmcnt(0)" ::: "memory");
}

struct Args { const float* in[21]; float* out; unsigned char* ws; int lo, hi; };

__device__ __forceinline__ const float* x_in_row(const float* xp, const float* xs, int row) {
    return row < NPROMPT_TOK ? xp + (size_t)row * DM : xs + (size_t)(row - NPROMPT_TOK) * DM;
}

__device__ __forceinline__ void phase_weights(const CAS Args* a, unsigned char* ws, int l, LAS unsigned char* lds, int gw, int NGW, int wave, int lane) {
    LAS float* scr = (LAS float*)(lds + wave * 16384);
    constexpr int I_IN = (DM / 64) * (INW / 32), I_BR = (MWD / 64) * (DM / 32), I_OUT = (DM / 64) * (DM / 32), I_F1 = (DM / 64) * (FFD / 32), I_F2 = (FFD / 64) * (DM / 32), I_G = 32 * 8;
    constexpr int NITEMS = I_IN + 3 * I_BR + I_OUT + I_F1 + I_F2 + I_G;
    for (int it = gw; it < NITEMS; it += NGW) {
        int r = it;
        if (r < I_IN) { transpose_item(a->in[6] + (size_t)l * DM * INW, DM, INW, (bf16*)(ws + WS_WIN), scr, r, lane, a->in[2] + (size_t)l * DM); continue; } r -= I_IN;
        if (r < 3 * I_BR) { const int b = r / I_BR; transpose_item(a->in[17] + ((size_t)l * 3 + b) * MWD * DM, MWD, DM, (bf16*)(ws + WS_WBR) + (size_t)b * DM * MWD, scr, r - b * I_BR, lane); continue; } r -= 3 * I_BR;
        if (r < I_OUT) { transpose_item(a->in[18] + (size_t)l * DM * DM, DM, DM, (bf16*)(ws + WS_WOUT), scr, r, lane); continue; } r -= I_OUT;
        if (r < I_F1) { transpose_item(a->in[19] + (size_t)l * DM * FFD, DM, FFD, (bf16*)(ws + WS_W1), scr, r, lane, a->in[4] + (size_t)l * DM); continue; } r -= I_F1;
        if (r < I_F2) { transpose_item(a->in[20] + (size_t)l * FFD * DM, FFD, DM, (bf16*)(ws + WS_W2), scr, r, lane); continue; } r -= I_F2;
        { const int mi = r >> 3, sub = r & 7;
          const int gate = mi >> 4, dd = (mi >> 3) & 1, blk = mi & 7;
          const float* src = (gate ? a->in[14] : a->in[12]) + (((size_t)l * 2 + dd) * 8 + blk) * 16384;
          transpose_item(src, 128, 128, (bf16*)(ws + WS_WG) + ((size_t)(dd * 2 + gate) * 8 + blk) * 16384, scr, sub, lane); }
    }
}

__device__ __forceinline__ void entry_row(const float* xrow, bf16* xb, float* rs, int lane) {
    const f32x4* xr = (const f32x4*)xrow + lane;
    f32x4 v[8]; float s = 0.f;
#pragma unroll
    for (int j = 0; j < 8; ++j) { v[j] = xr[64 * j]; s += (v[j].x * v[j].x + v[j].y * v[j].y) + (v[j].z * v[j].z + v[j].w * v[j].w); }
    u32x2* o8 = (u32x2*)xb + lane;
#pragma unroll
    for (int j = 0; j < 8; ++j) { u32x2 w; w.x = cvt_pk_bf16(v[j].x, v[j].y); w.y = cvt_pk_bf16(v[j].z, v[j].w); o8[64 * j] = w; }
    const float tot = wave_sum(s, lane);
    if (lane == 0) *rs = __builtin_amdgcn_rsqf(tot * (1.0f / DM) + EPS);
}
template <bool LAST>
__device__ __forceinline__ void resid_norm_row(const bf16* yrow, bf16* xrow, const float* g, float* rs, float* outrow, int lane) {
    float y[32], x[32]; float s = 0.f;
#pragma unroll
    for (int j = 0; j < 4; ++j) { const u32x4 w = ((const u32x4*)yrow)[64 * j + lane];
        y[8 * j + 0] = bf_lo(w.x); y[8 * j + 1] = bf_hi(w.x); y[8 * j + 2] = bf_lo(w.y); y[8 * j + 3] = bf_hi(w.y); y[8 * j + 4] = bf_lo(w.z); y[8 * j + 5] = bf_hi(w.z); y[8 * j + 6] = bf_lo(w.w); y[8 * j + 7] = bf_hi(w.w); }
#pragma unroll
    for (int j = 0; j < 4; ++j) { const u32x4 w = ((const u32x4*)xrow)[64 * j + lane];
        x[8 * j + 0] = bf_lo(w.x); x[8 * j + 1] = bf_hi(w.x); x[8 * j + 2] = bf_lo(w.y); x[8 * j + 3] = bf_hi(w.y); x[8 * j + 4] = bf_lo(w.z); x[8 * j + 5] = bf_hi(w.z); x[8 * j + 6] = bf_lo(w.w); x[8 * j + 7] = bf_hi(w.w); }
#pragma unroll
    for (int i = 0; i < 32; ++i) s += y[i] * y[i];
    const float rstd = __builtin_amdgcn_rsqf(wave_sum(s, lane) * (1.0f / DM) + EPS);
    float s2 = 0.f;
#pragma unroll
    for (int j = 0; j < 4; ++j) { const f32x4 g0 = ((const f32x4*)g)[2 * (64 * j + lane)], g1 = ((const f32x4*)g)[2 * (64 * j + lane) + 1];
        const float gg[8] = {g0.x, g0.y, g0.z, g0.w, g1.x, g1.y, g1.z, g1.w};
#pragma unroll
        for (int e = 0; e < 8; ++e) { const float v = x[8 * j + e] + y[8 * j + e] * rstd * gg[e]; x[8 * j + e] = v; s2 += v * v; } }
    if constexpr (LAST) {
#pragma unroll
        for (int j = 0; j < 4; ++j) { ((f32x4*)outrow)[2 * (64 * j + lane)] = (f32x4){x[8 * j], x[8 * j + 1], x[8 * j + 2], x[8 * j + 3]}; ((f32x4*)outrow)[2 * (64 * j + lane) + 1] = (f32x4){x[8 * j + 4], x[8 * j + 5], x[8 * j + 6], x[8 * j + 7]}; }
    } else {
#pragma unroll
        for (int j = 0; j < 4; ++j) { u32x4 w; w.x = cvt_pk_bf16(x[8 * j], x[8 * j + 1]); w.y = cvt_pk_bf16(x[8 * j + 2], x[8 * j + 3]); w.z = cvt_pk_bf16(x[8 * j + 4], x[8 * j + 5]); w.w = cvt_pk_bf16(x[8 * j + 6], x[8 * j + 7]);
            ((u32x4*)xrow)[64 * j + lane] = w; }
        const float r2 = __builtin_amdgcn_rsqf(wave_sum(s2, lane) * (1.0f / DM) + EPS);
        if (lane == 0) *rs = r2;
    }
}

__device__ __forceinline__ void krope_token(bf16* prow, const f32x2* taba, const f32x2* tab1, const float* kn, int lane) {
    const f32x2 csa = taba[lane], cs1 = tab1[lane];
    const float kg1 = kn[lane], kg2 = kn[64 + lane];
#pragma unroll
    for (int h = 0; h < 2; ++h) {
        bf16* p = prow + KA_OFF + h * HD;
        const float x1 = bf2f(p[lane]), x2 = bf2f(p[64 + lane]);
        const float rstd = 1.0f / sqrtf(wave_sum(x1 * x1 + x2 * x2, lane) * (1.0f / HD) + EPS);
        const float y1 = x1 * rstd * kg1, y2 = x2 * rstd * kg2;
        const float o1 = y1 * csa.x - y2 * csa.y, o2 = y2 * csa.x + y1 * csa.y;
        p[lane] = (bf16)(cvt_pk_bf16(o1, o1) & 0xffffu); p[64 + lane] = (bf16)(cvt_pk_bf16(o2, o2) & 0xffffu);
    }
#pragma unroll
    for (int h = 0; h < 2; ++h) {
        bf16* p = prow + KB_OFF + h * HD;
        const float x1 = bf2f(p[lane]), x2 = bf2f(p[64 + lane]);
        const float o1 = x1 * cs1.x - x2 * cs1.y, o2 = x2 * cs1.x + x1 * cs1.y;
        p[lane] = (bf16)(cvt_pk_bf16(o1, o1) & 0xffffu); p[64 + lane] = (bf16)(cvt_pk_bf16(o2, o2) & 0xffffu);
    }
}
__device__ __forceinline__ void rope_tables(f32x2* tab1, f32x2* taba, int gtid, int nthr) {
    for (int i = gtid; i < SEQ * 64; i += nthr) {
        const int pos = i >> 6, j = i & 63;
        const double rev1 = (double)pos * ROPE_F1[j];
        const double reva = (double)(j < 32 ? (pos >> 6) : (pos & 63)) * ROPE_FA[j & 31];
        const float f1 = (float)(rev1 - __builtin_floor(rev1)), fa = (float)(reva - __builtin_floor(reva));
        tab1[i] = (f32x2){__builtin_amdgcn_cosf(f1), __builtin_amdgcn_sinf(f1)};
        taba[i] = (f32x2){__builtin_amdgcn_cosf(fa), __builtin_amdgcn_sinf(fa)};
    }
}

struct CParams { const float* conv_w; const float* conv_b; const float* gate_r_b; const float* gate_i_b; const float* lam; const bf16* WG; };
constexpr int CSPAN = 512, NSPAN = SEQ / CSPAN;
template <int PASS, int DIR>
__device__ __forceinline__ void c_sweep(LAS unsigned char* lds, const bf16* P, bf16* OC, const CParams& cp, f32x2* SUM, int seq, int nb, int sp) {
    constexpr int UP = 136;
    LAS bf16* U = (LAS bf16*)lds;
    LAS float* AD = (LAS float*)(lds + 32768);
    int tid_ = threadIdx.x; asm volatile("" : "+v"(tid_));
    const int tid = tid_, wave = tid >> 6, lane = tid & 63;
    const int t0 = tid >> 4, c8 = (tid & 15) * 8, cg8 = nb * 128 + c8;
    LAS float* CW = (LAS float*)(lds + 32768 + 65536);
    for (int i = tid; i < 5 * 128; i += 512) CW[i] = (i < 512) ? cp.conv_w[(i >> 7) * MWD + nb * 128 + (i & 127)] : cp.conv_b[nb * 128 + (i & 127)];
    const int q = wave & 3, th = wave >> 2, r = lane & 31, h = lane >> 5;
    bf16x8 bfr[8], bfi[8];
    { const bf16* wrp = cp.WG + ((size_t)((DIR * 2 + 0) * 8 + nb) * 128 + 32 * q + r) * 128 + 8 * h;
      const bf16* wip = cp.WG + ((size_t)((DIR * 2 + 1) * 8 + nb) * 128 + 32 * q + r) * 128 + 8 * h;
#pragma unroll
      for (int ks = 0; ks < 8; ++ks) { bfr[ks] = *(const bf16x8*)(wrp + 16 * ks); bfi[ks] = *(const bf16x8*)(wip + 16 * ks); } }
    const int ch = 32 * q + r, cg = nb * 128 + ch;
    constexpr float L2E = 1.4426950408889634f;
    const float rbn = -L2E * cp.gate_r_b[DIR * MWD + cg], ibn = -L2E * cp.gate_i_b[DIR * MWD + cg], lam = cp.lam[DIR * MWD + cg];
    const float el = __builtin_amdgcn_exp2f(-L2E * lam);
    const float ls8 = -8.0f * (lam > 3.0f ? el * (1.0f - el * (0.5f - el * (1.0f / 3.0f))) : 0.6931471805599453f * __builtin_amdgcn_logf(1.0f + el));
    const f32x2 ls8e = {ls8 * L2E, ls8 * L2E}, ls82 = {2.0f * ls8, 2.0f * ls8}, rbn2 = {rbn, rbn}, ibn2 = {ibn, ibn};
    float hh = 0.f, pp = 1.f;
    if constexpr (PASS == 3) {
        if (tid < 128) {
            const f32x2* sb = SUM + ((size_t)(seq * NSPAN) * 2 + DIR) * MWD + nb * 128 + tid;
            f32x2 sv[NSPAN];
#pragma unroll
            for (int s = 0; s < NSPAN; ++s) sv[s] = sb[(size_t)s * 2 * MWD];
#pragma unroll
            for (int s = 0; s < NSPAN; ++s) { const int ss = DIR ? NSPAN - 1 - s : s; const bool use = DIR ? (ss > sp) : (ss < sp); hh = use ? sv[ss].x * hh + sv[ss].y : hh; }
        }
    }
    const size_t rowbase = (size_t)seq * SEQ + (size_t)sp * CSPAN;
    const int posbase = sp * CSPAN;
    u32x4 xw[2][4];
#define C_LOADX(tile) do { _Pragma("unroll") for (int hf = 0; hf < 2; ++hf) _Pragma("unroll") for (int j = 0; j < 4; ++j) { const int tt = posbase + (tile) * 64 + t0 + 32 * hf - 2 + j; \
        const int ttc = tt < 0 ? 0 : (tt >= SEQ ? SEQ - 1 : tt); const u32x4 xv = *(const u32x4*)(P + ((size_t)seq * SEQ + ttc) * PWD + XC_OFF + cg8); \
        const unsigned keep = (tt >= 0 && tt < SEQ) ? 0xffffffffu : 0u; xw[hf][j] = (u32x4){xv.x & keep, xv.y & keep, xv.z & keep, xv.w & keep}; } } while (0)
    C_LOADX(DIR ? 7 : 0);
    __syncthreads();
    for (int it = 0; it < 8; ++it) {
        const int tile = DIR ? 7 - it : it;
#pragma unroll
        for (int hf = 0; hf < 2; ++hf) {
            float u8[8];
            { const f32x4 b0 = *(const LAS f32x4*)(CW + 512 + c8), b1 = *(const LAS f32x4*)(CW + 512 + c8 + 4); u8[0] = b0.x; u8[1] = b0.y; u8[2] = b0.z; u8[3] = b0.w; u8[4] = b1.x; u8[5] = b1.y; u8[6] = b1.z; u8[7] = b1.w; }
#pragma unroll
            for (int j = 0; j < 4; ++j) { const u32x4 x = xw[hf][j]; const f32x4 w0 = *(const LAS f32x4*)(CW + j * 128 + c8), w1 = *(const LAS f32x4*)(CW + j * 128 + c8 + 4);
                u8[0] += bf_lo(x.x) * w0.x; u8[1] += bf_hi(x.x) * w0.y; u8[2] += bf_lo(x.y) * w0.z; u8[3] += bf_hi(x.y) * w0.w;
                u8[4] += bf_lo(x.z) * w1.x; u8[5] += bf_hi(x.z) * w1.y; u8[6] += bf_lo(x.w) * w1.z; u8[7] += bf_hi(x.w) * w1.w; }
            u32x4 w; w.x = cvt_pk_bf16(u8[0], u8[1]); w.y = cvt_pk_bf16(u8[2], u8[3]); w.z = cvt_pk_bf16(u8[4], u8[5]); w.w = cvt_pk_bf16(u8[6], u8[7]);
            *(LAS u32x4*)(U + (t0 + 32 * hf) * UP + c8) = w;
        }
        if (it < 7) C_LOADX(DIR ? 6 - it : it + 1);
        __syncthreads();
        {
            f32x16 accr = {}, acci = {};
#pragma unroll
            for (int ks = 0; ks < 8; ++ks) {
                const bf16x8 af = *(const LAS bf16x8*)(U + (32 * th + r) * UP + 16 * ks + 8 * h);
                accr = __builtin_amdgcn_mfma_f32_32x32x16_bf16(af, bfr[ks], accr, 0, 0, 0);
                acci = __builtin_amdgcn_mfma_f32_32x32x16_bf16(af, bfi[ks], acci, 0, 0, 0);
            }
            LAS float* pa = AD + ch; LAS float* pd = AD + 64 * 128 + ch;
#pragma unroll
            for (int reg = 0; reg < 16; reg += 2) {
                const int tt = 32 * th + (reg & 3) + 8 * (reg >> 2) + 4 * h;
                const f32x2 er = (f32x2){accr[reg], accr[reg + 1]} * (-L2E) + rbn2, ei = (f32x2){acci[reg], acci[reg + 1]} * (-L2E) + ibn2;
                f32x2 rr, ii; rr.x = __builtin_amdgcn_rcpf(1.0f + __builtin_amdgcn_exp2f(er.x)); rr.y = __builtin_amdgcn_rcpf(1.0f + __builtin_amdgcn_exp2f(er.y));
                ii.x = __builtin_amdgcn_rcpf(1.0f + __builtin_amdgcn_exp2f(ei.x)); ii.y = __builtin_amdgcn_rcpf(1.0f + __builtin_amdgcn_exp2f(ei.y));
                const f32x2 le = ls8e * rr, x2 = ls82 * rr;
                f32x2 av; av.x = __builtin_amdgcn_exp2f(le.x); av.y = __builtin_amdgcn_exp2f(le.y);
                const f32x2 pol = -x2 * (1.0f + x2 * (0.5f + x2 * ((1.0f / 6.0f) + x2 * ((1.0f / 24.0f) + x2 * (1.0f / 120.0f))))), dir = 1.0f - av * av;
                f32x2 om; om.x = x2.x > -0.25f ? pol.x : dir.x; om.y = x2.y > -0.25f ? pol.y : dir.y;
                const f32x2 uf = {bf2f(U[tt * UP + ch]), bf2f(U[(tt + 1) * UP + ch])};
                f32x2 sq; sq.x = __builtin_amdgcn_sqrtf(om.x); sq.y = __builtin_amdgcn_sqrtf(om.y);
                const f32x2 dr = sq * (ii * uf);
                pa[tt * 128] = av.x; pa[(tt + 1) * 128] = av.y; pd[tt * 128] = dr.x; pd[(tt + 1) * 128] = dr.y;
            }
        }
        u32x4 yw[2], ow[2];
        if constexpr (PASS == 3) {
#pragma unroll
            for (int hf = 0; hf < 2; ++hf) { const size_t row = rowbase + tile * 64 + t0 + 32 * hf; yw[hf] = *(const u32x4*)(P + row * PWD + YC_OFF + cg8);
                if constexpr (DIR == 1) ow[hf] = *(const u32x4*)(OC + row * MWD + cg8); }
        }
        __syncthreads();
        if (tid < 128) {
            LAS float* pa = AD + tid; LAS float* pd = AD + 64 * 128 + tid;
#pragma unroll
            for (int s0 = 0; s0 < 64; s0 += 16) {
                float av[16], dv[16];
#pragma unroll
                for (int s = 0; s < 16; ++s) { const int t = DIR ? 63 - (s0 + s) : (s0 + s); av[s] = pa[t * 128]; dv[s] = pd[t * 128]; }
#pragma unroll
                for (int s = 0; s < 16; ++s) { hh = av[s] * hh + dv[s]; if constexpr (PASS == 1) pp *= av[s]; else dv[s] = hh; }
                if constexpr (PASS == 3) {
#pragma unroll
                    for (int s = 0; s < 16; ++s) { const int t = DIR ? 63 - (s0 + s) : (s0 + s); pa[t * 128] = dv[s]; } }
            }
        }
        if constexpr (PASS == 3) {
            __syncthreads();
#pragma unroll
            for (int hf = 0; hf < 2; ++hf) { const int t = t0 + 32 * hf; const size_t row = rowbase + tile * 64 + t;
                const u32x4 y4 = yw[hf];
                const float y[8] = {bf_lo(y4.x), bf_hi(y4.x), bf_lo(y4.y), bf_hi(y4.y), bf_lo(y4.z), bf_hi(y4.z), bf_lo(y4.w), bf_hi(y4.w)};
                const LAS float* hp = AD + t * 128 + c8;
                float o[8];
#pragma unroll
                for (int j = 0; j < 8; ++j) { const float z = 0.7978845608028654f * (y[j] + 0.044715f * y[j] * y[j] * y[j]);
                    o[j] = hp[j] * (y[j] * fast_sigmoid(2.0f * z)); }
                if constexpr (DIR == 1) { const u32x4 p4 = ow[hf]; o[0] += bf_lo(p4.x); o[1] += bf_hi(p4.x); o[2] += bf_lo(p4.y); o[3] += bf_hi(p4.y); o[4] += bf_lo(p4.z); o[5] += bf_hi(p4.z); o[6] += bf_lo(p4.w); o[7] += bf_hi(p4.w); }
                u32x4 w; w.x = cvt_pk_bf16(o[0], o[1]); w.y = cvt_pk_bf16(o[2], o[3]); w.z = cvt_pk_bf16(o[4], o[5]); w.w = cvt_pk_bf16(o[6], o[7]);
                *(u32x4*)(OC + row * MWD + cg8) = w; }
        }
    }
#undef C_LOADX
    if constexpr (PASS == 1) { if (tid < 128) SUM[((size_t)(seq * NSPAN + sp) * 2 + DIR) * MWD + nb * 128 + tid] = (f32x2){pp, hh}; }
    __syncthreads();
}

__global__ void __launch_bounds__(512, 2) mk_fwd(Args args) {
    extern __shared__ __attribute__((aligned(16))) unsigned char lds_raw[];
    LAS unsigned char* lds = (LAS unsigned char*)lds_raw;
    {
        volatile LAS unsigned* MISC = (volatile LAS unsigned*)(lds + MISC_OFF);
        for (int u = threadIdx.x; u < (LDS_BYTES - MISC_OFF) / 4; u += 512) MISC[u] = 0u;
        __syncthreads();
    }
#if MK_SINGLE
    XcdBarrier bar = xcd_barrier_post((unsigned*)(args.ws + WS_CTL) + CW_BAR, (volatile LAS unsigned*)(lds + MISC_OFF) + 8);
#define GRID_BAR() xcd_barrier(bar)
#else
#define GRID_BAR() do {} while (0)
#endif
    const int lo = args.lo, hi = args.hi;
    int step = 0;
#define RUN(k) (lo <= (k) && (k) < hi)
#define SEAM(k) do { if (RUN((k) + 1)) GRID_BAR(); } while (0)
#define PHASE_ENTER() int tid = threadIdx.x; asm volatile("" : "+v"(tid)); int bx = blockIdx.x; asm volatile("" : "+s"(bx)); int G = gridDim.x; asm volatile("" : "+s"(G)); const int NGW = G * 8; (void)NGW; \
    const int lane = tid & 63, wave = __builtin_amdgcn_readfirstlane(tid >> 6), gw = bx * 8 + wave; \
    const CAS Args* ap = (const CAS Args*)__builtin_amdgcn_kernarg_segment_ptr(); asm volatile("" : "+s"(ap)); \
    unsigned char* ws = ap->ws; float* out = ap->out; (void)lane; (void)gw; (void)out; \
    bf16* const P = (bf16*)(ws + WS_P); bf16* const Y = (bf16*)(ws + WS_P); bf16* const GT = (bf16*)(ws + WS_G); bf16* const O = (bf16*)(ws + WS_O); bf16* const HID = (bf16*)(ws + WS_G); \
    (void)P; (void)Y; (void)GT; (void)O; (void)HID

    for (int l = 0; l < DEPTH; ++l) {
        { const int k = step++; if (RUN(k) && ((PH_MASK >> 0) & 1)) { PHASE_ENTER(); for (int rep_ = 0; rep_ < NREP(0); ++rep_) phase_weights(ap, ws, l, lds, gw, NGW, wave, lane);
            if (l == 0) {
                rope_tables((f32x2*)(ws + WS_TAB1), (f32x2*)(ws + WS_TABA), bx * 512 + tid, G * 512);
                for (int row = gw; row < NTOK; row += NGW) entry_row(x_in_row(ap->in[0], ap->in[1], row), (bf16*)(ws + WS_XB) + (size_t)row * DM, (float*)(ws + WS_RS) + row, lane); }
            SEAM(k); } }
        for (int c = 0; c < NCHUNK; ++c) {
            const int row0 = c * TC;
            #define XBC ((bf16*)(ws + WS_XB) + (size_t)c * TC * DM)
            #define RSC ((float*)(ws + WS_RS) + (size_t)c * TC)
            #define MRG ((bf16*)(ws + WS_P + 64 * MiB))
            { const int k = step++; if (RUN(k) && ((PH_MASK >> 2) & 1)) { PHASE_ENTER();
                pg8::Gemm g{XBC, (bf16*)(ws + WS_WIN), DM}; pg8::StaticOrder S; S.init(TC, INW, G, bx); pg8::EpiIn E{P, GT, RSC};
                for (int rep_ = 0; rep_ < NREP(2); ++rep_) pg8::gemm_phase<pg8::EpiIn, pg8::StaticOrder>(lds, g, S, E);
                SEAM(k); } }
            { const int k = step++; if (RUN(k) && ((PH_MASK >> 3) & 1)) { PHASE_ENTER();
                const float* kn = ap->in[8] + (size_t)l * HD;
                for (int m = gw; m < TC; m += NGW) { const int pos = m & (SEQ - 1); krope_token(P + (size_t)m * PWD, (const f32x2*)(ws + WS_TABA) + pos * 64, (const f32x2*)(ws + WS_TAB1) + pos * 64, kn, lane); }
                CParams cp{ap->in[10] + (size_t)l * 4 * MWD, ap->in[11] + (size_t)l * MWD, ap->in[13] + (size_t)l * 2 * MWD, ap->in[15] + (size_t)l * 2 * MWD, ap->in[16] + (size_t)l * 2 * MWD, (bf16*)(ws + WS_WG)};
                for (int rep_ = 0; rep_ < NREP(3); ++rep_) for (int u = bx; u < 2 * 8 * NSPAN; u += G) { const int sp = u & (NSPAN - 1), nb = (u >> 4) & 7, seq = u >> 7;
                    c_sweep<1, 0>(lds, P, nullptr, cp, (f32x2*)(ws + WS_SUM), seq, nb, sp); c_sweep<1, 1>(lds, P, nullptr, cp, (f32x2*)(ws + WS_SUM), seq, nb, sp); }
                SEAM(k); } }
            { const int k = step++; if (RUN(k) && ((PH_MASK >> 5) & 1)) {
                if (SUBMASK & 1) { PHASE_ENTER(); const int xcd = bx & 7, rank = bx >> 3, nrank = G >> 3; for (int rep_ = 0; rep_ < NREP(12); ++rep_) for (int i = rank; i < 64; i += nrank) {
                    const int seq = xcd >> 2, kvh = (xcd >> 1) & 1, head = kvh * 4 + (xcd & 1) * 2 + (i >> 5), qb = i & 31;
                    const bf16* Qb = P + (size_t)(seq * SEQ + qb * 256) * PWD + QA_OFF + head * HD;
                    const bf16* Kh = P + (size_t)(seq * SEQ) * PWD + KA_OFF + kvh * HD; const bf16* Vh = P + (size_t)(seq * SEQ) * PWD + VA_OFF + kvh * HD;
                    att::attn_unit<0, SD_A>(Qb, Kh, Vh, O + (size_t)(seq * SEQ + qb * 256) * MWD + head * HD, SEQ / 64, 0, 0.f, (char*)lds_raw, (const f32x2*)(ws + WS_TABA) + qb * 256 * 64, ap->in[7] + (size_t)l * HD);
                } }
                if (SUBMASK & 2) { PHASE_ENTER(); const int xcd = bx & 7, rank = bx >> 3, nrank = G >> 3; for (int rep_ = 0; rep_ < NREP(13); ++rep_) for (int i = rank; i < 64; i += nrank) {
                    const int seq = xcd >> 2, kvh = (xcd >> 1) & 1, head = kvh * 4 + (xcd & 1) * 2 + (i >> 5), qb = i & 31;
                    const int k0 = (qb == 0) ? 0 : qb * 256 - 128, k1 = (qb == 31) ? SEQ : qb * 256 + 384;
                    const bf16* Qb = P + (size_t)(seq * SEQ + qb * 256) * PWD + QB_OFF + head * HD;
                    const bf16* Kh = P + (size_t)(seq * SEQ + k0) * PWD + KB_OFF + kvh * HD; const bf16* Vh = P + (size_t)(seq * SEQ + k0) * PWD + VB_OFF + kvh * HD;
                    att::attn_unit<1, SD_B>(Qb, Kh, Vh, O + (size_t)TC * MWD + (size_t)(seq * SEQ + qb * 256) * MWD + head * HD, (k1 - k0) / 64, qb * 256 - k0, ap->in[9][l * 8 + head], (char*)lds_raw, (const f32x2*)(ws + WS_TAB1) + qb * 256 * 64, nullptr);
                } }
                if (SUBMASK & 4) { PHASE_ENTER();
                CParams cp{ap->in[10] + (size_t)l * 4 * MWD, ap->in[11] + (size_t)l * MWD, ap->in[13] + (size_t)l * 2 * MWD, ap->in[15] + (size_t)l * 2 * MWD, ap->in[16] + (size_t)l * 2 * MWD, (bf16*)(ws + WS_WG)};
                for (int rep_ = 0; rep_ < NREP(14); ++rep_) for (int u = bx; u < 2 * 8 * NSPAN; u += G) { const int sp = u & (NSPAN - 1), nb = (u >> 4) & 7, seq = u >> 7;
                    c_sweep<3, 0>(lds, P, O + (size_t)2 * TC * MWD, cp, (f32x2*)(ws + WS_SUM), seq, nb, sp); c_sweep<3, 1>(lds, P, O + (size_t)2 * TC * MWD, cp, (f32x2*)(ws + WS_SUM), seq, nb, sp); } }
                SEAM(k); } }
            { const int k = step++; if (RUN(k) && ((PH_MASK >> 6) & 1)) { PHASE_ENTER();
                pg8::Gemm g{O, (bf16*)(ws + WS_WBR), MWD}; pg8::BranchOrder S; S.base.init(TC, DM, G, bx); S.npanel = TC / 256;
                pg8::EpiBr E{GT, MRG, (float*)(ws + WS_BRS) + (size_t)bx * 65536};
                for (int rep_ = 0; rep_ < NREP(6); ++rep_) pg8::gemm_phase<pg8::EpiBr, pg8::BranchOrder>(lds, g, S, E);
                SEAM(k); } }
            { const int k = step++; if (RUN(k) && ((PH_MASK >> 7) & 1)) { PHASE_ENTER();
                pg8::Gemm g{MRG, (bf16*)(ws + WS_WOUT), DM}; pg8::StaticOrder S; S.init(TC, DM, G, bx); pg8::EpiBf16 E{Y, DM};
                for (int rep_ = 0; rep_ < NREP(7); ++rep_) pg8::gemm_phase<pg8::EpiBf16, pg8::StaticOrder>(lds, g, S, E);
                SEAM(k); } }
            { const int k = step++; if (RUN(k) && ((PH_MASK >> 8) & 1)) { PHASE_ENTER();
                const float* g1 = ap->in[3] + (size_t)l * DM;
                for (int m = gw; m < TC; m += NGW) resid_norm_row<false>(Y + (size_t)m * DM, XBC + (size_t)m * DM, g1, RSC + m, nullptr, lane);
                SEAM(k); } }
            { const int k = step++; if (RUN(k) && ((PH_MASK >> 9) & 1)) { PHASE_ENTER();
                pg8::Gemm g{XBC, (bf16*)(ws + WS_W1), DM}; pg8::StaticOrder S; S.init(TC, FFD, G, bx); pg8::EpiRelu2 E{HID, FFD, RSC};
                for (int rep_ = 0; rep_ < NREP(9); ++rep_) pg8::gemm_phase<pg8::EpiRelu2, pg8::StaticOrder>(lds, g, S, E);
                SEAM(k); } }
            { const int k = step++; if (RUN(k) && ((PH_MASK >> 10) & 1)) { PHASE_ENTER();
                pg8::Gemm g{HID, (bf16*)(ws + WS_W2), FFD}; pg8::StaticOrder S; S.init(TC, DM, G, bx); pg8::EpiBf16 E{Y, DM};
                for (int rep_ = 0; rep_ < NREP(10); ++rep_) pg8::gemm_phase<pg8::EpiBf16, pg8::StaticOrder>(lds, g, S, E);
                SEAM(k); } }
            { const int k = step++; if (RUN(k) && ((PH_MASK >> 11) & 1)) { PHASE_ENTER();
                const float* g1 = ap->in[5] + (size_t)l * DM;
                if (l + 1 < DEPTH) { for (int m = gw; m < TC; m += NGW) resid_norm_row<false>(Y + (size_t)m * DM, XBC + (size_t)m * DM, g1, RSC + m, nullptr, lane); }
                else { for (int m = gw; m < TC; m += NGW) resid_norm_row<true>(Y + (size_t)m * DM, XBC + (size_t)m * DM, g1, nullptr, out + (size_t)(row0 + m) * DM, lane); }
                SEAM(k); } }
        }
    }
#undef RUN
#undef SEAM
}
constexpr int NSTEPS = DEPTH * (1 + NCHUNK * 9);

extern "C" void kernel_launch(void* const* d_in, const int* in_sizes, int n_in, void* d_out, int out_size, void* d_ws, size_t ws_size, hipStream_t stream) {
    static int grid = 0;
    if (grid == 0) {
        if (n_in != 21 || out_size != NTOK * DM || ws_size < WS_END) { fprintf(stderr, "kernel_launch: unexpected shapes (n_in %d out %d ws %zu)\n", n_in, out_size, ws_size); grid = -1; return; }
        int dev = 0, cus = 0, per_cu = 0;
        if (hipGetDevice(&dev) != hipSuccess || hipDeviceGetAttribute(&cus, hipDeviceAttributeMultiprocessorCount, dev) != hipSuccess) { grid = -1; return; }
        if (hipFuncSetAttribute((const void*)mk_fwd, hipFuncAttributeMaxDynamicSharedMemorySize, LDS_BYTES) != hipSuccess) { fprintf(stderr, "kernel_launch: hipFuncSetAttribute failed\n"); grid = -1; return; }
        if (hipOccupancyMaxActiveBlocksPerMultiprocessor(&per_cu, (const void*)mk_fwd, 512, LDS_BYTES) != hipSuccess || per_cu < 1) { fprintf(stderr, "kernel_launch: occupancy query says %d\n", per_cu); }
        (void)hipGetLastError();
        grid = cus;
    }
    if (grid < 0) return;
    if (hipMemsetAsync((char*)d_ws + WS_CTL, 0, CTL_ZERO_BYTES, stream) != hipSuccess) return;
    Args a{};
    for (int i = 0; i < 21; ++i) a.in[i] = (const float*)d_in[i];
    a.out = (float*)d_out; a.ws = (unsigned char*)d_ws;
#if MK_SINGLE
    a.lo = 0; a.hi = NSTEPS;
    hipLaunchKernelGGL(mk_fwd, dim3(grid), dim3(512), LDS_BYTES, stream, a);
#else
    for (int s = 0; s < NSTEPS; ++s) { a.lo = s; a.hi = s + 1; hipLaunchKernelGGL(mk_fwd, dim3(grid), dim3(512), LDS_BYTES, stream, a); }
#endif
    const hipError_t le = hipPeekAtLastError();
    if (le != hipSuccess) fprintf(stderr, "kernel_launch: launch failed: %s\n", hipGetErrorName(le));
}
```

```cpp
#include <hip/hip_runtime.h>
#include <cstdio>
#include <cstdint>

#ifndef PH_MASK
#define PH_MASK 0xFFF
#endif
#ifndef SUBMASK
#define SUBMASK 7
#endif
#ifndef SD_A
#define SD_A 2
#endif
#ifndef SD_B
#define SD_B 1
#endif
#ifndef DUP_MASK
#define DUP_MASK 0
#endif
#define NREP(i) (1 + ((DUP_MASK >> (i)) & 1))
#ifndef MK_SINGLE
#define MK_SINGLE 1
#endif

#define LAS __attribute__((address_space(3)))
#define GAS __attribute__((address_space(1)))
#define CAS __attribute__((address_space(4)))
typedef unsigned short bf16;
typedef short bf16x8 __attribute__((ext_vector_type(8)));
typedef short s16x4 __attribute__((ext_vector_type(4)));
typedef float f32x4 __attribute__((ext_vector_type(4)));
typedef float f32x2 __attribute__((ext_vector_type(2)));
typedef float f32x16 __attribute__((ext_vector_type(16)));
typedef unsigned u32x4 __attribute__((ext_vector_type(4)));
typedef unsigned u32x2 __attribute__((ext_vector_type(2)));

constexpr int DM = 2048, SEQ = 8192, NTOK = 49152, TCMAX = 32768, NCHUNK = 2, DEPTH = 4;
constexpr int INW = 11264, PWD = 5120, GWD = 6144, FFD = 8192, MWD = 1024, HD = 128;
constexpr int QA_OFF = 0, KA_OFF = 1024, VA_OFF = 1280, QB_OFF = 1536, KB_OFF = 2560, VB_OFF = 2816, XC_OFF = 3072, YC_OFF = 4096;
constexpr int NPROMPT_TOK = 32768;
constexpr float EPS = 1e-6f;

constexpr size_t MiB = 1u << 20;
constexpr size_t WS_CTL = 0, CTL_ZERO_BYTES = 1 * MiB;
constexpr size_t WS_WIN = 2 * MiB;
constexpr size_t WS_WBR = 46 * MiB;
constexpr size_t WS_WOUT = 58 * MiB;
constexpr size_t WS_W1 = 66 * MiB;
constexpr size_t WS_W2 = 98 * MiB;
constexpr size_t WS_WG = 130 * MiB;
constexpr size_t WS_SUM = 131 * MiB;
constexpr size_t WS_BRS = 143 * MiB;
constexpr size_t WS_P = 207 * MiB;
constexpr size_t WS_G = 527 * MiB;
constexpr size_t WS_O = 911 * MiB;
constexpr size_t WS_TAB1 = 1103 * MiB;
constexpr size_t WS_TABA = 1107 * MiB;
constexpr size_t WS_XB = 1111 * MiB;
constexpr size_t WS_RS = 1303 * MiB;
constexpr size_t WS_END = 1304 * MiB;
constexpr int CW_BAR = 4096;

constexpr int LDS_BYTES = 147456;
constexpr int MISC_OFF = 143360;

__device__ __forceinline__ unsigned cvt_pk_bf16(float lo, float hi) { unsigned r; asm volatile("v_cvt_pk_bf16_f32 %0, %1, %2" : "=v"(r) : "v"(lo), "v"(hi)); return r; }
__device__ __forceinline__ float bf_lo(unsigned w) { return __uint_as_float(w << 16); }
__device__ __forceinline__ float bf_hi(unsigned w) { return __uint_as_float(w & 0xffff0000u); }
__device__ __forceinline__ float bf2f(bf16 b) { return __uint_as_float(((unsigned)b) << 16); }
__device__ __forceinline__ float fast_sigmoid(float v) { return __builtin_amdgcn_rcpf(1.0f + __builtin_amdgcn_exp2f(-1.4426950408889634f * v)); }
__device__ __forceinline__ float wave_sum(float v, int lane) {
#pragma unroll
    for (int o = 1; o < 64; o <<= 1) v += __int_as_float(__builtin_amdgcn_ds_bpermute((lane ^ o) << 2, __float_as_int(v)));
    return v;
}

__device__ const double ROPE_F1[64] = {
1.59154943091895346e-01, 1.37822502603982849e-01, 1.19349370211248862e-01, 1.03352296618434064e-01, 8.94994016088910133e-02, 7.75032887553740585e-02, 6.71150830052272551e-02, 5.81192674418762462e-02,
5.03292121044697269e-02, 4.35833029420947638e-02, 3.77415888468699103e-02, 3.26828760272190911e-02, 2.83022152813622411e-02, 2.45087241866802648e-02, 2.12237020815031856e-02, 1.83789966569160986e-02,
1.59154943091895339e-02, 1.37822502603982842e-02, 1.19349370211248869e-02, 1.03352296618434060e-02, 8.94994016088910202e-03, 7.75032887553740654e-03, 6.71150830052272551e-03, 5.81192674418762427e-03,
5.03292121044697286e-03, 4.35833029420947656e-03, 3.77415888468699086e-03, 3.26828760272190893e-03, 2.83022152813622403e-03, 2.45087241866802661e-03, 2.12237020815031847e-03, 1.83789966569160995e-03,
1.59154943091895335e-03, 1.37822502603982846e-03, 1.19349370211248865e-03, 1.03352296618434069e-03, 8.94994016088910115e-04, 7.75032887553740654e-04, 6.71150830052272508e-04, 5.81192674418762427e-04,
5.03292121044697243e-04, 4.35833029420947678e-04, 3.77415888468699086e-04, 3.26828760272190871e-04, 2.83022152813622381e-04, 2.45087241866802661e-04, 2.12237020815031847e-04, 1.83789966569160984e-04,
1.59154943091895346e-04, 1.37822502603982835e-04, 1.19349370211248871e-04, 1.03352296618434063e-04, 8.94994016088910088e-05, 7.75032887553740654e-05, 6.71150830052272508e-05, 5.81192674418762400e-05,
5.03292121044697243e-05, 4.35833029420947644e-05, 3.77415888468699120e-05, 3.26828760272190871e-05, 2.83022152813622381e-05, 2.45087241866802641e-05, 2.12237020815031861e-05, 1.83789966569160984e-05 };
__device__ const double ROPE_FA[32] = {
1.59154943091895346e-01, 1.19349370211248862e-01, 8.94994016088910133e-02, 6.71150830052272551e-02, 5.03292121044697269e-02, 3.77415888468699103e-02, 2.83022152813622411e-02, 2.12237020815031856e-02,
1.59154943091895339e-02, 1.19349370211248869e-02, 8.94994016088910202e-03, 6.71150830052272551e-03, 5.03292121044697286e-03, 3.77415888468699086e-03, 2.83022152813622403e-03, 2.12237020815031847e-03,
1.59154943091895335e-03, 1.19349370211248865e-03, 8.94994016088910115e-04, 6.71150830052272508e-04, 5.03292121044697243e-04, 3.77415888468699086e-04, 2.83022152813622381e-04, 2.12237020815031847e-04,
1.59154943091895346e-04, 1.19349370211248871e-04, 8.94994016088910088e-05, 6.71150830052272508e-05, 5.03292121044697243e-05, 3.77415888468699120e-05, 2.83022152813622381e-05, 2.12237020815031861e-05 };

namespace pg8 {
typedef unsigned short bf16_t;
constexpr int BM = 256, BK = 64, HALF = 128, HTB = HALF * BK * 2, STAGE_BYTES = 8 * HTB, NXCD = 8, WGM = 8;
__host__ __device__ __forceinline__ int lds_byte(int r, int c) { const int st = (r >> 4) * 2 + (c >> 5), rr = r & 15, cc = c & 31, ob = rr * 64 + cc * 2; return st * 1024 + (ob ^ (((ob >> 9) & 1) << 5)); }
__host__ __device__ __forceinline__ void stage_rc(int b, int& R, int& C) { const int st = b / 1024, sb = b % 1024, swz = sb ^ (((sb >> 9) & 1) << 5); R = (st >> 1) * 16 + swz / 64; C = (st & 1) * 32 + (swz % 64) / 2; }
__host__ __device__ __forceinline__ int perm32(int rho) { const int n = rho >> 4, i = rho & 15; return 8 * (i >> 2) + 4 * n + (i & 3); }

struct Unit { int pm, pn, ka, kb, sub; };
struct Gemm { const bf16_t* A; const bf16_t* Bt; int K; };

struct StaticOrder {
    int nM, nN, nwg, G, c;
    __device__ void init(int M, int N, int G_, int c_) { nM = M / BM; nN = N / BM; nwg = nM * nN; G = G_; c = c_; }
    __device__ bool next(int i, Unit& u) const {
        const long L = (long)i * G + c; if (L >= nwg) return false;
        int wgid = (int)L; { const int q = nwg / NXCD, r = nwg % NXCD, xcd = wgid % NXCD, off = wgid / NXCD; wgid = (xcd < r ? xcd * (q + 1) : r * (q + 1) + (xcd - r) * q) + off; }
        const int nig = WGM * nN, gid = wgid / nig, fm = gid * WGM, gsz = (nM - fm) < WGM ? (nM - fm) : WGM;
        u.pm = fm + ((wgid % nig) % gsz); u.pn = (wgid % nig) / gsz; u.ka = u.pm; u.kb = u.pn; u.sub = 0; return true;
    }
};
struct BranchOrder {
    StaticOrder base; int npanel;
    __device__ bool next(int i, Unit& u) const {
        const int t = i / 3, s = i - 3 * t; if (!base.next(t, u)) return false;
        u.sub = s; u.ka = s * npanel + u.pm; u.kb = s * 8 + u.pn; return true;
    }
};

struct EpiIn {
    static constexpr bool PERM = true;
    bf16_t* P; bf16_t* G; const float* rs;
    __device__ __forceinline__ bool operator()(f32x4 (&acc)[2][2][4][2], const Unit& u, int wr, int wc, int fr_, int fq) const {
        int fr = fr_; asm volatile("" : "+v"(fr));
        const int row0 = u.pm * BM + wr * 64 + fr; const bool gate = u.pn >= 20;
        bf16_t* base = gate ? G : P; const int ldc = gate ? GWD : PWD; const int col0 = (gate ? u.pn - 20 : u.pn) * BM + wc * 32 + 8 * fq;
#pragma unroll
        for (int ai = 0; ai < 2; ++ai)
#pragma unroll
            for (int m = 0; m < 4; ++m) { bf16_t* rowp = base + (size_t)(row0 + ai * HALF + m * 16) * ldc + col0; const float rsv = rs[row0 + ai * HALF + m * 16];
#pragma unroll
                for (int bj = 0; bj < 2; ++bj) { f32x4 v0 = acc[ai][bj][m][0] * rsv, v1 = acc[ai][bj][m][1] * rsv;
                    if (gate) {
#pragma unroll
                        for (int j = 0; j < 4; ++j) { v0[j] = fast_sigmoid(v0[j]); v1[j] = fast_sigmoid(v1[j]); } }
                    u32x4 w; w.x = cvt_pk_bf16(v0[0], v0[1]); w.y = cvt_pk_bf16(v0[2], v0[3]); w.z = cvt_pk_bf16(v1[0], v1[1]); w.w = cvt_pk_bf16(v1[2], v1[3]);
                    *(u32x4*)(rowp + bj * HALF) = w; } }
        return true;
    }
};
struct EpiBr {
    static constexpr bool PERM = true;
    const bf16_t* G; bf16_t* OUT;
    __device__ __forceinline__ bool operator()(f32x4 (&acc)[2][2][4][2], const Unit& u, int wr, int wc, int fr_, int fq) const {
        int fr = fr_; asm volatile("" : "+v"(fr));
        const int row0 = u.pm * BM + wr * 64 + fr, col0 = u.pn * BM + wc * 32 + 8 * fq; const int sub = u.sub;
#pragma unroll
        for (int ai = 0; ai < 2; ++ai)
#pragma unroll
            for (int m = 0; m < 4; ++m) { const size_t row = (size_t)(row0 + ai * HALF + m * 16);
#pragma unroll
                for (int bj = 0; bj < 2; ++bj) {
                    const u32x4 gw = *(const u32x4*)(G + row * GWD + sub * DM + col0 + bj * HALF);
                    f32x4 s0 = {fmaxf(bf_lo(gw.x), 1e-30f), fmaxf(bf_hi(gw.x), 1e-30f), fmaxf(bf_lo(gw.y), 1e-30f), fmaxf(bf_hi(gw.y), 1e-30f)};
                    f32x4 s1 = {fmaxf(bf_lo(gw.z), 1e-30f), fmaxf(bf_hi(gw.z), 1e-30f), fmaxf(bf_lo(gw.w), 1e-30f), fmaxf(bf_hi(gw.w), 1e-30f)};
                    if (sub < 2) {
                        const u32x4 gn = *(const u32x4*)(G + row * GWD + (sub + 1) * DM + col0 + bj * HALF);
                        s0 *= (f32x4){__builtin_amdgcn_rcpf(fmaxf(bf_lo(gn.x), 1e-30f)), __builtin_amdgcn_rcpf(fmaxf(bf_hi(gn.x), 1e-30f)), __builtin_amdgcn_rcpf(fmaxf(bf_lo(gn.y), 1e-30f)), __builtin_amdgcn_rcpf(fmaxf(bf_hi(gn.y), 1e-30f))};
                        s1 *= (f32x4){__builtin_amdgcn_rcpf(fmaxf(bf_lo(gn.z), 1e-30f)), __builtin_amdgcn_rcpf(fmaxf(bf_hi(gn.z), 1e-30f)), __builtin_amdgcn_rcpf(fmaxf(bf_lo(gn.w), 1e-30f)), __builtin_amdgcn_rcpf(fmaxf(bf_hi(gn.w), 1e-30f))};
                        acc[ai][bj][m][0] *= s0; acc[ai][bj][m][1] *= s1;
                    } else {
                        const f32x4 v0 = acc[ai][bj][m][0] * s0, v1 = acc[ai][bj][m][1] * s1;
                        u32x4 w; w.x = cvt_pk_bf16(v0[0], v0[1]); w.y = cvt_pk_bf16(v0[2], v0[3]); w.z = cvt_pk_bf16(v1[0], v1[1]); w.w = cvt_pk_bf16(v1[2], v1[3]);
                        *(u32x4*)(OUT + row * DM + col0 + bj * HALF) = w; } }
                asm volatile("" ::: "memory"); }
        return sub == 2;
    }
};
struct EpiBf16 {
    static constexpr bool PERM = true;
    bf16_t* O; int ldc;
    __device__ __forceinline__ bool operator()(f32x4 (&acc)[2][2][4][2], const Unit& u, int wr, int wc, int fr_, int fq) const {
        int fr = fr_; asm volatile("" : "+v"(fr));
        const int row0 = u.pm * BM + wr * 64 + fr, col0 = u.pn * BM + wc * 32 + 8 * fq;
#pragma unroll
        for (int ai = 0; ai < 2; ++ai)
#pragma unroll
            for (int m = 0; m < 4; ++m) { bf16_t* rowp = O + (size_t)(row0 + ai * HALF + m * 16) * ldc + col0;
#pragma unroll
                for (int bj = 0; bj < 2; ++bj) { const f32x4 v0 = acc[ai][bj][m][0], v1 = acc[ai][bj][m][1];
                    u32x4 w; w.x = cvt_pk_bf16(v0[0], v0[1]); w.y = cvt_pk_bf16(v0[2], v0[3]); w.z = cvt_pk_bf16(v1[0], v1[1]); w.w = cvt_pk_bf16(v1[2], v1[3]);
                    *(u32x4*)(rowp + bj * HALF) = w; } }
        return true;
    }
};
struct EpiRelu2 {
    static constexpr bool PERM = true;
    bf16_t* O; int ldc; const float* rs;
    __device__ __forceinline__ bool operator()(f32x4 (&acc)[2][2][4][2], const Unit& u, int wr, int wc, int fr_, int fq) const {
        int fr = fr_; asm volatile("" : "+v"(fr));
        const int row0 = u.pm * BM + wr * 64 + fr, col0 = u.pn * BM + wc * 32 + 8 * fq;
#pragma unroll
        for (int ai = 0; ai < 2; ++ai)
#pragma unroll
            for (int m = 0; m < 4; ++m) { bf16_t* rowp = O + (size_t)(row0 + ai * HALF + m * 16) * ldc + col0; const float rsv = rs[row0 + ai * HALF + m * 16];
#pragma unroll
                for (int bj = 0; bj < 2; ++bj) { f32x4 v0 = acc[ai][bj][m][0], v1 = acc[ai][bj][m][1];
#pragma unroll
                    for (int j = 0; j < 4; ++j) { const float a = fmaxf(v0[j] * rsv, 0.f), b = fmaxf(v1[j] * rsv, 0.f); v0[j] = a * a; v1[j] = b * b; }
                    u32x4 w; w.x = cvt_pk_bf16(v0[0], v0[1]); w.y = cvt_pk_bf16(v0[2], v0[3]); w.z = cvt_pk_bf16(v1[0], v1[1]); w.w = cvt_pk_bf16(v1[2], v1[3]);
                    *(u32x4*)(rowp + bj * HALF) = w; } }
        return true;
    }
};

template <class Epi, class Sched, bool ALIGN_EPI = true>
__device__ __forceinline__ void gemm_phase(LAS unsigned char* lds, const Gemm g, const Sched& S, const Epi& E) {
    int tid_ = threadIdx.x; asm volatile("" : "+v"(tid_));
    const int tid = tid_, wid = __builtin_amdgcn_readfirstlane(tid >> 6), lane = tid & 63, wr = wid >> 2, wc = wid & 3, fr = lane & 15, fq = lane >> 4;
    const int K = g.K, nt = K / BK;
    unsigned voffA[2], voffB[2];
#pragma unroll
    for (int i = 0; i < 2; ++i) { int R, C; stage_rc(tid * 16 + i * 8192, R, C); const int Rb = Epi::PERM ? ((R & ~31) + perm32(R & 31)) : R;
        voffA[i] = (unsigned)(R * K + C) * 2u; voffB[i] = (unsigned)(Rb * K + C) * 2u; }
    const size_t kstep = (size_t)(BK * 2);
    const size_t hstep = (size_t)HALF * K * 2;
    const size_t tstep = 2 * hstep;
    const unsigned ldsw = (unsigned)wid * 1024u;
    const int aoff = lds_byte(wr * 64 + fr, fq * 8), boff = lds_byte(wc * 32 + fr, fq * 8);
#define PG8_SA(b, h) (((b) * 2 + (h)) * HTB)
#define PG8_SB(b, h) ((4 + (b) * 2 + (h)) * HTB)
#define PG8_STAGE(bufoff, gbase, voff) do { _Pragma("unroll") for (int _i = 0; _i < 2; ++_i) \
        __builtin_amdgcn_global_load_lds((const unsigned*)((const char*)(gbase) + (voff)[_i]), (LAS unsigned*)(lds + (bufoff) + ldsw + _i * 8192), 16, 0, 0); } while (0)
#define PG8_LDA(dst, b, h) do { _Pragma("unroll") for (int m = 0; m < 4; ++m) _Pragma("unroll") for (int k = 0; k < 2; ++k) dst[m][k] = *(const LAS bf16x8*)(lds + PG8_SA(b, h) + aoff + m * 2048 + k * 1024); } while (0)
#define PG8_LDB(dst, b, h) do { _Pragma("unroll") for (int n = 0; n < 2; ++n) _Pragma("unroll") for (int k = 0; k < 2; ++k) dst[n][k] = *(const LAS bf16x8*)(lds + PG8_SB(b, h) + boff + n * 2048 + k * 1024); } while (0)
#define PG8_MMA(ai, bj, At, Bt) do { __builtin_amdgcn_s_setprio(1); _Pragma("unroll") for (int m = 0; m < 4; ++m) _Pragma("unroll") for (int n = 0; n < 2; ++n) _Pragma("unroll") for (int k = 0; k < 2; ++k) \
        acc[ai][bj][m][n] = __builtin_amdgcn_mfma_f32_16x16x32_bf16(Bt[n][k], At[m][k], acc[ai][bj][m][n], 0, 0, 0); __builtin_amdgcn_s_setprio(0); } while (0)
#define PG8_WAIT_V(n) asm volatile("s_waitcnt vmcnt(" #n ")" ::: "memory")
#define PG8_WAIT_L(n) asm volatile("s_waitcnt lgkmcnt(" #n ")" ::: "memory")
#define PG8_BAR __builtin_amdgcn_s_barrier()
#define PG8_SCHED __builtin_amdgcn_sched_barrier(0)
    Unit cur, nxt; int ui = 0;
    if (!S.next(0, cur)) return;
    f32x4 acc[2][2][4][2];
#pragma unroll
    for (int a = 0; a < 2; ++a)
#pragma unroll
        for (int b = 0; b < 2; ++b)
#pragma unroll
            for (int m = 0; m < 4; ++m)
#pragma unroll
                for (int n = 0; n < 2; ++n) acc[a][b][m][n] = (f32x4){0.f, 0.f, 0.f, 0.f};
    bf16x8 At[4][2], B0[2][2], B1[2][2];
    const char* cA = (const char*)g.A + (size_t)cur.ka * tstep; const char* cB = (const char*)g.Bt + (size_t)cur.kb * tstep;
    PG8_STAGE(PG8_SB(0, 0), cB, voffB); PG8_STAGE(PG8_SB(0, 1), cB + hstep, voffB); PG8_STAGE(PG8_SA(0, 0), cA, voffA); PG8_STAGE(PG8_SA(0, 1), cA + hstep, voffA);
    if (wr == 1) PG8_BAR;
    PG8_WAIT_V(2); PG8_BAR;
    PG8_STAGE(PG8_SB(1, 0), cB + kstep, voffB); PG8_STAGE(PG8_SA(1, 0), cA + kstep, voffA); PG8_STAGE(PG8_SB(1, 1), cB + hstep + kstep, voffB);
    PG8_WAIT_V(6); PG8_BAR;
    for (;;) {
        const bool has_next = S.next(ui + 1, nxt);
        const char* nA = has_next ? (const char*)g.A + (size_t)nxt.ka * tstep : cA; const char* nB = has_next ? (const char*)g.Bt + (size_t)nxt.kb * tstep : cB;
        for (int t = 0; t < nt; t += 2) {
            const bool last = (t == nt - 2);
            const char* a1 = cA + (size_t)(t + 1) * kstep;
            const char* a2 = last ? nA : cA + (size_t)(t + 2) * kstep; const char* b2 = last ? nB : cB + (size_t)(t + 2) * kstep;
            const char* a3 = a2 + kstep; const char* b3 = b2 + kstep;
            PG8_LDB(B0, 0, 0); PG8_LDB(B1, 0, 1); PG8_SCHED; PG8_LDA(At, 0, 0); PG8_STAGE(PG8_SA(1, 1), a1 + hstep, voffA);
            PG8_WAIT_V(8); PG8_WAIT_L(0); PG8_BAR; PG8_MMA(0, 0, At, B0); PG8_MMA(0, 1, At, B1); PG8_BAR; PG8_SCHED;
            PG8_LDA(At, 0, 1); PG8_STAGE(PG8_SB(0, 0), b2, voffB); PG8_STAGE(PG8_SB(0, 1), b2 + hstep, voffB); PG8_STAGE(PG8_SA(0, 0), a2, voffA);
            PG8_WAIT_V(8); PG8_WAIT_L(0); PG8_BAR; PG8_MMA(1, 0, At, B0); PG8_MMA(1, 1, At, B1); PG8_BAR; PG8_SCHED;
            PG8_LDB(B0, 1, 0); PG8_LDB(B1, 1, 1); PG8_SCHED; PG8_LDA(At, 1, 0); PG8_STAGE(PG8_SA(0, 1), a2 + hstep, voffA);
            PG8_WAIT_V(8); PG8_WAIT_L(0); PG8_BAR; PG8_MMA(0, 0, At, B0); PG8_MMA(0, 1, At, B1); PG8_BAR; PG8_SCHED;
            PG8_LDA(At, 1, 1); PG8_STAGE(PG8_SB(1, 0), b3, voffB); PG8_STAGE(PG8_SB(1, 1), b3 + hstep, voffB); PG8_STAGE(PG8_SA(1, 0), a3, voffA);
            PG8_WAIT_V(8); PG8_WAIT_L(0); PG8_BAR; PG8_MMA(1, 0, At, B0); PG8_MMA(1, 1, At, B1); PG8_BAR; PG8_SCHED;
        }
        if constexpr (ALIGN_EPI) { if (wr == 0) PG8_BAR; }
        const bool reset = E(acc, cur, wr, wc, fr, fq);
        if (!has_next) break;
        if (reset) {
#pragma unroll
        for (int a = 0; a < 2; ++a)
#pragma unroll
            for (int b = 0; b < 2; ++b)
#pragma unroll
                for (int m = 0; m < 4; ++m)
#pragma unroll
                    for (int n = 0; n < 2; ++n) acc[a][b][m][n] = (f32x4){0.f, 0.f, 0.f, 0.f};
        }
        cur = nxt; cA = nA; cB = nB; ++ui;
        if constexpr (ALIGN_EPI) { if (wr == 1) PG8_BAR; }
    }
    PG8_WAIT_V(0);
    if constexpr (!ALIGN_EPI) { if (wr == 0) PG8_BAR; }
    PG8_BAR;
#undef PG8_SA
#undef PG8_SB
#undef PG8_STAGE
#undef PG8_LDA
#undef PG8_LDB
#undef PG8_MMA
#undef PG8_WAIT_V
#undef PG8_WAIT_L
#undef PG8_BAR
#undef PG8_SCHED
}
}

namespace att {
constexpr int D = 128, NW = 8, QBLK = 32, KVBLK = 64;
constexpr float SCALE = 0.088388347648318440f;
constexpr float THR = 8.f;
constexpr int LDQ = PWD, LDK = PWD, LDO = MWD;
constexpr int SHM_V = KVBLK * D * 2, SHM_K = KVBLK * D * 2;
constexpr int OST_PITCH = 272;
constexpr int OST_OFF = 2 * SHM_V + 2 * SHM_K + NW * 64 * 4;
constexpr int ATT_LDS = OST_OFF + NW * 32 * OST_PITCH;
#define KSWZ(row, colB) ((row) * 256 + ((colB) ^ (((row) & 7) << 4)))
#define SBAR() __builtin_amdgcn_sched_barrier(0)
__device__ __forceinline__ int crow(int r, int hi) { return (r & 3) + 8 * (r >> 2) + 4 * hi; }

template <bool MASKED>
__device__ __forceinline__ void partialSM(f32x16& p0, f32x16& p1, float& m_reg, float& mn, float& alpha, int mbase) {
  constexpr float C = SCALE * 1.4426950408889634f;
  if constexpr (MASKED) {
    const float ninf = -__builtin_inff();
#pragma unroll
    for (int r = 0; r < 16; ++r) { const int c = (r & 3) + 8 * (r >> 2);
      p0[r] = ((unsigned)(mbase - c) <= 256u) ? p0[r] : ninf;
      p1[r] = ((unsigned)(mbase - c - 32) <= 256u) ? p1[r] : ninf; }
  }
  float pmax = p0[0];
#pragma unroll
  for (int r = 1; r < 16; ++r) pmax = fmaxf(pmax, p0[r]);
#pragma unroll
  for (int r = 0; r < 16; ++r) pmax = fmaxf(pmax, p1[r]);
  { auto rr = __builtin_amdgcn_permlane32_swap(__float_as_uint(pmax), __float_as_uint(pmax), false, false);
    pmax = fmaxf(__uint_as_float(rr[0]), __uint_as_float(rr[1])); }
  if (__builtin_expect(__all(pmax - m_reg <= THR / SCALE), 1)) { mn = m_reg; alpha = 1.f; }
  else { mn = fmaxf(m_reg, pmax); alpha = __builtin_amdgcn_exp2f((m_reg - mn) * C); m_reg = mn; }
  float mnC = -mn * C;
#pragma unroll
  for (int r = 0; r < 16; ++r) p0[r] = fmaf(p0[r], C, mnC);
#pragma unroll
  for (int r = 0; r < 16; ++r) p1[r] = fmaf(p1[r], C, mnC);
#pragma unroll
  for (int r = 0; r < 16; ++r) p0[r] = __builtin_amdgcn_exp2f(p0[r]);
}
__device__ __forceinline__ void finishSM(f32x16& p0, f32x16& p1, float alpha, float& l_reg, bf16x8& pa0, bf16x8& pa1, bf16x8& pa2, bf16x8& pa3) {
#pragma unroll
  for (int r = 0; r < 16; ++r) p1[r] = __builtin_amdgcn_exp2f(p1[r]);
  float ps = 0;
#pragma unroll
  for (int r = 0; r < 16; ++r) ps += p0[r];
#pragma unroll
  for (int r = 0; r < 16; ++r) ps += p1[r];
  { auto rr = __builtin_amdgcn_permlane32_swap(__float_as_uint(ps), __float_as_uint(ps), false, false);
    ps = __uint_as_float(rr[0]) + __uint_as_float(rr[1]); }
  l_reg = l_reg * alpha + ps;
#define PK4(P, BASE, OUT) do { unsigned a0 = cvt_pk_bf16(P[BASE + 0], P[BASE + 1]), a1 = cvt_pk_bf16(P[BASE + 2], P[BASE + 3]);   \
    unsigned b0 = cvt_pk_bf16(P[BASE + 4], P[BASE + 5]), b1 = cvt_pk_bf16(P[BASE + 6], P[BASE + 7]);                              \
    auto r0 = __builtin_amdgcn_permlane32_swap(a0, b0, false, false); auto r1 = __builtin_amdgcn_permlane32_swap(a1, b1, false, false); \
    u32x4 w = {r0[0], r1[0], r0[1], r1[1]}; OUT = *reinterpret_cast<bf16x8*>(&w); } while (0)
  PK4(p0, 0, pa0); PK4(p0, 8, pa1); PK4(p1, 0, pa2); PK4(p1, 8, pa3);
#undef PK4
}
__device__ __forceinline__ void qkt(f32x16& p0, f32x16& p1, const bf16* Ks, const bf16x8* qr, int r32, int hi) {
  p0 = f32x16{}; p1 = f32x16{};
#pragma unroll
  for (int d0 = 0; d0 < 8; ++d0) { int cb = (d0 * 16 + hi * 8) * 2;
    bf16x8 b0 = *reinterpret_cast<const bf16x8*>((const char*)Ks + KSWZ(r32, cb));
    bf16x8 b1 = *reinterpret_cast<const bf16x8*>((const char*)Ks + KSWZ(32 + r32, cb));
    p0 = __builtin_amdgcn_mfma_f32_32x32x16_bf16(b0, qr[d0], p0, 0, 0, 0);
    p1 = __builtin_amdgcn_mfma_f32_32x32x16_bf16(b1, qr[d0], p1, 0, 0, 0); }
}
__device__ __forceinline__ int v_st(int k, int c) { const int kk = (k & ~0xC) | ((k & 4) << 1) | ((k & 8) >> 1); return ((kk >> 3) * 4 + (c >> 5)) * 512 + ((kk & 7) * 32 + (c & 31)) * 2; }
__device__ __forceinline__ int v_rd_base(int lane) { return ((lane & 3) << 3) | (((lane >> 2) & 3) << 6) | (((lane >> 4) & 1) << 5) | (((lane >> 5) & 1) << 8); }
constexpr int v_rd_off(int d0, int ks, int half) { return d0 * 512 + ks * 4096 + half * 2048; }
template <int OFF> __device__ __forceinline__ s16x4 tr_read(int vb) {
  s16x4 r; asm volatile("ds_read_b64_tr_b16 %0, %1 offset:%2" : "=&v"(r) : "v"(vb), "i"(OFF) : "memory"); return r;
}
template <int D0> __device__ __forceinline__ void pv_one(f32x16& od, int vb, bf16x8 pa0, bf16x8 pa1, bf16x8 pa2, bf16x8 pa3) {
  const s16x4 l0 = tr_read<v_rd_off(D0, 0, 0)>(vb), h0 = tr_read<v_rd_off(D0, 0, 1)>(vb), l1 = tr_read<v_rd_off(D0, 1, 0)>(vb), h1 = tr_read<v_rd_off(D0, 1, 1)>(vb);
  const s16x4 l2 = tr_read<v_rd_off(D0, 2, 0)>(vb), h2 = tr_read<v_rd_off(D0, 2, 1)>(vb), l3 = tr_read<v_rd_off(D0, 3, 0)>(vb), h3 = tr_read<v_rd_off(D0, 3, 1)>(vb);
  asm volatile("s_waitcnt lgkmcnt(0)" ::: "memory"); SBAR();
#define PK(L, H) (bf16x8){L[0], L[1], L[2], L[3], H[0], H[1], H[2], H[3]}
  od = __builtin_amdgcn_mfma_f32_32x32x16_bf16(pa0, PK(l0, h0), od, 0, 0, 0);
  od = __builtin_amdgcn_mfma_f32_32x32x16_bf16(pa1, PK(l1, h1), od, 0, 0, 0);
  od = __builtin_amdgcn_mfma_f32_32x32x16_bf16(pa2, PK(l2, h2), od, 0, 0, 0);
  od = __builtin_amdgcn_mfma_f32_32x32x16_bf16(pa3, PK(l3, h3), od, 0, 0, 0);
#undef PK
}
__device__ __forceinline__ void pv_d0(f32x16* o, int vb, bf16x8 pa0, bf16x8 pa1, bf16x8 pa2, bf16x8 pa3) {
  pv_one<0>(o[0], vb, pa0, pa1, pa2, pa3); pv_one<1>(o[1], vb, pa0, pa1, pa2, pa3); pv_one<2>(o[2], vb, pa0, pa1, pa2, pa3); pv_one<3>(o[3], vb, pa0, pa1, pa2, pa3);
}

template <int MODE, int SD>
__device__ __forceinline__ void attn_unit(const bf16* __restrict__ Qb, const bf16* __restrict__ Kh, const bf16* __restrict__ Vh, bf16* __restrict__ Ob, int NT, int dq0, float sink, char* lds,
                                          const f32x2* __restrict__ tab  , const float* __restrict__ gq  ) {
  int tid_ = threadIdx.x; asm volatile("" : "+v"(tid_));
  const int tid = tid_, wid = tid >> 6, lane = tid & 63, r32 = lane & 31, hi = lane >> 5;
  bf16* V_lds = (bf16*)lds; bf16* K_lds = (bf16*)(lds + 2 * SHM_V);
  float* ws = (float*)(lds + 2 * SHM_V + 2 * SHM_K) + wid * 64; float* li_l = ws; float* al_l = ws + 32;
  float m_reg = MODE ? sink * (1.0f / SCALE) : -1e30f, l_reg = MODE ? 1.0f : 0.0f; f32x16 o[4] = {}; bf16x8 qr[8];
  const bf16* Qw = Qb + (long)(wid * QBLK + r32) * LDQ + hi * 8;
#pragma unroll
  for (int d0 = 0; d0 < 8; ++d0) qr[d0] = *reinterpret_cast<const bf16x8*>(Qw + d0 * 16);
  {
    float rstd = 1.f;
    if constexpr (MODE == 0) {
      float ss = 0.f;
#pragma unroll
      for (int d0 = 0; d0 < 8; ++d0) { const u32x4 w = *reinterpret_cast<const u32x4*>(&qr[d0]);
        const float a0 = bf_lo(w.x), a1 = bf_hi(w.x), a2 = bf_lo(w.y), a3 = bf_hi(w.y), a4 = bf_lo(w.z), a5 = bf_hi(w.z), a6 = bf_lo(w.w), a7 = bf_hi(w.w);
        ss += (a0 * a0 + a1 * a1) + (a2 * a2 + a3 * a3) + (a4 * a4 + a5 * a5) + (a6 * a6 + a7 * a7); }
      { auto rr = __builtin_amdgcn_permlane32_swap(__float_as_uint(ss), __float_as_uint(ss), false, false); ss = __uint_as_float(rr[0]) + __uint_as_float(rr[1]); }
      rstd = 1.0f / sqrtf(ss * (1.0f / D) + EPS);
    }
    const f32x4* tp = (const f32x4*)(tab + (wid * QBLK + r32) * 64 + hi * 8);
#pragma unroll
    for (int d0 = 0; d0 < 4; ++d0) {
      const u32x4 w1 = *reinterpret_cast<const u32x4*>(&qr[d0]), w2 = *reinterpret_cast<const u32x4*>(&qr[d0 + 4]);
      float x1[8] = {bf_lo(w1.x), bf_hi(w1.x), bf_lo(w1.y), bf_hi(w1.y), bf_lo(w1.z), bf_hi(w1.z), bf_lo(w1.w), bf_hi(w1.w)};
      float x2[8] = {bf_lo(w2.x), bf_hi(w2.x), bf_lo(w2.y), bf_hi(w2.y), bf_lo(w2.z), bf_hi(w2.z), bf_lo(w2.w), bf_hi(w2.w)};
      if constexpr (MODE == 0) {
        const f32x4 g1a = *(const f32x4*)(gq + d0 * 16 + hi * 8), g1b = *(const f32x4*)(gq + d0 * 16 + hi * 8 + 4), g2a = *(const f32x4*)(gq + 64 + d0 * 16 + hi * 8), g2b = *(const f32x4*)(gq + 64 + d0 * 16 + hi * 8 + 4);
        const float g1[8] = {g1a.x, g1a.y, g1a.z, g1a.w, g1b.x, g1b.y, g1b.z, g1b.w}, g2[8] = {g2a.x, g2a.y, g2a.z, g2a.w, g2b.x, g2b.y, g2b.z, g2b.w};
#pragma unroll
        for (int e = 0; e < 8; ++e) { x1[e] = x1[e] * rstd * g1[e]; x2[e] = x2[e] * rstd * g2[e]; }
      }
      float o1[8], o2[8];
#pragma unroll
      for (int e2 = 0; e2 < 4; ++e2) { const f32x4 cs = tp[d0 * 8 + e2];
        o1[2 * e2] = x1[2 * e2] * cs.x - x2[2 * e2] * cs.y; o2[2 * e2] = x2[2 * e2] * cs.x + x1[2 * e2] * cs.y;
        o1[2 * e2 + 1] = x1[2 * e2 + 1] * cs.z - x2[2 * e2 + 1] * cs.w; o2[2 * e2 + 1] = x2[2 * e2 + 1] * cs.z + x1[2 * e2 + 1] * cs.w; }
      u32x4 p1, p2; p1.x = cvt_pk_bf16(o1[0], o1[1]); p1.y = cvt_pk_bf16(o1[2], o1[3]); p1.z = cvt_pk_bf16(o1[4], o1[5]); p1.w = cvt_pk_bf16(o1[6], o1[7]);
      p2.x = cvt_pk_bf16(o2[0], o2[1]); p2.y = cvt_pk_bf16(o2[2], o2[3]); p2.z = cvt_pk_bf16(o2[4], o2[5]); p2.w = cvt_pk_bf16(o2[6], o2[7]);
      qr[d0] = *reinterpret_cast<bf16x8*>(&p1); qr[d0 + 4] = *reinterpret_cast<bf16x8*>(&p2);
    }
  }
  const int sr = tid >> 4, sc = (tid & 15) * 8, vst0 = v_st(sr, sc), vst1 = v_st(32 + sr, sc);
  const int vb0 = (int)(uintptr_t)V_lds + v_rd_base(lane);
  const int mb0 = dq0 + wid * QBLK + r32 + 128 - 4 * hi;
  struct { bf16x8 vs0, vs1, ks0, ks1; } sr_[SD];
#define SLOAD(i, k0) do { sr_[i].vs0 = *reinterpret_cast<const bf16x8*>(&Vh[(long)((k0) + sr) * LDK + sc]); sr_[i].vs1 = *reinterpret_cast<const bf16x8*>(&Vh[(long)((k0) + 32 + sr) * LDK + sc]); \
    sr_[i].ks0 = *reinterpret_cast<const bf16x8*>(&Kh[(long)((k0) + sr) * LDK + sc]); sr_[i].ks1 = *reinterpret_cast<const bf16x8*>(&Kh[(long)((k0) + 32 + sr) * LDK + sc]); } while (0)
#define SWRITE(b, i) do { *(bf16x8*)((char*)V_lds + (b) * SHM_V + vst0) = sr_[i].vs0;          \
    *(bf16x8*)((char*)V_lds + (b) * SHM_V + vst1) = sr_[i].vs1; int kc = sc * 2;               \
    *(bf16x8*)((char*)K_lds + (b) * SHM_K + KSWZ(sr, kc)) = sr_[i].ks0;                       \
    *(bf16x8*)((char*)K_lds + (b) * SHM_K + KSWZ(32 + sr, kc)) = sr_[i].ks1; } while (0)
#define SWAIT() do { if constexpr (SD == 2) asm volatile("s_waitcnt vmcnt(4)" ::: "memory"); else asm volatile("s_waitcnt vmcnt(0)" ::: "memory"); } while (0)
#define RESC(a) do { if (__any((a) < 1.f)) { if (hi == 0) al_l[r32] = (a); asm volatile("s_waitcnt lgkmcnt(0)" ::: "memory"); \
    _Pragma("unroll") for (int d = 0; d < 4; ++d) _Pragma("unroll") for (int r = 0; r < 16; ++r) o[d][r] *= al_l[crow(r, hi)]; } } while (0)
#define PSM(P0, P1, MN, AL, J) partialSM<MODE != 0>(P0, P1, m_reg, MN, AL, mb0 - 64 * (J))
  f32x16 pA0, pA1, pB0, pB1; float mnA, mnB, alA, alB; bf16x8 pa0, pa1, pa2, pa3;
  constexpr int SE = 0, SO = SD - 1;
  SLOAD(SE, 0); asm volatile("s_waitcnt vmcnt(0)" ::: "memory"); SWRITE(0, SE); __syncthreads();
  qkt(pA0, pA1, K_lds, qr, r32, hi); PSM(pA0, pA1, mnA, alA, 0);
  SLOAD(SO, KVBLK); if constexpr (SD == 2) { if (2 < NT) SLOAD(SE, 2 * KVBLK); }
  SWAIT(); SWRITE(1, SO); __syncthreads();
  for (int j = 1; j + 1 < NT; j += 2) {
    SBAR(); qkt(pB0, pB1, (bf16*)((char*)K_lds + SHM_K), qr, r32, hi);
    finishSM(pA0, pA1, alA, l_reg, pa0, pa1, pa2, pa3); SBAR();
    SLOAD(SO, (j + SD) * KVBLK); SBAR();
    pv_d0(o, vb0, pa0, pa1, pa2, pa3); PSM(pB0, pB1, mnB, alB, j);
    __syncthreads(); SWAIT(); SWRITE(0, SE);
    RESC(alB); __syncthreads();
    SBAR(); qkt(pA0, pA1, K_lds, qr, r32, hi);
    finishSM(pB0, pB1, alB, l_reg, pa0, pa1, pa2, pa3); SBAR();
    if (SD == 1 || j + 3 < NT) SLOAD(SE, (j + 1 + SD) * KVBLK); SBAR();
    pv_d0(o, vb0 + (int)SHM_V, pa0, pa1, pa2, pa3); PSM(pA0, pA1, mnA, alA, j + 1);
    __syncthreads(); SWAIT(); SWRITE(1, SO);
    RESC(alA); __syncthreads();
  }
  SBAR(); qkt(pB0, pB1, (bf16*)((char*)K_lds + SHM_K), qr, r32, hi);
  finishSM(pA0, pA1, alA, l_reg, pa0, pa1, pa2, pa3); SBAR();
  pv_d0(o, vb0, pa0, pa1, pa2, pa3); PSM(pB0, pB1, mnB, alB, NT - 1);
  __syncthreads(); RESC(alB);
  finishSM(pB0, pB1, alB, l_reg, pa0, pa1, pa2, pa3); SBAR();
  pv_d0(o, vb0 + (int)SHM_V, pa0, pa1, pa2, pa3);
  if (hi == 0) li_l[r32] = l_reg; asm volatile("s_waitcnt lgkmcnt(0)" ::: "memory");
  float rli[16];
#pragma unroll
  for (int r = 0; r < 16; ++r) rli[r] = __builtin_amdgcn_rcpf(li_l[crow(r, hi)]);
  char* ost = lds + OST_OFF + wid * (32 * OST_PITCH);
#pragma unroll
  for (int r = 0; r < 16; ++r) { const int orow = crow(r, hi);
#pragma unroll
    for (int d0 = 0; d0 < 4; ++d0) { const float v = o[d0][r] * rli[r]; *(bf16*)(ost + orow * OST_PITCH + (d0 * 32 + r32) * 2) = (bf16)(cvt_pk_bf16(v, v) & 0xffffu); } }
  asm volatile("s_waitcnt lgkmcnt(0)" ::: "memory");
  bf16* Ow = Ob + (long)(wid * QBLK) * LDO;
#pragma unroll
  for (int i = 0; i < 8; ++i) { const int row = (lane >> 4) + 4 * i, cc = (lane & 15);
    const u32x4 w = *(const u32x4*)(ost + row * OST_PITCH + cc * 16);
    *(u32x4*)(Ow + (long)row * LDO + cc * 8) = w; }
  __syncthreads();
#undef SLOAD
#undef SWRITE
#undef SWAIT
#undef RESC
#undef PSM
}
}

#define XB_TMO      128
#define XB_XCNT(j)  (256  + 64 * (j))
#define XB_XSUB(j)  (1280 + 64 * (j))
#define XB_XGEN(j)  (2304 + 64 * (j))
#define XB_TOP      3328
#define XB_TOPGEN   3392
#define XCD_BAR_WORDS 3456
#define XB_SPIN_CAP (1u << 20)
__device__ __forceinline__ unsigned xb_ld(unsigned* p)              { return __hip_atomic_load(p, __ATOMIC_RELAXED, __HIP_MEMORY_SCOPE_AGENT); }
__device__ __forceinline__ unsigned xb_add(unsigned* p, unsigned v) { return __hip_atomic_fetch_add(p, v, __ATOMIC_RELAXED, __HIP_MEMORY_SCOPE_AGENT); }
__device__ __forceinline__ unsigned xb_xcc_id() { return (unsigned)__builtin_amdgcn_s_getreg((3 << 11) | 20) & 0xFu; }
#define XB_SPIN(cond, bar) do { unsigned _sp = 0; while (cond) { __builtin_amdgcn_s_sleep(1); \
    if ((++_sp & 255u) == 0u) { if (xb_ld(&(bar)[XB_TMO])) break; if (_sp > XB_SPIN_CAP) { atomicAdd(&(bar)[XB_TMO], 1u); break; } } } } while (0)
struct XcdBarrier { unsigned* bar; unsigned x; volatile LAS unsigned* st; };
__device__ __forceinline__ XcdBarrier xcd_barrier_post(unsigned* bar, volatile LAS unsigned* st) {
    XcdBarrier b; b.bar = bar; b.x = xb_xcc_id(); b.st = st;
    if (threadIdx.x == 0) (void)xb_add(&bar[XB_XCNT(b.x)], 1u);
    return b;
}
__device__ __forceinline__ void xcd_barrier_complete(unsigned* bar, unsigned x, unsigned& nloc, unsigned& nx) {
    const unsigned G = gridDim.x * gridDim.y * gridDim.z;
    unsigned sum, cnt, mine, sp = 0u;
    for (;;) {
        sum = 0u; cnt = 0u; mine = 0u;
#pragma unroll
        for (unsigned j = 0; j < 16; ++j) { const unsigned c = xb_ld(&bar[XB_XCNT(j)]); sum += c; cnt += (c > 0u) ? 1u : 0u; mine = (j == x) ? c : mine; }
        if (sum == G) break;
        __builtin_amdgcn_s_sleep(1);
        if ((++sp & 255u) == 0u) { if (xb_ld(&bar[XB_TMO])) break; if (sp > XB_SPIN_CAP) { atomicAdd(&bar[XB_TMO], 1u); break; } }
    }
    nloc = mine > 0u ? mine : 1u; nx = cnt > 0u ? cnt : 1u;
}
__device__ __forceinline__ void xcd_barrier(const XcdBarrier& b) {
    asm volatile("s_waitcnt vmcnt(0)" ::: "memory");
    __syncthreads();
    if (threadIdx.x == 0) {
        unsigned* bar = b.bar;
        __builtin_amdgcn_s_waitcnt(0);
        unsigned nloc = b.st[0], nx = b.st[1];
        if (nloc == 0u) { xcd_barrier_complete(bar, b.x, nloc, nx); b.st[0] = nloc; b.st[1] = nx; }
        const unsigned old = xb_add(&bar[XB_XSUB(b.x)], 1u);
        const unsigned gen = old / nloc;
        if (old + 1u == (gen + 1u) * nloc) {
            __builtin_amdgcn_fence(__ATOMIC_RELEASE, "agent");
            asm volatile("s_waitcnt vmcnt(0)" ::: "memory");
            const unsigned og = xb_add(&bar[XB_TOP], 1u);
            const unsigned tg = og / nx;
            if (og + 1u == (tg + 1u) * nx) xb_add(&bar[XB_TOPGEN], 1u);
            else XB_SPIN(xb_ld(&bar[XB_TOPGEN]) == tg, bar);
            __builtin_amdgcn_fence(__ATOMIC_ACQUIRE, "agent");
            xb_add(&bar[XB_XGEN(b.x)], 1u);
            asm volatile("s_waitcnt vmcnt(0)" ::: "memory");
        } else {
            XB_SPIN(xb_ld(&bar[XB_XGEN(b.x)]) == gen, bar);
            __builtin_amdgcn_fence(__ATOMIC_ACQUIRE, "agent");
            asm volatile("s_waitcnt vmcnt(0)" ::: "memory");
        }
    }
    __syncthreads();
}

__device__ __forceinline__ void transpose_item(const float* W, int K, int N, bf16* WT, LAS float* scr, int item, int lane, const float* gk = nullptr) {
    const int nblk = N / 32, kb = item / nblk, nb = item % nblk, k0 = 64 * kb, n0 = 32 * nb;
#pragma unroll 8
    for (int i = 0; i < 32; ++i) { const int kk = 2 * i + (lane >> 5); scr[kk * 33 + (lane & 31)] = W[(size_t)(k0 + kk) * N + n0 + (lane & 31)] * (gk ? gk[k0 + kk] : 1.0f); }
    asm volatile("s_waitcnt lgkmcnt(0)" ::: "memory");
    const int c = lane & 7;
#pragma unroll
    for (int j = 0; j < 4; ++j) { const int n = (lane >> 3) + 8 * j; const LAS float* s = scr + (8 * c) * 33 + n;
        u32x4 o; o.x = cvt_pk_bf16(s[0 * 33], s[1 * 33]); o.y = cvt_pk_bf16(s[2 * 33], s[3 * 33]); o.z = cvt_pk_bf16(s[4 * 33], s[5 * 33]); o.w = cvt_pk_bf16(s[6 * 33], s[7 * 33]);
        *(u32x4*)(WT + (size_t)(n0 + n) * K + k0 + 8 * c) = o; }
    asm volatile("s_waitcnt lgkmcnt(0)" ::: "memory");
}

struct Args { const float* in[21]; float* out; unsigned char* ws; int lo, hi; };

__device__ __forceinline__ const float* x_in_row(const float* xp, const float* xs, int row) {
    return row < NPROMPT_TOK ? xp + (size_t)row * DM : xs + (size_t)(row - NPROMPT_TOK) * DM;
}

__device__ __forceinline__ void phase_weights(const CAS Args* a, unsigned char* ws, int l, LAS unsigned char* lds, int gw, int NGW, int wave, int lane) {
    LAS float* scr = (LAS float*)(lds + wave * 16384);
    constexpr int I_IN = (DM / 64) * (INW / 32), I_BR = (MWD / 64) * (DM / 32), I_OUT = (DM / 64) * (DM / 32), I_F1 = (DM / 64) * (FFD / 32), I_F2 = (FFD / 64) * (DM / 32), I_G = 32 * 8;
    constexpr int NITEMS = I_IN + 3 * I_BR + I_OUT + I_F1 + I_F2 + I_G;
    for (int it = gw; it < NITEMS; it += NGW) {
        int r = it;
        if (r < I_IN) { transpose_item(a->in[6] + (size_t)l * DM * INW, DM, INW, (bf16*)(ws + WS_WIN), scr, r, lane, a->in[2] + (size_t)l * DM); continue; } r -= I_IN;
        if (r < 3 * I_BR) { const int b = r / I_BR; transpose_item(a->in[17] + ((size_t)l * 3 + b) * MWD * DM, MWD, DM, (bf16*)(ws + WS_WBR) + (size_t)b * DM * MWD, scr, r - b * I_BR, lane); continue; } r -= 3 * I_BR;
        if (r < I_OUT) { transpose_item(a->in[18] + (size_t)l * DM * DM, DM, DM, (bf16*)(ws + WS_WOUT), scr, r, lane); continue; } r -= I_OUT;
        if (r < I_F1) { transpose_item(a->in[19] + (size_t)l * DM * FFD, DM, FFD, (bf16*)(ws + WS_W1), scr, r, lane, a->in[4] + (size_t)l * DM); continue; } r -= I_F1;
        if (r < I_F2) { transpose_item(a->in[20] + (size_t)l * FFD * DM, FFD, DM, (bf16*)(ws + WS_W2), scr, r, lane); continue; } r -= I_F2;
        { const int mi = r >> 3, sub = r & 7;
          const int gate = mi >> 4, dd = (mi >> 3) & 1, blk = mi & 7;
          const float* src = (gate ? a->in[14] : a->in[12]) + (((size_t)l * 2 + dd) * 8 + blk) * 16384;
          transpose_item(src, 128, 128, (bf16*)(ws + WS_WG) + ((size_t)(dd * 2 + gate) * 8 + blk) * 16384, scr, sub, lane); }
    }
}

__device__ __forceinline__ void entry_row(const float* xrow, bf16* xb, float* rs, int lane) {
    const f32x4* xr = (const f32x4*)xrow + lane;
    f32x4 v[8]; float s = 0.f;
#pragma unroll
    for (int j = 0; j < 8; ++j) { v[j] = xr[64 * j]; s += (v[j].x * v[j].x + v[j].y * v[j].y) + (v[j].z * v[j].z + v[j].w * v[j].w); }
    u32x2* o8 = (u32x2*)xb + lane;
#pragma unroll
    for (int j = 0; j < 8; ++j) { u32x2 w; w.x = cvt_pk_bf16(v[j].x, v[j].y); w.y = cvt_pk_bf16(v[j].z, v[j].w); o8[64 * j] = w; }
    const float tot = wave_sum(s, lane);
    if (lane == 0) *rs = __builtin_amdgcn_rsqf(tot * (1.0f / DM) + EPS);
}
template <bool LAST>
__device__ __forceinline__ void resid_norm_row(const bf16* yrow, bf16* xrow, const float* g, float* rs, float* outrow, int lane) {
    float y[32], x[32]; float s = 0.f;
#pragma unroll
    for (int j = 0; j < 4; ++j) { const u32x4 w = ((const u32x4*)yrow)[64 * j + lane];
        y[8 * j + 0] = bf_lo(w.x); y[8 * j + 1] = bf_hi(w.x); y[8 * j + 2] = bf_lo(w.y); y[8 * j + 3] = bf_hi(w.y); y[8 * j + 4] = bf_lo(w.z); y[8 * j + 5] = bf_hi(w.z); y[8 * j + 6] = bf_lo(w.w); y[8 * j + 7] = bf_hi(w.w); }
#pragma unroll
    for (int j = 0; j < 4; ++j) { const u32x4 w = ((const u32x4*)xrow)[64 * j + lane];
        x[8 * j + 0] = bf_lo(w.x); x[8 * j + 1] = bf_hi(w.x); x[8 * j + 2] = bf_lo(w.y); x[8 * j + 3] = bf_hi(w.y); x[8 * j + 4] = bf_lo(w.z); x[8 * j + 5] = bf_hi(w.z); x[8 * j + 6] = bf_lo(w.w); x[8 * j + 7] = bf_hi(w.w); }
#pragma unroll
    for (int i = 0; i < 32; ++i) s += y[i] * y[i];
    const float rstd = __builtin_amdgcn_rsqf(wave_sum(s, lane) * (1.0f / DM) + EPS);
    float s2 = 0.f;
#pragma unroll
    for (int j = 0; j < 4; ++j) { const f32x4 g0 = ((const f32x4*)g)[2 * (64 * j + lane)], g1 = ((const f32x4*)g)[2 * (64 * j + lane) + 1];
        const float gg[8] = {g0.x, g0.y, g0.z, g0.w, g1.x, g1.y, g1.z, g1.w};
#pragma unroll
        for (int e = 0; e < 8; ++e) { const float v = x[8 * j + e] + y[8 * j + e] * rstd * gg[e]; x[8 * j + e] = v; s2 += v * v; } }
    if constexpr (LAST) {
#pragma unroll
        for (int j = 0; j < 4; ++j) { ((f32x4*)outrow)[2 * (64 * j + lane)] = (f32x4){x[8 * j], x[8 * j + 1], x[8 * j + 2], x[8 * j + 3]}; ((f32x4*)outrow)[2 * (64 * j + lane) + 1] = (f32x4){x[8 * j + 4], x[8 * j + 5], x[8 * j + 6], x[8 * j + 7]}; }
    } else {
#pragma unroll
        for (int j = 0; j < 4; ++j) { u32x4 w; w.x = cvt_pk_bf16(x[8 * j], x[8 * j + 1]); w.y = cvt_pk_bf16(x[8 * j + 2], x[8 * j + 3]); w.z = cvt_pk_bf16(x[8 * j + 4], x[8 * j + 5]); w.w = cvt_pk_bf16(x[8 * j + 6], x[8 * j + 7]);
            ((u32x4*)xrow)[64 * j + lane] = w; }
        const float r2 = __builtin_amdgcn_rsqf(wave_sum(s2, lane) * (1.0f / DM) + EPS);
        if (lane == 0) *rs = r2;
    }
}

__device__ __forceinline__ void krope_token(bf16* prow, const f32x2* taba, const f32x2* tab1, const float* kn, int lane) {
    const f32x2 csa = taba[lane], cs1 = tab1[lane];
    const float kg1 = kn[lane], kg2 = kn[64 + lane];
#pragma unroll
    for (int h = 0; h < 2; ++h) {
        bf16* p = prow + KA_OFF + h * HD;
        const float x1 = bf2f(p[lane]), x2 = bf2f(p[64 + lane]);
        const float rstd = 1.0f / sqrtf(wave_sum(x1 * x1 + x2 * x2, lane) * (1.0f / HD) + EPS);
        const float y1 = x1 * rstd * kg1, y2 = x2 * rstd * kg2;
        const float o1 = y1 * csa.x - y2 * csa.y, o2 = y2 * csa.x + y1 * csa.y;
        p[lane] = (bf16)(cvt_pk_bf16(o1, o1) & 0xffffu); p[64 + lane] = (bf16)(cvt_pk_bf16(o2, o2) & 0xffffu);
    }
#pragma unroll
    for (int h = 0; h < 2; ++h) {
        bf16* p = prow + KB_OFF + h * HD;
        const float x1 = bf2f(p[lane]), x2 = bf2f(p[64 + lane]);
        const float o1 = x1 * cs1.x - x2 * cs1.y, o2 = x2 * cs1.x + x1 * cs1.y;
        p[lane] = (bf16)(cvt_pk_bf16(o1, o1) & 0xffffu); p[64 + lane] = (bf16)(cvt_pk_bf16(o2, o2) & 0xffffu);
    }
}
__device__ __forceinline__ void rope_tables(f32x2* tab1, f32x2* taba, int gtid, int nthr) {
    for (int i = gtid; i < SEQ * 64; i += nthr) {
        const int pos = i >> 6, j = i & 63;
        const double rev1 = (double)pos * ROPE_F1[j];
        const double reva = (double)(j < 32 ? (pos >> 6) : (pos & 63)) * ROPE_FA[j & 31];
        const float f1 = (float)(rev1 - __builtin_floor(rev1)), fa = (float)(reva - __builtin_floor(reva));
        tab1[i] = (f32x2){__builtin_amdgcn_cosf(f1), __builtin_amdgcn_sinf(f1)};
        taba[i] = (f32x2){__builtin_amdgcn_cosf(fa), __builtin_amdgcn_sinf(fa)};
    }
}

struct CParams { const float* conv_w; const float* conv_b; const float* gate_r_b; const float* gate_i_b; const float* lam; const bf16* WG; };
constexpr int CSPAN = 512, NSPAN = SEQ / CSPAN;
template <int PASS, int DIR>
__device__ __forceinline__ void c_sweep(LAS unsigned char* lds, const bf16* P, bf16* OC, const CParams& cp, f32x2* SUM, int seq, int nb, int sp) {
    constexpr int UP = 136;
    LAS bf16* U = (LAS bf16*)lds;
    LAS float* AD = (LAS float*)(lds + 32768);
    int tid_ = threadIdx.x; asm volatile("" : "+v"(tid_));
    const int tid = tid_, wave = tid >> 6, lane = tid & 63;
    const int t0 = tid >> 4, c8 = (tid & 15) * 8, cg8 = nb * 128 + c8;
    LAS float* CW = (LAS float*)(lds + 32768 + 65536);
    for (int i = tid; i < 5 * 128; i += 512) CW[i] = (i < 512) ? cp.conv_w[(i >> 7) * MWD + nb * 128 + (i & 127)] : cp.conv_b[nb * 128 + (i & 127)];
    const int q = wave & 3, th = wave >> 2, r = lane & 31, h = lane >> 5;
    bf16x8 bfr[8], bfi[8];
    { const bf16* wrp = cp.WG + ((size_t)((DIR * 2 + 0) * 8 + nb) * 128 + 32 * q + r) * 128 + 8 * h;
      const bf16* wip = cp.WG + ((size_t)((DIR * 2 + 1) * 8 + nb) * 128 + 32 * q + r) * 128 + 8 * h;
#pragma unroll
      for (int ks = 0; ks < 8; ++ks) { bfr[ks] = *(const bf16x8*)(wrp + 16 * ks); bfi[ks] = *(const bf16x8*)(wip + 16 * ks); } }
    const int ch = 32 * q + r, cg = nb * 128 + ch;
    constexpr float L2E = 1.4426950408889634f;
    const float rbn = -L2E * cp.gate_r_b[DIR * MWD + cg], ibn = -L2E * cp.gate_i_b[DIR * MWD + cg], lam = cp.lam[DIR * MWD + cg];
    const float el = __builtin_amdgcn_exp2f(-L2E * lam);
    const float ls8 = -8.0f * (lam > 3.0f ? el * (1.0f - el * (0.5f - el * (1.0f / 3.0f))) : 0.6931471805599453f * __builtin_amdgcn_logf(1.0f + el));
    const f32x2 ls8e = {ls8 * L2E, ls8 * L2E}, ls82 = {2.0f * ls8, 2.0f * ls8}, rbn2 = {rbn, rbn}, ibn2 = {ibn, ibn};
    float hh = 0.f, pp = 1.f;
    if constexpr (PASS == 3) {
        if (tid < 128) {
            const f32x2* sb = SUM + ((size_t)(seq * NSPAN) * 2 + DIR) * MWD + nb * 128 + tid;
            f32x2 sv[NSPAN];
#pragma unroll
            for (int s = 0; s < NSPAN; ++s) sv[s] = sb[(size_t)s * 2 * MWD];
#pragma unroll
            for (int s = 0; s < NSPAN; ++s) { const int ss = DIR ? NSPAN - 1 - s : s; const bool use = DIR ? (ss > sp) : (ss < sp); hh = use ? sv[ss].x * hh + sv[ss].y : hh; }
        }
    }
    const size_t rowbase = (size_t)seq * SEQ + (size_t)sp * CSPAN;
    const int posbase = sp * CSPAN;
    u32x4 xw[2][4];
#define C_LOADX(tile) do { _Pragma("unroll") for (int hf = 0; hf < 2; ++hf) _Pragma("unroll") for (int j = 0; j < 4; ++j) { const int tt = posbase + (tile) * 64 + t0 + 32 * hf - 2 + j; \
        const int ttc = tt < 0 ? 0 : (tt >= SEQ ? SEQ - 1 : tt); const u32x4 xv = *(const u32x4*)(P + ((size_t)seq * SEQ + ttc) * PWD + XC_OFF + cg8); \
        const unsigned keep = (tt >= 0 && tt < SEQ) ? 0xffffffffu : 0u; xw[hf][j] = (u32x4){xv.x & keep, xv.y & keep, xv.z & keep, xv.w & keep}; } } while (0)
    C_LOADX(DIR ? 7 : 0);
    __syncthreads();
    for (int it = 0; it < 8; ++it) {
        const int tile = DIR ? 7 - it : it;
#pragma unroll
        for (int hf = 0; hf < 2; ++hf) {
            float u8[8];
            { const f32x4 b0 = *(const LAS f32x4*)(CW + 512 + c8), b1 = *(const LAS f32x4*)(CW + 512 + c8 + 4); u8[0] = b0.x; u8[1] = b0.y; u8[2] = b0.z; u8[3] = b0.w; u8[4] = b1.x; u8[5] = b1.y; u8[6] = b1.z; u8[7] = b1.w; }
#pragma unroll
            for (int j = 0; j < 4; ++j) { const u32x4 x = xw[hf][j]; const f32x4 w0 = *(const LAS f32x4*)(CW + j * 128 + c8), w1 = *(const LAS f32x4*)(CW + j * 128 + c8 + 4);
                u8[0] += bf_lo(x.x) * w0.x; u8[1] += bf_hi(x.x) * w0.y; u8[2] += bf_lo(x.y) * w0.z; u8[3] += bf_hi(x.y) * w0.w;
                u8[4] += bf_lo(x.z) * w1.x; u8[5] += bf_hi(x.z) * w1.y; u8[6] += bf_lo(x.w) * w1.z; u8[7] += bf_hi(x.w) * w1.w; }
            u32x4 w; w.x = cvt_pk_bf16(u8[0], u8[1]); w.y = cvt_pk_bf16(u8[2], u8[3]); w.z = cvt_pk_bf16(u8[4], u8[5]); w.w = cvt_pk_bf16(u8[6], u8[7]);
            *(LAS u32x4*)(U + (t0 + 32 * hf) * UP + c8) = w;
        }
        if (it < 7) C_LOADX(DIR ? 6 - it : it + 1);
        __syncthreads();
        {
            f32x16 accr = {}, acci = {};
#pragma unroll
            for (int ks = 0; ks < 8; ++ks) {
                const bf16x8 af = *(const LAS bf16x8*)(U + (32 * th + r) * UP + 16 * ks + 8 * h);
                accr = __builtin_amdgcn_mfma_f32_32x32x16_bf16(af, bfr[ks], accr, 0, 0, 0);
                acci = __builtin_amdgcn_mfma_f32_32x32x16_bf16(af, bfi[ks], acci, 0, 0, 0);
            }
            LAS float* pa = AD + ch; LAS float* pd = AD + 64 * 128 + ch;
#pragma unroll
            for (int reg = 0; reg < 16; reg += 2) {
                const int tt = 32 * th + (reg & 3) + 8 * (reg >> 2) + 4 * h;
                const f32x2 er = (f32x2){accr[reg], accr[reg + 1]} * (-L2E) + rbn2, ei = (f32x2){acci[reg], acci[reg + 1]} * (-L2E) + ibn2;
                f32x2 rr, ii; rr.x = __builtin_amdgcn_rcpf(1.0f + __builtin_amdgcn_exp2f(er.x)); rr.y = __builtin_amdgcn_rcpf(1.0f + __builtin_amdgcn_exp2f(er.y));
                ii.x = __builtin_amdgcn_rcpf(1.0f + __builtin_amdgcn_exp2f(ei.x)); ii.y = __builtin_amdgcn_rcpf(1.0f + __builtin_amdgcn_exp2f(ei.y));
                const f32x2 le = ls8e * rr, x2 = ls82 * rr;
                f32x2 av; av.x = __builtin_amdgcn_exp2f(le.x); av.y = __builtin_amdgcn_exp2f(le.y);
                const f32x2 pol = -x2 * (1.0f + x2 * (0.5f + x2 * ((1.0f / 6.0f) + x2 * ((1.0f / 24.0f) + x2 * (1.0f / 120.0f))))), dir = 1.0f - av * av;
                f32x2 om; om.x = x2.x > -0.25f ? pol.x : dir.x; om.y = x2.y > -0.25f ? pol.y : dir.y;
                const f32x2 uf = {bf2f(U[tt * UP + ch]), bf2f(U[(tt + 1) * UP + ch])};
                f32x2 sq; sq.x = __builtin_amdgcn_sqrtf(om.x); sq.y = __builtin_amdgcn_sqrtf(om.y);
                const f32x2 dr = sq * (ii * uf);
                pa[tt * 128] = av.x; pa[(tt + 1) * 128] = av.y; pd[tt * 128] = dr.x; pd[(tt + 1) * 128] = dr.y;
            }
        }
        u32x4 yw[2], ow[2];
        if constexpr (PASS == 3) {
#pragma unroll
            for (int hf = 0; hf < 2; ++hf) { const size_t row = rowbase + tile * 64 + t0 + 32 * hf; yw[hf] = *(const u32x4*)(P + row * PWD + YC_OFF + cg8);
                if constexpr (DIR == 1) ow[hf] = *(const u32x4*)(OC + row * MWD + cg8); }
        }
        __syncthreads();
        if (tid < 128) {
            LAS float* pa = AD + tid; LAS float* pd = AD + 64 * 128 + tid;
#pragma unroll
            for (int s0 = 0; s0 < 64; s0 += 16) {
                float av[16], dv[16];
#pragma unroll
                for (int s = 0; s < 16; ++s) { const int t = DIR ? 63 - (s0 + s) : (s0 + s); av[s] = pa[t * 128]; dv[s] = pd[t * 128]; }
#pragma unroll
                for (int s = 0; s < 16; ++s) { hh = av[s] * hh + dv[s]; if constexpr (PASS == 1) pp *= av[s]; else dv[s] = hh; }
                if constexpr (PASS == 3) {
#pragma unroll
                    for (int s = 0; s < 16; ++s) { const int t = DIR ? 63 - (s0 + s) : (s0 + s); pa[t * 128] = dv[s]; } }
            }
        }
        if constexpr (PASS == 3) {
            __syncthreads();
#pragma unroll
            for (int hf = 0; hf < 2; ++hf) { const int t = t0 + 32 * hf; const size_t row = rowbase + tile * 64 + t;
                const u32x4 y4 = yw[hf];
                const float y[8] = {bf_lo(y4.x), bf_hi(y4.x), bf_lo(y4.y), bf_hi(y4.y), bf_lo(y4.z), bf_hi(y4.z), bf_lo(y4.w), bf_hi(y4.w)};
                const LAS float* hp = AD + t * 128 + c8;
                float o[8];
#pragma unroll
                for (int j = 0; j < 8; ++j) { const float z = 0.7978845608028654f * (y[j] + 0.044715f * y[j] * y[j] * y[j]);
                    o[j] = hp[j] * (y[j] * fast_sigmoid(2.0f * z)); }
                if constexpr (DIR == 1) { const u32x4 p4 = ow[hf]; o[0] += bf_lo(p4.x); o[1] += bf_hi(p4.x); o[2] += bf_lo(p4.y); o[3] += bf_hi(p4.y); o[4] += bf_lo(p4.z); o[5] += bf_hi(p4.z); o[6] += bf_lo(p4.w); o[7] += bf_hi(p4.w); }
                u32x4 w; w.x = cvt_pk_bf16(o[0], o[1]); w.y = cvt_pk_bf16(o[2], o[3]); w.z = cvt_pk_bf16(o[4], o[5]); w.w = cvt_pk_bf16(o[6], o[7]);
                *(u32x4*)(OC + row * MWD + cg8) = w; }
        }
    }
#undef C_LOADX
    if constexpr (PASS == 1) { if (tid < 128) SUM[((size_t)(seq * NSPAN + sp) * 2 + DIR) * MWD + nb * 128 + tid] = (f32x2){pp, hh}; }
    __syncthreads();
}

__global__ void __launch_bounds__(512, 2) mk_fwd(Args args) {
    extern __shared__ __attribute__((aligned(16))) unsigned char lds_raw[];
    LAS unsigned char* lds = (LAS unsigned char*)lds_raw;
    {
        volatile LAS unsigned* MISC = (volatile LAS unsigned*)(lds + MISC_OFF);
        for (int u = threadIdx.x; u < (LDS_BYTES - MISC_OFF) / 4; u += 512) MISC[u] = 0u;
        __syncthreads();
    }
#if MK_SINGLE
    XcdBarrier bar = xcd_barrier_post((unsigned*)(args.ws + WS_CTL) + CW_BAR, (volatile LAS unsigned*)(lds + MISC_OFF) + 8);
#define GRID_BAR() xcd_barrier(bar)
#else
#define GRID_BAR() do {} while (0)
#endif
    const int lo = args.lo, hi = args.hi;
    int step = 0;
#define RUN(k) (lo <= (k) && (k) < hi)
#define SEAM(k) do { if (RUN((k) + 1)) GRID_BAR(); } while (0)
#define PHASE_ENTER() int tid = threadIdx.x; asm volatile("" : "+v"(tid)); int bx = blockIdx.x; asm volatile("" : "+s"(bx)); int G = gridDim.x; asm volatile("" : "+s"(G)); const int NGW = G * 8; (void)NGW; \
    const int lane = tid & 63, wave = __builtin_amdgcn_readfirstlane(tid >> 6), gw = bx * 8 + wave; \
    const CAS Args* ap = (const CAS Args*)__builtin_amdgcn_kernarg_segment_ptr(); asm volatile("" : "+s"(ap)); \
    unsigned char* ws = ap->ws; float* out = ap->out; (void)lane; (void)gw; (void)out; \
    bf16* const P = (bf16*)(ws + WS_P); bf16* const Y = (bf16*)(ws + WS_P); bf16* const GT = (bf16*)(ws + WS_G); bf16* const O = (bf16*)(ws + WS_O); bf16* const HID = (bf16*)(ws + WS_G); \
    (void)P; (void)Y; (void)GT; (void)O; (void)HID

    for (int l = 0; l < DEPTH; ++l) {
        { const int k = step++; if (RUN(k) && ((PH_MASK >> 0) & 1)) { PHASE_ENTER(); for (int rep_ = 0; rep_ < NREP(0); ++rep_) phase_weights(ap, ws, l, lds, gw, NGW, wave, lane);
            if (l == 0) {
                rope_tables((f32x2*)(ws + WS_TAB1), (f32x2*)(ws + WS_TABA), bx * 512 + tid, G * 512);
                for (int row = gw; row < NTOK; row += NGW) entry_row(x_in_row(ap->in[0], ap->in[1], row), (bf16*)(ws + WS_XB) + (size_t)row * DM, (float*)(ws + WS_RS) + row, lane); }
            SEAM(k); } }
        for (int c = 0; c < NCHUNK; ++c) {
            const int row0 = c ? 32768 : 0, nseq = c ? 2 : 4, TC = nseq * SEQ;
            #define XBC ((bf16*)(ws + WS_XB) + (size_t)row0 * DM)
            #define RSC ((float*)(ws + WS_RS) + (size_t)row0)
            #define MRG ((bf16*)(ws + WS_P + 128 * MiB))
            { const int k = step++; if (RUN(k) && ((PH_MASK >> 2) & 1)) { PHASE_ENTER();
                pg8::Gemm g{XBC, (bf16*)(ws + WS_WIN), DM}; pg8::StaticOrder S; S.init(TC, INW, G, bx); pg8::EpiIn E{P, GT, RSC};
                for (int rep_ = 0; rep_ < NREP(2); ++rep_) pg8::gemm_phase<pg8::EpiIn, pg8::StaticOrder>(lds, g, S, E);
                SEAM(k); } }
            { const int k = step++; if (RUN(k) && ((PH_MASK >> 3) & 1)) { PHASE_ENTER();
                const float* kn = ap->in[8] + (size_t)l * HD;
                for (int m = gw; m < TC; m += NGW) { const int pos = m & (SEQ - 1); krope_token(P + (size_t)m * PWD, (const f32x2*)(ws + WS_TABA) + pos * 64, (const f32x2*)(ws + WS_TAB1) + pos * 64, kn, lane); }
                CParams cp{ap->in[10] + (size_t)l * 4 * MWD, ap->in[11] + (size_t)l * MWD, ap->in[13] + (size_t)l * 2 * MWD, ap->in[15] + (size_t)l * 2 * MWD, ap->in[16] + (size_t)l * 2 * MWD, (bf16*)(ws + WS_WG)};
                for (int rep_ = 0; rep_ < NREP(3); ++rep_) for (int u = bx; u < nseq * 8 * NSPAN; u += G) { const int sp = u & (NSPAN - 1), nb = (u >> 4) & 7, seq = u >> 7;
                    c_sweep<1, 0>(lds, P, nullptr, cp, (f32x2*)(ws + WS_SUM), seq, nb, sp); c_sweep<1, 1>(lds, P, nullptr, cp, (f32x2*)(ws + WS_SUM), seq, nb, sp); }
                SEAM(k); } }
            { const int k = step++; if (RUN(k) && ((PH_MASK >> 5) & 1)) {
                if (SUBMASK & 1) { PHASE_ENTER(); const int xcd = bx & 7, rank = bx >> 3, nrank = G >> 3; for (int rep_ = 0; rep_ < NREP(12); ++rep_) for (int i = rank; i < 32 * nseq; i += nrank) {
                    const int uid = xcd * 32 * nseq + i, seq = uid >> 8, head = (uid >> 5) & 7, kvh = head >> 2, qb = uid & 31;
                    const bf16* Qb = P + (size_t)(seq * SEQ + qb * 256) * PWD + QA_OFF + head * HD;
                    const bf16* Kh = P + (size_t)(seq * SEQ) * PWD + KA_OFF + kvh * HD; const bf16* Vh = P + (size_t)(seq * SEQ) * PWD + VA_OFF + kvh * HD;
                    att::attn_unit<0, SD_A>(Qb, Kh, Vh, O + (size_t)(seq * SEQ + qb * 256) * MWD + head * HD, SEQ / 64, 0, 0.f, (char*)lds_raw, (const f32x2*)(ws + WS_TABA) + qb * 256 * 64, ap->in[7] + (size_t)l * HD);
                } }
                if (SUBMASK & 2) { PHASE_ENTER(); const int xcd = bx & 7, rank = bx >> 3, nrank = G >> 3; for (int rep_ = 0; rep_ < NREP(13); ++rep_) for (int i = rank; i < 32 * nseq; i += nrank) {
                    const int uid = xcd * 32 * nseq + i, seq = uid >> 8, head = (uid >> 5) & 7, kvh = head >> 2, qb = uid & 31;
                    const int k0 = (qb == 0) ? 0 : qb * 256 - 128, k1 = (qb == 31) ? SEQ : qb * 256 + 384;
                    const bf16* Qb = P + (size_t)(seq * SEQ + qb * 256) * PWD + QB_OFF + head * HD;
                    const bf16* Kh = P + (size_t)(seq * SEQ + k0) * PWD + KB_OFF + kvh * HD; const bf16* Vh = P + (size_t)(seq * SEQ + k0) * PWD + VB_OFF + kvh * HD;
                    att::attn_unit<1, SD_B>(Qb, Kh, Vh, O + (size_t)TC * MWD + (size_t)(seq * SEQ + qb * 256) * MWD + head * HD, (k1 - k0) / 64, qb * 256 - k0, ap->in[9][l * 8 + head], (char*)lds_raw, (const f32x2*)(ws + WS_TAB1) + qb * 256 * 64, nullptr);
                } }
                if (SUBMASK & 4) { PHASE_ENTER();
                CParams cp{ap->in[10] + (size_t)l * 4 * MWD, ap->in[11] + (size_t)l * MWD, ap->in[13] + (size_t)l * 2 * MWD, ap->in[15] + (size_t)l * 2 * MWD, ap->in[16] + (size_t)l * 2 * MWD, (bf16*)(ws + WS_WG)};
                for (int rep_ = 0; rep_ < NREP(14); ++rep_) for (int u = bx; u < nseq * 8 * NSPAN; u += G) { const int sp = u & (NSPAN - 1), nb = (u >> 4) & 7, seq = u >> 7;
                    c_sweep<3, 0>(lds, P, O + (size_t)2 * TC * MWD, cp, (f32x2*)(ws + WS_SUM), seq, nb, sp); c_sweep<3, 1>(lds, P, O + (size_t)2 * TC * MWD, cp, (f32x2*)(ws + WS_SUM), seq, nb, sp); } }
                SEAM(k); } }
            { const int k = step++; if (RUN(k) && ((PH_MASK >> 6) & 1)) { PHASE_ENTER();
                pg8::Gemm g{O, (bf16*)(ws + WS_WBR), MWD}; pg8::BranchOrder S; S.base.init(TC, DM, G, bx); S.npanel = TC / 256;
                pg8::EpiBr E{GT, MRG};
                for (int rep_ = 0; rep_ < NREP(6); ++rep_) pg8::gemm_phase<pg8::EpiBr, pg8::BranchOrder>(lds, g, S, E);
                SEAM(k); } }
            { const int k = step++; if (RUN(k) && ((PH_MASK >> 7) & 1)) { PHASE_ENTER();
                pg8::Gemm g{MRG, (bf16*)(ws + WS_WOUT), DM}; pg8::StaticOrder S; S.init(TC, DM, G, bx); pg8::EpiBf16 E{Y, DM};
                for (int rep_ = 0; rep_ < NREP(7); ++rep_) pg8::gemm_phase<pg8::EpiBf16, pg8::StaticOrder>(lds, g, S, E);
                SEAM(k); } }
            { const int k = step++; if (RUN(k) && ((PH_MASK >> 8) & 1)) { PHASE_ENTER();
                const float* g1 = ap->in[3] + (size_t)l * DM;
                for (int m = gw; m < TC; m += NGW) resid_norm_row<false>(Y + (size_t)m * DM, XBC + (size_t)m * DM, g1, RSC + m, nullptr, lane);
                SEAM(k); } }
            { const int k = step++; if (RUN(k) && ((PH_MASK >> 9) & 1)) { PHASE_ENTER();
                pg8::Gemm g{XBC, (bf16*)(ws + WS_W1), DM}; pg8::StaticOrder S; S.init(TC, FFD, G, bx); pg8::EpiRelu2 E{HID, FFD, RSC};
                for (int rep_ = 0; rep_ < NREP(9); ++rep_) pg8::gemm_phase<pg8::EpiRelu2, pg8::StaticOrder>(lds, g, S, E);
                SEAM(k); } }
            { const int k = step++; if (RUN(k) && ((PH_MASK >> 10) & 1)) { PHASE_ENTER();
                pg8::Gemm g{HID, (bf16*)(ws + WS_W2), FFD}; pg8::StaticOrder S; S.init(TC, DM, G, bx); pg8::EpiBf16 E{Y, DM};
                for (int rep_ = 0; rep_ < NREP(10); ++rep_) pg8::gemm_phase<pg8::EpiBf16, pg8::StaticOrder>(lds, g, S, E);
                SEAM(k); } }
            { const int k = step++; if (RUN(k) && ((PH_MASK >> 11) & 1)) { PHASE_ENTER();
                const float* g1 = ap->in[5] + (size_t)l * DM;
                if (l + 1 < DEPTH) { for (int m = gw; m < TC; m += NGW) resid_norm_row<false>(Y + (size_t)m * DM, XBC + (size_t)m * DM, g1, RSC + m, nullptr, lane); }
                else { for (int m = gw; m < TC; m += NGW) resid_norm_row<true>(Y + (size_t)m * DM, XBC + (size_t)m * DM, g1, nullptr, out + (size_t)(row0 + m) * DM, lane); }
                SEAM(k); } }
        }
    }
#undef RUN
#undef SEAM
}
constexpr int NSTEPS = DEPTH * (1 + NCHUNK * 9);

extern "C" void kernel_launch(void* const* d_in, const int* in_sizes, int n_in, void* d_out, int out_size, void* d_ws, size_t ws_size, hipStream_t stream) {
    static int grid = 0;
    if (grid == 0) {
        if (n_in != 21 || out_size != NTOK * DM || ws_size < WS_END) { fprintf(stderr, "kernel_launch: unexpected shapes (n_in %d out %d ws %zu)\n", n_in, out_size, ws_size); grid = -1; return; }
        int dev = 0, cus = 0, per_cu = 0;
        if (hipGetDevice(&dev) != hipSuccess || hipDeviceGetAttribute(&cus, hipDeviceAttributeMultiprocessorCount, dev) != hipSuccess) { grid = -1; return; }
        if (hipFuncSetAttribute((const void*)mk_fwd, hipFuncAttributeMaxDynamicSharedMemorySize, LDS_BYTES) != hipSuccess) { fprintf(stderr, "kernel_launch: hipFuncSetAttribute failed\n"); grid = -1; return; }
        if (hipOccupancyMaxActiveBlocksPerMultiprocessor(&per_cu, (const void*)mk_fwd, 512, LDS_BYTES) != hipSuccess || per_cu < 1) { fprintf(stderr, "kernel_launch: occupancy query says %d\n", per_cu); }
        (void)hipGetLastError();
        grid = cus;
    }
    if (grid < 0) return;
    if (hipMemsetAsync((char*)d_ws + WS_CTL, 0, CTL_ZERO_BYTES, stream) != hipSuccess) return;
    Args a{};
    for (int i = 0; i < 21; ++i) a.in[i] = (const float*)d_in[i];
    a.out = (float*)d_out; a.ws = (unsigned char*)d_ws;
#if MK_SINGLE
    a.lo = 0; a.hi = NSTEPS;
    hipLaunchKernelGGL(mk_fwd, dim3(grid), dim3(512), LDS_BYTES, stream, a);
#else
    for (int s = 0; s < NSTEPS; ++s) { a.lo = s; a.hi = s + 1; hipLaunchKernelGGL(mk_fwd, dim3(grid), dim3(512), LDS_BYTES, stream, a); }
#endif
    const hipError_t le = hipPeekAtLastError();
    if (le != hipSuccess) fprintf(stderr, "kernel_launch: launch failed: %s\n", hipGetErrorName(le));
}
```

```cpp
#include <hip/hip_runtime.h>
#include <cstdio>
#include <cstdint>

#ifndef PH_MASK
#define PH_MASK 0xFFF
#endif
#ifndef SUBMASK
#define SUBMASK 7
#endif
#ifndef SD_A
#define SD_A 2
#endif
#ifndef SD_B
#define SD_B 1
#endif
#ifndef DUP_MASK
#define DUP_MASK 0
#endif
#define NREP(i) (1 + ((DUP_MASK >> (i)) & 1))
#ifndef MK_SINGLE
#define MK_SINGLE 1
#endif

#define LAS __attribute__((address_space(3)))
#define GAS __attribute__((address_space(1)))
#define CAS __attribute__((address_space(4)))
typedef unsigned short bf16;
typedef short bf16x8 __attribute__((ext_vector_type(8)));
typedef short s16x4 __attribute__((ext_vector_type(4)));
typedef float f32x4 __attribute__((ext_vector_type(4)));
typedef float f32x2 __attribute__((ext_vector_type(2)));
typedef float f32x16 __attribute__((ext_vector_type(16)));
typedef unsigned u32x4 __attribute__((ext_vector_type(4)));
typedef unsigned u32x2 __attribute__((ext_vector_type(2)));

constexpr int DM = 2048, SEQ = 8192, NTOK = 49152, TCMAX = 32768, NCHUNK = 2, DEPTH = 4;
constexpr int INW = 11264, PWD = 5120, GWD = 6144, FFD = 8192, MWD = 1024, HD = 128;
constexpr int QA_OFF = 0, KA_OFF = 1024, VA_OFF = 1280, QB_OFF = 1536, KB_OFF = 2560, VB_OFF = 2816, XC_OFF = 3072, YC_OFF = 4096;
constexpr int NPROMPT_TOK = 32768;
constexpr float EPS = 1e-6f;

constexpr size_t MiB = 1u << 20;
constexpr size_t WS_CTL = 0, CTL_ZERO_BYTES = 1 * MiB;
constexpr size_t WS_WIN = 2 * MiB;
constexpr size_t WS_WBR = 46 * MiB;
constexpr size_t WS_WOUT = 58 * MiB;
constexpr size_t WS_W1 = 66 * MiB;
constexpr size_t WS_W2 = 98 * MiB;
constexpr size_t WS_WG = 130 * MiB;
constexpr size_t WS_SUM = 131 * MiB;
constexpr size_t WS_BRS = 143 * MiB;
constexpr size_t WS_P = 207 * MiB;
constexpr size_t WS_G = 527 * MiB;
constexpr size_t WS_O = 911 * MiB;
constexpr size_t WS_TAB1 = 1103 * MiB;
constexpr size_t WS_TABA = 1107 * MiB;
constexpr size_t WS_XB = 1111 * MiB;
constexpr size_t WS_RS = 1303 * MiB;
constexpr size_t WS_END = 1304 * MiB;
constexpr int CW_BAR = 4096;

constexpr int LDS_BYTES = 147456;
constexpr int MISC_OFF = 143360;

__device__ __forceinline__ unsigned cvt_pk_bf16(float lo, float hi) { unsigned r; asm volatile("v_cvt_pk_bf16_f32 %0, %1, %2" : "=v"(r) : "v"(lo), "v"(hi)); return r; }
__device__ __forceinline__ float bf_lo(unsigned w) { return __uint_as_float(w << 16); }
__device__ __forceinline__ float bf_hi(unsigned w) { return __uint_as_float(w & 0xffff0000u); }
__device__ __forceinline__ float bf2f(bf16 b) { return __uint_as_float(((unsigned)b) << 16); }
__device__ __forceinline__ float fast_sigmoid(float v) { return __builtin_amdgcn_rcpf(1.0f + __builtin_amdgcn_exp2f(-1.4426950408889634f * v)); }
__device__ __forceinline__ float wave_sum(float v, int lane) {
#pragma unroll
    for (int o = 1; o < 64; o <<= 1) v += __int_as_float(__builtin_amdgcn_ds_bpermute((lane ^ o) << 2, __float_as_int(v)));
    return v;
}

__device__ const double ROPE_F1[64] = {
1.59154943091895346e-01, 1.37822502603982849e-01, 1.19349370211248862e-01, 1.03352296618434064e-01, 8.94994016088910133e-02, 7.75032887553740585e-02, 6.71150830052272551e-02, 5.81192674418762462e-02,
5.03292121044697269e-02, 4.35833029420947638e-02, 3.77415888468699103e-02, 3.26828760272190911e-02, 2.83022152813622411e-02, 2.45087241866802648e-02, 2.12237020815031856e-02, 1.83789966569160986e-02,
1.59154943091895339e-02, 1.37822502603982842e-02, 1.19349370211248869e-02, 1.03352296618434060e-02, 8.94994016088910202e-03, 7.75032887553740654e-03, 6.71150830052272551e-03, 5.81192674418762427e-03,
5.03292121044697286e-03, 4.35833029420947656e-03, 3.77415888468699086e-03, 3.26828760272190893e-03, 2.83022152813622403e-03, 2.45087241866802661e-03, 2.12237020815031847e-03, 1.83789966569160995e-03,
1.59154943091895335e-03, 1.37822502603982846e-03, 1.19349370211248865e-03, 1.03352296618434069e-03, 8.94994016088910115e-04, 7.75032887553740654e-04, 6.71150830052272508e-04, 5.81192674418762427e-04,
5.03292121044697243e-04, 4.35833029420947678e-04, 3.77415888468699086e-04, 3.26828760272190871e-04, 2.83022152813622381e-04, 2.45087241866802661e-04, 2.12237020815031847e-04, 1.83789966569160984e-04,
1.59154943091895346e-04, 1.37822502603982835e-04, 1.19349370211248871e-04, 1.03352296618434063e-04, 8.94994016088910088e-05, 7.75032887553740654e-05, 6.71150830052272508e-05, 5.81192674418762400e-05,
5.03292121044697243e-05, 4.35833029420947644e-05, 3.77415888468699120e-05, 3.26828760272190871e-05, 2.83022152813622381e-05, 2.45087241866802641e-05, 2.12237020815031861e-05, 1.83789966569160984e-05 };
__device__ const double ROPE_FA[32] = {
1.59154943091895346e-01, 1.19349370211248862e-01, 8.94994016088910133e-02, 6.71150830052272551e-02, 5.03292121044697269e-02, 3.77415888468699103e-02, 2.83022152813622411e-02, 2.12237020815031856e-02,
1.59154943091895339e-02, 1.19349370211248869e-02, 8.94994016088910202e-03, 6.71150830052272551e-03, 5.03292121044697286e-03, 3.77415888468699086e-03, 2.83022152813622403e-03, 2.12237020815031847e-03,
1.59154943091895335e-03, 1.19349370211248865e-03, 8.94994016088910115e-04, 6.71150830052272508e-04, 5.03292121044697243e-04, 3.77415888468699086e-04, 2.83022152813622381e-04, 2.12237020815031847e-04,
1.59154943091895346e-04, 1.19349370211248871e-04, 8.94994016088910088e-05, 6.71150830052272508e-05, 5.03292121044697243e-05, 3.77415888468699120e-05, 2.83022152813622381e-05, 2.12237020815031861e-05 };

namespace pg8 {
typedef unsigned short bf16_t;
constexpr int BM = 256, BK = 64, HALF = 128, HTB = HALF * BK * 2, STAGE_BYTES = 8 * HTB, NXCD = 8, WGM = 8;
__host__ __device__ __forceinline__ int lds_byte(int r, int c) { const int st = (r >> 4) * 2 + (c >> 5), rr = r & 15, cc = c & 31, ob = rr * 64 + cc * 2; return st * 1024 + (ob ^ (((ob >> 9) & 1) << 5)); }
__host__ __device__ __forceinline__ void stage_rc(int b, int& R, int& C) { const int st = b / 1024, sb = b % 1024, swz = sb ^ (((sb >> 9) & 1) << 5); R = (st >> 1) * 16 + swz / 64; C = (st & 1) * 32 + (swz % 64) / 2; }
__host__ __device__ __forceinline__ int perm32(int rho) { const int n = rho >> 4, i = rho & 15; return 8 * (i >> 2) + 4 * n + (i & 3); }

struct Unit { int pm, pn, ka, kb, sub; };
struct Gemm { const bf16_t* A; const bf16_t* Bt; int K; };

struct StaticOrder {
    int nM, nN, nwg, G, c;
    __device__ void init(int M, int N, int G_, int c_) { nM = M / BM; nN = N / BM; nwg = nM * nN; G = G_; c = c_; }
    __device__ bool next(int i, Unit& u) const {
        const long L = (long)i * G + c; if (L >= nwg) return false;
        int wgid = (int)L; { const int q = nwg / NXCD, r = nwg % NXCD, xcd = wgid % NXCD, off = wgid / NXCD; wgid = (xcd < r ? xcd * (q + 1) : r * (q + 1) + (xcd - r) * q) + off; }
        const int nig = WGM * nN, gid = wgid / nig, fm = gid * WGM, gsz = (nM - fm) < WGM ? (nM - fm) : WGM;
        u.pm = fm + ((wgid % nig) % gsz); u.pn = (wgid % nig) / gsz; u.ka = u.pm; u.kb = u.pn; u.sub = 0; return true;
    }
};
struct BranchOrder {
    StaticOrder base; int npanel;
    __device__ bool next(int i, Unit& u) const {
        const int t = i / 3, s = i - 3 * t; if (!base.next(t, u)) return false;
        u.sub = s; u.ka = s * npanel + u.pm; u.kb = s * 8 + u.pn; return true;
    }
};

struct EpiIn {
    static constexpr bool PERM = true;
    bf16_t* P; bf16_t* G; const float* rs;
    __device__ __forceinline__ bool operator()(f32x4 (&acc)[2][2][4][2], const Unit& u, int wr, int wc, int fr_, int fq) const {
        int fr = fr_; asm volatile("" : "+v"(fr));
        const int row0 = u.pm * BM + wr * 64 + fr; const bool gate = u.pn >= 20;
        bf16_t* base = gate ? G : P; const int ldc = gate ? GWD : PWD; const int col0 = (gate ? u.pn - 20 : u.pn) * BM + wc * 32 + 8 * fq;
#pragma unroll
        for (int ai = 0; ai < 2; ++ai)
#pragma unroll
            for (int m = 0; m < 4; ++m) { bf16_t* rowp = base + (size_t)(row0 + ai * HALF + m * 16) * ldc + col0; const float rsv = rs[row0 + ai * HALF + m * 16];
#pragma unroll
                for (int bj = 0; bj < 2; ++bj) { f32x4 v0 = acc[ai][bj][m][0] * rsv, v1 = acc[ai][bj][m][1] * rsv;
                    if (gate) {
#pragma unroll
                        for (int j = 0; j < 4; ++j) { v0[j] = fmaxf(fast_sigmoid(v0[j]), 1e-30f); v1[j] = fmaxf(fast_sigmoid(v1[j]), 1e-30f); } }
                    u32x4 w; w.x = cvt_pk_bf16(v0[0], v0[1]); w.y = cvt_pk_bf16(v0[2], v0[3]); w.z = cvt_pk_bf16(v1[0], v1[1]); w.w = cvt_pk_bf16(v1[2], v1[3]);
                    *(u32x4*)(rowp + bj * HALF) = w; } }
        return true;
    }
};
struct EpiBr {
    static constexpr bool PERM = true;
    const bf16_t* G; bf16_t* OUT;
    __device__ __forceinline__ bool operator()(f32x4 (&acc)[2][2][4][2], const Unit& u, int wr, int wc, int fr_, int fq) const {
        int fr = fr_; asm volatile("" : "+v"(fr));
        const int row0 = u.pm * BM + wr * 64 + fr, col0 = u.pn * BM + wc * 32 + 8 * fq; const int sub = u.sub;
#pragma unroll
        for (int ai = 0; ai < 2; ++ai)
#pragma unroll
            for (int m = 0; m < 4; ++m) { const size_t row = (size_t)(row0 + ai * HALF + m * 16);
#pragma unroll
                for (int bj = 0; bj < 2; ++bj) {
                    const u32x4 gw = *(const u32x4*)(G + row * GWD + sub * DM + col0 + bj * HALF);
                    f32x4 s0 = {bf_lo(gw.x), bf_hi(gw.x), bf_lo(gw.y), bf_hi(gw.y)};
                    f32x4 s1 = {bf_lo(gw.z), bf_hi(gw.z), bf_lo(gw.w), bf_hi(gw.w)};
                    if (sub < 2) {
                        const u32x4 gn = *(const u32x4*)(G + row * GWD + (sub + 1) * DM + col0 + bj * HALF);
                        s0 *= (f32x4){__builtin_amdgcn_rcpf(bf_lo(gn.x)), __builtin_amdgcn_rcpf(bf_hi(gn.x)), __builtin_amdgcn_rcpf(bf_lo(gn.y)), __builtin_amdgcn_rcpf(bf_hi(gn.y))};
                        s1 *= (f32x4){__builtin_amdgcn_rcpf(bf_lo(gn.z)), __builtin_amdgcn_rcpf(bf_hi(gn.z)), __builtin_amdgcn_rcpf(bf_lo(gn.w)), __builtin_amdgcn_rcpf(bf_hi(gn.w))};
                        acc[ai][bj][m][0] *= s0; acc[ai][bj][m][1] *= s1;
                    } else {
                        const f32x4 v0 = acc[ai][bj][m][0] * s0, v1 = acc[ai][bj][m][1] * s1;
                        u32x4 w; w.x = cvt_pk_bf16(v0[0], v0[1]); w.y = cvt_pk_bf16(v0[2], v0[3]); w.z = cvt_pk_bf16(v1[0], v1[1]); w.w = cvt_pk_bf16(v1[2], v1[3]);
                        *(u32x4*)(OUT + row * DM + col0 + bj * HALF) = w; } }
                asm volatile("" ::: "memory"); }
        return sub == 2;
    }
};
struct EpiBf16 {
    static constexpr bool PERM = true;
    bf16_t* O; int ldc;
    __device__ __forceinline__ bool operator()(f32x4 (&acc)[2][2][4][2], const Unit& u, int wr, int wc, int fr_, int fq) const {
        int fr = fr_; asm volatile("" : "+v"(fr));
        const int row0 = u.pm * BM + wr * 64 + fr, col0 = u.pn * BM + wc * 32 + 8 * fq;
#pragma unroll
        for (int ai = 0; ai < 2; ++ai)
#pragma unroll
            for (int m = 0; m < 4; ++m) { bf16_t* rowp = O + (size_t)(row0 + ai * HALF + m * 16) * ldc + col0;
#pragma unroll
                for (int bj = 0; bj < 2; ++bj) { const f32x4 v0 = acc[ai][bj][m][0], v1 = acc[ai][bj][m][1];
                    u32x4 w; w.x = cvt_pk_bf16(v0[0], v0[1]); w.y = cvt_pk_bf16(v0[2], v0[3]); w.z = cvt_pk_bf16(v1[0], v1[1]); w.w = cvt_pk_bf16(v1[2], v1[3]);
                    *(u32x4*)(rowp + bj * HALF) = w; } }
        return true;
    }
};
struct EpiRelu2 {
    static constexpr bool PERM = true;
    bf16_t* O; int ldc; const float* rs;
    __device__ __forceinline__ bool operator()(f32x4 (&acc)[2][2][4][2], const Unit& u, int wr, int wc, int fr_, int fq) const {
        int fr = fr_; asm volatile("" : "+v"(fr));
        const int row0 = u.pm * BM + wr * 64 + fr, col0 = u.pn * BM + wc * 32 + 8 * fq;
#pragma unroll
        for (int ai = 0; ai < 2; ++ai)
#pragma unroll
            for (int m = 0; m < 4; ++m) { bf16_t* rowp = O + (size_t)(row0 + ai * HALF + m * 16) * ldc + col0; const float rsv = rs[row0 + ai * HALF + m * 16];
#pragma unroll
                for (int bj = 0; bj < 2; ++bj) { f32x4 v0 = acc[ai][bj][m][0], v1 = acc[ai][bj][m][1];
#pragma unroll
                    for (int j = 0; j < 4; ++j) { const float a = fmaxf(v0[j] * rsv, 0.f), b = fmaxf(v1[j] * rsv, 0.f); v0[j] = a * a; v1[j] = b * b; }
                    u32x4 w; w.x = cvt_pk_bf16(v0[0], v0[1]); w.y = cvt_pk_bf16(v0[2], v0[3]); w.z = cvt_pk_bf16(v1[0], v1[1]); w.w = cvt_pk_bf16(v1[2], v1[3]);
                    *(u32x4*)(rowp + bj * HALF) = w; } }
        return true;
    }
};

template <class Epi, class Sched, bool ALIGN_EPI = true>
__device__ __forceinline__ void gemm_phase(LAS unsigned char* lds, const Gemm g, const Sched& S, const Epi& E) {
    int tid_ = threadIdx.x; asm volatile("" : "+v"(tid_));
    const int tid = tid_, wid = __builtin_amdgcn_readfirstlane(tid >> 6), lane = tid & 63, wr = wid >> 2, wc = wid & 3, fr = lane & 15, fq = lane >> 4;
    const int K = g.K, nt = K / BK;
    unsigned voffA[2], voffB[2];
#pragma unroll
    for (int i = 0; i < 2; ++i) { int R, C; stage_rc(tid * 16 + i * 8192, R, C); const int Rb = Epi::PERM ? ((R & ~31) + perm32(R & 31)) : R;
        voffA[i] = (unsigned)(R * K + C) * 2u; voffB[i] = (unsigned)(Rb * K + C) * 2u; }
    const size_t kstep = (size_t)(BK * 2);
    const size_t hstep = (size_t)HALF * K * 2;
    const size_t tstep = 2 * hstep;
    const unsigned ldsw = (unsigned)wid * 1024u;
    const int aoff = lds_byte(wr * 64 + fr, fq * 8), boff = lds_byte(wc * 32 + fr, fq * 8);
#define PG8_SA(b, h) (((b) * 2 + (h)) * HTB)
#define PG8_SB(b, h) ((4 + (b) * 2 + (h)) * HTB)
#define PG8_STAGE(bufoff, gbase, voff) do { _Pragma("unroll") for (int _i = 0; _i < 2; ++_i) \
        __builtin_amdgcn_global_load_lds((const unsigned*)((const char*)(gbase) + (voff)[_i]), (LAS unsigned*)(lds + (bufoff) + ldsw + _i * 8192), 16, 0, 0); } while (0)
#define PG8_LDA(dst, b, h) do { _Pragma("unroll") for (int m = 0; m < 4; ++m) _Pragma("unroll") for (int k = 0; k < 2; ++k) dst[m][k] = *(const LAS bf16x8*)(lds + PG8_SA(b, h) + aoff + m * 2048 + k * 1024); } while (0)
#define PG8_LDB(dst, b, h) do { _Pragma("unroll") for (int n = 0; n < 2; ++n) _Pragma("unroll") for (int k = 0; k < 2; ++k) dst[n][k] = *(const LAS bf16x8*)(lds + PG8_SB(b, h) + boff + n * 2048 + k * 1024); } while (0)
#define PG8_MMA(ai, bj, At, Bt) do { __builtin_amdgcn_s_setprio(1); _Pragma("unroll") for (int m = 0; m < 4; ++m) _Pragma("unroll") for (int n = 0; n < 2; ++n) _Pragma("unroll") for (int k = 0; k < 2; ++k) \
        acc[ai][bj][m][n] = __builtin_amdgcn_mfma_f32_16x16x32_bf16(Bt[n][k], At[m][k], acc[ai][bj][m][n], 0, 0, 0); __builtin_amdgcn_s_setprio(0); } while (0)
#define PG8_WAIT_V(n) asm volatile("s_waitcnt vmcnt(" #n ")" ::: "memory")
#define PG8_WAIT_L(n) asm volatile("s_waitcnt lgkmcnt(" #n ")" ::: "memory")
#define PG8_BAR __builtin_amdgcn_s_barrier()
#define PG8_SCHED __builtin_amdgcn_sched_barrier(0)
    Unit cur, nxt; int ui = 0;
    if (!S.next(0, cur)) return;
    f32x4 acc[2][2][4][2];
#pragma unroll
    for (int a = 0; a < 2; ++a)
#pragma unroll
        for (int b = 0; b < 2; ++b)
#pragma unroll
            for (int m = 0; m < 4; ++m)
#pragma unroll
                for (int n = 0; n < 2; ++n) acc[a][b][m][n] = (f32x4){0.f, 0.f, 0.f, 0.f};
    bf16x8 At[4][2], B0[2][2], B1[2][2];
    const char* cA = (const char*)g.A + (size_t)cur.ka * tstep; const char* cB = (const char*)g.Bt + (size_t)cur.kb * tstep;
    PG8_STAGE(PG8_SB(0, 0), cB, voffB); PG8_STAGE(PG8_SB(0, 1), cB + hstep, voffB); PG8_STAGE(PG8_SA(0, 0), cA, voffA); PG8_STAGE(PG8_SA(0, 1), cA + hstep, voffA);
    if (wr == 1) PG8_BAR;
    PG8_WAIT_V(2); PG8_BAR;
    PG8_STAGE(PG8_SB(1, 0), cB + kstep, voffB); PG8_STAGE(PG8_SA(1, 0), cA + kstep, voffA); PG8_STAGE(PG8_SB(1, 1), cB + hstep + kstep, voffB);
    PG8_WAIT_V(6); PG8_BAR;
    for (;;) {
        const bool has_next = S.next(ui + 1, nxt);
        const char* nA = has_next ? (const char*)g.A + (size_t)nxt.ka * tstep : cA; const char* nB = has_next ? (const char*)g.Bt + (size_t)nxt.kb * tstep : cB;
        for (int t = 0; t < nt; t += 2) {
            const bool last = (t == nt - 2);
            const char* a1 = cA + (size_t)(t + 1) * kstep;
            const char* a2 = last ? nA : cA + (size_t)(t + 2) * kstep; const char* b2 = last ? nB : cB + (size_t)(t + 2) * kstep;
            const char* a3 = a2 + kstep; const char* b3 = b2 + kstep;
            PG8_LDB(B0, 0, 0); PG8_LDB(B1, 0, 1); PG8_SCHED; PG8_LDA(At, 0, 0); PG8_STAGE(PG8_SA(1, 1), a1 + hstep, voffA);
            PG8_WAIT_V(8); PG8_WAIT_L(0); PG8_BAR; PG8_MMA(0, 0, At, B0); PG8_MMA(0, 1, At, B1); PG8_BAR; PG8_SCHED;
            PG8_LDA(At, 0, 1); PG8_STAGE(PG8_SB(0, 0), b2, voffB); PG8_STAGE(PG8_SB(0, 1), b2 + hstep, voffB); PG8_STAGE(PG8_SA(0, 0), a2, voffA);
            PG8_WAIT_V(8); PG8_WAIT_L(0); PG8_BAR; PG8_MMA(1, 0, At, B0); PG8_MMA(1, 1, At, B1); PG8_BAR; PG8_SCHED;
            PG8_LDB(B0, 1, 0); PG8_LDB(B1, 1, 1); PG8_SCHED; PG8_LDA(At, 1, 0); PG8_STAGE(PG8_SA(0, 1), a2 + hstep, voffA);
            PG8_WAIT_V(8); PG8_WAIT_L(0); PG8_BAR; PG8_MMA(0, 0, At, B0); PG8_MMA(0, 1, At, B1); PG8_BAR; PG8_SCHED;
            PG8_LDA(At, 1, 1); PG8_STAGE(PG8_SB(1, 0), b3, voffB); PG8_STAGE(PG8_SB(1, 1), b3 + hstep, voffB); PG8_STAGE(PG8_SA(1, 0), a3, voffA);
            PG8_WAIT_V(8); PG8_WAIT_L(0); PG8_BAR; PG8_MMA(1, 0, At, B0); PG8_MMA(1, 1, At, B1); PG8_BAR; PG8_SCHED;
        }
        if constexpr (ALIGN_EPI) { if (wr == 0) PG8_BAR; }
        const bool reset = E(acc, cur, wr, wc, fr, fq);
        if (!has_next) break;
        if (reset) {
#pragma unroll
        for (int a = 0; a < 2; ++a)
#pragma unroll
            for (int b = 0; b < 2; ++b)
#pragma unroll
                for (int m = 0; m < 4; ++m)
#pragma unroll
                    for (int n = 0; n < 2; ++n) acc[a][b][m][n] = (f32x4){0.f, 0.f, 0.f, 0.f};
        }
        cur = nxt; cA = nA; cB = nB; ++ui;
        if constexpr (ALIGN_EPI) { if (wr == 1) PG8_BAR; }
    }
    PG8_WAIT_V(0);
    if constexpr (!ALIGN_EPI) { if (wr == 0) PG8_BAR; }
    PG8_BAR;
#undef PG8_SA
#undef PG8_SB
#undef PG8_STAGE
#undef PG8_LDA
#undef PG8_LDB
#undef PG8_MMA
#undef PG8_WAIT_V
#undef PG8_WAIT_L
#undef PG8_BAR
#undef PG8_SCHED
}
}

namespace att {
constexpr int D = 128, NW = 8, QBLK = 32, KVBLK = 64;
constexpr float SCALE = 0.088388347648318440f;
constexpr float THR = 8.f;
constexpr int LDQ = PWD, LDK = PWD, LDO = MWD;
constexpr int SHM_V = KVBLK * D * 2, SHM_K = KVBLK * D * 2;
constexpr int OST_PITCH = 272;
constexpr int OST_OFF = 2 * SHM_V + 2 * SHM_K + NW * 64 * 4;
constexpr int ATT_LDS = OST_OFF + NW * 32 * OST_PITCH;
#define KSWZ(row, colB) ((row) * 256 + ((colB) ^ (((row) & 7) << 4)))
#define SBAR() __builtin_amdgcn_sched_barrier(0)
__device__ __forceinline__ int crow(int r, int hi) { return (r & 3) + 8 * (r >> 2) + 4 * hi; }

template <bool MASKED>
__device__ __forceinline__ void partialSM(f32x16& p0, f32x16& p1, float& m_reg, float& mn, float& alpha, int mbase) {
  constexpr float C = SCALE * 1.4426950408889634f;
  if constexpr (MASKED) {
    const float ninf = -__builtin_inff();
#pragma unroll
    for (int r = 0; r < 16; ++r) { const int c = (r & 3) + 8 * (r >> 2);
      p0[r] = ((unsigned)(mbase - c) <= 256u) ? p0[r] : ninf;
      p1[r] = ((unsigned)(mbase - c - 32) <= 256u) ? p1[r] : ninf; }
  }
  float pmax = p0[0];
#pragma unroll
  for (int r = 1; r < 16; ++r) pmax = fmaxf(pmax, p0[r]);
#pragma unroll
  for (int r = 0; r < 16; ++r) pmax = fmaxf(pmax, p1[r]);
  { auto rr = __builtin_amdgcn_permlane32_swap(__float_as_uint(pmax), __float_as_uint(pmax), false, false);
    pmax = fmaxf(__uint_as_float(rr[0]), __uint_as_float(rr[1])); }
  if (__builtin_expect(__all(pmax - m_reg <= THR / SCALE), 1)) { mn = m_reg; alpha = 1.f; }
  else { mn = fmaxf(m_reg, pmax); alpha = __builtin_amdgcn_exp2f((m_reg - mn) * C); m_reg = mn; }
  float mnC = -mn * C;
#pragma unroll
  for (int r = 0; r < 16; ++r) p0[r] = fmaf(p0[r], C, mnC);
#pragma unroll
  for (int r = 0; r < 16; ++r) p1[r] = fmaf(p1[r], C, mnC);
#pragma unroll
  for (int r = 0; r < 16; ++r) p0[r] = __builtin_amdgcn_exp2f(p0[r]);
}
__device__ __forceinline__ void finishSM(f32x16& p0, f32x16& p1, float alpha, float& l_reg, bf16x8& pa0, bf16x8& pa1, bf16x8& pa2, bf16x8& pa3) {
#pragma unroll
  for (int r = 0; r < 16; ++r) p1[r] = __builtin_amdgcn_exp2f(p1[r]);
  float ps = 0;
#pragma unroll
  for (int r = 0; r < 16; ++r) ps += p0[r];
#pragma unroll
  for (int r = 0; r < 16; ++r) ps += p1[r];
  { auto rr = __builtin_amdgcn_permlane32_swap(__float_as_uint(ps), __float_as_uint(ps), false, false);
    ps = __uint_as_float(rr[0]) + __uint_as_float(rr[1]); }
  l_reg = l_reg * alpha + ps;
#define PK4(P, BASE, OUT) do { unsigned a0 = cvt_pk_bf16(P[BASE + 0], P[BASE + 1]), a1 = cvt_pk_bf16(P[BASE + 2], P[BASE + 3]);   \
    unsigned b0 = cvt_pk_bf16(P[BASE + 4], P[BASE + 5]), b1 = cvt_pk_bf16(P[BASE + 6], P[BASE + 7]);                              \
    auto r0 = __builtin_amdgcn_permlane32_swap(a0, b0, false, false); auto r1 = __builtin_amdgcn_permlane32_swap(a1, b1, false, false); \
    u32x4 w = {r0[0], r1[0], r0[1], r1[1]}; OUT = *reinterpret_cast<bf16x8*>(&w); } while (0)
  PK4(p0, 0, pa0); PK4(p0, 8, pa1); PK4(p1, 0, pa2); PK4(p1, 8, pa3);
#undef PK4
}
__device__ __forceinline__ void qkt(f32x16& p0, f32x16& p1, const bf16* Ks, const bf16x8* qr, int r32, int hi) {
  p0 = f32x16{}; p1 = f32x16{};
#pragma unroll
  for (int d0 = 0; d0 < 8; ++d0) { int cb = (d0 * 16 + hi * 8) * 2;
    bf16x8 b0 = *reinterpret_cast<const bf16x8*>((const char*)Ks + KSWZ(r32, cb));
    bf16x8 b1 = *reinterpret_cast<const bf16x8*>((const char*)Ks + KSWZ(32 + r32, cb));
    p0 = __builtin_amdgcn_mfma_f32_32x32x16_bf16(b0, qr[d0], p0, 0, 0, 0);
    p1 = __builtin_amdgcn_mfma_f32_32x32x16_bf16(b1, qr[d0], p1, 0, 0, 0); }
}
__device__ __forceinline__ int v_st(int k, int c) { const int kk = (k & ~0xC) | ((k & 4) << 1) | ((k & 8) >> 1); return ((kk >> 3) * 4 + (c >> 5)) * 512 + ((kk & 7) * 32 + (c & 31)) * 2; }
__device__ __forceinline__ int v_rd_base(int lane) { return ((lane & 3) << 3) | (((lane >> 2) & 3) << 6) | (((lane >> 4) & 1) << 5) | (((lane >> 5) & 1) << 8); }
constexpr int v_rd_off(int d0, int ks, int half) { return d0 * 512 + ks * 4096 + half * 2048; }
template <int OFF> __device__ __forceinline__ s16x4 tr_read(int vb) {
  s16x4 r; asm volatile("ds_read_b64_tr_b16 %0, %1 offset:%2" : "=&v"(r) : "v"(vb), "i"(OFF) : "memory"); return r;
}
template <int D0> __device__ __forceinline__ void pv_one(f32x16& od, int vb, bf16x8 pa0, bf16x8 pa1, bf16x8 pa2, bf16x8 pa3) {
  const s16x4 l0 = tr_read<v_rd_off(D0, 0, 0)>(vb), h0 = tr_read<v_rd_off(D0, 0, 1)>(vb), l1 = tr_read<v_rd_off(D0, 1, 0)>(vb), h1 = tr_read<v_rd_off(D0, 1, 1)>(vb);
  const s16x4 l2 = tr_read<v_rd_off(D0, 2, 0)>(vb), h2 = tr_read<v_rd_off(D0, 2, 1)>(vb), l3 = tr_read<v_rd_off(D0, 3, 0)>(vb), h3 = tr_read<v_rd_off(D0, 3, 1)>(vb);
  asm volatile("s_waitcnt lgkmcnt(0)" ::: "memory"); SBAR();
#define PK(L, H) (bf16x8){L[0], L[1], L[2], L[3], H[0], H[1], H[2], H[3]}
  od = __builtin_amdgcn_mfma_f32_32x32x16_bf16(pa0, PK(l0, h0), od, 0, 0, 0);
  od = __builtin_amdgcn_mfma_f32_32x32x16_bf16(pa1, PK(l1, h1), od, 0, 0, 0);
  od = __builtin_amdgcn_mfma_f32_32x32x16_bf16(pa2, PK(l2, h2), od, 0, 0, 0);
  od = __builtin_amdgcn_mfma_f32_32x32x16_bf16(pa3, PK(l3, h3), od, 0, 0, 0);
#undef PK
}
__device__ __forceinline__ void pv_d0(f32x16* o, int vb, bf16x8 pa0, bf16x8 pa1, bf16x8 pa2, bf16x8 pa3) {
  pv_one<0>(o[0], vb, pa0, pa1, pa2, pa3); pv_one<1>(o[1], vb, pa0, pa1, pa2, pa3); pv_one<2>(o[2], vb, pa0, pa1, pa2, pa3); pv_one<3>(o[3], vb, pa0, pa1, pa2, pa3);
}

template <int MODE, int SD>
__device__ __forceinline__ void attn_unit(const bf16* __restrict__ Qb, const bf16* __restrict__ Kh, const bf16* __restrict__ Vh, bf16* __restrict__ Ob, int NT, int dq0, float sink, char* lds,
                                          const f32x2* __restrict__ tab  , const float* __restrict__ gq  ) {
  int tid_ = threadIdx.x; asm volatile("" : "+v"(tid_));
  const int tid = tid_, wid = tid >> 6, lane = tid & 63, r32 = lane & 31, hi = lane >> 5;
  bf16* V_lds = (bf16*)lds; bf16* K_lds = (bf16*)(lds + 2 * SHM_V);
  float* ws = (float*)(lds + 2 * SHM_V + 2 * SHM_K) + wid * 64; float* li_l = ws; float* al_l = ws + 32;
  float m_reg = MODE ? sink * (1.0f / SCALE) : -1e30f, l_reg = MODE ? 1.0f : 0.0f; f32x16 o[4] = {}; bf16x8 qr[8];
  const bf16* Qw = Qb + (long)(wid * QBLK + r32) * LDQ + hi * 8;
#pragma unroll
  for (int d0 = 0; d0 < 8; ++d0) qr[d0] = *reinterpret_cast<const bf16x8*>(Qw + d0 * 16);
  {
    float rstd = 1.f;
    if constexpr (MODE == 0) {
      float ss = 0.f;
#pragma unroll
      for (int d0 = 0; d0 < 8; ++d0) { const u32x4 w = *reinterpret_cast<const u32x4*>(&qr[d0]);
        const float a0 = bf_lo(w.x), a1 = bf_hi(w.x), a2 = bf_lo(w.y), a3 = bf_hi(w.y), a4 = bf_lo(w.z), a5 = bf_hi(w.z), a6 = bf_lo(w.w), a7 = bf_hi(w.w);
        ss += (a0 * a0 + a1 * a1) + (a2 * a2 + a3 * a3) + (a4 * a4 + a5 * a5) + (a6 * a6 + a7 * a7); }
      { auto rr = __builtin_amdgcn_permlane32_swap(__float_as_uint(ss), __float_as_uint(ss), false, false); ss = __uint_as_float(rr[0]) + __uint_as_float(rr[1]); }
      rstd = 1.0f / sqrtf(ss * (1.0f / D) + EPS);
    }
    const f32x4* tp = (const f32x4*)(tab + (wid * QBLK + r32) * 64 + hi * 8);
#pragma unroll
    for (int d0 = 0; d0 < 4; ++d0) {
      const u32x4 w1 = *reinterpret_cast<const u32x4*>(&qr[d0]), w2 = *reinterpret_cast<const u32x4*>(&qr[d0 + 4]);
      float x1[8] = {bf_lo(w1.x), bf_hi(w1.x), bf_lo(w1.y), bf_hi(w1.y), bf_lo(w1.z), bf_hi(w1.z), bf_lo(w1.w), bf_hi(w1.w)};
      float x2[8] = {bf_lo(w2.x), bf_hi(w2.x), bf_lo(w2.y), bf_hi(w2.y), bf_lo(w2.z), bf_hi(w2.z), bf_lo(w2.w), bf_hi(w2.w)};
      if constexpr (MODE == 0) {
        const f32x4 g1a = *(const f32x4*)(gq + d0 * 16 + hi * 8), g1b = *(const f32x4*)(gq + d0 * 16 + hi * 8 + 4), g2a = *(const f32x4*)(gq + 64 + d0 * 16 + hi * 8), g2b = *(const f32x4*)(gq + 64 + d0 * 16 + hi * 8 + 4);
        const float g1[8] = {g1a.x, g1a.y, g1a.z, g1a.w, g1b.x, g1b.y, g1b.z, g1b.w}, g2[8] = {g2a.x, g2a.y, g2a.z, g2a.w, g2b.x, g2b.y, g2b.z, g2b.w};
#pragma unroll
        for (int e = 0; e < 8; ++e) { x1[e] = x1[e] * rstd * g1[e]; x2[e] = x2[e] * rstd * g2[e]; }
      }
      float o1[8], o2[8];
#pragma unroll
      for (int e2 = 0; e2 < 4; ++e2) { const f32x4 cs = tp[d0 * 8 + e2];
        o1[2 * e2] = x1[2 * e2] * cs.x - x2[2 * e2] * cs.y; o2[2 * e2] = x2[2 * e2] * cs.x + x1[2 * e2] * cs.y;
        o1[2 * e2 + 1] = x1[2 * e2 + 1] * cs.z - x2[2 * e2 + 1] * cs.w; o2[2 * e2 + 1] = x2[2 * e2 + 1] * cs.z + x1[2 * e2 + 1] * cs.w; }
      u32x4 p1, p2; p1.x = cvt_pk_bf16(o1[0], o1[1]); p1.y = cvt_pk_bf16(o1[2], o1[3]); p1.z = cvt_pk_bf16(o1[4], o1[5]); p1.w = cvt_pk_bf16(o1[6], o1[7]);
      p2.x = cvt_pk_bf16(o2[0], o2[1]); p2.y = cvt_pk_bf16(o2[2], o2[3]); p2.z = cvt_pk_bf16(o2[4], o2[5]); p2.w = cvt_pk_bf16(o2[6], o2[7]);
      qr[d0] = *reinterpret_cast<bf16x8*>(&p1); qr[d0 + 4] = *reinterpret_cast<bf16x8*>(&p2);
    }
  }
  const int sr = tid >> 4, sc = (tid & 15) * 8, vst0 = v_st(sr, sc), vst1 = v_st(32 + sr, sc);
  const int vb0 = (int)(uintptr_t)V_lds + v_rd_base(lane);
  const int mb0 = dq0 + wid * QBLK + r32 + 128 - 4 * hi;
  struct { bf16x8 vs0, vs1, ks0, ks1; } sr_[SD];
#define SLOAD(i, k0) do { sr_[i].vs0 = *reinterpret_cast<const bf16x8*>(&Vh[(long)((k0) + sr) * LDK + sc]); sr_[i].vs1 = *reinterpret_cast<const bf16x8*>(&Vh[(long)((k0) + 32 + sr) * LDK + sc]); \
    sr_[i].ks0 = *reinterpret_cast<const bf16x8*>(&Kh[(long)((k0) + sr) * LDK + sc]); sr_[i].ks1 = *reinterpret_cast<const bf16x8*>(&Kh[(long)((k0) + 32 + sr) * LDK + sc]); } while (0)
#define SWRITE(b, i) do { *(bf16x8*)((char*)V_lds + (b) * SHM_V + vst0) = sr_[i].vs0;          \
    *(bf16x8*)((char*)V_lds + (b) * SHM_V + vst1) = sr_[i].vs1; int kc = sc * 2;               \
    *(bf16x8*)((char*)K_lds + (b) * SHM_K + KSWZ(sr, kc)) = sr_[i].ks0;                       \
    *(bf16x8*)((char*)K_lds + (b) * SHM_K + KSWZ(32 + sr, kc)) = sr_[i].ks1; } while (0)
#define SWAIT() do { if constexpr (SD == 2) asm volatile("s_waitcnt vmcnt(4)" ::: "memory"); else asm volatile("s_waitcnt vmcnt(0)" ::: "memory"); } while (0)
#define RESC(a) do { if (__any((a) < 1.f)) { if (hi == 0) al_l[r32] = (a); asm volatile("s_waitcnt lgkmcnt(0)" ::: "memory"); \
    _Pragma("unroll") for (int d = 0; d < 4; ++d) _Pragma("unroll") for (int r = 0; r < 16; ++r) o[d][r] *= al_l[crow(r, hi)]; } } while (0)
#define PSM(P0, P1, MN, AL, J) partialSM<MODE != 0>(P0, P1, m_reg, MN, AL, mb0 - 64 * (J))
  f32x16 pA0, pA1, pB0, pB1; float mnA, mnB, alA, alB; bf16x8 pa0, pa1, pa2, pa3;
  constexpr int SE = 0, SO = SD - 1;
  SLOAD(SE, 0); asm volatile("s_waitcnt vmcnt(0)" ::: "memory"); SWRITE(0, SE); __syncthreads();
  qkt(pA0, pA1, K_lds, qr, r32, hi); PSM(pA0, pA1, mnA, alA, 0);
  SLOAD(SO, KVBLK); if constexpr (SD == 2) { if (2 < NT) SLOAD(SE, 2 * KVBLK); }
  SWAIT(); SWRITE(1, SO); __syncthreads();
  for (int j = 1; j + 1 < NT; j += 2) {
    SBAR(); qkt(pB0, pB1, (bf16*)((char*)K_lds + SHM_K), qr, r32, hi);
    finishSM(pA0, pA1, alA, l_reg, pa0, pa1, pa2, pa3); SBAR();
    SLOAD(SO, (j + SD) * KVBLK); SBAR();
    pv_d0(o, vb0, pa0, pa1, pa2, pa3); PSM(pB0, pB1, mnB, alB, j);
    __syncthreads(); SWAIT(); SWRITE(0, SE);
    RESC(alB); __syncthreads();
    SBAR(); qkt(pA0, pA1, K_lds, qr, r32, hi);
    finishSM(pB0, pB1, alB, l_reg, pa0, pa1, pa2, pa3); SBAR();
    if (SD == 1 || j + 3 < NT) SLOAD(SE, (j + 1 + SD) * KVBLK); SBAR();
    pv_d0(o, vb0 + (int)SHM_V, pa0, pa1, pa2, pa3); PSM(pA0, pA1, mnA, alA, j + 1);
    __syncthreads(); SWAIT(); SWRITE(1, SO);
    RESC(alA); __syncthreads();
  }
  SBAR(); qkt(pB0, pB1, (bf16*)((char*)K_lds + SHM_K), qr, r32, hi);
  finishSM(pA0, pA1, alA, l_reg, pa0, pa1, pa2, pa3); SBAR();
  pv_d0(o, vb0, pa0, pa1, pa2, pa3); PSM(pB0, pB1, mnB, alB, NT - 1);
  __syncthreads(); RESC(alB);
  finishSM(pB0, pB1, alB, l_reg, pa0, pa1, pa2, pa3); SBAR();
  pv_d0(o, vb0 + (int)SHM_V, pa0, pa1, pa2, pa3);
  if (hi == 0) li_l[r32] = l_reg; asm volatile("s_waitcnt lgkmcnt(0)" ::: "memory");
  float rli[16];
#pragma unroll
  for (int r = 0; r < 16; ++r) rli[r] = __builtin_amdgcn_rcpf(li_l[crow(r, hi)]);
  char* ost = lds + OST_OFF + wid * (32 * OST_PITCH);
#pragma unroll
  for (int r = 0; r < 16; ++r) { const int orow = crow(r, hi);
#pragma unroll
    for (int d0 = 0; d0 < 4; ++d0) { const float v = o[d0][r] * rli[r]; *(bf16*)(ost + orow * OST_PITCH + (d0 * 32 + r32) * 2) = (bf16)(cvt_pk_bf16(v, v) & 0xffffu); } }
  asm volatile("s_waitcnt lgkmcnt(0)" ::: "memory");
  bf16* Ow = Ob + (long)(wid * QBLK) * LDO;
#pragma unroll
  for (int i = 0; i < 8; ++i) { const int row = (lane >> 4) + 4 * i, cc = (lane & 15);
    const u32x4 w = *(const u32x4*)(ost + row * OST_PITCH + cc * 16);
    *(u32x4*)(Ow + (long)row * LDO + cc * 8) = w; }
  __syncthreads();
#undef SLOAD
#undef SWRITE
#undef SWAIT
#undef RESC
#undef PSM
}
}

#define XB_TMO      128
#define XB_XCNT(j)  (256  + 64 * (j))
#define XB_XSUB(j)  (1280 + 64 * (j))
#define XB_XGEN(j)  (2304 + 64 * (j))
#define XB_TOP      3328
#define XB_TOPGEN   3392
#define XCD_BAR_WORDS 3456
#define XB_SPIN_CAP (1u << 20)
__device__ __forceinline__ unsigned xb_ld(unsigned* p)              { return __hip_atomic_load(p, __ATOMIC_RELAXED, __HIP_MEMORY_SCOPE_AGENT); }
__device__ __forceinline__ unsigned xb_add(unsigned* p, unsigned v) { return __hip_atomic_fetch_add(p, v, __ATOMIC_RELAXED, __HIP_MEMORY_SCOPE_AGENT); }
__device__ __forceinline__ unsigned xb_xcc_id() { return (unsigned)__builtin_amdgcn_s_getreg((3 << 11) | 20) & 0xFu; }
#define XB_SPIN(cond, bar) do { unsigned _sp = 0; while (cond) { __builtin_amdgcn_s_sleep(1); \
    if ((++_sp & 255u) == 0u) { if (xb_ld(&(bar)[XB_TMO])) break; if (_sp > XB_SPIN_CAP) { atomicAdd(&(bar)[XB_TMO], 1u); break; } } } } while (0)
struct XcdBarrier { unsigned* bar; unsigned x; volatile LAS unsigned* st; };
__device__ __forceinline__ XcdBarrier xcd_barrier_post(unsigned* bar, volatile LAS unsigned* st) {
    XcdBarrier b; b.bar = bar; b.x = xb_xcc_id(); b.st = st;
    if (threadIdx.x == 0) (void)xb_add(&bar[XB_XCNT(b.x)], 1u);
    return b;
}
__device__ __forceinline__ void xcd_barrier_complete(unsigned* bar, unsigned x, unsigned& nloc, unsigned& nx) {
    const unsigned G = gridDim.x * gridDim.y * gridDim.z;
    unsigned sum, cnt, mine, sp = 0u;
    for (;;) {
        sum = 0u; cnt = 0u; mine = 0u;
#pragma unroll
        for (unsigned j = 0; j < 16; ++j) { const unsigned c = xb_ld(&bar[XB_XCNT(j)]); sum += c; cnt += (c > 0u) ? 1u : 0u; mine = (j == x) ? c : mine; }
        if (sum == G) break;
        __builtin_amdgcn_s_sleep(1);
        if ((++sp & 255u) == 0u) { if (xb_ld(&bar[XB_TMO])) break; if (sp > XB_SPIN_CAP) { atomicAdd(&bar[XB_TMO], 1u); break; } }
    }
    nloc = mine > 0u ? mine : 1u; nx = cnt > 0u ? cnt : 1u;
}
__device__ __forceinline__ void xcd_barrier(const XcdBarrier& b) {
    asm volatile("s_waitcnt vmcnt(0)" ::: "memory");
    __syncthreads();
    if (threadIdx.x == 0) {
        unsigned* bar = b.bar;
        __builtin_amdgcn_s_waitcnt(0);
        unsigned nloc = b.st[0], nx = b.st[1];
        if (nloc == 0u) { xcd_barrier_complete(bar, b.x, nloc, nx); b.st[0] = nloc; b.st[1] = nx; }
        const unsigned old = xb_add(&bar[XB_XSUB(b.x)], 1u);
        const unsigned gen = old / nloc;
        if (old + 1u == (gen + 1u) * nloc) {
            __builtin_amdgcn_fence(__ATOMIC_RELEASE, "agent");
            asm volatile("s_waitcnt vmcnt(0)" ::: "memory");
            const unsigned og = xb_add(&bar[XB_TOP], 1u);
            const unsigned tg = og / nx;
            if (og + 1u == (tg + 1u) * nx) xb_add(&bar[XB_TOPGEN], 1u);
            else XB_SPIN(xb_ld(&bar[XB_TOPGEN]) == tg, bar);
            __builtin_amdgcn_fence(__ATOMIC_ACQUIRE, "agent");
            xb_add(&bar[XB_XGEN(b.x)], 1u);
            asm volatile("s_waitcnt vmcnt(0)" ::: "memory");
        } else {
            XB_SPIN(xb_ld(&bar[XB_XGEN(b.x)]) == gen, bar);
            __builtin_amdgcn_fence(__ATOMIC_ACQUIRE, "agent");
            asm volatile("s_waitcnt vmcnt(0)" ::: "memory");
        }
    }
    __syncthreads();
}

__device__ __forceinline__ void transpose_item(const float* W, int K, int N, bf16* WT, LAS float* scr, int item, int lane, const float* gk = nullptr) {
    const int nblk = N / 32, kb = item / nblk, nb = item % nblk, k0 = 64 * kb, n0 = 32 * nb;
#pragma unroll 8
    for (int i = 0; i < 32; ++i) { const int kk = 2 * i + (lane >> 5); scr[kk * 33 + (lane & 31)] = W[(size_t)(k0 + kk) * N + n0 + (lane & 31)] * (gk ? gk[k0 + kk] : 1.0f); }
    asm volatile("s_waitcnt lgkmcnt(0)" ::: "memory");
    const int c = lane & 7;
#pragma unroll
    for (int j = 0; j < 4; ++j) { const int n = (lane >> 3) + 8 * j; const LAS float* s = scr + (8 * c) * 33 + n;
        u32x4 o; o.x = cvt_pk_bf16(s[0 * 33], s[1 * 33]); o.y = cvt_pk_bf16(s[2 * 33], s[3 * 33]); o.z = cvt_pk_bf16(s[4 * 33], s[5 * 33]); o.w = cvt_pk_bf16(s[6 * 33], s[7 * 33]);
        *(u32x4*)(WT + (size_t)(n0 + n) * K + k0 + 8 * c) = o; }
    asm volatile("s_waitcnt lgkmcnt(0)" ::: "memory");
}

struct Args { const float* in[21]; float* out; unsigned char* ws; int lo, hi; };

__device__ __forceinline__ const float* x_in_row(const float* xp, const float* xs, int row) {
    return row < NPROMPT_TOK ? xp + (size_t)row * DM : xs + (size_t)(row - NPROMPT_TOK) * DM;
}

__device__ __forceinline__ void phase_weights(const CAS Args* a, unsigned char* ws, int l, LAS unsigned char* lds, int gw, int NGW, int wave, int lane) {
    LAS float* scr = (LAS float*)(lds + wave * 16384);
    constexpr int I_IN = (DM / 64) * (INW / 32), I_BR = (MWD / 64) * (DM / 32), I_OUT = (DM / 64) * (DM / 32), I_F1 = (DM / 64) * (FFD / 32), I_F2 = (FFD / 64) * (DM / 32), I_G = 32 * 8;
    constexpr int NITEMS = I_IN + 3 * I_BR + I_OUT + I_F1 + I_F2 + I_G;
    for (int it = gw; it < NITEMS; it += NGW) {
        int r = it;
        if (r < I_IN) { transpose_item(a->in[6] + (size_t)l * DM * INW, DM, INW, (bf16*)(ws + WS_WIN), scr, r, lane, a->in[2] + (size_t)l * DM); continue; } r -= I_IN;
        if (r < 3 * I_BR) { const int b = r / I_BR; transpose_item(a->in[17] + ((size_t)l * 3 + b) * MWD * DM, MWD, DM, (bf16*)(ws + WS_WBR) + (size_t)b * DM * MWD, scr, r - b * I_BR, lane); continue; } r -= 3 * I_BR;
        if (r < I_OUT) { transpose_item(a->in[18] + (size_t)l * DM * DM, DM, DM, (bf16*)(ws + WS_WOUT), scr, r, lane); continue; } r -= I_OUT;
        if (r < I_F1) { transpose_item(a->in[19] + (size_t)l * DM * FFD, DM, FFD, (bf16*)(ws + WS_W1), scr, r, lane, a->in[4] + (size_t)l * DM); continue; } r -= I_F1;
        if (r < I_F2) { transpose_item(a->in[20] + (size_t)l * FFD * DM, FFD, DM, (bf16*)(ws + WS_W2), scr, r, lane); continue; } r -= I_F2;
        { const int mi = r >> 3, sub = r & 7;
          const int gate = mi >> 4, dd = (mi >> 3) & 1, blk = mi & 7;
          const float* src = (gate ? a->in[14] : a->in[12]) + (((size_t)l * 2 + dd) * 8 + blk) * 16384;
          transpose_item(src, 128, 128, (bf16*)(ws + WS_WG) + ((size_t)(dd * 2 + gate) * 8 + blk) * 16384, scr, sub, lane); }
    }
}

__device__ __forceinline__ void entry_row(const float* xrow, bf16* xb, float* rs, int lane) {
    const f32x4* xr = (const f32x4*)xrow + lane;
    f32x4 v[8]; float s = 0.f;
#pragma unroll
    for (int j = 0; j < 8; ++j) { v[j] = xr[64 * j]; s += (v[j].x * v[j].x + v[j].y * v[j].y) + (v[j].z * v[j].z + v[j].w * v[j].w); }
    u32x2* o8 = (u32x2*)xb + lane;
#pragma unroll
    for (int j = 0; j < 8; ++j) { u32x2 w; w.x = cvt_pk_bf16(v[j].x, v[j].y); w.y = cvt_pk_bf16(v[j].z, v[j].w); o8[64 * j] = w; }
    const float tot = wave_sum(s, lane);
    if (lane == 0) *rs = __builtin_amdgcn_rsqf(tot * (1.0f / DM) + EPS);
}
template <bool LAST>
__device__ __forceinline__ void resid_norm_row(const bf16* yrow, bf16* xrow, const float* g, float* rs, float* outrow, int lane) {
    float y[32], x[32]; float s = 0.f;
#pragma unroll
    for (int j = 0; j < 4; ++j) { const u32x4 w = ((const u32x4*)yrow)[64 * j + lane];
        y[8 * j + 0] = bf_lo(w.x); y[8 * j + 1] = bf_hi(w.x); y[8 * j + 2] = bf_lo(w.y); y[8 * j + 3] = bf_hi(w.y); y[8 * j + 4] = bf_lo(w.z); y[8 * j + 5] = bf_hi(w.z); y[8 * j + 6] = bf_lo(w.w); y[8 * j + 7] = bf_hi(w.w); }
#pragma unroll
    for (int j = 0; j < 4; ++j) { const u32x4 w = ((const u32x4*)xrow)[64 * j + lane];
        x[8 * j + 0] = bf_lo(w.x); x[8 * j + 1] = bf_hi(w.x); x[8 * j + 2] = bf_lo(w.y); x[8 * j + 3] = bf_hi(w.y); x[8 * j + 4] = bf_lo(w.z); x[8 * j + 5] = bf_hi(w.z); x[8 * j + 6] = bf_lo(w.w); x[8 * j + 7] = bf_hi(w.w); }
#pragma unroll
    for (int i = 0; i < 32; ++i) s += y[i] * y[i];
    const float rstd = __builtin_amdgcn_rsqf(wave_sum(s, lane) * (1.0f / DM) + EPS);
    float s2 = 0.f;
#pragma unroll
    for (int j = 0; j < 4; ++j) { const f32x4 g0 = ((const f32x4*)g)[2 * (64 * j + lane)], g1 = ((const f32x4*)g)[2 * (64 * j + lane) + 1];
        const float gg[8] = {g0.x, g0.y, g0.z, g0.w, g1.x, g1.y, g1.z, g1.w};
#pragma unroll
        for (int e = 0; e < 8; ++e) { const float v = x[8 * j + e] + y[8 * j + e] * rstd * gg[e]; x[8 * j + e] = v; s2 += v * v; } }
    if constexpr (LAST) {
#pragma unroll
        for (int j = 0; j < 4; ++j) { ((f32x4*)outrow)[2 * (64 * j + lane)] = (f32x4){x[8 * j], x[8 * j + 1], x[8 * j + 2], x[8 * j + 3]}; ((f32x4*)outrow)[2 * (64 * j + lane) + 1] = (f32x4){x[8 * j + 4], x[8 * j + 5], x[8 * j + 6], x[8 * j + 7]}; }
    } else {
#pragma unroll
        for (int j = 0; j < 4; ++j) { u32x4 w; w.x = cvt_pk_bf16(x[8 * j], x[8 * j + 1]); w.y = cvt_pk_bf16(x[8 * j + 2], x[8 * j + 3]); w.z = cvt_pk_bf16(x[8 * j + 4], x[8 * j + 5]); w.w = cvt_pk_bf16(x[8 * j + 6], x[8 * j + 7]);
            ((u32x4*)xrow)[64 * j + lane] = w; }
        const float r2 = __builtin_amdgcn_rsqf(wave_sum(s2, lane) * (1.0f / DM) + EPS);
        if (lane == 0) *rs = r2;
    }
}

__device__ __forceinline__ void krope_token(bf16* prow, const f32x2* taba, const f32x2* tab1, const float* kn, int lane) {
    const f32x2 csa = taba[lane], cs1 = tab1[lane];
    const float kg1 = kn[lane], kg2 = kn[64 + lane];
#pragma unroll
    for (int h = 0; h < 2; ++h) {
        bf16* p = prow + KA_OFF + h * HD;
        const float x1 = bf2f(p[lane]), x2 = bf2f(p[64 + lane]);
        const float rstd = 1.0f / sqrtf(wave_sum(x1 * x1 + x2 * x2, lane) * (1.0f / HD) + EPS);
        const float y1 = x1 * rstd * kg1, y2 = x2 * rstd * kg2;
        const float o1 = y1 * csa.x - y2 * csa.y, o2 = y2 * csa.x + y1 * csa.y;
        p[lane] = (bf16)(cvt_pk_bf16(o1, o1) & 0xffffu); p[64 + lane] = (bf16)(cvt_pk_bf16(o2, o2) & 0xffffu);
    }
#pragma unroll
    for (int h = 0; h < 2; ++h) {
        bf16* p = prow + KB_OFF + h * HD;
        const float x1 = bf2f(p[lane]), x2 = bf2f(p[64 + lane]);
        const float o1 = x1 * cs1.x - x2 * cs1.y, o2 = x2 * cs1.x + x1 * cs1.y;
        p[lane] = (bf16)(cvt_pk_bf16(o1, o1) & 0xffffu); p[64 + lane] = (bf16)(cvt_pk_bf16(o2, o2) & 0xffffu);
    }
}
__device__ __forceinline__ void rope_tables(f32x2* tab1, f32x2* taba, int gtid, int nthr) {
    for (int i = gtid; i < SEQ * 64; i += nthr) {
        const int pos = i >> 6, j = i & 63;
        const double rev1 = (double)pos * ROPE_F1[j];
        const double reva = (double)(j < 32 ? (pos >> 6) : (pos & 63)) * ROPE_FA[j & 31];
        const float f1 = (float)(rev1 - __builtin_floor(rev1)), fa = (float)(reva - __builtin_floor(reva));
        tab1[i] = (f32x2){__builtin_amdgcn_cosf(f1), __builtin_amdgcn_sinf(f1)};
        taba[i] = (f32x2){__builtin_amdgcn_cosf(fa), __builtin_amdgcn_sinf(fa)};
    }
}

struct CParams { const float* conv_w; const float* conv_b; const float* gate_r_b; const float* gate_i_b; const float* lam; const bf16* WG; };
constexpr int CSPAN = 512, NSPAN = SEQ / CSPAN;
template <int PASS, int DIR>
__device__ __forceinline__ void c_sweep(LAS unsigned char* lds, const bf16* P, bf16* OC, const CParams& cp, f32x2* SUM, int seq, int nb, int sp) {
    constexpr int UP = 136;
    LAS bf16* U = (LAS bf16*)lds;
    LAS float* AD = (LAS float*)(lds + 32768);
    int tid_ = threadIdx.x; asm volatile("" : "+v"(tid_));
    const int tid = tid_, wave = tid >> 6, lane = tid & 63;
    const int t0 = tid >> 4, c8 = (tid & 15) * 8, cg8 = nb * 128 + c8;
    LAS float* CW = (LAS float*)(lds + 32768 + 65536);
    for (int i = tid; i < 5 * 128; i += 512) CW[i] = (i < 512) ? cp.conv_w[(i >> 7) * MWD + nb * 128 + (i & 127)] : cp.conv_b[nb * 128 + (i & 127)];
    const int q = wave & 3, th = wave >> 2, r = lane & 31, h = lane >> 5;
    bf16x8 bfr[8], bfi[8];
    { const bf16* wrp = cp.WG + ((size_t)((DIR * 2 + 0) * 8 + nb) * 128 + 32 * q + r) * 128 + 8 * h;
      const bf16* wip = cp.WG + ((size_t)((DIR * 2 + 1) * 8 + nb) * 128 + 32 * q + r) * 128 + 8 * h;
#pragma unroll
      for (int ks = 0; ks < 8; ++ks) { bfr[ks] = *(const bf16x8*)(wrp + 16 * ks); bfi[ks] = *(const bf16x8*)(wip + 16 * ks); } }
    const int ch = 32 * q + r, cg = nb * 128 + ch;
    constexpr float L2E = 1.4426950408889634f;
    const float rbn = -L2E * cp.gate_r_b[DIR * MWD + cg], ibn = -L2E * cp.gate_i_b[DIR * MWD + cg], lam = cp.lam[DIR * MWD + cg];
    const float el = __builtin_amdgcn_exp2f(-L2E * lam);
    const float ls8 = -8.0f * (lam > 3.0f ? el * (1.0f - el * (0.5f - el * (1.0f / 3.0f))) : 0.6931471805599453f * __builtin_amdgcn_logf(1.0f + el));
    const f32x2 ls8e = {ls8 * L2E, ls8 * L2E}, ls82 = {2.0f * ls8, 2.0f * ls8}, rbn2 = {rbn, rbn}, ibn2 = {ibn, ibn};
    float hh = 0.f, pp = 1.f;
    if constexpr (PASS == 3) {
        if (tid < 128) {
            const f32x2* sb = SUM + ((size_t)(seq * NSPAN) * 2 + DIR) * MWD + nb * 128 + tid;
            f32x2 sv[NSPAN];
#pragma unroll
            for (int s = 0; s < NSPAN; ++s) sv[s] = sb[(size_t)s * 2 * MWD];
#pragma unroll
            for (int s = 0; s < NSPAN; ++s) { const int ss = DIR ? NSPAN - 1 - s : s; const bool use = DIR ? (ss > sp) : (ss < sp); hh = use ? sv[ss].x * hh + sv[ss].y : hh; }
        }
    }
    const size_t rowbase = (size_t)seq * SEQ + (size_t)sp * CSPAN;
    const int posbase = sp * CSPAN;
    u32x4 xw[2][4];
#define C_LOADX(tile) do { _Pragma("unroll") for (int hf = 0; hf < 2; ++hf) _Pragma("unroll") for (int j = 0; j < 4; ++j) { const int tt = posbase + (tile) * 64 + t0 + 32 * hf - 2 + j; \
        const int ttc = tt < 0 ? 0 : (tt >= SEQ ? SEQ - 1 : tt); const u32x4 xv = *(const u32x4*)(P + ((size_t)seq * SEQ + ttc) * PWD + XC_OFF + cg8); \
        const unsigned keep = (tt >= 0 && tt < SEQ) ? 0xffffffffu : 0u; xw[hf][j] = (u32x4){xv.x & keep, xv.y & keep, xv.z & keep, xv.w & keep}; } } while (0)
    C_LOADX(DIR ? 7 : 0);
    __syncthreads();
    for (int it = 0; it < 8; ++it) {
        const int tile = DIR ? 7 - it : it;
#pragma unroll
        for (int hf = 0; hf < 2; ++hf) {
            float u8[8];
            { const f32x4 b0 = *(const LAS f32x4*)(CW + 512 + c8), b1 = *(const LAS f32x4*)(CW + 512 + c8 + 4); u8[0] = b0.x; u8[1] = b0.y; u8[2] = b0.z; u8[3] = b0.w; u8[4] = b1.x; u8[5] = b1.y; u8[6] = b1.z; u8[7] = b1.w; }
#pragma unroll
            for (int j = 0; j < 4; ++j) { const u32x4 x = xw[hf][j]; const f32x4 w0 = *(const LAS f32x4*)(CW + j * 128 + c8), w1 = *(const LAS f32x4*)(CW + j * 128 + c8 + 4);
                u8[0] += bf_lo(x.x) * w0.x; u8[1] += bf_hi(x.x) * w0.y; u8[2] += bf_lo(x.y) * w0.z; u8[3] += bf_hi(x.y) * w0.w;
                u8[4] += bf_lo(x.z) * w1.x; u8[5] += bf_hi(x.z) * w1.y; u8[6] += bf_lo(x.w) * w1.z; u8[7] += bf_hi(x.w) * w1.w; }
            u32x4 w; w.x = cvt_pk_bf16(u8[0], u8[1]); w.y = cvt_pk_bf16(u8[2], u8[3]); w.z = cvt_pk_bf16(u8[4], u8[5]); w.w = cvt_pk_bf16(u8[6], u8[7]);
            *(LAS u32x4*)(U + (t0 + 32 * hf) * UP + c8) = w;
        }
        if (it < 7) C_LOADX(DIR ? 6 - it : it + 1);
        __syncthreads();
        {
            f32x16 accr = {}, acci = {};
#pragma unroll
            for (int ks = 0; ks < 8; ++ks) {
                const bf16x8 af = *(const LAS bf16x8*)(U + (32 * th + r) * UP + 16 * ks + 8 * h);
                accr = __builtin_amdgcn_mfma_f32_32x32x16_bf16(af, bfr[ks], accr, 0, 0, 0);
                acci = __builtin_amdgcn_mfma_f32_32x32x16_bf16(af, bfi[ks], acci, 0, 0, 0);
            }
            LAS float* pa = AD + ch; LAS float* pd = AD + 64 * 128 + ch;
#pragma unroll
            for (int reg = 0; reg < 16; reg += 2) {
                const int tt = 32 * th + (reg & 3) + 8 * (reg >> 2) + 4 * h;
                const f32x2 er = (f32x2){accr[reg], accr[reg + 1]} * (-L2E) + rbn2, ei = (f32x2){acci[reg], acci[reg + 1]} * (-L2E) + ibn2;
                f32x2 rr, ii; rr.x = __builtin_amdgcn_rcpf(1.0f + __builtin_amdgcn_exp2f(er.x)); rr.y = __builtin_amdgcn_rcpf(1.0f + __builtin_amdgcn_exp2f(er.y));
                ii.x = __builtin_amdgcn_rcpf(1.0f + __builtin_amdgcn_exp2f(ei.x)); ii.y = __builtin_amdgcn_rcpf(1.0f + __builtin_amdgcn_exp2f(ei.y));
                const f32x2 le = ls8e * rr, x2 = ls82 * rr;
                f32x2 av; av.x = __builtin_amdgcn_exp2f(le.x); av.y = __builtin_amdgcn_exp2f(le.y);
                const f32x2 pol = -x2 * (1.0f + x2 * (0.5f + x2 * ((1.0f / 6.0f) + x2 * ((1.0f / 24.0f) + x2 * (1.0f / 120.0f))))), dir = 1.0f - av * av;
                f32x2 om; om.x = x2.x > -0.25f ? pol.x : dir.x; om.y = x2.y > -0.25f ? pol.y : dir.y;
                const f32x2 uf = {bf2f(U[tt * UP + ch]), bf2f(U[(tt + 1) * UP + ch])};
                f32x2 sq; sq.x = __builtin_amdgcn_sqrtf(om.x); sq.y = __builtin_amdgcn_sqrtf(om.y);
                const f32x2 dr = sq * (ii * uf);
                pa[tt * 128] = av.x; pa[(tt + 1) * 128] = av.y; pd[tt * 128] = dr.x; pd[(tt + 1) * 128] = dr.y;
            }
        }
        u32x4 yw[2], ow[2];
        if constexpr (PASS == 3) {
#pragma unroll
            for (int hf = 0; hf < 2; ++hf) { const size_t row = rowbase + tile * 64 + t0 + 32 * hf; yw[hf] = *(const u32x4*)(P + row * PWD + YC_OFF + cg8);
                if constexpr (DIR == 1) ow[hf] = *(const u32x4*)(OC + row * MWD + cg8); }
        }
        __syncthreads();
        if (tid < 128) {
            LAS float* pa = AD + tid; LAS float* pd = AD + 64 * 128 + tid;
#pragma unroll
            for (int s0 = 0; s0 < 64; s0 += 16) {
                float av[16], dv[16];
#pragma unroll
                for (int s = 0; s < 16; ++s) { const int t = DIR ? 63 - (s0 + s) : (s0 + s); av[s] = pa[t * 128]; dv[s] = pd[t * 128]; }
#pragma unroll
                for (int s = 0; s < 16; ++s) { hh = av[s] * hh + dv[s]; if constexpr (PASS == 1) pp *= av[s]; else dv[s] = hh; }
                if constexpr (PASS == 3) {
#pragma unroll
                    for (int s = 0; s < 16; ++s) { const int t = DIR ? 63 - (s0 + s) : (s0 + s); pa[t * 128] = dv[s]; } }
            }
        }
        if constexpr (PASS == 3) {
            __syncthreads();
#pragma unroll
            for (int hf = 0; hf < 2; ++hf) { const int t = t0 + 32 * hf; const size_t row = rowbase + tile * 64 + t;
                const u32x4 y4 = yw[hf];
                const float y[8] = {bf_lo(y4.x), bf_hi(y4.x), bf_lo(y4.y), bf_hi(y4.y), bf_lo(y4.z), bf_hi(y4.z), bf_lo(y4.w), bf_hi(y4.w)};
                const LAS float* hp = AD + t * 128 + c8;
                float o[8];
#pragma unroll
                for (int j = 0; j < 8; ++j) { const float z = 0.7978845608028654f * (y[j] + 0.044715f * y[j] * y[j] * y[j]);
                    o[j] = hp[j] * (y[j] * fast_sigmoid(2.0f * z)); }
                if constexpr (DIR == 1) { const u32x4 p4 = ow[hf]; o[0] += bf_lo(p4.x); o[1] += bf_hi(p4.x); o[2] += bf_lo(p4.y); o[3] += bf_hi(p4.y); o[4] += bf_lo(p4.z); o[5] += bf_hi(p4.z); o[6] += bf_lo(p4.w); o[7] += bf_hi(p4.w); }
                u32x4 w; w.x = cvt_pk_bf16(o[0], o[1]); w.y = cvt_pk_bf16(o[2], o[3]); w.z = cvt_pk_bf16(o[4], o[5]); w.w = cvt_pk_bf16(o[6], o[7]);
                *(u32x4*)(OC + row * MWD + cg8) = w; }
        }
    }
#undef C_LOADX
    if constexpr (PASS == 1) { if (tid < 128) SUM[((size_t)(seq * NSPAN + sp) * 2 + DIR) * MWD + nb * 128 + tid] = (f32x2){pp, hh}; }
    __syncthreads();
}

__global__ void __launch_bounds__(512, 2) mk_fwd(Args args) {
    extern __shared__ __attribute__((aligned(16))) unsigned char lds_raw[];
    LAS unsigned char* lds = (LAS unsigned char*)lds_raw;
    {
        volatile LAS unsigned* MISC = (volatile LAS unsigned*)(lds + MISC_OFF);
        for (int u = threadIdx.x; u < (LDS_BYTES - MISC_OFF) / 4; u += 512) MISC[u] = 0u;
        __syncthreads();
    }
#if MK_SINGLE
    XcdBarrier bar = xcd_barrier_post((unsigned*)(args.ws + WS_CTL) + CW_BAR, (volatile LAS unsigned*)(lds + MISC_OFF) + 8);
#define GRID_BAR() xcd_barrier(bar)
#else
#define GRID_BAR() do {} while (0)
#endif
    const int lo = args.lo, hi = args.hi;
    int step = 0;
#define RUN(k) (lo <= (k) && (k) < hi)
#define SEAM(k) do { if (RUN((k) + 1)) GRID_BAR(); } while (0)
#define PHASE_ENTER() int tid = threadIdx.x; asm volatile("" : "+v"(tid)); int bx = blockIdx.x; asm volatile("" : "+s"(bx)); int G = gridDim.x; asm volatile("" : "+s"(G)); const int NGW = G * 8; (void)NGW; \
    const int lane = tid & 63, wave = __builtin_amdgcn_readfirstlane(tid >> 6), gw = bx * 8 + wave; \
    const CAS Args* ap = (const CAS Args*)__builtin_amdgcn_kernarg_segment_ptr(); asm volatile("" : "+s"(ap)); \
    unsigned char* ws = ap->ws; float* out = ap->out; (void)lane; (void)gw; (void)out; \
    bf16* const P = (bf16*)(ws + WS_P); bf16* const Y = (bf16*)(ws + WS_P); bf16* const GT = (bf16*)(ws + WS_G); bf16* const O = (bf16*)(ws + WS_O); bf16* const HID = (bf16*)(ws + WS_G); \
    (void)P; (void)Y; (void)GT; (void)O; (void)HID

    for (int l = 0; l < DEPTH; ++l) {
        { const int k = step++; if (RUN(k) && ((PH_MASK >> 0) & 1)) { PHASE_ENTER(); for (int rep_ = 0; rep_ < NREP(0); ++rep_) phase_weights(ap, ws, l, lds, gw, NGW, wave, lane);
            if (l == 0) {
                rope_tables((f32x2*)(ws + WS_TAB1), (f32x2*)(ws + WS_TABA), bx * 512 + tid, G * 512);
                for (int row = gw; row < NTOK; row += NGW) entry_row(x_in_row(ap->in[0], ap->in[1], row), (bf16*)(ws + WS_XB) + (size_t)row * DM, (float*)(ws + WS_RS) + row, lane); }
            SEAM(k); } }
        for (int c = 0; c < NCHUNK; ++c) {
            const int row0 = c ? 32768 : 0, nseq = c ? 2 : 4, TC = nseq * SEQ;
            #define XBC ((bf16*)(ws + WS_XB) + (size_t)row0 * DM)
            #define RSC ((float*)(ws + WS_RS) + (size_t)row0)
            #define MRG ((bf16*)(ws + WS_P + 128 * MiB))
            #define YF ((bf16*)(ws + WS_P + 160 * MiB))
            { const int k = step++; if (RUN(k) && ((PH_MASK >> 2) & 1)) { PHASE_ENTER();
                pg8::Gemm g{XBC, (bf16*)(ws + WS_WIN), DM}; pg8::StaticOrder S; S.init(TC, INW, G, bx); pg8::EpiIn E{P, GT, RSC};
                for (int rep_ = 0; rep_ < NREP(2); ++rep_) pg8::gemm_phase<pg8::EpiIn, pg8::StaticOrder>(lds, g, S, E);
                SEAM(k); } }
            { const int k = step++; if (RUN(k) && ((PH_MASK >> 3) & 1)) { PHASE_ENTER();
                const float* kn = ap->in[8] + (size_t)l * HD;
                for (int m = gw; m < TC; m += NGW) { const int pos = m & (SEQ - 1); krope_token(P + (size_t)m * PWD, (const f32x2*)(ws + WS_TABA) + pos * 64, (const f32x2*)(ws + WS_TAB1) + pos * 64, kn, lane); }
                CParams cp{ap->in[10] + (size_t)l * 4 * MWD, ap->in[11] + (size_t)l * MWD, ap->in[13] + (size_t)l * 2 * MWD, ap->in[15] + (size_t)l * 2 * MWD, ap->in[16] + (size_t)l * 2 * MWD, (bf16*)(ws + WS_WG)};
                for (int rep_ = 0; rep_ < NREP(3); ++rep_) for (int u = bx; u < nseq * 8 * NSPAN; u += G) { const int sp = u & (NSPAN - 1), nb = (u >> 4) & 7, seq = u >> 7;
                    c_sweep<1, 0>(lds, P, nullptr, cp, (f32x2*)(ws + WS_SUM), seq, nb, sp); c_sweep<1, 1>(lds, P, nullptr, cp, (f32x2*)(ws + WS_SUM), seq, nb, sp); }
                SEAM(k); } }
            { const int k = step++; if (RUN(k) && ((PH_MASK >> 5) & 1)) {
                if (SUBMASK & 1) { PHASE_ENTER(); const int xcd = bx & 7, rank = bx >> 3, nrank = G >> 3; for (int rep_ = 0; rep_ < NREP(12); ++rep_) for (int i = rank; i < 32 * nseq; i += nrank) {
                    const int uid = xcd * 32 * nseq + i, seq = uid >> 8, head = (uid >> 5) & 7, kvh = head >> 2, qb = uid & 31;
                    const bf16* Qb = P + (size_t)(seq * SEQ + qb * 256) * PWD + QA_OFF + head * HD;
                    const bf16* Kh = P + (size_t)(seq * SEQ) * PWD + KA_OFF + kvh * HD; const bf16* Vh = P + (size_t)(seq * SEQ) * PWD + VA_OFF + kvh * HD;
                    att::attn_unit<0, SD_A>(Qb, Kh, Vh, O + (size_t)(seq * SEQ + qb * 256) * MWD + head * HD, SEQ / 64, 0, 0.f, (char*)lds_raw, (const f32x2*)(ws + WS_TABA) + qb * 256 * 64, ap->in[7] + (size_t)l * HD);
                } }
                if (SUBMASK & 2) { PHASE_ENTER(); const int xcd = bx & 7, rank = bx >> 3, nrank = G >> 3; for (int rep_ = 0; rep_ < NREP(13); ++rep_) for (int i = rank; i < 32 * nseq; i += nrank) {
                    const int uid = xcd * 32 * nseq + i, seq = uid >> 8, head = (uid >> 5) & 7, kvh = head >> 2, qb = uid & 31;
                    const int k0 = (qb == 0) ? 0 : qb * 256 - 128, k1 = (qb == 31) ? SEQ : qb * 256 + 384;
                    const bf16* Qb = P + (size_t)(seq * SEQ + qb * 256) * PWD + QB_OFF + head * HD;
                    const bf16* Kh = P + (size_t)(seq * SEQ + k0) * PWD + KB_OFF + kvh * HD; const bf16* Vh = P + (size_t)(seq * SEQ + k0) * PWD + VB_OFF + kvh * HD;
                    att::attn_unit<1, SD_B>(Qb, Kh, Vh, O + (size_t)TC * MWD + (size_t)(seq * SEQ + qb * 256) * MWD + head * HD, (k1 - k0) / 64, qb * 256 - k0, ap->in[9][l * 8 + head], (char*)lds_raw, (const f32x2*)(ws + WS_TAB1) + qb * 256 * 64, nullptr);
                } }
                if (SUBMASK & 4) { PHASE_ENTER();
                CParams cp{ap->in[10] + (size_t)l * 4 * MWD, ap->in[11] + (size_t)l * MWD, ap->in[13] + (size_t)l * 2 * MWD, ap->in[15] + (size_t)l * 2 * MWD, ap->in[16] + (size_t)l * 2 * MWD, (bf16*)(ws + WS_WG)};
                for (int rep_ = 0; rep_ < NREP(14); ++rep_) for (int u = bx; u < nseq * 8 * NSPAN; u += G) { const int sp = u & (NSPAN - 1), nb = (u >> 4) & 7, seq = u >> 7;
                    c_sweep<3, 0>(lds, P, O + (size_t)2 * TC * MWD, cp, (f32x2*)(ws + WS_SUM), seq, nb, sp); c_sweep<3, 1>(lds, P, O + (size_t)2 * TC * MWD, cp, (f32x2*)(ws + WS_SUM), seq, nb, sp); } }
                SEAM(k); } }
            { const int k = step++; if (RUN(k) && ((PH_MASK >> 6) & 1)) { PHASE_ENTER();
                pg8::Gemm g{O, (bf16*)(ws + WS_WBR), MWD}; pg8::BranchOrder S; S.base.init(TC, DM, G, bx); S.npanel = TC / 256;
                pg8::EpiBr E{GT, MRG};
                for (int rep_ = 0; rep_ < NREP(6); ++rep_) pg8::gemm_phase<pg8::EpiBr, pg8::BranchOrder>(lds, g, S, E);
                SEAM(k); } }
            { const int k = step++; if (RUN(k) && ((PH_MASK >> 7) & 1)) { PHASE_ENTER();
                pg8::Gemm g{MRG, (bf16*)(ws + WS_WOUT), DM}; pg8::StaticOrder S; S.init(TC, DM, G, bx); pg8::EpiBf16 E{Y, DM};
                for (int rep_ = 0; rep_ < NREP(7); ++rep_) pg8::gemm_phase<pg8::EpiBf16, pg8::StaticOrder>(lds, g, S, E);
                SEAM(k); } }
            { const int k = step++; if (RUN(k) && ((PH_MASK >> 8) & 1)) { PHASE_ENTER();
                const float* g1 = ap->in[3] + (size_t)l * DM;
                for (int m = gw; m < TC; m += NGW) resid_norm_row<false>(Y + (size_t)m * DM, XBC + (size_t)m * DM, g1, RSC + m, nullptr, lane);
                SEAM(k); } }
            { const int k = step++; if (RUN(k) && ((PH_MASK >> 9) & 1)) { PHASE_ENTER();
                pg8::Gemm g{XBC, (bf16*)(ws + WS_W1), DM}; pg8::StaticOrder S; S.init(TC, FFD, G, bx); pg8::EpiRelu2 E{HID, FFD, RSC};
                for (int rep_ = 0; rep_ < NREP(9); ++rep_) pg8::gemm_phase<pg8::EpiRelu2, pg8::StaticOrder>(lds, g, S, E);
                SEAM(k); } }
            { const int k = step++; if (RUN(k) && ((PH_MASK >> 10) & 1)) { PHASE_ENTER();
                pg8::Gemm g{HID, (bf16*)(ws + WS_W2), FFD}; pg8::StaticOrder S; S.init(TC, DM, G, bx); pg8::EpiBf16 E{YF, DM};
                for (int rep_ = 0; rep_ < NREP(10); ++rep_) pg8::gemm_phase<pg8::EpiBf16, pg8::StaticOrder>(lds, g, S, E);
                SEAM(k); } }
            { const int k = step++; if (RUN(k) && ((PH_MASK >> 11) & 1)) { PHASE_ENTER();
                const float* g1 = ap->in[5] + (size_t)l * DM;
                if (l + 1 < DEPTH) { for (int m = gw; m < TC; m += NGW) resid_norm_row<false>(YF + (size_t)m * DM, XBC + (size_t)m * DM, g1, RSC + m, nullptr, lane); }
                else { for (int m = gw; m < TC; m += NGW) resid_norm_row<true>(YF + (size_t)m * DM, XBC + (size_t)m * DM, g1, nullptr, out + (size_t)(row0 + m) * DM, lane); }
                } }
        }
    }
#undef RUN
#undef SEAM
}
constexpr int NSTEPS = DEPTH * (1 + NCHUNK * 9);

extern "C" void kernel_launch(void* const* d_in, const int* in_sizes, int n_in, void* d_out, int out_size, void* d_ws, size_t ws_size, hipStream_t stream) {
    static int grid = 0;
    if (grid == 0) {
        if (n_in != 21 || out_size != NTOK * DM || ws_size < WS_END) { fprintf(stderr, "kernel_launch: unexpected shapes (n_in %d out %d ws %zu)\n", n_in, out_size, ws_size); grid = -1; return; }
        int dev = 0, cus = 0, per_cu = 0;
        if (hipGetDevice(&dev) != hipSuccess || hipDeviceGetAttribute(&cus, hipDeviceAttributeMultiprocessorCount, dev) != hipSuccess) { grid = -1; return; }
        if (hipFuncSetAttribute((const void*)mk_fwd, hipFuncAttributeMaxDynamicSharedMemorySize, LDS_BYTES) != hipSuccess) { fprintf(stderr, "kernel_launch: hipFuncSetAttribute failed\n"); grid = -1; return; }
        if (hipOccupancyMaxActiveBlocksPerMultiprocessor(&per_cu, (const void*)mk_fwd, 512, LDS_BYTES) != hipSuccess || per_cu < 1) { fprintf(stderr, "kernel_launch: occupancy query says %d\n", per_cu); }
        (void)hipGetLastError();
        grid = cus;
    }
    if (grid < 0) return;
    if (hipMemsetAsync((char*)d_ws + WS_CTL, 0, CTL_ZERO_BYTES, stream) != hipSuccess) return;
    Args a{};
    for (int i = 0; i < 21; ++i) a.in[i] = (const float*)d_in[i];
    a.out = (float*)d_out; a.ws = (unsigned char*)d_ws;
#if MK_SINGLE
    a.lo = 0; a.hi = NSTEPS;
    hipLaunchKernelGGL(mk_fwd, dim3(grid), dim3(512), LDS_BYTES, stream, a);
#else
    for (int s = 0; s < NSTEPS; ++s) { a.lo = s; a.hi = s + 1; hipLaunchKernelGGL(mk_fwd, dim3(grid), dim3(512), LDS_BYTES, stream, a); }
#endif
    const hipError_t le = hipPeekAtLastError();
    if (le != hipSuccess) fprintf(stderr, "kernel_launch: launch failed: %s\n", hipGetErrorName(le));
}
```

```cpp
#include <hip/hip_runtime.h>
#include <cstdio>
#include <cstdint>

#ifndef PH_MASK
#define PH_MASK 0xFFF
#endif
#ifndef SUBMASK
#define SUBMASK 7
#endif
#ifndef SD_A
#define SD_A 1
#endif
#ifndef SD_B
#define SD_B 1
#endif
#ifndef DUP_MASK
#define DUP_MASK 0
#endif
#define NREP(i) (1 + ((DUP_MASK >> (i)) & 1))
#ifndef TSEL
#define TSEL 0
#endif
#ifndef ATT_PP
#define ATT_PP 0
#endif
#if ATT_PP
#define ATT_UNIT(M, SD) att::attn_unit_pp<M>
#else
#define ATT_UNIT(M, SD) att::attn_unit<M, SD>
#endif
#ifndef WGM_G1
#define WGM_G1 4
#endif
#ifndef WGM_G2
#define WGM_G2 4
#endif
#ifndef WGM_G3
#define WGM_G3 4
#endif
#ifndef WGM_G4
#define WGM_G4 4
#endif
#ifndef WGM_G5
#define WGM_G5 4
#endif
#ifndef MK_SINGLE
#define MK_SINGLE 1
#endif

#define LAS __attribute__((address_space(3)))
#define GAS __attribute__((address_space(1)))
#define CAS __attribute__((address_space(4)))
typedef unsigned short bf16;
typedef short bf16x8 __attribute__((ext_vector_type(8)));
typedef short s16x4 __attribute__((ext_vector_type(4)));
typedef float f32x4 __attribute__((ext_vector_type(4)));
typedef float f32x2 __attribute__((ext_vector_type(2)));
typedef float f32x16 __attribute__((ext_vector_type(16)));
typedef unsigned u32x4 __attribute__((ext_vector_type(4)));
typedef unsigned u32x2 __attribute__((ext_vector_type(2)));
typedef int v4i __attribute__((ext_vector_type(4)));

constexpr int DM = 2048, SEQ = 8192, NTOK = 49152, TCMAX = 32768, NCHUNK = 2, DEPTH = 4;
constexpr int QKVW = 3072  , XYW = 2048  , I8W = 9216  ;
constexpr int INW = 11264, PWD = 5120, GWD = 6144, FFD = 8192, MWD = 1024, HD = 128;
constexpr int QA_OFF = 0, KA_OFF = 1024, VA_OFF = 1280, QB_OFF = 1536, KB_OFF = 2560, VB_OFF = 2816, XC_OFF = 3072, YC_OFF = 4096;
constexpr int NPROMPT_TOK = 32768;
constexpr float EPS = 1e-6f;

constexpr size_t MiB = 1u << 20;
constexpr size_t WS_CTL = 0, CTL_ZERO_BYTES = 1 * MiB;
constexpr size_t WS_WIN = 2 * MiB;
constexpr size_t WS_WBR = 46 * MiB;
constexpr size_t WS_WOUT = 58 * MiB;
constexpr size_t WS_W1 = 66 * MiB;
constexpr size_t WS_W2 = 98 * MiB;
constexpr size_t WS_WG = 130 * MiB;
constexpr size_t WS_SUM = 131 * MiB;
constexpr size_t WS_BRS = 143 * MiB;
constexpr size_t WS_P = 207 * MiB;
constexpr size_t WS_G = 527 * MiB;
constexpr size_t WS_O = 911 * MiB;
constexpr size_t WS_TAB1 = 1103 * MiB;
constexpr size_t WS_TABA = 1107 * MiB;
constexpr size_t WS_XB = 1111 * MiB;
constexpr size_t WS_RS = 1303 * MiB;
constexpr size_t WS_XQ = 1304 * MiB;
constexpr size_t WS_SX = 1400 * MiB;
constexpr size_t WS_WQ = 22 * MiB;
constexpr size_t WS_END = 1401 * MiB;
constexpr int CW_CMAX1 = 16384 + 4 * 9216;
constexpr int CW_CMAX = 16384;
constexpr int CW_BAR = 4096;

constexpr int LDS_BYTES = 147456;
constexpr int MISC_OFF = 143360;

__device__ __forceinline__ unsigned cvt_pk_bf16(float lo, float hi) { unsigned r; asm volatile("v_cvt_pk_bf16_f32 %0, %1, %2" : "=v"(r) : "v"(lo), "v"(hi)); return r; }
__device__ __forceinline__ float bf_lo(unsigned w) { return __uint_as_float(w << 16); }
__device__ __forceinline__ float bf_hi(unsigned w) { return __uint_as_float(w & 0xffff0000u); }
__device__ __forceinline__ float bf2f(bf16 b) { return __uint_as_float(((unsigned)b) << 16); }
__device__ __forceinline__ float fast_sigmoid(float v) { return __builtin_amdgcn_rcpf(1.0f + __builtin_amdgcn_exp2f(-1.4426950408889634f * v)); }
__device__ __forceinline__ float dpp_f(float v, const int ctrl_sel) {
    const int x = __float_as_int(v);
    switch (ctrl_sel) {
        case 0: return __int_as_float(__builtin_amdgcn_update_dpp(0, x, 0xB1, 0xF, 0xF, true));
        case 1: return __int_as_float(__builtin_amdgcn_update_dpp(0, x, 0x4E, 0xF, 0xF, true));
        case 2: return __int_as_float(__builtin_amdgcn_update_dpp(0, x, 0x141, 0xF, 0xF, true));
        default: return __int_as_float(__builtin_amdgcn_update_dpp(0, x, 0x140, 0xF, 0xF, true));
    }
}
__device__ __forceinline__ float wave_max(float v, int lane) {
    (void)lane;
    v = fmaxf(v, dpp_f(v, 0)); v = fmaxf(v, dpp_f(v, 1)); v = fmaxf(v, dpp_f(v, 2)); v = fmaxf(v, dpp_f(v, 3));
    const int x = __float_as_int(v);
    return fmaxf(fmaxf(__int_as_float(__builtin_amdgcn_readlane(x, 0)), __int_as_float(__builtin_amdgcn_readlane(x, 16))), fmaxf(__int_as_float(__builtin_amdgcn_readlane(x, 32)), __int_as_float(__builtin_amdgcn_readlane(x, 48))));
}
__device__ __forceinline__ float wave_sum(float v, int lane) {
    (void)lane;
    v += dpp_f(v, 0); v += dpp_f(v, 1); v += dpp_f(v, 2); v += dpp_f(v, 3);
    const int x = __float_as_int(v);
    return (__int_as_float(__builtin_amdgcn_readlane(x, 0)) + __int_as_float(__builtin_amdgcn_readlane(x, 16))) + (__int_as_float(__builtin_amdgcn_readlane(x, 32)) + __int_as_float(__builtin_amdgcn_readlane(x, 48)));
}

__device__ const double ROPE_F1[64] = {
1.59154943091895346e-01, 1.37822502603982849e-01, 1.19349370211248862e-01, 1.03352296618434064e-01, 8.94994016088910133e-02, 7.75032887553740585e-02, 6.71150830052272551e-02, 5.81192674418762462e-02,
5.03292121044697269e-02, 4.35833029420947638e-02, 3.77415888468699103e-02, 3.26828760272190911e-02, 2.83022152813622411e-02, 2.45087241866802648e-02, 2.12237020815031856e-02, 1.83789966569160986e-02,
1.59154943091895339e-02, 1.37822502603982842e-02, 1.19349370211248869e-02, 1.03352296618434060e-02, 8.94994016088910202e-03, 7.75032887553740654e-03, 6.71150830052272551e-03, 5.81192674418762427e-03,
5.03292121044697286e-03, 4.35833029420947656e-03, 3.77415888468699086e-03, 3.26828760272190893e-03, 2.83022152813622403e-03, 2.45087241866802661e-03, 2.12237020815031847e-03, 1.83789966569160995e-03,
1.59154943091895335e-03, 1.37822502603982846e-03, 1.19349370211248865e-03, 1.03352296618434069e-03, 8.94994016088910115e-04, 7.75032887553740654e-04, 6.71150830052272508e-04, 5.81192674418762427e-04,
5.03292121044697243e-04, 4.35833029420947678e-04, 3.77415888468699086e-04, 3.26828760272190871e-04, 2.83022152813622381e-04, 2.45087241866802661e-04, 2.12237020815031847e-04, 1.83789966569160984e-04,
1.59154943091895346e-04, 1.37822502603982835e-04, 1.19349370211248871e-04, 1.03352296618434063e-04, 8.94994016088910088e-05, 7.75032887553740654e-05, 6.71150830052272508e-05, 5.81192674418762400e-05,
5.03292121044697243e-05, 4.35833029420947644e-05, 3.77415888468699120e-05, 3.26828760272190871e-05, 2.83022152813622381e-05, 2.45087241866802641e-05, 2.12237020815031861e-05, 1.83789966569160984e-05 };
__device__ const double ROPE_FA[32] = {
1.59154943091895346e-01, 1.19349370211248862e-01, 8.94994016088910133e-02, 6.71150830052272551e-02, 5.03292121044697269e-02, 3.77415888468699103e-02, 2.83022152813622411e-02, 2.12237020815031856e-02,
1.59154943091895339e-02, 1.19349370211248869e-02, 8.94994016088910202e-03, 6.71150830052272551e-03, 5.03292121044697286e-03, 3.77415888468699086e-03, 2.83022152813622403e-03, 2.12237020815031847e-03,
1.59154943091895335e-03, 1.19349370211248865e-03, 8.94994016088910115e-04, 6.71150830052272508e-04, 5.03292121044697243e-04, 3.77415888468699086e-04, 2.83022152813622381e-04, 2.12237020815031847e-04,
1.59154943091895346e-04, 1.19349370211248871e-04, 8.94994016088910088e-05, 6.71150830052272508e-05, 5.03292121044697243e-05, 3.77415888468699120e-05, 2.83022152813622381e-05, 2.12237020815031861e-05 };

namespace pg8 {
typedef unsigned short bf16_t;
constexpr int BM = 256, BK = 64, HALF = 128, HTB = HALF * BK * 2, STAGE_BYTES = 8 * HTB, NXCD = 8, WGM = 4;
__host__ __device__ __forceinline__ int lds_byte(int r, int c) { const int st = (r >> 4) * 2 + (c >> 5), rr = r & 15, cc = c & 31, ob = rr * 64 + cc * 2; return st * 1024 + (ob ^ (((ob >> 9) & 1) << 5)); }
__host__ __device__ __forceinline__ void stage_rc(int b, int& R, int& C) { const int st = b / 1024, sb = b % 1024, swz = sb ^ (((sb >> 9) & 1) << 5); R = (st >> 1) * 16 + swz / 64; C = (st & 1) * 32 + (swz % 64) / 2; }
__host__ __device__ __forceinline__ int perm32(int rho) { const int n = rho >> 4, i = rho & 15; return 8 * (i >> 2) + 4 * n + (i & 3); }

struct Unit { int pm, pn, ka, kb, sub; };
struct Gemm { const bf16_t* A; const bf16_t* Bt; int K; };

struct StaticOrder {
    int nM, nN, nwg, G, c, wgm;
    __device__ void init(int M, int N, int G_, int c_, int wgm_ = WGM) { nM = M / BM; nN = N / BM; nwg = nM * nN; G = G_; c = c_; wgm = wgm_; }
    __device__ bool next(int i, Unit& u) const {
        const long L = (long)i * G + c; if (L >= nwg) return false;
        int wgid = (int)L; { const int q = nwg / NXCD, r = nwg % NXCD, xcd = wgid % NXCD, off = wgid / NXCD; wgid = (xcd < r ? xcd * (q + 1) : r * (q + 1) + (xcd - r) * q) + off; }
        const int nig = wgm * nN, gid = wgid / nig, fm = gid * wgm, gsz = (nM - fm) < wgm ? (nM - fm) : wgm;
        u.pm = fm + ((wgid % nig) % gsz); u.pn = (wgid % nig) / gsz; u.ka = u.pm; u.kb = u.pn; u.sub = 0; return true;
    }
};
struct BranchOrder {
    StaticOrder base; int npanel;
    __device__ bool next(int i, Unit& u) const {
        const int t = i / 3, s = i - 3 * t; if (!base.next(t, u)) return false;
        u.sub = s; u.ka = s * npanel + u.pm; u.kb = s * 8 + u.pn; return true;
    }
};

struct EpiIn {
    static constexpr bool PERM = true; static constexpr int NSTORES = 16;
    bf16_t* P; bf16_t* G; const float* rs;
    __device__ __forceinline__ bool operator()(f32x4 (&acc)[2][2][4][2], const Unit& u, int wr, int wc, int fr_, int fq) const {
        int fr = fr_; asm volatile("" : "+v"(fr));
        const int row0 = u.pm * BM + wr * 64 + fr; const bool gate = u.pn >= 20;
        bf16_t* base = gate ? G : P; const int ldc = gate ? GWD : PWD; const int col0 = (gate ? u.pn - 20 : u.pn) * BM + wc * 32 + 8 * fq;
#pragma unroll
        for (int ai = 0; ai < 2; ++ai)
#pragma unroll
            for (int m = 0; m < 4; ++m) { bf16_t* rowp = base + (size_t)(row0 + ai * HALF + m * 16) * ldc + col0; const float rsv = rs[row0 + ai * HALF + m * 16];
#pragma unroll
                for (int bj = 0; bj < 2; ++bj) { f32x4 v0 = acc[ai][bj][m][0] * rsv, v1 = acc[ai][bj][m][1] * rsv;
                    if (gate) {
#pragma unroll
                        for (int j = 0; j < 4; ++j) { v0[j] = fmaxf(fast_sigmoid(v0[j]), 1e-30f); v1[j] = fmaxf(fast_sigmoid(v1[j]), 1e-30f); } }
                    u32x4 w; w.x = cvt_pk_bf16(v0[0], v0[1]); w.y = cvt_pk_bf16(v0[2], v0[3]); w.z = cvt_pk_bf16(v1[0], v1[1]); w.w = cvt_pk_bf16(v1[2], v1[3]);
                    *(u32x4*)(rowp + bj * HALF) = w; } }
        return true;
    }
};
struct EpiXY {
    static constexpr bool PERM = true; static constexpr int NSTORES = 16;
    bf16_t* P; const float* rs;
    __device__ __forceinline__ bool operator()(f32x4 (&acc)[2][2][4][2], const Unit& u, int wr, int wc, int fr_, int fq) const {
        int fr = fr_; asm volatile("" : "+v"(fr));
        const int row0 = u.pm * BM + wr * 64 + fr, col0 = QKVW + u.pn * BM + wc * 32 + 8 * fq;
        float rsa[2][4];
#pragma unroll
        for (int ai = 0; ai < 2; ++ai)
#pragma unroll
            for (int m = 0; m < 4; ++m) rsa[ai][m] = rs[row0 + ai * HALF + m * 16];
#pragma unroll
        for (int ai = 0; ai < 2; ++ai)
#pragma unroll
            for (int m = 0; m < 4; ++m) { const int row = row0 + ai * HALF + m * 16; bf16_t* rowp = P + (size_t)row * PWD + col0; const float rsv = rsa[ai][m];
#pragma unroll
                for (int bj = 0; bj < 2; ++bj) { const f32x4 v0 = acc[ai][bj][m][0] * rsv, v1 = acc[ai][bj][m][1] * rsv;
                    u32x4 w; w.x = cvt_pk_bf16(v0[0], v0[1]); w.y = cvt_pk_bf16(v0[2], v0[3]); w.z = cvt_pk_bf16(v1[0], v1[1]); w.w = cvt_pk_bf16(v1[2], v1[3]);
                    *(u32x4*)(rowp + bj * HALF) = w; } }
        return true;
    }
};
struct EpiGateQ {
    static constexpr bool PERM = true; static constexpr int NSTORES = 16;
    bf16_t* P; bf16_t* G; const float* rs; const float* sx; const float* cmax;
    __device__ __forceinline__ bool operator()(f32x4 (&acc)[2][2][4][2], const Unit& u, int wr, int wc, int fr_, int fq) const {
        int fr = fr_; asm volatile("" : "+v"(fr));
        const int row0 = u.pm * BM + wr * 64 + fr; const bool gate = u.pn >= 12;
        bf16_t* base = gate ? G : P; const int ldc = gate ? GWD : PWD; const int col0 = (gate ? u.pn - 12 : u.pn) * BM + wc * 32 + 8 * fq, ccol0 = u.pn * BM + wc * 32 + 8 * fq;
        f32x4 cw[2][2];
#pragma unroll
        for (int bj = 0; bj < 2; ++bj) { cw[bj][0] = *(const f32x4*)(cmax + ccol0 + bj * HALF) * (1.0f / 127.0f); cw[bj][1] = *(const f32x4*)(cmax + ccol0 + bj * HALF + 4) * (1.0f / 127.0f); }
        float rsa[2][4];
#pragma unroll
        for (int ai = 0; ai < 2; ++ai)
#pragma unroll
            for (int m = 0; m < 4; ++m) { const int row = row0 + ai * HALF + m * 16; rsa[ai][m] = rs[row] * sx[row]; }
#pragma unroll
        for (int ai = 0; ai < 2; ++ai)
#pragma unroll
            for (int m = 0; m < 4; ++m) { const int row = row0 + ai * HALF + m * 16; bf16_t* rowp = base + (size_t)row * ldc + col0; const float rsv = rsa[ai][m];
#pragma unroll
                for (int bj = 0; bj < 2; ++bj) { const v4i i0 = __builtin_bit_cast(v4i, acc[ai][bj][m][0]), i1 = __builtin_bit_cast(v4i, acc[ai][bj][m][1]);
                    f32x4 v0 = (f32x4){(float)i0[0], (float)i0[1], (float)i0[2], (float)i0[3]} * cw[bj][0] * rsv, v1 = (f32x4){(float)i1[0], (float)i1[1], (float)i1[2], (float)i1[3]} * cw[bj][1] * rsv;
                    if (gate) {
#pragma unroll
                        for (int j = 0; j < 4; ++j) { v0[j] = fmaxf(fast_sigmoid(v0[j]), 1e-30f); v1[j] = fmaxf(fast_sigmoid(v1[j]), 1e-30f); } }
                    u32x4 w; w.x = cvt_pk_bf16(v0[0], v0[1]); w.y = cvt_pk_bf16(v0[2], v0[3]); w.z = cvt_pk_bf16(v1[0], v1[1]); w.w = cvt_pk_bf16(v1[2], v1[3]);
                    *(u32x4*)(rowp + bj * HALF) = w; } }
        return true;
    }
};
struct EpiBr {
    static constexpr bool PERM = true; static constexpr int NSTORES = 0;
    const bf16_t* G; bf16_t* OUT;
    __device__ __forceinline__ bool operator()(f32x4 (&acc)[2][2][4][2], const Unit& u, int wr, int wc, int fr_, int fq) const {
        int fr = fr_; asm volatile("" : "+v"(fr));
        const int row0 = u.pm * BM + wr * 64 + fr, col0 = u.pn * BM + wc * 32 + 8 * fq; const int sub = u.sub;
        if (sub < 2) {
#pragma unroll
            for (int ai = 0; ai < 2; ++ai) {
                const bf16_t* gp = G + (size_t)(row0 + ai * HALF) * GWD + sub * DM + col0;
                u32x4 gw[4][2], gn[4][2];
#pragma unroll
                for (int m = 0; m < 4; ++m)
#pragma unroll
                    for (int bj = 0; bj < 2; ++bj) { gw[m][bj] = *(const u32x4*)(gp + (size_t)(m * 16) * GWD + bj * HALF); gn[m][bj] = *(const u32x4*)(gp + (size_t)(m * 16) * GWD + DM + bj * HALF); }
#pragma unroll
                for (int m = 0; m < 4; ++m)
#pragma unroll
                    for (int bj = 0; bj < 2; ++bj) { const u32x4 a = gw[m][bj], n = gn[m][bj];
                        f32x4 s0 = {bf_lo(a.x), bf_hi(a.x), bf_lo(a.y), bf_hi(a.y)};
                        f32x4 s1 = {bf_lo(a.z), bf_hi(a.z), bf_lo(a.w), bf_hi(a.w)};
                        s0 *= (f32x4){__builtin_amdgcn_rcpf(bf_lo(n.x)), __builtin_amdgcn_rcpf(bf_hi(n.x)), __builtin_amdgcn_rcpf(bf_lo(n.y)), __builtin_amdgcn_rcpf(bf_hi(n.y))};
                        s1 *= (f32x4){__builtin_amdgcn_rcpf(bf_lo(n.z)), __builtin_amdgcn_rcpf(bf_hi(n.z)), __builtin_amdgcn_rcpf(bf_lo(n.w)), __builtin_amdgcn_rcpf(bf_hi(n.w))};
                        acc[ai][bj][m][0] *= s0; acc[ai][bj][m][1] *= s1; }
                asm volatile("" ::: "memory"); }
        } else {
#pragma unroll
            for (int ai = 0; ai < 2; ++ai) {
                const bf16_t* gp = G + (size_t)(row0 + ai * HALF) * GWD + sub * DM + col0;
                u32x4 gw[4][2];
#pragma unroll
                for (int m = 0; m < 4; ++m)
#pragma unroll
                    for (int bj = 0; bj < 2; ++bj) gw[m][bj] = *(const u32x4*)(gp + (size_t)(m * 16) * GWD + bj * HALF);
#pragma unroll
                for (int m = 0; m < 4; ++m)
#pragma unroll
                    for (int bj = 0; bj < 2; ++bj) { const u32x4 a = gw[m][bj];
                        const f32x4 s0 = {bf_lo(a.x), bf_hi(a.x), bf_lo(a.y), bf_hi(a.y)};
                        const f32x4 s1 = {bf_lo(a.z), bf_hi(a.z), bf_lo(a.w), bf_hi(a.w)};
                        const f32x4 v0 = acc[ai][bj][m][0] * s0, v1 = acc[ai][bj][m][1] * s1;
                        u32x4 w; w.x = cvt_pk_bf16(v0[0], v0[1]); w.y = cvt_pk_bf16(v0[2], v0[3]); w.z = cvt_pk_bf16(v1[0], v1[1]); w.w = cvt_pk_bf16(v1[2], v1[3]);
                        *(u32x4*)(OUT + (size_t)(row0 + ai * HALF + m * 16) * DM + col0 + bj * HALF) = w; }
                asm volatile("" ::: "memory"); }
        }
        return sub == 2;
    }
};
struct EpiBf16 {
    static constexpr bool PERM = true; static constexpr int NSTORES = 16;
    bf16_t* O; int ldc;
    __device__ __forceinline__ bool operator()(f32x4 (&acc)[2][2][4][2], const Unit& u, int wr, int wc, int fr_, int fq) const {
        int fr = fr_; asm volatile("" : "+v"(fr));
        const int row0 = u.pm * BM + wr * 64 + fr, col0 = u.pn * BM + wc * 32 + 8 * fq;
#pragma unroll
        for (int ai = 0; ai < 2; ++ai)
#pragma unroll
            for (int m = 0; m < 4; ++m) { bf16_t* rowp = O + (size_t)(row0 + ai * HALF + m * 16) * ldc + col0;
#pragma unroll
                for (int bj = 0; bj < 2; ++bj) { const f32x4 v0 = acc[ai][bj][m][0], v1 = acc[ai][bj][m][1];
                    u32x4 w; w.x = cvt_pk_bf16(v0[0], v0[1]); w.y = cvt_pk_bf16(v0[2], v0[3]); w.z = cvt_pk_bf16(v1[0], v1[1]); w.w = cvt_pk_bf16(v1[2], v1[3]);
                    *(u32x4*)(rowp + bj * HALF) = w; } }
        return true;
    }
};
struct EpiRelu2Q {
    static constexpr bool PERM = true; static constexpr int NSTORES = 16;
    bf16_t* O; int ldc; const float* rs; const float* sx; const float* cmax;
    __device__ __forceinline__ bool operator()(f32x4 (&acc)[2][2][4][2], const Unit& u, int wr, int wc, int fr_, int fq) const {
        int fr = fr_; asm volatile("" : "+v"(fr));
        const int row0 = u.pm * BM + wr * 64 + fr, col0 = u.pn * BM + wc * 32 + 8 * fq;
        f32x4 cw[2][2];
#pragma unroll
        for (int bj = 0; bj < 2; ++bj) { cw[bj][0] = *(const f32x4*)(cmax + col0 + bj * HALF) * (1.0f / 127.0f); cw[bj][1] = *(const f32x4*)(cmax + col0 + bj * HALF + 4) * (1.0f / 127.0f); }
        float rsa[2][4];
#pragma unroll
        for (int ai = 0; ai < 2; ++ai)
#pragma unroll
            for (int m = 0; m < 4; ++m) { const int row = row0 + ai * HALF + m * 16; rsa[ai][m] = rs[row] * sx[row]; }
#pragma unroll
        for (int ai = 0; ai < 2; ++ai)
#pragma unroll
            for (int m = 0; m < 4; ++m) { const int row = row0 + ai * HALF + m * 16; bf16_t* rowp = O + (size_t)row * ldc + col0; const float rsv = rsa[ai][m];
#pragma unroll
                for (int bj = 0; bj < 2; ++bj) { const v4i i0 = __builtin_bit_cast(v4i, acc[ai][bj][m][0]), i1 = __builtin_bit_cast(v4i, acc[ai][bj][m][1]);
                    f32x4 v0 = (f32x4){(float)i0[0], (float)i0[1], (float)i0[2], (float)i0[3]} * cw[bj][0] * rsv, v1 = (f32x4){(float)i1[0], (float)i1[1], (float)i1[2], (float)i1[3]} * cw[bj][1] * rsv;
#pragma unroll
                    for (int j = 0; j < 4; ++j) { const float a = fmaxf(v0[j], 0.f), b = fmaxf(v1[j], 0.f); v0[j] = a * a; v1[j] = b * b; }
                    u32x4 w; w.x = cvt_pk_bf16(v0[0], v0[1]); w.y = cvt_pk_bf16(v0[2], v0[3]); w.z = cvt_pk_bf16(v1[0], v1[1]); w.w = cvt_pk_bf16(v1[2], v1[3]);
                    *(u32x4*)(rowp + bj * HALF) = w; } }
        return true;
    }
};
struct EpiRelu2 {
    static constexpr bool PERM = true; static constexpr int NSTORES = 16;
    bf16_t* O; int ldc; const float* rs;
    __device__ __forceinline__ bool operator()(f32x4 (&acc)[2][2][4][2], const Unit& u, int wr, int wc, int fr_, int fq) const {
        int fr = fr_; asm volatile("" : "+v"(fr));
        const int row0 = u.pm * BM + wr * 64 + fr, col0 = u.pn * BM + wc * 32 + 8 * fq;
#pragma unroll
        for (int ai = 0; ai < 2; ++ai)
#pragma unroll
            for (int m = 0; m < 4; ++m) { bf16_t* rowp = O + (size_t)(row0 + ai * HALF + m * 16) * ldc + col0; const float rsv = rs[row0 + ai * HALF + m * 16];
#pragma unroll
                for (int bj = 0; bj < 2; ++bj) { f32x4 v0 = acc[ai][bj][m][0], v1 = acc[ai][bj][m][1];
#pragma unroll
                    for (int j = 0; j < 4; ++j) { const float a = fmaxf(v0[j] * rsv, 0.f), b = fmaxf(v1[j] * rsv, 0.f); v0[j] = a * a; v1[j] = b * b; }
                    u32x4 w; w.x = cvt_pk_bf16(v0[0], v0[1]); w.y = cvt_pk_bf16(v0[2], v0[3]); w.z = cvt_pk_bf16(v1[0], v1[1]); w.w = cvt_pk_bf16(v1[2], v1[3]);
                    *(u32x4*)(rowp + bj * HALF) = w; } }
        return true;
    }
};

template <class Epi, class Sched, bool ALIGN_EPI = true, bool I8 = false>
__device__ __forceinline__ void gemm_phase(LAS unsigned char* lds, const Gemm g, const Sched& S, const Epi& E) {
    int tid_ = threadIdx.x; asm volatile("" : "+v"(tid_));
    const int tid = tid_, wid = __builtin_amdgcn_readfirstlane(tid >> 6), lane = tid & 63, wr = wid >> 2, wc = wid & 3, fr = lane & 15, fq = lane >> 4;
    const int K = g.K, PB = I8 ? K : 2 * K  , nt = PB / (BK * 2);
    unsigned voffA[2], voffB[2];
#pragma unroll
    for (int i = 0; i < 2; ++i) { int R, C; stage_rc(tid * 16 + i * 8192, R, C); const int Rb = Epi::PERM ? ((R & ~31) + perm32(R & 31)) : R;
        voffA[i] = (unsigned)(R * PB + C * 2); voffB[i] = (unsigned)(Rb * PB + C * 2); }
    const size_t kstep = (size_t)(BK * 2);
    const size_t hstep = (size_t)HALF * PB;
    const size_t tstep = 2 * hstep;
    const unsigned ldsw = (unsigned)wid * 1024u;
    const int aoff = lds_byte(wr * 64 + fr, fq * 8), boff = lds_byte(wc * 32 + fr, fq * 8);
#define PG8_SA(b, h) (((b) * 2 + (h)) * HTB)
#define PG8_SB(b, h) ((4 + (b) * 2 + (h)) * HTB)
#define PG8_STAGE(bufoff, gbase, voff) do { _Pragma("unroll") for (int _i = 0; _i < 2; ++_i) \
        __builtin_amdgcn_global_load_lds((const unsigned*)((const char*)(gbase) + (voff)[_i]), (LAS unsigned*)(lds + (bufoff) + ldsw + _i * 8192), 16, 0, 0); } while (0)
#define PG8_LDA(dst, b, h) do { _Pragma("unroll") for (int m = 0; m < 4; ++m) _Pragma("unroll") for (int k = 0; k < 2; ++k) dst[m][k] = *(const LAS bf16x8*)(lds + PG8_SA(b, h) + aoff + m * 2048 + k * 1024); } while (0)
#define PG8_LDB(dst, b, h) do { _Pragma("unroll") for (int n = 0; n < 2; ++n) _Pragma("unroll") for (int k = 0; k < 2; ++k) dst[n][k] = *(const LAS bf16x8*)(lds + PG8_SB(b, h) + boff + n * 2048 + k * 1024); } while (0)
#define PG8_MMA(ai, bj, At, Bt) do { __builtin_amdgcn_s_setprio(1); _Pragma("unroll") for (int m = 0; m < 4; ++m) _Pragma("unroll") for (int n = 0; n < 2; ++n) _Pragma("unroll") for (int k = 0; k < 2; ++k) \
        { if constexpr (I8) acc[ai][bj][m][n] = __builtin_bit_cast(f32x4, __builtin_amdgcn_mfma_i32_16x16x64_i8(__builtin_bit_cast(v4i, Bt[n][k]), __builtin_bit_cast(v4i, At[m][k]), __builtin_bit_cast(v4i, acc[ai][bj][m][n]), 0, 0, 0)); \
          else acc[ai][bj][m][n] = __builtin_amdgcn_mfma_f32_16x16x32_bf16(Bt[n][k], At[m][k], acc[ai][bj][m][n], 0, 0, 0); } __builtin_amdgcn_s_setprio(0); } while (0)
#define PG8_WAIT_V(n) asm volatile("s_waitcnt vmcnt(" #n ")" ::: "memory")
#define PG8_WAIT_L(n) asm volatile("s_waitcnt lgkmcnt(" #n ")" ::: "memory")
#define PG8_BAR __builtin_amdgcn_s_barrier()
#define PG8_SCHED __builtin_amdgcn_sched_barrier(0)
    Unit cur, nxt; int ui = 0;
    if (!S.next(0, cur)) return;
    f32x4 acc[2][2][4][2];
#pragma unroll
    for (int a = 0; a < 2; ++a)
#pragma unroll
        for (int b = 0; b < 2; ++b)
#pragma unroll
            for (int m = 0; m < 4; ++m)
#pragma unroll
                for (int n = 0; n < 2; ++n) acc[a][b][m][n] = (f32x4){0.f, 0.f, 0.f, 0.f};
    bf16x8 At[4][2], B0[2][2], B1[2][2];
    const char* cA = (const char*)g.A + (size_t)cur.ka * tstep; const char* cB = (const char*)g.Bt + (size_t)cur.kb * tstep;
    PG8_STAGE(PG8_SB(0, 0), cB, voffB); PG8_STAGE(PG8_SB(0, 1), cB + hstep, voffB); PG8_STAGE(PG8_SA(0, 0), cA, voffA); PG8_STAGE(PG8_SA(0, 1), cA + hstep, voffA);
    if (wr == 1) PG8_BAR;
    PG8_WAIT_V(2); PG8_BAR;
    PG8_STAGE(PG8_SB(1, 0), cB + kstep, voffB); PG8_STAGE(PG8_SA(1, 0), cA + kstep, voffA); PG8_STAGE(PG8_SB(1, 1), cB + hstep + kstep, voffB);
    PG8_WAIT_V(6); PG8_BAR;
    for (;;) {
        const bool has_next = S.next(ui + 1, nxt);
        const char* nA = has_next ? (const char*)g.A + (size_t)nxt.ka * tstep : cA; const char* nB = has_next ? (const char*)g.Bt + (size_t)nxt.kb * tstep : cB;
#pragma nounroll
        for (int t = 0; t < nt; t += 2) {
            const bool last = (t == nt - 2);
            const bool rlx = Epi::NSTORES == 16 && ui > 0 && t == 0;
            const char* a1 = cA + (size_t)(t + 1) * kstep;
            const char* a2 = last ? nA : cA + (size_t)(t + 2) * kstep; const char* b2 = last ? nB : cB + (size_t)(t + 2) * kstep;
            const char* a3 = a2 + kstep; const char* b3 = b2 + kstep;
            PG8_LDB(B0, 0, 0); PG8_LDB(B1, 0, 1); PG8_SCHED; PG8_LDA(At, 0, 0); PG8_STAGE(PG8_SA(1, 1), a1 + hstep, voffA);
            if (rlx) PG8_WAIT_V(24); else PG8_WAIT_V(8); PG8_WAIT_L(0); PG8_BAR; PG8_MMA(0, 0, At, B0); PG8_MMA(0, 1, At, B1); PG8_BAR; PG8_SCHED;
            PG8_LDA(At, 0, 1); PG8_STAGE(PG8_SB(0, 0), b2, voffB); PG8_STAGE(PG8_SB(0, 1), b2 + hstep, voffB); PG8_STAGE(PG8_SA(0, 0), a2, voffA);
            if (rlx) PG8_WAIT_V(24); else PG8_WAIT_V(8); PG8_WAIT_L(0); PG8_BAR; PG8_MMA(1, 0, At, B0); PG8_MMA(1, 1, At, B1); PG8_BAR; PG8_SCHED;
            PG8_LDB(B0, 1, 0); PG8_LDB(B1, 1, 1); PG8_SCHED; PG8_LDA(At, 1, 0); PG8_STAGE(PG8_SA(0, 1), a2 + hstep, voffA);
            if (rlx) PG8_WAIT_V(26); else PG8_WAIT_V(8); PG8_WAIT_L(0); PG8_BAR; PG8_MMA(0, 0, At, B0); PG8_MMA(0, 1, At, B1); PG8_BAR; PG8_SCHED;
            PG8_LDA(At, 1, 1); PG8_STAGE(PG8_SB(1, 0), b3, voffB); PG8_STAGE(PG8_SB(1, 1), b3 + hstep, voffB); PG8_STAGE(PG8_SA(1, 0), a3, voffA);
            PG8_WAIT_V(8); PG8_WAIT_L(0); PG8_BAR; PG8_MMA(1, 0, At, B0); PG8_MMA(1, 1, At, B1); PG8_BAR; PG8_SCHED;
        }
        if constexpr (ALIGN_EPI) { if (wr == 0) PG8_BAR; }
        const bool reset = E(acc, cur, wr, wc, fr, fq);
        if (!has_next) break;
        if (reset) {
#pragma unroll
        for (int a = 0; a < 2; ++a)
#pragma unroll
            for (int b = 0; b < 2; ++b)
#pragma unroll
                for (int m = 0; m < 4; ++m)
#pragma unroll
                    for (int n = 0; n < 2; ++n) acc[a][b][m][n] = (f32x4){0.f, 0.f, 0.f, 0.f};
        }
        cur = nxt; cA = nA; cB = nB; ++ui;
        if constexpr (ALIGN_EPI) { if (wr == 1) PG8_BAR; }
    }
    PG8_WAIT_V(0);
    if constexpr (!ALIGN_EPI) { if (wr == 0) PG8_BAR; }
    PG8_BAR;
#undef PG8_SA
#undef PG8_SB
#undef PG8_STAGE
#undef PG8_LDA
#undef PG8_LDB
#undef PG8_MMA
#undef PG8_WAIT_V
#undef PG8_WAIT_L
#undef PG8_BAR
#undef PG8_SCHED
}
}

namespace att {
constexpr int D = 128, NW = 8, QBLK = 32, KVBLK = 64;
constexpr float SCALE = 0.088388347648318440f;
constexpr float THR = 8.f;
constexpr int LDQ = PWD, LDK = PWD, LDO = MWD;
constexpr int SHM_V = KVBLK * D * 2, SHM_K = KVBLK * D * 2;
constexpr int OST_PITCH = 272;
constexpr int OST_OFF = 2 * SHM_V + 2 * SHM_K + NW * 64 * 4;
constexpr int ATT_LDS = OST_OFF + NW * 32 * OST_PITCH;
#define KSWZ(row, colB) ((row) * 256 + ((colB) ^ (((row) & 7) << 4)))
#define SBAR() __builtin_amdgcn_sched_barrier(0)
__device__ __forceinline__ int crow(int r, int hi) { return (r & 3) + 8 * (r >> 2) + 4 * hi; }

template <bool MASKED>
__device__ __forceinline__ void partialSM(f32x16& p0, f32x16& p1, float& m_reg, float& mn, float& alpha, int mbase) {
  constexpr float C = SCALE * 1.4426950408889634f;
  if constexpr (MASKED) {
    const float ninf = -__builtin_inff();
#pragma unroll
    for (int r = 0; r < 16; ++r) { const int c = (r & 3) + 8 * (r >> 2);
      p0[r] = ((unsigned)(mbase - c) <= 256u) ? p0[r] : ninf;
      p1[r] = ((unsigned)(mbase - c - 32) <= 256u) ? p1[r] : ninf; }
  }
  float pmax = p0[0];
#pragma unroll
  for (int r = 1; r < 16; ++r) pmax = fmaxf(pmax, p0[r]);
#pragma unroll
  for (int r = 0; r < 16; ++r) pmax = fmaxf(pmax, p1[r]);
  { auto rr = __builtin_amdgcn_permlane32_swap(__float_as_uint(pmax), __float_as_uint(pmax), false, false);
    pmax = fmaxf(__uint_as_float(rr[0]), __uint_as_float(rr[1])); }
  if (__builtin_expect(__all(pmax - m_reg <= THR / SCALE), 1)) { mn = m_reg; alpha = 1.f; }
  else { mn = fmaxf(m_reg, pmax); alpha = __builtin_amdgcn_exp2f((m_reg - mn) * C); m_reg = mn; }
  float mnC = -mn * C;
#pragma unroll
  for (int r = 0; r < 16; ++r) p0[r] = fmaf(p0[r], C, mnC);
#pragma unroll
  for (int r = 0; r < 16; ++r) p1[r] = fmaf(p1[r], C, mnC);
#pragma unroll
  for (int r = 0; r < 16; ++r) p0[r] = __builtin_amdgcn_exp2f(p0[r]);
}
__device__ __forceinline__ void finishSM(f32x16& p0, f32x16& p1, float alpha, float& l_reg, bf16x8& pa0, bf16x8& pa1, bf16x8& pa2, bf16x8& pa3) {
#pragma unroll
  for (int r = 0; r < 16; ++r) p1[r] = __builtin_amdgcn_exp2f(p1[r]);
  float ps = 0;
#pragma unroll
  for (int r = 0; r < 16; ++r) ps += p0[r];
#pragma unroll
  for (int r = 0; r < 16; ++r) ps += p1[r];
  { auto rr = __builtin_amdgcn_permlane32_swap(__float_as_uint(ps), __float_as_uint(ps), false, false);
    ps = __uint_as_float(rr[0]) + __uint_as_float(rr[1]); }
  l_reg = l_reg * alpha + ps;
#define PK4(P, BASE, OUT) do { unsigned a0 = cvt_pk_bf16(P[BASE + 0], P[BASE + 1]), a1 = cvt_pk_bf16(P[BASE + 2], P[BASE + 3]);   \
    unsigned b0 = cvt_pk_bf16(P[BASE + 4], P[BASE + 5]), b1 = cvt_pk_bf16(P[BASE + 6], P[BASE + 7]);                              \
    auto r0 = __builtin_amdgcn_permlane32_swap(a0, b0, false, false); auto r1 = __builtin_amdgcn_permlane32_swap(a1, b1, false, false); \
    u32x4 w = {r0[0], r1[0], r0[1], r1[1]}; OUT = *reinterpret_cast<bf16x8*>(&w); } while (0)
  PK4(p0, 0, pa0); PK4(p0, 8, pa1); PK4(p1, 0, pa2); PK4(p1, 8, pa3);
#undef PK4
}
__device__ __forceinline__ void qkt(f32x16& p0, f32x16& p1, const bf16* Ks, const bf16x8* qr, int r32, int hi) {
  p0 = f32x16{}; p1 = f32x16{};
#pragma unroll
  for (int d0 = 0; d0 < 8; ++d0) { int cb = (d0 * 16 + hi * 8) * 2;
    bf16x8 b0 = *reinterpret_cast<const bf16x8*>((const char*)Ks + KSWZ(r32, cb));
    bf16x8 b1 = *reinterpret_cast<const bf16x8*>((const char*)Ks + KSWZ(32 + r32, cb));
    p0 = __builtin_amdgcn_mfma_f32_32x32x16_bf16(b0, qr[d0], p0, 0, 0, 0);
    p1 = __builtin_amdgcn_mfma_f32_32x32x16_bf16(b1, qr[d0], p1, 0, 0, 0); }
}
__device__ __forceinline__ int v_st(int k, int c) { const int kk = (k & ~0xC) | ((k & 4) << 1) | ((k & 8) >> 1); return ((kk >> 3) * 4 + (c >> 5)) * 512 + ((kk & 7) * 32 + (c & 31)) * 2; }
__device__ __forceinline__ int v_rd_base(int lane) { return ((lane & 3) << 3) | (((lane >> 2) & 3) << 6) | (((lane >> 4) & 1) << 5) | (((lane >> 5) & 1) << 8); }
constexpr int v_rd_off(int d0, int ks, int half) { return d0 * 512 + ks * 4096 + half * 2048; }
template <int OFF> __device__ __forceinline__ s16x4 tr_read(int vb) {
  s16x4 r; asm volatile("ds_read_b64_tr_b16 %0, %1 offset:%2" : "=&v"(r) : "v"(vb), "i"(OFF) : "memory"); return r;
}
template <int D0> __device__ __forceinline__ void pv_one(f32x16& od, int vb, bf16x8 pa0, bf16x8 pa1, bf16x8 pa2, bf16x8 pa3) {
  const s16x4 l0 = tr_read<v_rd_off(D0, 0, 0)>(vb), h0 = tr_read<v_rd_off(D0, 0, 1)>(vb), l1 = tr_read<v_rd_off(D0, 1, 0)>(vb), h1 = tr_read<v_rd_off(D0, 1, 1)>(vb);
  const s16x4 l2 = tr_read<v_rd_off(D0, 2, 0)>(vb), h2 = tr_read<v_rd_off(D0, 2, 1)>(vb), l3 = tr_read<v_rd_off(D0, 3, 0)>(vb), h3 = tr_read<v_rd_off(D0, 3, 1)>(vb);
  asm volatile("s_waitcnt lgkmcnt(0)" ::: "memory"); SBAR();
#define PK(L, H) (bf16x8){L[0], L[1], L[2], L[3], H[0], H[1], H[2], H[3]}
  od = __builtin_amdgcn_mfma_f32_32x32x16_bf16(pa0, PK(l0, h0), od, 0, 0, 0);
  od = __builtin_amdgcn_mfma_f32_32x32x16_bf16(pa1, PK(l1, h1), od, 0, 0, 0);
  od = __builtin_amdgcn_mfma_f32_32x32x16_bf16(pa2, PK(l2, h2), od, 0, 0, 0);
  od = __builtin_amdgcn_mfma_f32_32x32x16_bf16(pa3, PK(l3, h3), od, 0, 0, 0);
#undef PK
}
__device__ __forceinline__ void pv_d0(f32x16* o, int vb, bf16x8 pa0, bf16x8 pa1, bf16x8 pa2, bf16x8 pa3) {
  pv_one<0>(o[0], vb, pa0, pa1, pa2, pa3); pv_one<1>(o[1], vb, pa0, pa1, pa2, pa3); pv_one<2>(o[2], vb, pa0, pa1, pa2, pa3); pv_one<3>(o[3], vb, pa0, pa1, pa2, pa3);
}

constexpr float THR2 = THR * 1.4426950408889634f;
__device__ __forceinline__ void qkt_n(f32x16& p0, f32x16& p1, const bf16* Ks, const bf16x8* qr, const f32x16& negm, int r32, int hi) {
#pragma unroll
  for (int d0 = 0; d0 < 8; ++d0) { int cb = (d0 * 16 + hi * 8) * 2;
    bf16x8 b0 = *reinterpret_cast<const bf16x8*>((const char*)Ks + KSWZ(r32, cb));
    bf16x8 b1 = *reinterpret_cast<const bf16x8*>((const char*)Ks + KSWZ(32 + r32, cb));
    if (d0 == 0) { p0 = __builtin_amdgcn_mfma_f32_32x32x16_bf16(b0, qr[0], negm, 0, 0, 0); p1 = __builtin_amdgcn_mfma_f32_32x32x16_bf16(b1, qr[0], negm, 0, 0, 0); }
    else { p0 = __builtin_amdgcn_mfma_f32_32x32x16_bf16(b0, qr[d0], p0, 0, 0, 0); p1 = __builtin_amdgcn_mfma_f32_32x32x16_bf16(b1, qr[d0], p1, 0, 0, 0); } }
}
template <bool MASKED>
__device__ __forceinline__ void partialSM_n(f32x16& p0, f32x16& p1, float& m_reg, f32x16& negm, float& alpha, int mbase) {
  if constexpr (MASKED) {
    const float ninf = -__builtin_inff();
#pragma unroll
    for (int r = 0; r < 16; ++r) { const int c = (r & 3) + 8 * (r >> 2);
      p0[r] = ((unsigned)(mbase - c) <= 256u) ? p0[r] : ninf;
      p1[r] = ((unsigned)(mbase - c - 32) <= 256u) ? p1[r] : ninf; }
  }
  float pmax = p0[0];
#pragma unroll
  for (int r = 1; r < 16; ++r) pmax = fmaxf(pmax, p0[r]);
#pragma unroll
  for (int r = 0; r < 16; ++r) pmax = fmaxf(pmax, p1[r]);
  { auto rr = __builtin_amdgcn_permlane32_swap(__float_as_uint(pmax), __float_as_uint(pmax), false, false);
    pmax = fmaxf(__uint_as_float(rr[0]), __uint_as_float(rr[1])); }
  if (__builtin_expect(__all(pmax <= THR2), 1)) { alpha = 1.f; }
  else { const float sh = fmaxf(pmax, 0.f); alpha = __builtin_amdgcn_exp2f(-sh); m_reg += sh;
#pragma unroll
    for (int r = 0; r < 16; ++r) { p0[r] -= sh; p1[r] -= sh; negm[r] = -m_reg; } }
#pragma unroll
  for (int r = 0; r < 16; ++r) p0[r] = __builtin_amdgcn_exp2f(p0[r]);
}
template <int MODE, int SD>
__device__ __forceinline__ void attn_unit(const bf16* __restrict__ Qb, const bf16* __restrict__ Kh, const bf16* __restrict__ Vh, bf16* __restrict__ Ob, int NT, int dq0, const float* sinkp  , char* lds,
                                          const f32x2* __restrict__ tab  , const float* __restrict__ gq  ) {
  int tid_ = threadIdx.x; asm volatile("" : "+v"(tid_));
  const int tid = tid_, wid = tid >> 6, lane = tid & 63, r32 = lane & 31, hi = lane >> 5;
  bf16* V_lds = (bf16*)lds; bf16* K_lds = (bf16*)(lds + 2 * SHM_V);
  float* ws = (float*)(lds + 2 * SHM_V + 2 * SHM_K) + wid * 64; float* li_l = ws; float* al_l = ws + 32;
  const int wrow = MODE ? (wid >> 2) * QBLK : wid * QBLK, wcol = MODE ? (wid & 3) * D : 0;
  float m_reg = MODE ? sinkp[wid & 3] * (1.0f / SCALE) : 0.0f, l_reg = MODE ? 1.0f : 0.0f; f32x16 o[4] = {}; bf16x8 qr[8];
  f32x16 negm;
#pragma unroll
  for (int r = 0; r < 16; ++r) negm[r] = -m_reg;
  const bf16* Qw = Qb + (long)(wrow + r32) * LDQ + wcol + hi * 8;
#pragma unroll
  for (int d0 = 0; d0 < 8; ++d0) qr[d0] = *reinterpret_cast<const bf16x8*>(Qw + d0 * 16);
  const int sr = tid >> 4, sc = (tid & 15) * 8, vst0 = v_st(sr, sc), vst1 = v_st(32 + sr, sc);
  struct { bf16x8 vs0, vs1, ks0, ks1; } sr_[SD];
#define SLOAD(i, k0) do { sr_[i].vs0 = *reinterpret_cast<const bf16x8*>(&Vh[(long)((k0) + sr) * LDK + sc]); sr_[i].vs1 = *reinterpret_cast<const bf16x8*>(&Vh[(long)((k0) + 32 + sr) * LDK + sc]); \
    sr_[i].ks0 = *reinterpret_cast<const bf16x8*>(&Kh[(long)((k0) + sr) * LDK + sc]); sr_[i].ks1 = *reinterpret_cast<const bf16x8*>(&Kh[(long)((k0) + 32 + sr) * LDK + sc]); } while (0)
  SLOAD(0, 0);
  {
    float rstd = 1.f;
    if constexpr (MODE == 0) {
      float ss = 0.f;
#pragma unroll
      for (int d0 = 0; d0 < 8; ++d0) { const u32x4 w = *reinterpret_cast<const u32x4*>(&qr[d0]);
        const float a0 = bf_lo(w.x), a1 = bf_hi(w.x), a2 = bf_lo(w.y), a3 = bf_hi(w.y), a4 = bf_lo(w.z), a5 = bf_hi(w.z), a6 = bf_lo(w.w), a7 = bf_hi(w.w);
        ss += (a0 * a0 + a1 * a1) + (a2 * a2 + a3 * a3) + (a4 * a4 + a5 * a5) + (a6 * a6 + a7 * a7); }
      { auto rr = __builtin_amdgcn_permlane32_swap(__float_as_uint(ss), __float_as_uint(ss), false, false); ss = __uint_as_float(rr[0]) + __uint_as_float(rr[1]); }
      rstd = 1.0f / sqrtf(ss * (1.0f / D) + EPS);
    }
    const f32x4* tp = (const f32x4*)(tab + (wrow + r32) * 64 + hi * 8);
#pragma unroll
    for (int d0 = 0; d0 < 4; ++d0) {
      const u32x4 w1 = *reinterpret_cast<const u32x4*>(&qr[d0]), w2 = *reinterpret_cast<const u32x4*>(&qr[d0 + 4]);
      float x1[8] = {bf_lo(w1.x), bf_hi(w1.x), bf_lo(w1.y), bf_hi(w1.y), bf_lo(w1.z), bf_hi(w1.z), bf_lo(w1.w), bf_hi(w1.w)};
      float x2[8] = {bf_lo(w2.x), bf_hi(w2.x), bf_lo(w2.y), bf_hi(w2.y), bf_lo(w2.z), bf_hi(w2.z), bf_lo(w2.w), bf_hi(w2.w)};
      if constexpr (MODE == 0) {
        const f32x4 g1a = *(const f32x4*)(gq + d0 * 16 + hi * 8), g1b = *(const f32x4*)(gq + d0 * 16 + hi * 8 + 4), g2a = *(const f32x4*)(gq + 64 + d0 * 16 + hi * 8), g2b = *(const f32x4*)(gq + 64 + d0 * 16 + hi * 8 + 4);
        const float g1[8] = {g1a.x, g1a.y, g1a.z, g1a.w, g1b.x, g1b.y, g1b.z, g1b.w}, g2[8] = {g2a.x, g2a.y, g2a.z, g2a.w, g2b.x, g2b.y, g2b.z, g2b.w};
#pragma unroll
        for (int e = 0; e < 8; ++e) { x1[e] = x1[e] * rstd * g1[e]; x2[e] = x2[e] * rstd * g2[e]; }
      }
      float o1[8], o2[8];
#pragma unroll
      for (int e2 = 0; e2 < 4; ++e2) { const f32x4 cs = tp[d0 * 8 + e2];
        o1[2 * e2] = x1[2 * e2] * cs.x - x2[2 * e2] * cs.y; o2[2 * e2] = x2[2 * e2] * cs.x + x1[2 * e2] * cs.y;
        o1[2 * e2 + 1] = x1[2 * e2 + 1] * cs.z - x2[2 * e2 + 1] * cs.w; o2[2 * e2 + 1] = x2[2 * e2 + 1] * cs.z + x1[2 * e2 + 1] * cs.w; }
      if constexpr (MODE == 0) { constexpr float CQ = SCALE * 1.4426950408889634f;
#pragma unroll
        for (int e = 0; e < 8; ++e) { o1[e] *= CQ; o2[e] *= CQ; } }
      u32x4 p1, p2; p1.x = cvt_pk_bf16(o1[0], o1[1]); p1.y = cvt_pk_bf16(o1[2], o1[3]); p1.z = cvt_pk_bf16(o1[4], o1[5]); p1.w = cvt_pk_bf16(o1[6], o1[7]);
      p2.x = cvt_pk_bf16(o2[0], o2[1]); p2.y = cvt_pk_bf16(o2[2], o2[3]); p2.z = cvt_pk_bf16(o2[4], o2[5]); p2.w = cvt_pk_bf16(o2[6], o2[7]);
      qr[d0] = *reinterpret_cast<bf16x8*>(&p1); qr[d0 + 4] = *reinterpret_cast<bf16x8*>(&p2);
    }
  }
  const int vb0 = (int)(uintptr_t)V_lds + v_rd_base(lane);
  const int mb0 = dq0 + wrow + r32 + 128 - 4 * hi;
#define SWRITE(b, i) do { *(bf16x8*)((char*)V_lds + (b) * SHM_V + vst0) = sr_[i].vs0;          \
    *(bf16x8*)((char*)V_lds + (b) * SHM_V + vst1) = sr_[i].vs1; int kc = sc * 2;               \
    *(bf16x8*)((char*)K_lds + (b) * SHM_K + KSWZ(sr, kc)) = sr_[i].ks0;                       \
    *(bf16x8*)((char*)K_lds + (b) * SHM_K + KSWZ(32 + sr, kc)) = sr_[i].ks1; } while (0)
#define SWAIT() do { if constexpr (SD == 2) asm volatile("s_waitcnt vmcnt(4)" ::: "memory"); else asm volatile("s_waitcnt vmcnt(0)" ::: "memory"); } while (0)
#define RESC(a) do { if (__any((a) < 1.f)) { if (hi == 0) al_l[r32] = (a); asm volatile("s_waitcnt lgkmcnt(0)" ::: "memory"); \
    _Pragma("unroll") for (int d = 0; d < 4; ++d) _Pragma("unroll") for (int r = 0; r < 16; ++r) o[d][r] *= al_l[crow(r, hi)]; } } while (0)
#define PSM(P0, P1, MN, AL, J) do { if constexpr (MODE == 0) partialSM_n<false>(P0, P1, m_reg, negm, AL, 0); else partialSM<true>(P0, P1, m_reg, MN, AL, mb0 - 64 * (J)); } while (0)
#define QKT(P0, P1, KS) do { if constexpr (MODE == 0) qkt_n(P0, P1, KS, qr, negm, r32, hi); else qkt(P0, P1, KS, qr, r32, hi); } while (0)
  const int wq0 = dq0 + __builtin_amdgcn_readfirstlane(wrow);
#define NEED(T) (MODE == 0 || (64 * (T) <= wq0 + 31 + 128 && 64 * (T) + 63 >= wq0 - 128))
  f32x16 pA0, pA1, pB0, pB1; float mnA, mnB, alA, alB; bf16x8 pa0, pa1, pa2, pa3;
  constexpr int SE = 0, SO = SD - 1;
  asm volatile("s_waitcnt vmcnt(0)" ::: "memory"); SWRITE(0, SE); __syncthreads();
  alA = 1.f; alB = 1.f;
  if (NEED(0)) { QKT(pA0, pA1, K_lds); PSM(pA0, pA1, mnA, alA, 0); }
  SLOAD(SO, KVBLK); if constexpr (SD == 2) { if (2 < NT) SLOAD(SE, 2 * KVBLK); }
  SWAIT(); SWRITE(1, SO); __syncthreads();
  for (int j = 1; j + 1 < NT; j += 2) {
    const bool nB = NEED(j), nA0 = NEED(j - 1);
    SBAR(); if (nB) QKT(pB0, pB1, (bf16*)((char*)K_lds + SHM_K));
    if (nA0) finishSM(pA0, pA1, alA, l_reg, pa0, pa1, pa2, pa3); SBAR();
    SLOAD(SO, (j + SD) * KVBLK); SBAR();
    if (nA0) pv_d0(o, vb0, pa0, pa1, pa2, pa3); alB = 1.f; if (nB) PSM(pB0, pB1, mnB, alB, j);
    __syncthreads(); SWAIT(); SWRITE(0, SE);
    RESC(alB); __syncthreads();
    const bool nA1 = NEED(j + 1);
    SBAR(); if (nA1) QKT(pA0, pA1, K_lds);
    if (nB) finishSM(pB0, pB1, alB, l_reg, pa0, pa1, pa2, pa3); SBAR();
    if (SD == 1 || j + 3 < NT) SLOAD(SE, (j + 1 + SD) * KVBLK); SBAR();
    if (nB) pv_d0(o, vb0 + (int)SHM_V, pa0, pa1, pa2, pa3); alA = 1.f; if (nA1) PSM(pA0, pA1, mnA, alA, j + 1);
    __syncthreads(); SWAIT(); SWRITE(1, SO);
    RESC(alA); __syncthreads();
  }
  { const bool nB = NEED(NT - 1), nA0 = NEED(NT - 2);
  SBAR(); if (nB) QKT(pB0, pB1, (bf16*)((char*)K_lds + SHM_K));
  if (nA0) finishSM(pA0, pA1, alA, l_reg, pa0, pa1, pa2, pa3); SBAR();
  if (nA0) pv_d0(o, vb0, pa0, pa1, pa2, pa3); alB = 1.f; if (nB) PSM(pB0, pB1, mnB, alB, NT - 1);
  __syncthreads(); RESC(alB);
  if (nB) { finishSM(pB0, pB1, alB, l_reg, pa0, pa1, pa2, pa3); SBAR();
  pv_d0(o, vb0 + (int)SHM_V, pa0, pa1, pa2, pa3); } }
  if (hi == 0) li_l[r32] = l_reg; asm volatile("s_waitcnt lgkmcnt(0)" ::: "memory");
  float rli[16];
#pragma unroll
  for (int r = 0; r < 16; ++r) rli[r] = __builtin_amdgcn_rcpf(li_l[crow(r, hi)]);
  char* ost = lds + OST_OFF + wid * (32 * OST_PITCH);
#pragma unroll
  for (int r = 0; r < 16; ++r) { const int orow = crow(r, hi);
#pragma unroll
    for (int d0 = 0; d0 < 4; ++d0) { const float v = o[d0][r] * rli[r]; *(bf16*)(ost + orow * OST_PITCH + (d0 * 32 + r32) * 2) = (bf16)(cvt_pk_bf16(v, v) & 0xffffu); } }
  asm volatile("s_waitcnt lgkmcnt(0)" ::: "memory");
  bf16* Ow = Ob + (long)wrow * LDO + wcol;
#pragma unroll
  for (int i = 0; i < 8; ++i) { const int row = (lane >> 4) + 4 * i, cc = (lane & 15);
    const u32x4 w = *(const u32x4*)(ost + row * OST_PITCH + cc * 16);
    *(u32x4*)(Ow + (long)row * LDO + cc * 8) = w; }
  __syncthreads();
#undef SLOAD
#undef SWRITE
#undef SWAIT
#undef RESC
#undef PSM
#undef QKT
#undef NEED
}

__device__ __forceinline__ void qkt2(f32x16& p0, f32x16& p1, const char* Ks, const bf16x8* qr, int r32, int hi) {
  const int x = (r32 & 7) << 4;
  const char* ka = Ks + r32 * 256; const char* kb = Ks + (32 + r32) * 256;
#define KOFF(d0) ((((d0) * 32 + hi * 16)) ^ x)
  bf16x8 a0 = *reinterpret_cast<const bf16x8*>(ka + KOFF(0)), b0 = *reinterpret_cast<const bf16x8*>(kb + KOFF(0));
  bf16x8 a1 = *reinterpret_cast<const bf16x8*>(ka + KOFF(1)), b1 = *reinterpret_cast<const bf16x8*>(kb + KOFF(1));
  bf16x8 a2 = *reinterpret_cast<const bf16x8*>(ka + KOFF(2)), b2 = *reinterpret_cast<const bf16x8*>(kb + KOFF(2));
  bf16x8 a3 = *reinterpret_cast<const bf16x8*>(ka + KOFF(3)), b3 = *reinterpret_cast<const bf16x8*>(kb + KOFF(3));
  p0 = f32x16{}; p1 = f32x16{};
  SBAR();
  p0 = __builtin_amdgcn_mfma_f32_32x32x16_bf16(a0, qr[0], p0, 0, 0, 0); p1 = __builtin_amdgcn_mfma_f32_32x32x16_bf16(b0, qr[0], p1, 0, 0, 0);
  a0 = *reinterpret_cast<const bf16x8*>(ka + KOFF(4)); b0 = *reinterpret_cast<const bf16x8*>(kb + KOFF(4)); SBAR();
  p0 = __builtin_amdgcn_mfma_f32_32x32x16_bf16(a1, qr[1], p0, 0, 0, 0); p1 = __builtin_amdgcn_mfma_f32_32x32x16_bf16(b1, qr[1], p1, 0, 0, 0);
  a1 = *reinterpret_cast<const bf16x8*>(ka + KOFF(5)); b1 = *reinterpret_cast<const bf16x8*>(kb + KOFF(5)); SBAR();
  p0 = __builtin_amdgcn_mfma_f32_32x32x16_bf16(a2, qr[2], p0, 0, 0, 0); p1 = __builtin_amdgcn_mfma_f32_32x32x16_bf16(b2, qr[2], p1, 0, 0, 0);
  a2 = *reinterpret_cast<const bf16x8*>(ka + KOFF(6)); b2 = *reinterpret_cast<const bf16x8*>(kb + KOFF(6)); SBAR();
  p0 = __builtin_amdgcn_mfma_f32_32x32x16_bf16(a3, qr[3], p0, 0, 0, 0); p1 = __builtin_amdgcn_mfma_f32_32x32x16_bf16(b3, qr[3], p1, 0, 0, 0);
  a3 = *reinterpret_cast<const bf16x8*>(ka + KOFF(7)); b3 = *reinterpret_cast<const bf16x8*>(kb + KOFF(7)); SBAR();
  p0 = __builtin_amdgcn_mfma_f32_32x32x16_bf16(a0, qr[4], p0, 0, 0, 0); p1 = __builtin_amdgcn_mfma_f32_32x32x16_bf16(b0, qr[4], p1, 0, 0, 0); SBAR();
  p0 = __builtin_amdgcn_mfma_f32_32x32x16_bf16(a1, qr[5], p0, 0, 0, 0); p1 = __builtin_amdgcn_mfma_f32_32x32x16_bf16(b1, qr[5], p1, 0, 0, 0); SBAR();
  p0 = __builtin_amdgcn_mfma_f32_32x32x16_bf16(a2, qr[6], p0, 0, 0, 0); p1 = __builtin_amdgcn_mfma_f32_32x32x16_bf16(b2, qr[6], p1, 0, 0, 0); SBAR();
  p0 = __builtin_amdgcn_mfma_f32_32x32x16_bf16(a3, qr[7], p0, 0, 0, 0); p1 = __builtin_amdgcn_mfma_f32_32x32x16_bf16(b3, qr[7], p1, 0, 0, 0);
#undef KOFF
}
#define PV_RD(L, H, KS) do { L##0 = tr_read<v_rd_off(0, KS, 0)>(vb); H##0 = tr_read<v_rd_off(0, KS, 1)>(vb); L##1 = tr_read<v_rd_off(1, KS, 0)>(vb); H##1 = tr_read<v_rd_off(1, KS, 1)>(vb); \
    L##2 = tr_read<v_rd_off(2, KS, 0)>(vb); H##2 = tr_read<v_rd_off(2, KS, 1)>(vb); L##3 = tr_read<v_rd_off(3, KS, 0)>(vb); H##3 = tr_read<v_rd_off(3, KS, 1)>(vb); } while (0)
#define PV_PK(L, H) (bf16x8){L[0], L[1], L[2], L[3], H[0], H[1], H[2], H[3]}
#define PV_MM(PA, L, H) do { o[0] = __builtin_amdgcn_mfma_f32_32x32x16_bf16(PA, PV_PK(L##0, H##0), o[0], 0, 0, 0); o[1] = __builtin_amdgcn_mfma_f32_32x32x16_bf16(PA, PV_PK(L##1, H##1), o[1], 0, 0, 0); \
    o[2] = __builtin_amdgcn_mfma_f32_32x32x16_bf16(PA, PV_PK(L##2, H##2), o[2], 0, 0, 0); o[3] = __builtin_amdgcn_mfma_f32_32x32x16_bf16(PA, PV_PK(L##3, H##3), o[3], 0, 0, 0); } while (0)
__device__ __forceinline__ void pv2(f32x16* o, int vb, bf16x8 pa0, bf16x8 pa1, bf16x8 pa2, bf16x8 pa3) {
  s16x4 la0, la1, la2, la3, ha0, ha1, ha2, ha3, lb0, lb1, lb2, lb3, hb0, hb1, hb2, hb3;
  PV_RD(la, ha, 0); PV_RD(lb, hb, 1);
  asm volatile("s_waitcnt lgkmcnt(8)" ::: "memory"); SBAR(); PV_MM(pa0, la, ha); SBAR();
  PV_RD(la, ha, 2);
  asm volatile("s_waitcnt lgkmcnt(8)" ::: "memory"); SBAR(); PV_MM(pa1, lb, hb); SBAR();
  PV_RD(lb, hb, 3);
  asm volatile("s_waitcnt lgkmcnt(8)" ::: "memory"); SBAR(); PV_MM(pa2, la, ha); SBAR();
  asm volatile("s_waitcnt lgkmcnt(0)" ::: "memory"); SBAR(); PV_MM(pa3, lb, hb);
}
#undef PV_RD
#undef PV_PK
#undef PV_MM

constexpr int PP_K = 0, PP_V = 2 * SHM_K, PP_WS = 2 * SHM_K + 3 * SHM_V, PP_OST = 0;
static_assert(PP_WS + NW * 64 * 4 <= MISC_OFF && NW * 32 * OST_PITCH <= PP_WS, "attention LDS map");
__device__ __forceinline__ void pv_d0v(f32x16* o, int vb, bf16x8 pa0, bf16x8 pa1, bf16x8 pa2, bf16x8 pa3) { pv_d0(o, vb, pa0, pa1, pa2, pa3); }
template <int MODE>
__device__ __forceinline__ void attn_unit_pp(const bf16* __restrict__ Qb, const bf16* __restrict__ Kh, const bf16* __restrict__ Vh, bf16* __restrict__ Ob, int NT, int dq0, float sink, char* lds,
                                             const f32x2* __restrict__ tab, const float* __restrict__ gq) {
  int tid_ = threadIdx.x; asm volatile("" : "+v"(tid_));
  const int tid = tid_, wid = tid >> 6, lane = tid & 63, r32 = lane & 31, hi = lane >> 5, wr = __builtin_amdgcn_readfirstlane(wid >> 2);
  char* K_lds = lds + PP_K; char* V_lds = lds + PP_V;
  float* ws = (float*)(lds + PP_WS) + wid * 64; float* li_l = ws; float* al_l = ws + 32;
  float m_reg = MODE ? sink * (1.0f / SCALE) : -1e30f, l_reg = MODE ? 1.0f : 0.0f; f32x16 o[4] = {}; bf16x8 qr[8];
  const bf16* Qw = Qb + (long)(wid * QBLK + r32) * LDQ + hi * 8;
#pragma unroll
  for (int d0 = 0; d0 < 8; ++d0) qr[d0] = *reinterpret_cast<const bf16x8*>(Qw + d0 * 16);
  {
    float rstd = 1.f;
    if constexpr (MODE == 0) {
      float ss = 0.f;
#pragma unroll
      for (int d0 = 0; d0 < 8; ++d0) { const u32x4 w = *reinterpret_cast<const u32x4*>(&qr[d0]);
        const float a0 = bf_lo(w.x), a1 = bf_hi(w.x), a2 = bf_lo(w.y), a3 = bf_hi(w.y), a4 = bf_lo(w.z), a5 = bf_hi(w.z), a6 = bf_lo(w.w), a7 = bf_hi(w.w);
        ss += (a0 * a0 + a1 * a1) + (a2 * a2 + a3 * a3) + (a4 * a4 + a5 * a5) + (a6 * a6 + a7 * a7); }
      { auto rr = __builtin_amdgcn_permlane32_swap(__float_as_uint(ss), __float_as_uint(ss), false, false); ss = __uint_as_float(rr[0]) + __uint_as_float(rr[1]); }
      rstd = 1.0f / sqrtf(ss * (1.0f / D) + EPS);
    }
    const f32x4* tp = (const f32x4*)(tab + (wid * QBLK + r32) * 64 + hi * 8);
#pragma unroll
    for (int d0 = 0; d0 < 4; ++d0) {
      const u32x4 w1 = *reinterpret_cast<const u32x4*>(&qr[d0]), w2 = *reinterpret_cast<const u32x4*>(&qr[d0 + 4]);
      float x1[8] = {bf_lo(w1.x), bf_hi(w1.x), bf_lo(w1.y), bf_hi(w1.y), bf_lo(w1.z), bf_hi(w1.z), bf_lo(w1.w), bf_hi(w1.w)};
      float x2[8] = {bf_lo(w2.x), bf_hi(w2.x), bf_lo(w2.y), bf_hi(w2.y), bf_lo(w2.z), bf_hi(w2.z), bf_lo(w2.w), bf_hi(w2.w)};
      if constexpr (MODE == 0) {
        const f32x4 g1a = *(const f32x4*)(gq + d0 * 16 + hi * 8), g1b = *(const f32x4*)(gq + d0 * 16 + hi * 8 + 4), g2a = *(const f32x4*)(gq + 64 + d0 * 16 + hi * 8), g2b = *(const f32x4*)(gq + 64 + d0 * 16 + hi * 8 + 4);
        const float g1[8] = {g1a.x, g1a.y, g1a.z, g1a.w, g1b.x, g1b.y, g1b.z, g1b.w}, g2[8] = {g2a.x, g2a.y, g2a.z, g2a.w, g2b.x, g2b.y, g2b.z, g2b.w};
#pragma unroll
        for (int e = 0; e < 8; ++e) { x1[e] = x1[e] * rstd * g1[e]; x2[e] = x2[e] * rstd * g2[e]; }
      }
      float o1[8], o2[8];
#pragma unroll
      for (int e2 = 0; e2 < 4; ++e2) { const f32x4 cs = tp[d0 * 8 + e2];
        o1[2 * e2] = x1[2 * e2] * cs.x - x2[2 * e2] * cs.y; o2[2 * e2] = x2[2 * e2] * cs.x + x1[2 * e2] * cs.y;
        o1[2 * e2 + 1] = x1[2 * e2 + 1] * cs.z - x2[2 * e2 + 1] * cs.w; o2[2 * e2 + 1] = x2[2 * e2 + 1] * cs.z + x1[2 * e2 + 1] * cs.w; }
      u32x4 p1, p2; p1.x = cvt_pk_bf16(o1[0], o1[1]); p1.y = cvt_pk_bf16(o1[2], o1[3]); p1.z = cvt_pk_bf16(o1[4], o1[5]); p1.w = cvt_pk_bf16(o1[6], o1[7]);
      p2.x = cvt_pk_bf16(o2[0], o2[1]); p2.y = cvt_pk_bf16(o2[2], o2[3]); p2.z = cvt_pk_bf16(o2[4], o2[5]); p2.w = cvt_pk_bf16(o2[6], o2[7]);
      qr[d0] = *reinterpret_cast<bf16x8*>(&p1); qr[d0 + 4] = *reinterpret_cast<bf16x8*>(&p2);
    }
  }
  const int sr = tid >> 4, sc = (tid & 15) * 8, vst0 = v_st(sr, sc), vst1 = v_st(32 + sr, sc);
  const int vb0 = (int)(uintptr_t)V_lds + v_rd_base(lane);
  const int mb0 = dq0 + wid * QBLK + r32 + 128 - 4 * hi;
  struct { bf16x8 vs0, vs1, ks0, ks1; } sr_[2];
#define SLOAD(i, t) do { const long k0_ = (long)(t) * KVBLK; sr_[i].vs0 = *reinterpret_cast<const bf16x8*>(&Vh[(k0_ + sr) * LDK + sc]); sr_[i].vs1 = *reinterpret_cast<const bf16x8*>(&Vh[(k0_ + 32 + sr) * LDK + sc]); \
    sr_[i].ks0 = *reinterpret_cast<const bf16x8*>(&Kh[(k0_ + sr) * LDK + sc]); sr_[i].ks1 = *reinterpret_cast<const bf16x8*>(&Kh[(k0_ + 32 + sr) * LDK + sc]); } while (0)
#define SWRITE(i, kbuf, vbuf) do { *(bf16x8*)(V_lds + (vbuf) * SHM_V + vst0) = sr_[i].vs0; *(bf16x8*)(V_lds + (vbuf) * SHM_V + vst1) = sr_[i].vs1; const int kc = sc * 2; \
    *(bf16x8*)(K_lds + (kbuf) * SHM_K + KSWZ(sr, kc)) = sr_[i].ks0; *(bf16x8*)(K_lds + (kbuf) * SHM_K + KSWZ(32 + sr, kc)) = sr_[i].ks1; } while (0)
#define PPBAR() do { SBAR(); asm volatile("s_waitcnt lgkmcnt(0)" ::: "memory"); __builtin_amdgcn_s_barrier(); asm volatile("" ::: "memory"); SBAR(); } while (0)
#define RESC(a) do { if (__any((a) < 1.f)) { if (hi == 0) al_l[r32] = (a); asm volatile("s_waitcnt lgkmcnt(0)" ::: "memory"); \
    _Pragma("unroll") for (int d = 0; d < 4; ++d) _Pragma("unroll") for (int r = 0; r < 16; ++r) o[d][r] *= al_l[crow(r, hi)]; } } while (0)
  f32x16 p0, p1; bf16x8 pa0, pa1, pa2, pa3; float mn, al;
#define PPSTEP(j, SL) do { const int j_ = (j); \
    if (j_ + 2 < NT) { SWRITE(SL, (j_ + 2) & 1, (j_ + 2) % 3); if (j_ + 4 < NT) SLOAD(SL, j_ + 4); } \
    SBAR(); \
    if (j_ + 1 < NT) qkt2(p0, p1, K_lds + ((j_ + 1) & 1) * SHM_K, qr, r32, hi); \
    if (j_ >= 0) pv2(o, vb0 + (j_ % 3) * (int)SHM_V, pa0, pa1, pa2, pa3); \
    PPBAR(); \
    if (j_ + 1 < NT) { partialSM<MODE != 0>(p0, p1, m_reg, mn, al, mb0 - 64 * (j_ + 1)); RESC(al); finishSM(p0, p1, al, l_reg, pa0, pa1, pa2, pa3); } \
    PPBAR(); } while (0)
  SLOAD(0, 0); SWRITE(0, 0, 0); SLOAD(1, 1); SLOAD(0, 2);
  PPBAR();
  if (wr == 1) PPBAR();
  PPSTEP(-1, 1);
  for (int j = 0; j < NT; j += 2) { PPSTEP(j, 0); PPSTEP(j + 1, 1); }
  if (wr == 0) PPBAR();
  if (hi == 0) li_l[r32] = l_reg; asm volatile("s_waitcnt lgkmcnt(0)" ::: "memory");
  float rli[16];
#pragma unroll
  for (int r = 0; r < 16; ++r) rli[r] = __builtin_amdgcn_rcpf(li_l[crow(r, hi)]);
  char* ost = lds + PP_OST + wid * (32 * OST_PITCH);
#pragma unroll
  for (int r = 0; r < 16; ++r) { const int orow = crow(r, hi);
#pragma unroll
    for (int d0 = 0; d0 < 4; ++d0) { const float v = o[d0][r] * rli[r]; *(bf16*)(ost + orow * OST_PITCH + (d0 * 32 + r32) * 2) = (bf16)(cvt_pk_bf16(v, v) & 0xffffu); } }
  asm volatile("s_waitcnt lgkmcnt(0)" ::: "memory");
  bf16* Ow = Ob + (long)(wid * QBLK) * LDO;
#pragma unroll
  for (int i = 0; i < 8; ++i) { const int row = (lane >> 4) + 4 * i, cc = (lane & 15);
    const u32x4 w = *(const u32x4*)(ost + row * OST_PITCH + cc * 16);
    *(u32x4*)(Ow + (long)row * LDO + cc * 8) = w; }
  PPBAR();
#undef SLOAD
#undef SWRITE
#undef PPBAR
#undef RESC
#undef PPSTEP
}
}

#define XB_TMO      128
#define XB_XCNT(j)  (256  + 64 * (j))
#define XB_XSUB(j)  (1280 + 64 * (j))
#define XB_XGEN(j)  (2304 + 64 * (j))
#define XB_TOP      3328
#define XB_TOPGEN   3392
#define XCD_BAR_WORDS 3456
#define XB_SPIN_CAP (1u << 20)
__device__ __forceinline__ unsigned xb_ld(unsigned* p)              { return __hip_atomic_load(p, __ATOMIC_RELAXED, __HIP_MEMORY_SCOPE_AGENT); }
__device__ __forceinline__ unsigned xb_add(unsigned* p, unsigned v) { return __hip_atomic_fetch_add(p, v, __ATOMIC_RELAXED, __HIP_MEMORY_SCOPE_AGENT); }
__device__ __forceinline__ unsigned xb_xcc_id() { return (unsigned)__builtin_amdgcn_s_getreg((3 << 11) | 20) & 0xFu; }
#define XB_SPIN(cond, bar) do { unsigned _sp = 0; while (cond) { __builtin_amdgcn_s_sleep(1); \
    if ((++_sp & 255u) == 0u) { if (xb_ld(&(bar)[XB_TMO])) break; if (_sp > XB_SPIN_CAP) { atomicAdd(&(bar)[XB_TMO], 1u); break; } } } } while (0)
struct XcdBarrier { unsigned* bar; unsigned x; volatile LAS unsigned* st; };
__device__ __forceinline__ XcdBarrier xcd_barrier_post(unsigned* bar, volatile LAS unsigned* st) {
    XcdBarrier b; b.bar = bar; b.x = xb_xcc_id(); b.st = st;
    if (threadIdx.x == 0) (void)xb_add(&bar[XB_XCNT(b.x)], 1u);
    return b;
}
__device__ __forceinline__ void xcd_barrier_complete(unsigned* bar, unsigned x, unsigned& nloc, unsigned& nx) {
    const unsigned G = gridDim.x * gridDim.y * gridDim.z;
    unsigned sum, cnt, mine, sp = 0u;
    for (;;) {
        sum = 0u; cnt = 0u; mine = 0u;
#pragma unroll
        for (unsigned j = 0; j < 16; ++j) { const unsigned c = xb_ld(&bar[XB_XCNT(j)]); sum += c; cnt += (c > 0u) ? 1u : 0u; mine = (j == x) ? c : mine; }
        if (sum == G) break;
        __builtin_amdgcn_s_sleep(1);
        if ((++sp & 255u) == 0u) { if (xb_ld(&bar[XB_TMO])) break; if (sp > XB_SPIN_CAP) { atomicAdd(&bar[XB_TMO], 1u); break; } }
    }
    nloc = mine > 0u ? mine : 1u; nx = cnt > 0u ? cnt : 1u;
}
__device__ __forceinline__ void xcd_barrier(const XcdBarrier& b) {
    asm volatile("s_waitcnt vmcnt(0)" ::: "memory");
    __syncthreads();
    if (threadIdx.x == 0) {
        unsigned* bar = b.bar;
        __builtin_amdgcn_s_waitcnt(0);
        unsigned nloc = b.st[0], nx = b.st[1];
        if (nloc == 0u) { xcd_barrier_complete(bar, b.x, nloc, nx); b.st[0] = nloc; b.st[1] = nx; }
        const unsigned old = xb_add(&bar[XB_XSUB(b.x)], 1u);
        const unsigned gen = old / nloc;
        if (old + 1u == (gen + 1u) * nloc) {
            __builtin_amdgcn_fence(__ATOMIC_RELEASE, "agent");
            asm volatile("s_waitcnt vmcnt(0)" ::: "memory");
            const unsigned og = xb_add(&bar[XB_TOP], 1u);
            const unsigned tg = og / nx;
            if (og + 1u == (tg + 1u) * nx) xb_add(&bar[XB_TOPGEN], 1u);
            else XB_SPIN(xb_ld(&bar[XB_TOPGEN]) == tg, bar);
            __builtin_amdgcn_fence(__ATOMIC_ACQUIRE, "agent");
            xb_add(&bar[XB_XGEN(b.x)], 1u);
            asm volatile("s_waitcnt vmcnt(0)" ::: "memory");
        } else {
            XB_SPIN(xb_ld(&bar[XB_XGEN(b.x)]) == gen, bar);
            __builtin_amdgcn_fence(__ATOMIC_ACQUIRE, "agent");
            asm volatile("s_waitcnt vmcnt(0)" ::: "memory");
        }
    }
    __syncthreads();
}

__device__ __forceinline__ void transpose_item(const float* W, int K, int N, bf16* WT, LAS float* scr, int item, int lane, const float* gk = nullptr) {
    const int nblk = N / 32, kb = item / nblk, nb = item % nblk, k0 = 64 * kb, n0 = 32 * nb;
#pragma unroll
    for (int i = 0; i < 8; ++i) { const int kk = 8 * i + (lane >> 3), c4 = (lane & 7) * 4;
        const f32x4 v = *(const f32x4*)(W + (size_t)(k0 + kk) * N + n0 + c4); const float g = gk ? gk[k0 + kk] : 1.0f;
        LAS float* d = scr + kk * 33 + c4; d[0] = v.x * g; d[1] = v.y * g; d[2] = v.z * g; d[3] = v.w * g; }
    asm volatile("s_waitcnt lgkmcnt(0)" ::: "memory");
    const int c = lane & 7;
#pragma unroll
    for (int j = 0; j < 4; ++j) { const int n = (lane >> 3) + 8 * j; const LAS float* s = scr + (8 * c) * 33 + n;
        u32x4 o; o.x = cvt_pk_bf16(s[0 * 33], s[1 * 33]); o.y = cvt_pk_bf16(s[2 * 33], s[3 * 33]); o.z = cvt_pk_bf16(s[4 * 33], s[5 * 33]); o.w = cvt_pk_bf16(s[6 * 33], s[7 * 33]);
        *(u32x4*)(WT + (size_t)(n0 + n) * K + k0 + 8 * c) = o; }
    asm volatile("s_waitcnt lgkmcnt(0)" ::: "memory");
}

__device__ __forceinline__ void transpose_item_sub(const float* W, int K, int N, int NS, bf16* WT, LAS float* scr, int item, int lane, const float* gk, int ncol0 = 0) {
    const int nblk = NS / 32, kb = item / nblk, nb = item % nblk, k0 = 64 * kb, n0 = 32 * nb;
#pragma unroll
    for (int i = 0; i < 8; ++i) { const int kk = 8 * i + (lane >> 3), c4 = (lane & 7) * 4;
        const f32x4 v = *(const f32x4*)(W + (size_t)(k0 + kk) * N + ncol0 + n0 + c4); const float g = gk[k0 + kk];
        LAS float* d = scr + kk * 33 + c4; d[0] = v.x * g; d[1] = v.y * g; d[2] = v.z * g; d[3] = v.w * g; }
    asm volatile("s_waitcnt lgkmcnt(0)" ::: "memory");
    const int c = lane & 7;
#pragma unroll
    for (int j = 0; j < 4; ++j) { const int n = (lane >> 3) + 8 * j; const LAS float* s = scr + (8 * c) * 33 + n;
        u32x4 o; o.x = cvt_pk_bf16(s[0 * 33], s[1 * 33]); o.y = cvt_pk_bf16(s[2 * 33], s[3 * 33]); o.z = cvt_pk_bf16(s[4 * 33], s[5 * 33]); o.w = cvt_pk_bf16(s[6 * 33], s[7 * 33]);
        *(u32x4*)(WT + (size_t)(n0 + n) * K + k0 + 8 * c) = o; }
    asm volatile("s_waitcnt lgkmcnt(0)" ::: "memory");
}
__device__ __forceinline__ void colmax_item(const float* W, int N, int nq, int gs, int gl, unsigned* cmax, int item, int lane, const float* gk) {
    const int nblk = nq / 32, kb = item / nblk, nb = item % nblk, k0 = 64 * kb, n0 = 32 * nb, c4 = (lane & 7) * 4, ncol0 = (n0 >= gs) ? gl : 0;
    f32x4 mx = {0.f, 0.f, 0.f, 0.f};
#pragma unroll
    for (int i = 0; i < 8; ++i) { const int kk = 8 * i + (lane >> 3);
        const f32x4 v = *(const f32x4*)(W + (size_t)(k0 + kk) * N + ncol0 + n0 + c4) * gk[k0 + kk];
        mx.x = fmaxf(mx.x, fabsf(v.x)); mx.y = fmaxf(mx.y, fabsf(v.y)); mx.z = fmaxf(mx.z, fabsf(v.z)); mx.w = fmaxf(mx.w, fabsf(v.w)); }
#pragma unroll
    for (int o = 8; o < 64; o <<= 1) {
        mx.x = fmaxf(mx.x, __int_as_float(__builtin_amdgcn_ds_bpermute((lane ^ o) << 2, __float_as_int(mx.x)))); mx.y = fmaxf(mx.y, __int_as_float(__builtin_amdgcn_ds_bpermute((lane ^ o) << 2, __float_as_int(mx.y))));
        mx.z = fmaxf(mx.z, __int_as_float(__builtin_amdgcn_ds_bpermute((lane ^ o) << 2, __float_as_int(mx.z)))); mx.w = fmaxf(mx.w, __int_as_float(__builtin_amdgcn_ds_bpermute((lane ^ o) << 2, __float_as_int(mx.w)))); }
    if (lane < 8) { unsigned* p = cmax + n0 + c4;
        __hip_atomic_fetch_max(p + 0, __float_as_uint(mx.x), __ATOMIC_RELAXED, __HIP_MEMORY_SCOPE_AGENT); __hip_atomic_fetch_max(p + 1, __float_as_uint(mx.y), __ATOMIC_RELAXED, __HIP_MEMORY_SCOPE_AGENT);
        __hip_atomic_fetch_max(p + 2, __float_as_uint(mx.z), __ATOMIC_RELAXED, __HIP_MEMORY_SCOPE_AGENT); __hip_atomic_fetch_max(p + 3, __float_as_uint(mx.w), __ATOMIC_RELAXED, __HIP_MEMORY_SCOPE_AGENT); }
}
__device__ __forceinline__ unsigned pack_i8x4(float a, float b, float c, float d) {
    const int ia = (int)__builtin_rintf(a), ib = (int)__builtin_rintf(b), ic = (int)__builtin_rintf(c), id = (int)__builtin_rintf(d);
    return (unsigned)(ia & 0xff) | ((unsigned)(ib & 0xff) << 8) | ((unsigned)(ic & 0xff) << 16) | ((unsigned)id << 24);
}
__device__ __forceinline__ void transpose_item_q(const float* W, int K, int N, int nq, int gs, int gl, unsigned char* WQ, const float* cmax, LAS float* scr, int item, int lane, const float* gk) {
    const int nblk = nq / 32, kb = item / nblk, nb = item % nblk, k0 = 64 * kb, n0 = 32 * nb, ncol0 = (n0 >= gs) ? gl : 0;
#pragma unroll
    for (int i = 0; i < 8; ++i) { const int kk = 8 * i + (lane >> 3), c4 = (lane & 7) * 4;
        const f32x4 v = *(const f32x4*)(W + (size_t)(k0 + kk) * N + ncol0 + n0 + c4); const float g = gk[k0 + kk];
        LAS float* d = scr + kk * 33 + c4; d[0] = v.x * g; d[1] = v.y * g; d[2] = v.z * g; d[3] = v.w * g; }
    asm volatile("s_waitcnt lgkmcnt(0)" ::: "memory");
    const int c = lane & 7;
#pragma unroll
    for (int j = 0; j < 4; ++j) { const int n = (lane >> 3) + 8 * j; const LAS float* s = scr + (8 * c) * 33 + n;
        const float q = 127.0f / fmaxf(cmax[n0 + n], 1e-30f);
        *(u32x2*)(WQ + (size_t)(n0 + n) * K + k0 + 8 * c) = (u32x2){pack_i8x4(s[0 * 33] * q, s[1 * 33] * q, s[2 * 33] * q, s[3 * 33] * q), pack_i8x4(s[4 * 33] * q, s[5 * 33] * q, s[6 * 33] * q, s[7 * 33] * q)}; }
    asm volatile("s_waitcnt lgkmcnt(0)" ::: "memory");
}

struct Args { const float* in[21]; float* out; unsigned char* ws; int lo, hi; };

__device__ __forceinline__ const float* x_in_row(const float* xp, const float* xs, int row) {
    return row < NPROMPT_TOK ? xp + (size_t)row * DM : xs + (size_t)(row - NPROMPT_TOK) * DM;
}

__device__ __forceinline__ void phase_weights(const CAS Args* a, unsigned char* ws, int l, LAS unsigned char* lds, int gw, int NGW, int wave, int lane) {
    LAS float* scr = (LAS float*)(lds + wave * 16384);
    constexpr int I_IN = (DM / 64) * (XYW / 32), I_GQ = (DM / 64) * (I8W / 32), I_BR = (MWD / 64) * (DM / 32), I_OUT = (DM / 64) * (DM / 32), I_F1 = (DM / 64) * (FFD / 32), I_F2 = (FFD / 64) * (DM / 32), I_G = 32 * 8;
    constexpr int NITEMS = I_IN + I_GQ + 3 * I_BR + I_OUT + I_F1 + I_F2 + I_G;
    for (int it = gw; it < NITEMS; it += NGW) {
        int r = it;
        if (r < I_IN) { transpose_item_sub(a->in[6] + (size_t)l * DM * INW, DM, INW, XYW, (bf16*)(ws + WS_WIN), scr, r, lane, a->in[2] + (size_t)l * DM, QKVW); continue; } r -= I_IN;
        if (r < I_GQ) { colmax_item(a->in[6] + (size_t)l * DM * INW, INW, I8W, QKVW, XYW, (unsigned*)(ws + WS_CTL) + CW_CMAX + l * I8W, r, lane, a->in[2] + (size_t)l * DM); continue; } r -= I_GQ;
        if (r < 3 * I_BR) { const int b = r / I_BR; transpose_item(a->in[17] + ((size_t)l * 3 + b) * MWD * DM, MWD, DM, (bf16*)(ws + WS_WBR) + (size_t)b * DM * MWD, scr, r - b * I_BR, lane); continue; } r -= 3 * I_BR;
        if (r < I_OUT) { transpose_item(a->in[18] + (size_t)l * DM * DM, DM, DM, (bf16*)(ws + WS_WOUT), scr, r, lane); continue; } r -= I_OUT;
        if (r < I_F1) { colmax_item(a->in[19] + (size_t)l * DM * FFD, FFD, FFD, 1 << 30, 0, (unsigned*)(ws + WS_CTL) + CW_CMAX1 + l * FFD, r, lane, a->in[4] + (size_t)l * DM); continue; } r -= I_F1;
        if (r < I_F2) { transpose_item(a->in[20] + (size_t)l * FFD * DM, FFD, DM, (bf16*)(ws + WS_W2), scr, r, lane); continue; } r -= I_F2;
        { const int mi = r >> 3, sub = r & 7;
          const int gate = mi >> 4, dd = (mi >> 3) & 1, blk = mi & 7;
          const float* src = (gate ? a->in[14] : a->in[12]) + (((size_t)l * 2 + dd) * 8 + blk) * 16384;
          transpose_item(src, 128, 128, (bf16*)(ws + WS_WG) + ((size_t)(dd * 2 + gate) * 8 + blk) * 16384, scr, sub, lane); }
    }
}

__device__ __forceinline__ void entry_row(const float* xrow, bf16* xb, float* rs, int lane, unsigned char* xq, float* sx) {
    const f32x4* xr = (const f32x4*)xrow + lane;
    f32x4 v[8]; float s = 0.f;
#pragma unroll
    for (int j = 0; j < 8; ++j) { v[j] = xr[64 * j]; s += (v[j].x * v[j].x + v[j].y * v[j].y) + (v[j].z * v[j].z + v[j].w * v[j].w); }
    float am = 0.f;
#pragma unroll
    for (int j = 0; j < 8; ++j) am = fmaxf(fmaxf(am, fmaxf(fabsf(v[j].x), fabsf(v[j].y))), fmaxf(fabsf(v[j].z), fabsf(v[j].w)));
    am = fmaxf(wave_max(am, lane), 1e-30f); const float qs = 127.0f / am;
    u32x2* o8 = (u32x2*)xb + lane;
#pragma unroll
    for (int j = 0; j < 8; ++j) { u32x2 w; w.x = cvt_pk_bf16(v[j].x, v[j].y); w.y = cvt_pk_bf16(v[j].z, v[j].w); o8[64 * j] = w;
        ((unsigned*)xq)[64 * j + lane] = pack_i8x4(v[j].x * qs, v[j].y * qs, v[j].z * qs, v[j].w * qs); }
    const float tot = wave_sum(s, lane);
    if (lane == 0) { *rs = __builtin_amdgcn_rsqf(tot * (1.0f / DM) + EPS); *sx = am * (1.0f / 127.0f); }
}
template <bool LAST>
__device__ __forceinline__ void resid_norm_row(const u32x4 (&yw)[4], const u32x4 (&xw)[4], bf16* xrow, const float* g, float* rs, float* outrow, int lane, bf16* xdst = nullptr, unsigned char* xq = nullptr, float* sx = nullptr) {
    if (!xdst) xdst = xrow;
    float y[32], x[32]; float s = 0.f;
#pragma unroll
    for (int j = 0; j < 4; ++j) { const u32x4 w = yw[j];
        y[8 * j + 0] = bf_lo(w.x); y[8 * j + 1] = bf_hi(w.x); y[8 * j + 2] = bf_lo(w.y); y[8 * j + 3] = bf_hi(w.y); y[8 * j + 4] = bf_lo(w.z); y[8 * j + 5] = bf_hi(w.z); y[8 * j + 6] = bf_lo(w.w); y[8 * j + 7] = bf_hi(w.w); }
#pragma unroll
    for (int j = 0; j < 4; ++j) { const u32x4 w = xw[j];
        x[8 * j + 0] = bf_lo(w.x); x[8 * j + 1] = bf_hi(w.x); x[8 * j + 2] = bf_lo(w.y); x[8 * j + 3] = bf_hi(w.y); x[8 * j + 4] = bf_lo(w.z); x[8 * j + 5] = bf_hi(w.z); x[8 * j + 6] = bf_lo(w.w); x[8 * j + 7] = bf_hi(w.w); }
#pragma unroll
    for (int i = 0; i < 32; ++i) s += y[i] * y[i];
    const float rstd = __builtin_amdgcn_rsqf(wave_sum(s, lane) * (1.0f / DM) + EPS);
    float s2 = 0.f;
#pragma unroll
    for (int j = 0; j < 4; ++j) { const f32x4 g0 = ((const f32x4*)g)[2 * (64 * j + lane)], g1 = ((const f32x4*)g)[2 * (64 * j + lane) + 1];
        const float gg[8] = {g0.x, g0.y, g0.z, g0.w, g1.x, g1.y, g1.z, g1.w};
#pragma unroll
        for (int e = 0; e < 8; ++e) { const float v = x[8 * j + e] + y[8 * j + e] * rstd * gg[e]; x[8 * j + e] = v; s2 += v * v; } }
    if constexpr (LAST) {
#pragma unroll
        for (int j = 0; j < 4; ++j) { ((f32x4*)outrow)[2 * (64 * j + lane)] = (f32x4){x[8 * j], x[8 * j + 1], x[8 * j + 2], x[8 * j + 3]}; ((f32x4*)outrow)[2 * (64 * j + lane) + 1] = (f32x4){x[8 * j + 4], x[8 * j + 5], x[8 * j + 6], x[8 * j + 7]}; }
    } else {
#pragma unroll
        for (int j = 0; j < 4; ++j) { u32x4 w; w.x = cvt_pk_bf16(x[8 * j], x[8 * j + 1]); w.y = cvt_pk_bf16(x[8 * j + 2], x[8 * j + 3]); w.z = cvt_pk_bf16(x[8 * j + 4], x[8 * j + 5]); w.w = cvt_pk_bf16(x[8 * j + 6], x[8 * j + 7]);
            ((u32x4*)xdst)[64 * j + lane] = w; }
        const float r2 = __builtin_amdgcn_rsqf(wave_sum(s2, lane) * (1.0f / DM) + EPS);
        if (lane == 0) *rs = r2;
        if (xq) {
            float am = 0.f;
#pragma unroll
            for (int i = 0; i < 32; ++i) am = fmaxf(am, fabsf(x[i]));
            am = fmaxf(wave_max(am, lane), 1e-30f); const float qs = 127.0f / am;
#pragma unroll
            for (int j = 0; j < 4; ++j) ((u32x2*)xq)[64 * j + lane] = (u32x2){pack_i8x4(x[8 * j] * qs, x[8 * j + 1] * qs, x[8 * j + 2] * qs, x[8 * j + 3] * qs), pack_i8x4(x[8 * j + 4] * qs, x[8 * j + 5] * qs, x[8 * j + 6] * qs, x[8 * j + 7] * qs)};
            if (lane == 0) *sx = am * (1.0f / 127.0f);
        }
    }
}
__device__ __forceinline__ void load_row16(const bf16* row, u32x4 (&w)[4], int lane) {
#pragma unroll
    for (int j = 0; j < 4; ++j) w[j] = ((const u32x4*)row)[64 * j + lane];
}
template <bool LAST, bool QUANT>
__device__ __forceinline__ void resid_norm_rows(const bf16* Ysrc, bf16* X, const float* g, float* rsbase, float* outbase, unsigned char* xqbase, float* sxbase, int TC, int gw, int NGW, int lane) {
    int m = gw; if (m >= TC) return;
    u32x4 yw[4], xw[4]; load_row16(Ysrc + (size_t)m * DM, yw, lane); load_row16(X + (size_t)m * DM, xw, lane);
    for (; m < TC; m += NGW) {
        const int ml = (m + NGW < TC) ? m + NGW : m;
        u32x4 yn[4], xn[4]; load_row16(Ysrc + (size_t)ml * DM, yn, lane); load_row16(X + (size_t)ml * DM, xn, lane);
        if constexpr (LAST) resid_norm_row<true>(yw, xw, X + (size_t)m * DM, g, nullptr, outbase + (size_t)m * DM, lane);
        else if constexpr (QUANT) resid_norm_row<false>(yw, xw, X + (size_t)m * DM, g, rsbase + m, nullptr, lane, nullptr, xqbase + (size_t)m * DM, sxbase + m);
        else resid_norm_row<false>(yw, xw, X + (size_t)m * DM, g, rsbase + m, nullptr, lane);
#pragma unroll
        for (int j = 0; j < 4; ++j) { yw[j] = yn[j]; xw[j] = xn[j]; }
    }
}

__device__ __forceinline__ void krope_token2(bf16* prow0, int pos0, const f32x2* taba, const f32x2* tab1, const float* kn, int lane) {
    const int th = lane >> 5, head = (lane >> 3) & 3, c8 = (lane & 7) * 8; const bool isA = head < 2;
    bf16* p = prow0 + (size_t)th * PWD + (isA ? KA_OFF + head * HD : KB_OFF + (head - 2) * HD) + c8;
    const u32x4 w1 = *(const u32x4*)p, w2 = *(const u32x4*)(p + 64);
    float x1[8] = {bf_lo(w1.x), bf_hi(w1.x), bf_lo(w1.y), bf_hi(w1.y), bf_lo(w1.z), bf_hi(w1.z), bf_lo(w1.w), bf_hi(w1.w)};
    float x2[8] = {bf_lo(w2.x), bf_hi(w2.x), bf_lo(w2.y), bf_hi(w2.y), bf_lo(w2.z), bf_hi(w2.z), bf_lo(w2.w), bf_hi(w2.w)};
    float ss = 0.f;
#pragma unroll
    for (int e = 0; e < 8; ++e) ss += x1[e] * x1[e] + x2[e] * x2[e];
#pragma unroll
    for (int o = 1; o < 8; o <<= 1) ss += __int_as_float(__builtin_amdgcn_ds_bpermute((lane ^ o) << 2, __float_as_int(ss)));
    const float rstd = isA ? __builtin_amdgcn_rsqf(ss * (1.0f / HD) + EPS) : 1.0f;
    const f32x4* tp = (const f32x4*)((isA ? taba : tab1) + (size_t)(pos0 + th) * 64 + c8);
    const f32x4 ga = *(const f32x4*)(kn + c8), gb = *(const f32x4*)(kn + c8 + 4), gc = *(const f32x4*)(kn + 64 + c8), gd = *(const f32x4*)(kn + 64 + c8 + 4);
    const float g1[8] = {ga.x, ga.y, ga.z, ga.w, gb.x, gb.y, gb.z, gb.w}, g2[8] = {gc.x, gc.y, gc.z, gc.w, gd.x, gd.y, gd.z, gd.w};
    float o1[8], o2[8];
#pragma unroll
    for (int e2 = 0; e2 < 4; ++e2) { const f32x4 cs = tp[e2];
#pragma unroll
        for (int k = 0; k < 2; ++k) { const int e = 2 * e2 + k; const float c = k ? cs.z : cs.x, s = k ? cs.w : cs.y;
            const float y1 = x1[e] * rstd * (isA ? g1[e] : 1.0f), y2 = x2[e] * rstd * (isA ? g2[e] : 1.0f);
            o1[e] = y1 * c - y2 * s; o2[e] = y2 * c + y1 * s; } }
    u32x4 q1, q2; q1.x = cvt_pk_bf16(o1[0], o1[1]); q1.y = cvt_pk_bf16(o1[2], o1[3]); q1.z = cvt_pk_bf16(o1[4], o1[5]); q1.w = cvt_pk_bf16(o1[6], o1[7]);
    q2.x = cvt_pk_bf16(o2[0], o2[1]); q2.y = cvt_pk_bf16(o2[2], o2[3]); q2.z = cvt_pk_bf16(o2[4], o2[5]); q2.w = cvt_pk_bf16(o2[6], o2[7]);
    *(u32x4*)p = q1; *(u32x4*)(p + 64) = q2;
}
__device__ __forceinline__ void rope_tables(f32x2* tab1, f32x2* taba, int gtid, int nthr) {
    for (int i = gtid; i < SEQ * 64; i += nthr) {
        const int pos = i >> 6, j = i & 63;
        const double rev1 = (double)pos * ROPE_F1[j];
        const double reva = (double)(j < 32 ? (pos >> 6) : (pos & 63)) * ROPE_FA[j & 31];
        const float f1 = (float)(rev1 - __builtin_floor(rev1)), fa = (float)(reva - __builtin_floor(reva));
        tab1[i] = (f32x2){__builtin_amdgcn_cosf(f1), __builtin_amdgcn_sinf(f1)};
        taba[i] = (f32x2){__builtin_amdgcn_cosf(fa), __builtin_amdgcn_sinf(fa)};
    }
}

struct CParams { const float* conv_w; const float* conv_b; const float* gate_r_b; const float* gate_i_b; const float* lam; const bf16* WG; };
constexpr int CSPAN = 512, NSPAN = SEQ / CSPAN;
template <int PASS, int DIR>
__device__ __forceinline__ void c_sweep(LAS unsigned char* lds, const bf16* P, bf16* OC, const CParams& cp, f32x2* SUM, bf16* UB, int seq, int nb, int sp) {
    constexpr bool FIRST = (PASS == 1 && DIR == 0);
    constexpr int UP = 136;
    LAS bf16* U = (LAS bf16*)lds;
    LAS float* AD = (LAS float*)(lds + 32768);
    int tid_ = threadIdx.x; asm volatile("" : "+v"(tid_));
    const int tid = tid_, wave = tid >> 6, lane = tid & 63;
    const int t0 = tid >> 4, c8 = (tid & 15) * 8, cg8 = nb * 128 + c8;
    LAS float* CW = (LAS float*)(lds + 32768 + 65536);
    const int q = wave & 3, th = wave >> 2, r = lane & 31, h = lane >> 5;
    bf16x8 bfr[8], bfi[8];
    { const bf16* wrp = cp.WG + ((size_t)((DIR * 2 + 0) * 8 + nb) * 128 + 32 * q + r) * 128 + 8 * h;
      const bf16* wip = cp.WG + ((size_t)((DIR * 2 + 1) * 8 + nb) * 128 + 32 * q + r) * 128 + 8 * h;
#pragma unroll
      for (int ks = 0; ks < 8; ++ks) { bfr[ks] = *(const bf16x8*)(wrp + 16 * ks); bfi[ks] = *(const bf16x8*)(wip + 16 * ks); } }
    const int ch = 32 * q + r, cg = nb * 128 + ch;
    constexpr float L2E = 1.4426950408889634f;
    const float rbn = -L2E * cp.gate_r_b[DIR * MWD + cg], ibn = -L2E * cp.gate_i_b[DIR * MWD + cg], lam = cp.lam[DIR * MWD + cg];
    const float el = __builtin_amdgcn_exp2f(-L2E * lam);
    const float ls8 = -8.0f * (lam > 3.0f ? el * (1.0f - el * (0.5f - el * (1.0f / 3.0f))) : 0.6931471805599453f * __builtin_amdgcn_logf(1.0f + el));
    const f32x2 ls8e = {ls8 * L2E, ls8 * L2E}, ls82 = {2.0f * ls8, 2.0f * ls8}, rbn2 = {rbn, rbn}, ibn2 = {ibn, ibn};
    float hh = 0.f, pp = 1.f;
    if constexpr (PASS == 3) {
        if (tid < 128) {
            const f32x2* sb = SUM + ((size_t)(seq * NSPAN) * 2 + DIR) * MWD + nb * 128 + tid;
            f32x2 sv[NSPAN];
#pragma unroll
            for (int s = 0; s < NSPAN; ++s) sv[s] = sb[(size_t)s * 2 * MWD];
#pragma unroll
            for (int s = 0; s < NSPAN; ++s) { const int ss = DIR ? NSPAN - 1 - s : s; const bool use = DIR ? (ss > sp) : (ss < sp); hh = use ? sv[ss].x * hh + sv[ss].y : hh; }
        }
    }
    const size_t rowbase = (size_t)seq * SEQ + (size_t)sp * CSPAN;
    const int posbase = sp * CSPAN;
    u32x4 xw[2][4];
#define C_LOADX(tile) do { _Pragma("unroll") for (int hf = 0; hf < 2; ++hf) _Pragma("unroll") for (int j = 0; j < 4; ++j) { const int tt = posbase + (tile) * 64 + t0 + 32 * hf - 2 + j; \
        const int ttc = tt < 0 ? 0 : (tt >= SEQ ? SEQ - 1 : tt); const u32x4 xv = *(const u32x4*)(P + ((size_t)seq * SEQ + ttc) * PWD + XC_OFF + cg8); \
        const unsigned keep = (tt >= 0 && tt < SEQ) ? 0xffffffffu : 0u; xw[hf][j] = (u32x4){xv.x & keep, xv.y & keep, xv.z & keep, xv.w & keep}; } } while (0)
    u32x4 uw[2];
#define C_LOADU(tile) do { _Pragma("unroll") for (int hf = 0; hf < 2; ++hf) uw[hf] = *(const u32x4*)(UB + (rowbase + (tile) * 64 + t0 + 32 * hf) * MWD + cg8); } while (0)
    if constexpr (FIRST) C_LOADX(DIR ? 7 : 0); else C_LOADU(DIR ? 7 : 0);
    for (int i = tid; i < 5 * 128; i += 512) CW[i] = (i < 512) ? cp.conv_w[(i >> 7) * MWD + nb * 128 + (i & 127)] : cp.conv_b[nb * 128 + (i & 127)];
    __syncthreads();
    for (int it = 0; it < 8; ++it) {
        const int tile = DIR ? 7 - it : it;
        if constexpr (FIRST) {
#pragma unroll
        for (int hf = 0; hf < 2; ++hf) {
            float u8[8];
            { const f32x4 b0 = *(const LAS f32x4*)(CW + 512 + c8), b1 = *(const LAS f32x4*)(CW + 512 + c8 + 4); u8[0] = b0.x; u8[1] = b0.y; u8[2] = b0.z; u8[3] = b0.w; u8[4] = b1.x; u8[5] = b1.y; u8[6] = b1.z; u8[7] = b1.w; }
#pragma unroll
            for (int j = 0; j < 4; ++j) { const u32x4 x = xw[hf][j]; const f32x4 w0 = *(const LAS f32x4*)(CW + j * 128 + c8), w1 = *(const LAS f32x4*)(CW + j * 128 + c8 + 4);
                u8[0] += bf_lo(x.x) * w0.x; u8[1] += bf_hi(x.x) * w0.y; u8[2] += bf_lo(x.y) * w0.z; u8[3] += bf_hi(x.y) * w0.w;
                u8[4] += bf_lo(x.z) * w1.x; u8[5] += bf_hi(x.z) * w1.y; u8[6] += bf_lo(x.w) * w1.z; u8[7] += bf_hi(x.w) * w1.w; }
            u32x4 w; w.x = cvt_pk_bf16(u8[0], u8[1]); w.y = cvt_pk_bf16(u8[2], u8[3]); w.z = cvt_pk_bf16(u8[4], u8[5]); w.w = cvt_pk_bf16(u8[6], u8[7]);
            *(LAS u32x4*)(U + (t0 + 32 * hf) * UP + c8) = w;
            *(u32x4*)(UB + (rowbase + tile * 64 + t0 + 32 * hf) * MWD + cg8) = w;
        }
        } else {
#pragma unroll
        for (int hf = 0; hf < 2; ++hf) *(LAS u32x4*)(U + (t0 + 32 * hf) * UP + c8) = uw[hf];
        }
        if (it < 7) { if constexpr (FIRST) C_LOADX(DIR ? 6 - it : it + 1); else C_LOADU(DIR ? 6 - it : it + 1); }
        __syncthreads();
        {
            f32x16 accr = {}, acci = {};
#pragma unroll
            for (int ks = 0; ks < 8; ++ks) {
                const bf16x8 af = *(const LAS bf16x8*)(U + (32 * th + r) * UP + 16 * ks + 8 * h);
                accr = __builtin_amdgcn_mfma_f32_32x32x16_bf16(af, bfr[ks], accr, 0, 0, 0);
                acci = __builtin_amdgcn_mfma_f32_32x32x16_bf16(af, bfi[ks], acci, 0, 0, 0);
            }
            LAS float* pa = AD + ch; LAS float* pd = AD + 64 * 128 + ch;
#define C_PAIR(reg, AV, DR) do { const int tt = 32 * th + ((reg) & 3) + 8 * ((reg) >> 2) + 4 * h; \
                const f32x2 er = (f32x2){accr[reg], accr[(reg) + 1]} * (-L2E) + rbn2, ei = (f32x2){acci[reg], acci[(reg) + 1]} * (-L2E) + ibn2;       \
                f32x2 rr, ii; rr.x = __builtin_amdgcn_rcpf(1.0f + __builtin_amdgcn_exp2f(er.x)); rr.y = __builtin_amdgcn_rcpf(1.0f + __builtin_amdgcn_exp2f(er.y)); \
                ii.x = __builtin_amdgcn_rcpf(1.0f + __builtin_amdgcn_exp2f(ei.x)); ii.y = __builtin_amdgcn_rcpf(1.0f + __builtin_amdgcn_exp2f(ei.y)); \
                const f32x2 le = ls8e * rr, x2 = ls82 * rr;                                          \
                f32x2 av_; av_.x = __builtin_amdgcn_exp2f(le.x); av_.y = __builtin_amdgcn_exp2f(le.y); \
                const f32x2 pol = -x2 * (1.0f + x2 * (0.5f + x2 * ((1.0f / 6.0f) + x2 * ((1.0f / 24.0f) + x2 * (1.0f / 120.0f))))), dir = 1.0f - av_ * av_;     \
                f32x2 om; om.x = x2.x > -0.25f ? pol.x : dir.x; om.y = x2.y > -0.25f ? pol.y : dir.y; \
                const f32x2 uf = {bf2f(U[tt * UP + ch]), bf2f(U[(tt + 1) * UP + ch])}; \
                f32x2 sq; sq.x = __builtin_amdgcn_sqrtf(om.x); sq.y = __builtin_amdgcn_sqrtf(om.y); \
                AV = av_; DR = sq * (ii * uf); } while (0)
            if constexpr (PASS == 1) {
#pragma unroll
                for (int g4 = 0; g4 < 4; ++g4) { f32x2 a01, d01, a23, d23; C_PAIR(4 * g4, a01, d01); C_PAIR(4 * g4 + 2, a23, d23);
                    float dd;
                    if constexpr (DIR == 0) { dd = a01.y * d01.x + d01.y; dd = a23.x * dd + d23.x; dd = a23.y * dd + d23.y; }
                    else { dd = a23.x * d23.y + d23.x; dd = a01.y * dd + d01.y; dd = a01.x * dd + d01.x; }
                    const int G4 = 8 * th + 2 * g4 + h;
                    pa[G4 * 128] = (a01.x * a01.y) * (a23.x * a23.y); pd[G4 * 128] = dd; }
            } else {
#pragma unroll
                for (int reg = 0; reg < 16; reg += 2) { f32x2 av, dr; C_PAIR(reg, av, dr); const int tt = 32 * th + (reg & 3) + 8 * (reg >> 2) + 4 * h;
                    pa[tt * 128] = av.x; pa[(tt + 1) * 128] = av.y; pd[tt * 128] = dr.x; pd[(tt + 1) * 128] = dr.y; }
            }
#undef C_PAIR
        }
        u32x4 yw[2], ow[2];
        if constexpr (PASS == 3 && DIR == 1) {
#pragma unroll
            for (int hf = 0; hf < 2; ++hf) { const size_t row = rowbase + tile * 64 + t0 + 32 * hf; yw[hf] = *(const u32x4*)(P + row * PWD + YC_OFF + cg8); ow[hf] = *(const u32x4*)(OC + row * MWD + cg8); }
        }
        __syncthreads();
        if (tid < 128) {
            LAS float* pa = AD + tid; LAS float* pd = AD + 64 * 128 + tid;
            if constexpr (PASS == 1) {
                float av[16], dv[16];
#pragma unroll
                for (int s = 0; s < 16; ++s) { const int g = DIR ? 15 - s : s; av[s] = pa[g * 128]; dv[s] = pd[g * 128]; }
#pragma unroll
                for (int s = 0; s < 16; ++s) { hh = av[s] * hh + dv[s]; pp *= av[s]; }
            } else
#pragma unroll
            for (int s0 = 0; s0 < 64; s0 += 16) {
                float av[16], dv[16];
#pragma unroll
                for (int s = 0; s < 16; ++s) { const int t = DIR ? 63 - (s0 + s) : (s0 + s); av[s] = pa[t * 128]; dv[s] = pd[t * 128]; }
#pragma unroll
                for (int s = 0; s < 16; ++s) { hh = av[s] * hh + dv[s]; if constexpr (PASS == 1) pp *= av[s]; else dv[s] = hh; }
                if constexpr (PASS == 3) {
#pragma unroll
                    for (int s = 0; s < 16; ++s) { const int t = DIR ? 63 - (s0 + s) : (s0 + s); pa[t * 128] = dv[s]; } }
            }
        }
        if constexpr (PASS == 3) {
            __syncthreads();
#pragma unroll
            for (int hf = 0; hf < 2; ++hf) { const int t = t0 + 32 * hf; const size_t row = rowbase + tile * 64 + t;
                const LAS float* hp = AD + t * 128 + c8;
                float o[8];
                if constexpr (DIR == 0) {
#pragma unroll
                    for (int j = 0; j < 8; ++j) o[j] = hp[j];
                } else {
                    const u32x4 y4 = yw[hf], p4 = ow[hf];
                    const float y[8] = {bf_lo(y4.x), bf_hi(y4.x), bf_lo(y4.y), bf_hi(y4.y), bf_lo(y4.z), bf_hi(y4.z), bf_lo(y4.w), bf_hi(y4.w)};
                    const float hf0[8] = {bf_lo(p4.x), bf_hi(p4.x), bf_lo(p4.y), bf_hi(p4.y), bf_lo(p4.z), bf_hi(p4.z), bf_lo(p4.w), bf_hi(p4.w)};
#pragma unroll
                    for (int j = 0; j < 8; ++j) { const float z = 0.7978845608028654f * (y[j] + 0.044715f * y[j] * y[j] * y[j]);
                        o[j] = (hp[j] + hf0[j]) * (y[j] * fast_sigmoid(2.0f * z)); }
                }
                u32x4 w; w.x = cvt_pk_bf16(o[0], o[1]); w.y = cvt_pk_bf16(o[2], o[3]); w.z = cvt_pk_bf16(o[4], o[5]); w.w = cvt_pk_bf16(o[6], o[7]);
                *(u32x4*)(OC + row * MWD + cg8) = w; }
        }
    }
#undef C_LOADX
#undef C_LOADU
    if constexpr (PASS == 1) { if (tid < 128) SUM[((size_t)(seq * NSPAN + sp) * 2 + DIR) * MWD + nb * 128 + tid] = (f32x2){pp, hh}; }
    __syncthreads();
}

__global__ void __launch_bounds__(512, 2) mk_fwd(Args args) {
    extern __shared__ __attribute__((aligned(16))) unsigned char lds_raw[];
    LAS unsigned char* lds = (LAS unsigned char*)lds_raw;
    {
        volatile LAS unsigned* MISC = (volatile LAS unsigned*)(lds + MISC_OFF);
        for (int u = threadIdx.x; u < (LDS_BYTES - MISC_OFF) / 4; u += 512) MISC[u] = 0u;
        __syncthreads();
    }
#if MK_SINGLE
    XcdBarrier bar = xcd_barrier_post((unsigned*)(args.ws + WS_CTL) + CW_BAR, (volatile LAS unsigned*)(lds + MISC_OFF) + 8);
#define GRID_BAR() xcd_barrier(bar)
#else
#define GRID_BAR() do {} while (0)
#endif
    const int lo = args.lo, hi = args.hi;
    int step = 0; unsigned long long tacc = 0ull; (void)tacc;
#define RUN(k) (lo <= (k) && (k) < hi)
#define SEAM(k) do { if (RUN((k) + 1)) { const unsigned long long tb_ = (TSEL == 1) ? __builtin_amdgcn_s_memrealtime() : 0ull; GRID_BAR(); if (TSEL == 1) tacc += __builtin_amdgcn_s_memrealtime() - tb_; } } while (0)
#define PHASE_EXIT(id) do { if (TSEL == 2 + (id)) tacc += __builtin_amdgcn_s_memrealtime() - t_enter_; if (TSEL == 102 + (id)) tacc += (__builtin_amdgcn_s_memtime() - c_enter_) / 24ull; } while (0)
#define PHASE_ENTER() const unsigned long long t_enter_ = TSEL ? __builtin_amdgcn_s_memrealtime() : 0ull; (void)t_enter_; const unsigned long long c_enter_ = (TSEL >= 100) ? __builtin_amdgcn_s_memtime() : 0ull; (void)c_enter_; int tid = threadIdx.x; asm volatile("" : "+v"(tid)); int bx = blockIdx.x; asm volatile("" : "+s"(bx)); int G = gridDim.x; asm volatile("" : "+s"(G)); const int NGW = G * 8; (void)NGW; \
    const int lane = tid & 63, wave = __builtin_amdgcn_readfirstlane(tid >> 6), gw = bx * 8 + wave; \
    const CAS Args* ap = (const CAS Args*)__builtin_amdgcn_kernarg_segment_ptr(); asm volatile("" : "+s"(ap)); \
    unsigned char* ws = ap->ws; float* out = ap->out; (void)lane; (void)gw; (void)out; \
    bf16* const P = (bf16*)(ws + WS_P); bf16* const Y = (bf16*)(ws + WS_P); bf16* const GT = (bf16*)(ws + WS_G); bf16* const O = (bf16*)(ws + WS_O); bf16* const HID = (bf16*)(ws + WS_G); \
    (void)P; (void)Y; (void)GT; (void)O; (void)HID

    for (int l = 0; l < DEPTH; ++l) {
        { const int k = step++; if (RUN(k) && ((PH_MASK >> 0) & 1)) { PHASE_ENTER(); for (int rep_ = 0; rep_ < NREP(0); ++rep_) phase_weights(ap, ws, l, lds, gw, NGW, wave, lane);
            if (l == 0) {
                rope_tables((f32x2*)(ws + WS_TAB1), (f32x2*)(ws + WS_TABA), bx * 512 + tid, G * 512);
                for (int row = gw; row < NTOK; row += NGW) entry_row(x_in_row(ap->in[0], ap->in[1], row), (bf16*)(ws + WS_XB) + (size_t)row * DM, (float*)(ws + WS_RS) + row, lane, ws + WS_XQ + (size_t)row * DM, (float*)(ws + WS_SX) + row); }
            PHASE_EXIT(0); SEAM(k); } }
        { const int k = step++; if (RUN(k) && ((PH_MASK >> 0) & 1)) { PHASE_ENTER();
            LAS float* scr = (LAS float*)(lds + wave * 16384);
            for (int it = gw; it < (DM / 64) * (I8W / 32); it += NGW) transpose_item_q(ap->in[6] + (size_t)l * DM * INW, DM, INW, I8W, QKVW, XYW, ws + WS_WQ, (const float*)((unsigned*)(ws + WS_CTL) + CW_CMAX + l * I8W), scr, it, lane, ap->in[2] + (size_t)l * DM);
            for (int it = gw; it < (DM / 64) * (FFD / 32); it += NGW) transpose_item_q(ap->in[19] + (size_t)l * DM * FFD, DM, FFD, FFD, 1 << 30, 0, ws + WS_W1, (const float*)((unsigned*)(ws + WS_CTL) + CW_CMAX1 + l * FFD), scr, it, lane, ap->in[4] + (size_t)l * DM);
            SEAM(k); } }
        for (int c = 0; c < NCHUNK; ++c) {
            const int row0 = c ? 32768 : 0, nseq = c ? 2 : 4, TC = nseq * SEQ;
            #define XBC ((bf16*)(ws + WS_XB) + (size_t)row0 * DM)
            #define RSC ((float*)(ws + WS_RS) + (size_t)row0)
            #define MRG ((bf16*)(ws + WS_P + 128 * MiB))
            #define YF ((bf16*)(ws + WS_P + 160 * MiB))
            { const int k = step++; if (RUN(k) && ((PH_MASK >> 2) & 1)) { PHASE_ENTER();
                for (int rep_ = 0; rep_ < NREP(2); ++rep_) {
                if (bx & 1) {
                { pg8::Gemm g{(const bf16*)(ws + WS_XQ + (size_t)row0 * DM), (const bf16*)(ws + WS_WQ), DM}; pg8::StaticOrder S; S.init(TC, I8W, G, bx, WGM_G1);
                  pg8::EpiGateQ E{P, GT, RSC, (const float*)(ws + WS_SX) + row0, (const float*)((unsigned*)(ws + WS_CTL) + CW_CMAX + l * I8W)};
                  pg8::gemm_phase<pg8::EpiGateQ, pg8::StaticOrder, true, true>(lds, g, S, E); }
                { pg8::Gemm g{XBC, (bf16*)(ws + WS_WIN), DM}; pg8::StaticOrder S; S.init(TC, XYW, G, bx, WGM_G1); pg8::EpiXY E{P, RSC};
                  pg8::gemm_phase<pg8::EpiXY, pg8::StaticOrder>(lds, g, S, E); }
                } else {
                { pg8::Gemm g{XBC, (bf16*)(ws + WS_WIN), DM}; pg8::StaticOrder S; S.init(TC, XYW, G, bx, WGM_G1); pg8::EpiXY E{P, RSC};
                  pg8::gemm_phase<pg8::EpiXY, pg8::StaticOrder>(lds, g, S, E); }
                { pg8::Gemm g{(const bf16*)(ws + WS_XQ + (size_t)row0 * DM), (const bf16*)(ws + WS_WQ), DM}; pg8::StaticOrder S; S.init(TC, I8W, G, bx, WGM_G1);
                  pg8::EpiGateQ E{P, GT, RSC, (const float*)(ws + WS_SX) + row0, (const float*)((unsigned*)(ws + WS_CTL) + CW_CMAX + l * I8W)};
                  pg8::gemm_phase<pg8::EpiGateQ, pg8::StaticOrder, true, true>(lds, g, S, E); }
                }
                }
                PHASE_EXIT(2); SEAM(k); } }
            { const int k = step++; if (RUN(k) && ((PH_MASK >> 3) & 1)) { PHASE_ENTER();
                const float* kn = ap->in[8] + (size_t)l * HD;
                for (int m = 2 * gw; m < TC; m += 2 * NGW) krope_token2(P + (size_t)m * PWD, m & (SEQ - 1), (const f32x2*)(ws + WS_TABA), (const f32x2*)(ws + WS_TAB1), kn, lane);
                CParams cp{ap->in[10] + (size_t)l * 4 * MWD, ap->in[11] + (size_t)l * MWD, ap->in[13] + (size_t)l * 2 * MWD, ap->in[15] + (size_t)l * 2 * MWD, ap->in[16] + (size_t)l * 2 * MWD, (bf16*)(ws + WS_WG)};
                for (int rep_ = 0; rep_ < NREP(3); ++rep_) for (int u = bx; u < nseq * 8 * NSPAN; u += G) { const int sp = u & (NSPAN - 1), nb = (u >> 4) & 7, seq = u >> 7;
                    c_sweep<1, 0>(lds, P, nullptr, cp, (f32x2*)(ws + WS_SUM), (bf16*)(ws + WS_BRS), seq, nb, sp); c_sweep<1, 1>(lds, P, nullptr, cp, (f32x2*)(ws + WS_SUM), (bf16*)(ws + WS_BRS), seq, nb, sp); }
                PHASE_EXIT(3); SEAM(k); } }
            { const int k = step++; if (RUN(k) && ((PH_MASK >> 5) & 1)) {
                if (SUBMASK & 4) { PHASE_ENTER();
                CParams cp{ap->in[10] + (size_t)l * 4 * MWD, ap->in[11] + (size_t)l * MWD, ap->in[13] + (size_t)l * 2 * MWD, ap->in[15] + (size_t)l * 2 * MWD, ap->in[16] + (size_t)l * 2 * MWD, (bf16*)(ws + WS_WG)};
                for (int rep_ = 0; rep_ < NREP(14); ++rep_) for (int u = bx; u < nseq * 8 * NSPAN; u += G) { const int sp = u & (NSPAN - 1), nb = (u >> 4) & 7, seq = u >> 7;
                    c_sweep<3, 0>(lds, P, O + (size_t)2 * TC * MWD, cp, (f32x2*)(ws + WS_SUM), (bf16*)(ws + WS_BRS), seq, nb, sp); c_sweep<3, 1>(lds, P, O + (size_t)2 * TC * MWD, cp, (f32x2*)(ws + WS_SUM), (bf16*)(ws + WS_BRS), seq, nb, sp); } PHASE_EXIT(14); }
                if (SUBMASK & 1) { PHASE_ENTER(); const int xcd = bx & 7, rank = bx >> 3, nrank = G >> 3; for (int rep_ = 0; rep_ < NREP(12); ++rep_) for (int i = rank; i < 32 * nseq; i += nrank) {
                    const int uid = xcd * 32 * nseq + i, seq = uid >> 8, head = (uid >> 5) & 7, kvh = head >> 2, qb = uid & 31;
                    const bf16* Qb = P + (size_t)(seq * SEQ + qb * 256) * PWD + QA_OFF + head * HD;
                    const bf16* Kh = P + (size_t)(seq * SEQ) * PWD + KA_OFF + kvh * HD; const bf16* Vh = P + (size_t)(seq * SEQ) * PWD + VA_OFF + kvh * HD;
                    ATT_UNIT(0, SD_A)(Qb, Kh, Vh, O + (size_t)(seq * SEQ + qb * 256) * MWD + head * HD, SEQ / 64, 0, nullptr, (char*)lds_raw, (const f32x2*)(ws + WS_TABA) + qb * 256 * 64, ap->in[7] + (size_t)l * HD);
                } PHASE_EXIT(12); }
                if (SUBMASK & 2) { PHASE_ENTER(); const int xcd = bx & 7, rank = bx >> 3, nrank = G >> 3; for (int rep_ = 0; rep_ < NREP(13); ++rep_) for (int i = rank; i < 32 * nseq; i += nrank) {
                    const int uid = xcd * 32 * nseq + i, seq = uid >> 8, kvh = (uid >> 7) & 1, q0 = (uid & 127) * 64;
                    int k0 = q0 - 128 < 0 ? 0 : q0 - 128, k1 = q0 + 256 > SEQ ? SEQ : q0 + 256;
                    if (((k1 - k0) >> 6) & 1) { if (k1 < SEQ) k1 += 64; else k0 -= 64; }
                    const bf16* Qb = P + (size_t)(seq * SEQ + q0) * PWD + QB_OFF + kvh * 4 * HD;
                    const bf16* Kh = P + (size_t)(seq * SEQ + k0) * PWD + KB_OFF + kvh * HD; const bf16* Vh = P + (size_t)(seq * SEQ + k0) * PWD + VB_OFF + kvh * HD;
                    ATT_UNIT(1, SD_B)(Qb, Kh, Vh, O + (size_t)TC * MWD + (size_t)(seq * SEQ + q0) * MWD + kvh * 4 * HD, (k1 - k0) / 64, q0 - k0, ap->in[9] + l * 8 + kvh * 4, (char*)lds_raw, (const f32x2*)(ws + WS_TAB1) + q0 * 64, nullptr);
                } PHASE_EXIT(13); }
                SEAM(k); } }
            { const int k = step++; if (RUN(k) && ((PH_MASK >> 6) & 1)) { PHASE_ENTER();
                pg8::Gemm g{O, (bf16*)(ws + WS_WBR), MWD}; pg8::BranchOrder S; S.base.init(TC, DM, G, bx, WGM_G2); S.npanel = TC / 256;
                pg8::EpiBr E{GT, MRG};
                for (int rep_ = 0; rep_ < NREP(6); ++rep_) pg8::gemm_phase<pg8::EpiBr, pg8::BranchOrder>(lds, g, S, E);
                PHASE_EXIT(6); SEAM(k); } }
            { const int k = step++; if (RUN(k) && ((PH_MASK >> 7) & 1)) { PHASE_ENTER();
                pg8::Gemm g{MRG, (bf16*)(ws + WS_WOUT), DM}; pg8::StaticOrder S; S.init(TC, DM, G, bx, WGM_G3); pg8::EpiBf16 E{Y, DM};
                for (int rep_ = 0; rep_ < NREP(7); ++rep_) pg8::gemm_phase<pg8::EpiBf16, pg8::StaticOrder>(lds, g, S, E);
                PHASE_EXIT(7); SEAM(k); } }
            { const int k = step++; if (RUN(k) && ((PH_MASK >> 8) & 1)) { PHASE_ENTER();
                const float* g1 = ap->in[3] + (size_t)l * DM;
                resid_norm_rows<false, true>(Y, XBC, g1, RSC, nullptr, ws + WS_XQ + (size_t)row0 * DM, (float*)(ws + WS_SX) + row0, TC, gw, NGW, lane);
                PHASE_EXIT(8); SEAM(k); } }
            { const int k = step++; if (RUN(k) && ((PH_MASK >> 9) & 1)) { PHASE_ENTER();
                pg8::Gemm g{(const bf16*)(ws + WS_XQ + (size_t)row0 * DM), (const bf16*)(ws + WS_W1), DM}; pg8::StaticOrder S; S.init(TC, FFD, G, bx, WGM_G4);
                pg8::EpiRelu2Q E{HID, FFD, RSC, (const float*)(ws + WS_SX) + row0, (const float*)((unsigned*)(ws + WS_CTL) + CW_CMAX1 + l * FFD)};
                for (int rep_ = 0; rep_ < NREP(9); ++rep_) pg8::gemm_phase<pg8::EpiRelu2Q, pg8::StaticOrder, true, true>(lds, g, S, E);
                PHASE_EXIT(9); SEAM(k); } }
            { const int k = step++; if (RUN(k) && ((PH_MASK >> 10) & 1)) { PHASE_ENTER();
                pg8::Gemm g{HID, (bf16*)(ws + WS_W2), FFD}; pg8::StaticOrder S; S.init(TC, DM, G, bx, WGM_G5); pg8::EpiBf16 E{YF, DM};
                for (int rep_ = 0; rep_ < NREP(10); ++rep_) pg8::gemm_phase<pg8::EpiBf16, pg8::StaticOrder>(lds, g, S, E);
                PHASE_EXIT(10); SEAM(k); } }
            { const int k = step++; if (RUN(k) && ((PH_MASK >> 11) & 1)) { PHASE_ENTER();
                const float* g1 = ap->in[5] + (size_t)l * DM;
                if (l + 1 < DEPTH) resid_norm_rows<false, true>(YF, XBC, g1, RSC, nullptr, ws + WS_XQ + (size_t)row0 * DM, (float*)(ws + WS_SX) + row0, TC, gw, NGW, lane);
                else resid_norm_rows<true, false>(YF, XBC, g1, nullptr, out + (size_t)row0 * DM, nullptr, nullptr, TC, gw, NGW, lane);
                PHASE_EXIT(11);
                } }
        }
    }
#if TSEL && MK_SINGLE
    {
        unsigned long long* tw = (unsigned long long*)(args.ws + WS_CTL + 512 * 1024);
        xcd_barrier(bar);
        if (threadIdx.x == 0) __hip_atomic_fetch_add(tw, tacc, __ATOMIC_RELAXED, __HIP_MEMORY_SCOPE_AGENT);
        xcd_barrier(bar);
        const unsigned long long tot = __hip_atomic_load(tw, __ATOMIC_RELAXED, __HIP_MEMORY_SCOPE_AGENT) / gridDim.x;
        const unsigned long long t0 = __builtin_amdgcn_s_memrealtime();
        while (__builtin_amdgcn_s_memrealtime() - t0 < tot) __builtin_amdgcn_s_sleep(8);
    }
#endif
#undef RUN
#undef SEAM
}
constexpr int NSTEPS = DEPTH * (2 + NCHUNK * 9);

extern "C" void kernel_launch(void* const* d_in, const int* in_sizes, int n_in, void* d_out, int out_size, void* d_ws, size_t ws_size, hipStream_t stream) {
    static int grid = 0;
    if (grid == 0) {
        if (n_in != 21 || out_size != NTOK * DM || ws_size < WS_END) { fprintf(stderr, "kernel_launch: unexpected shapes (n_in %d out %d ws %zu)\n", n_in, out_size, ws_size); grid = -1; return; }
        int dev = 0, cus = 0, per_cu = 0;
        if (hipGetDevice(&dev) != hipSuccess || hipDeviceGetAttribute(&cus, hipDeviceAttributeMultiprocessorCount, dev) != hipSuccess) { grid = -1; return; }
        if (hipFuncSetAttribute((const void*)mk_fwd, hipFuncAttributeMaxDynamicSharedMemorySize, LDS_BYTES) != hipSuccess) { fprintf(stderr, "kernel_launch: hipFuncSetAttribute failed\n"); grid = -1; return; }
        if (hipOccupancyMaxActiveBlocksPerMultiprocessor(&per_cu, (const void*)mk_fwd, 512, LDS_BYTES) != hipSuccess || per_cu < 1) { fprintf(stderr, "kernel_launch: occupancy query says %d\n", per_cu); }
        (void)hipGetLastError();
        grid = cus;
    }
    if (grid < 0) return;
    if (hipMemsetAsync((char*)d_ws + WS_CTL, 0, CTL_ZERO_BYTES, stream) != hipSuccess) return;
    Args a{};
    for (int i = 0; i < 21; ++i) a.in[i] = (const float*)d_in[i];
    a.out = (float*)d_out; a.ws = (unsigned char*)d_ws;
#if MK_SINGLE
    a.lo = 0; a.hi = NSTEPS;
    hipLaunchKernelGGL(mk_fwd, dim3(grid), dim3(512), LDS_BYTES, stream, a);
#else
    for (int s = 0; s < NSTEPS; ++s) { a.lo = s; a.hi = s + 1; hipLaunchKernelGGL(mk_fwd, dim3(grid), dim3(512), LDS_BYTES, stream, a); }
#endif
    const hipError_t le = hipPeekAtLastError();
    if (le != hipSuccess) fprintf(stderr, "kernel_launch: launch failed: %s\n", hipGetErrorName(le));
}
```

```cpp
#include <hip/hip_runtime.h>
#include <cstdio>
#include <cstdint>

#ifndef PH_MASK
#define PH_MASK 0xFFF
#endif
#ifndef SUBMASK
#define SUBMASK 7
#endif
#ifndef SD_A
#define SD_A 1
#endif
#ifndef SD_B
#define SD_B 1
#endif
#ifndef DUP_MASK
#define DUP_MASK 0
#endif
#define NREP(i) (1 + ((DUP_MASK >> (i)) & 1))
#ifndef TSEL
#define TSEL 0
#endif
#ifndef ATT_PP
#define ATT_PP 0
#endif
#if ATT_PP
#define ATT_UNIT(M, SD) att::attn_unit_pp<M>
#else
#define ATT_UNIT(M, SD) att::attn_unit<M, SD>
#endif
#ifndef WGM_G1
#define WGM_G1 4
#endif
#ifndef WGM_G2
#define WGM_G2 4
#endif
#ifndef WGM_G3
#define WGM_G3 4
#endif
#ifndef WGM_G4
#define WGM_G4 4
#endif
#ifndef WGM_G5
#define WGM_G5 4
#endif
#ifndef MK_SINGLE
#define MK_SINGLE 1
#endif

#define LAS __attribute__((address_space(3)))
#define GAS __attribute__((address_space(1)))
#define CAS __attribute__((address_space(4)))
typedef unsigned short bf16;
typedef short bf16x8 __attribute__((ext_vector_type(8)));
typedef short s16x4 __attribute__((ext_vector_type(4)));
typedef float f32x4 __attribute__((ext_vector_type(4)));
typedef float f32x2 __attribute__((ext_vector_type(2)));
typedef float f32x16 __attribute__((ext_vector_type(16)));
typedef unsigned u32x4 __attribute__((ext_vector_type(4)));
typedef unsigned u32x2 __attribute__((ext_vector_type(2)));
typedef int v4i __attribute__((ext_vector_type(4)));

constexpr int DM = 2048, SEQ = 8192, NTOK = 49152, TCMAX = 32768, NCHUNK = 2, DEPTH = 4;
constexpr int QKVW = 3072  , XYW = 2048  , I8W = 9216  ;
constexpr int INW = 11264, PWD = 5120, GWD = 6144, FFD = 8192, MWD = 1024, HD = 128;
constexpr int QA_OFF = 0, KA_OFF = 1024, VA_OFF = 1280, QB_OFF = 1536, KB_OFF = 2560, VB_OFF = 2816, XC_OFF = 3072, YC_OFF = 4096;
constexpr int NPROMPT_TOK = 32768;
constexpr float EPS = 1e-6f;

constexpr size_t MiB = 1u << 20;
constexpr size_t WS_CTL = 0, CTL_ZERO_BYTES = 1 * MiB;
constexpr size_t WS_WIN = 2 * MiB;
constexpr size_t WS_WBR = 46 * MiB;
constexpr size_t WS_WOUT = 58 * MiB;
constexpr size_t WS_W1 = 66 * MiB;
constexpr size_t WS_W2 = 98 * MiB;
constexpr size_t WS_WG = 130 * MiB;
constexpr size_t WS_SUM = 131 * MiB;
constexpr size_t WS_BRS = 143 * MiB;
constexpr size_t WS_P = 207 * MiB;
constexpr size_t WS_G = 527 * MiB;
constexpr size_t WS_O = 911 * MiB;
constexpr size_t WS_TAB1 = 1103 * MiB;
constexpr size_t WS_TABA = 1107 * MiB;
constexpr size_t WS_XB = 1111 * MiB;
constexpr size_t WS_RS = 1303 * MiB;
constexpr size_t WS_XQ = 1304 * MiB;
constexpr size_t WS_SX = 1400 * MiB;
constexpr size_t WS_WQ = 22 * MiB;
constexpr size_t WS_END = 1401 * MiB;
constexpr int CW_CMAX1 = 16384 + 4 * 9216;
constexpr int CW_CMAX = 16384;
constexpr int CW_BAR = 4096;

constexpr int LDS_BYTES = 147456;
constexpr int MISC_OFF = 143360;

__device__ __forceinline__ unsigned cvt_pk_bf16(float lo, float hi) { unsigned r; asm volatile("v_cvt_pk_bf16_f32 %0, %1, %2" : "=v"(r) : "v"(lo), "v"(hi)); return r; }
__device__ __forceinline__ float bf_lo(unsigned w) { return __uint_as_float(w << 16); }
__device__ __forceinline__ float bf_hi(unsigned w) { return __uint_as_float(w & 0xffff0000u); }
__device__ __forceinline__ float bf2f(bf16 b) { return __uint_as_float(((unsigned)b) << 16); }
__device__ __forceinline__ float fast_sigmoid(float v) { return __builtin_amdgcn_rcpf(1.0f + __builtin_amdgcn_exp2f(-1.4426950408889634f * v)); }
__device__ __forceinline__ float dpp_f(float v, const int ctrl_sel) {
    const int x = __float_as_int(v);
    switch (ctrl_sel) {
        case 0: return __int_as_float(__builtin_amdgcn_update_dpp(0, x, 0xB1, 0xF, 0xF, true));
        case 1: return __int_as_float(__builtin_amdgcn_update_dpp(0, x, 0x4E, 0xF, 0xF, true));
        case 2: return __int_as_float(__builtin_amdgcn_update_dpp(0, x, 0x141, 0xF, 0xF, true));
        default: return __int_as_float(__builtin_amdgcn_update_dpp(0, x, 0x140, 0xF, 0xF, true));
    }
}
__device__ __forceinline__ float wave_max(float v, int lane) {
    (void)lane;
    v = fmaxf(v, dpp_f(v, 0)); v = fmaxf(v, dpp_f(v, 1)); v = fmaxf(v, dpp_f(v, 2)); v = fmaxf(v, dpp_f(v, 3));
    const int x = __float_as_int(v);
    return fmaxf(fmaxf(__int_as_float(__builtin_amdgcn_readlane(x, 0)), __int_as_float(__builtin_amdgcn_readlane(x, 16))), fmaxf(__int_as_float(__builtin_amdgcn_readlane(x, 32)), __int_as_float(__builtin_amdgcn_readlane(x, 48))));
}
__device__ __forceinline__ float wave_sum(float v, int lane) {
    (void)lane;
    v += dpp_f(v, 0); v += dpp_f(v, 1); v += dpp_f(v, 2); v += dpp_f(v, 3);
    const int x = __float_as_int(v);
    return (__int_as_float(__builtin_amdgcn_readlane(x, 0)) + __int_as_float(__builtin_amdgcn_readlane(x, 16))) + (__int_as_float(__builtin_amdgcn_readlane(x, 32)) + __int_as_float(__builtin_amdgcn_readlane(x, 48)));
}

__device__ const double ROPE_F1[64] = {
1.59154943091895346e-01, 1.37822502603982849e-01, 1.19349370211248862e-01, 1.03352296618434064e-01, 8.94994016088910133e-02, 7.75032887553740585e-02, 6.71150830052272551e-02, 5.81192674418762462e-02,
5.03292121044697269e-02, 4.35833029420947638e-02, 3.77415888468699103e-02, 3.26828760272190911e-02, 2.83022152813622411e-02, 2.45087241866802648e-02, 2.12237020815031856e-02, 1.83789966569160986e-02,
1.59154943091895339e-02, 1.37822502603982842e-02, 1.19349370211248869e-02, 1.03352296618434060e-02, 8.94994016088910202e-03, 7.75032887553740654e-03, 6.71150830052272551e-03, 5.81192674418762427e-03,
5.03292121044697286e-03, 4.35833029420947656e-03, 3.77415888468699086e-03, 3.26828760272190893e-03, 2.83022152813622403e-03, 2.45087241866802661e-03, 2.12237020815031847e-03, 1.83789966569160995e-03,
1.59154943091895335e-03, 1.37822502603982846e-03, 1.19349370211248865e-03, 1.03352296618434069e-03, 8.94994016088910115e-04, 7.75032887553740654e-04, 6.71150830052272508e-04, 5.81192674418762427e-04,
5.03292121044697243e-04, 4.35833029420947678e-04, 3.77415888468699086e-04, 3.26828760272190871e-04, 2.83022152813622381e-04, 2.45087241866802661e-04, 2.12237020815031847e-04, 1.83789966569160984e-04,
1.59154943091895346e-04, 1.37822502603982835e-04, 1.19349370211248871e-04, 1.03352296618434063e-04, 8.94994016088910088e-05, 7.75032887553740654e-05, 6.71150830052272508e-05, 5.81192674418762400e-05,
5.03292121044697243e-05, 4.35833029420947644e-05, 3.77415888468699120e-05, 3.26828760272190871e-05, 2.83022152813622381e-05, 2.45087241866802641e-05, 2.12237020815031861e-05, 1.83789966569160984e-05 };
__device__ const double ROPE_FA[32] = {
1.59154943091895346e-01, 1.19349370211248862e-01, 8.94994016088910133e-02, 6.71150830052272551e-02, 5.03292121044697269e-02, 3.77415888468699103e-02, 2.83022152813622411e-02, 2.12237020815031856e-02,
1.59154943091895339e-02, 1.19349370211248869e-02, 8.94994016088910202e-03, 6.71150830052272551e-03, 5.03292121044697286e-03, 3.77415888468699086e-03, 2.83022152813622403e-03, 2.12237020815031847e-03,
1.59154943091895335e-03, 1.19349370211248865e-03, 8.94994016088910115e-04, 6.71150830052272508e-04, 5.03292121044697243e-04, 3.77415888468699086e-04, 2.83022152813622381e-04, 2.12237020815031847e-04,
1.59154943091895346e-04, 1.19349370211248871e-04, 8.94994016088910088e-05, 6.71150830052272508e-05, 5.03292121044697243e-05, 3.77415888468699120e-05, 2.83022152813622381e-05, 2.12237020815031861e-05 };

namespace pg8 {
typedef unsigned short bf16_t;
constexpr int BM = 256, BK = 64, HALF = 128, HTB = HALF * BK * 2, STAGE_BYTES = 8 * HTB, NXCD = 8, WGM = 4;
__host__ __device__ __forceinline__ int lds_byte(int r, int c) { const int st = (r >> 4) * 2 + (c >> 5), rr = r & 15, cc = c & 31, ob = rr * 64 + cc * 2; return st * 1024 + (ob ^ (((ob >> 9) & 1) << 5)); }
__host__ __device__ __forceinline__ void stage_rc(int b, int& R, int& C) { const int st = b / 1024, sb = b % 1024, swz = sb ^ (((sb >> 9) & 1) << 5); R = (st >> 1) * 16 + swz / 64; C = (st & 1) * 32 + (swz % 64) / 2; }
__host__ __device__ __forceinline__ int perm32(int rho) { const int n = rho >> 4, i = rho & 15; return 8 * (i >> 2) + 4 * n + (i & 3); }

struct Unit { int pm, pn, ka, kb, sub; };
struct Gemm { const bf16_t* A; const bf16_t* Bt; int K; };

struct StaticOrder {
    int nM, nN, nwg, G, c, wgm;
    __device__ void init(int M, int N, int G_, int c_, int wgm_ = WGM) { nM = M / BM; nN = N / BM; nwg = nM * nN; G = G_; c = c_; wgm = wgm_; }
    __device__ bool next(int i, Unit& u) const {
        const long L = (long)i * G + c; if (L >= nwg) return false;
        int wgid = (int)L; { const int q = nwg / NXCD, r = nwg % NXCD, xcd = wgid % NXCD, off = wgid / NXCD; wgid = (xcd < r ? xcd * (q + 1) : r * (q + 1) + (xcd - r) * q) + off; }
        const int nig = wgm * nN, gid = wgid / nig, fm = gid * wgm, gsz = (nM - fm) < wgm ? (nM - fm) : wgm;
        u.pm = fm + ((wgid % nig) % gsz); u.pn = (wgid % nig) / gsz; u.ka = u.pm; u.kb = u.pn; u.sub = 0; return true;
    }
};
struct BranchOrder {
    StaticOrder base; int npanel;
    __device__ bool next(int i, Unit& u) const {
        const int t = i / 3, s = i - 3 * t; if (!base.next(t, u)) return false;
        u.sub = s; u.ka = s * npanel + u.pm; u.kb = s * 8 + u.pn; return true;
    }
};

struct EpiIn {
    static constexpr bool PERM = true;
    bf16_t* P; bf16_t* G; const float* rs;
    __device__ __forceinline__ bool operator()(f32x4 (&acc)[2][2][4][2], const Unit& u, int wr, int wc, int fr_, int fq) const {
        int fr = fr_; asm volatile("" : "+v"(fr));
        const int row0 = u.pm * BM + wr * 64 + fr; const bool gate = u.pn >= 20;
        bf16_t* base = gate ? G : P; const int ldc = gate ? GWD : PWD; const int col0 = (gate ? u.pn - 20 : u.pn) * BM + wc * 32 + 8 * fq;
#pragma unroll
        for (int ai = 0; ai < 2; ++ai)
#pragma unroll
            for (int m = 0; m < 4; ++m) { bf16_t* rowp = base + (size_t)(row0 + ai * HALF + m * 16) * ldc + col0; const float rsv = rs[row0 + ai * HALF + m * 16];
#pragma unroll
                for (int bj = 0; bj < 2; ++bj) { f32x4 v0 = acc[ai][bj][m][0] * rsv, v1 = acc[ai][bj][m][1] * rsv;
                    if (gate) {
#pragma unroll
                        for (int j = 0; j < 4; ++j) { v0[j] = fmaxf(fast_sigmoid(v0[j]), 1e-30f); v1[j] = fmaxf(fast_sigmoid(v1[j]), 1e-30f); } }
                    u32x4 w; w.x = cvt_pk_bf16(v0[0], v0[1]); w.y = cvt_pk_bf16(v0[2], v0[3]); w.z = cvt_pk_bf16(v1[0], v1[1]); w.w = cvt_pk_bf16(v1[2], v1[3]);
                    *(u32x4*)(rowp + bj * HALF) = w; } }
        return true;
    }
};
struct EpiXY {
    static constexpr bool PERM = true;
    bf16_t* P; const float* rs;
    __device__ __forceinline__ bool operator()(f32x4 (&acc)[2][2][4][2], const Unit& u, int wr, int wc, int fr_, int fq) const {
        int fr = fr_; asm volatile("" : "+v"(fr));
        const int row0 = u.pm * BM + wr * 64 + fr, col0 = QKVW + u.pn * BM + wc * 32 + 8 * fq;
        float rsa[2][4];
#pragma unroll
        for (int ai = 0; ai < 2; ++ai)
#pragma unroll
            for (int m = 0; m < 4; ++m) rsa[ai][m] = rs[row0 + ai * HALF + m * 16];
#pragma unroll
        for (int ai = 0; ai < 2; ++ai)
#pragma unroll
            for (int m = 0; m < 4; ++m) { const int row = row0 + ai * HALF + m * 16; bf16_t* rowp = P + (size_t)row * PWD + col0; const float rsv = rsa[ai][m];
#pragma unroll
                for (int bj = 0; bj < 2; ++bj) { const f32x4 v0 = acc[ai][bj][m][0] * rsv, v1 = acc[ai][bj][m][1] * rsv;
                    u32x4 w; w.x = cvt_pk_bf16(v0[0], v0[1]); w.y = cvt_pk_bf16(v0[2], v0[3]); w.z = cvt_pk_bf16(v1[0], v1[1]); w.w = cvt_pk_bf16(v1[2], v1[3]);
                    *(u32x4*)(rowp + bj * HALF) = w; } }
        return true;
    }
};
struct EpiGateQ {
    static constexpr bool PERM = true;
    bf16_t* P; bf16_t* G; const float* rs; const float* sx; const float* cmax;
    __device__ __forceinline__ bool operator()(f32x4 (&acc)[2][2][4][2], const Unit& u, int wr, int wc, int fr_, int fq) const {
        int fr = fr_; asm volatile("" : "+v"(fr));
        const int row0 = u.pm * BM + wr * 64 + fr; const bool gate = u.pn >= 12;
        bf16_t* base = gate ? G : P; const int ldc = gate ? GWD : PWD; const int col0 = (gate ? u.pn - 12 : u.pn) * BM + wc * 32 + 8 * fq, ccol0 = u.pn * BM + wc * 32 + 8 * fq;
        f32x4 cw[2][2];
#pragma unroll
        for (int bj = 0; bj < 2; ++bj) { cw[bj][0] = *(const f32x4*)(cmax + ccol0 + bj * HALF) * (1.0f / 127.0f); cw[bj][1] = *(const f32x4*)(cmax + ccol0 + bj * HALF + 4) * (1.0f / 127.0f); }
        float rsa[2][4];
#pragma unroll
        for (int ai = 0; ai < 2; ++ai)
#pragma unroll
            for (int m = 0; m < 4; ++m) { const int row = row0 + ai * HALF + m * 16; rsa[ai][m] = rs[row] * sx[row]; }
#pragma unroll
        for (int ai = 0; ai < 2; ++ai)
#pragma unroll
            for (int m = 0; m < 4; ++m) { const int row = row0 + ai * HALF + m * 16; bf16_t* rowp = base + (size_t)row * ldc + col0; const float rsv = rsa[ai][m];
#pragma unroll
                for (int bj = 0; bj < 2; ++bj) { const v4i i0 = __builtin_bit_cast(v4i, acc[ai][bj][m][0]), i1 = __builtin_bit_cast(v4i, acc[ai][bj][m][1]);
                    f32x4 v0 = (f32x4){(float)i0[0], (float)i0[1], (float)i0[2], (float)i0[3]} * cw[bj][0] * rsv, v1 = (f32x4){(float)i1[0], (float)i1[1], (float)i1[2], (float)i1[3]} * cw[bj][1] * rsv;
                    if (gate) {
#pragma unroll
                        for (int j = 0; j < 4; ++j) { v0[j] = fmaxf(fast_sigmoid(v0[j]), 1e-30f); v1[j] = fmaxf(fast_sigmoid(v1[j]), 1e-30f); } }
                    u32x4 w; w.x = cvt_pk_bf16(v0[0], v0[1]); w.y = cvt_pk_bf16(v0[2], v0[3]); w.z = cvt_pk_bf16(v1[0], v1[1]); w.w = cvt_pk_bf16(v1[2], v1[3]);
                    *(u32x4*)(rowp + bj * HALF) = w; } }
        return true;
    }
};
struct EpiBr {
    static constexpr bool PERM = true;
    const bf16_t* G; bf16_t* OUT;
    __device__ __forceinline__ bool operator()(f32x4 (&acc)[2][2][4][2], const Unit& u, int wr, int wc, int fr_, int fq) const {
        int fr = fr_; asm volatile("" : "+v"(fr));
        const int row0 = u.pm * BM + wr * 64 + fr, col0 = u.pn * BM + wc * 32 + 8 * fq; const int sub = u.sub;
        if (sub < 2) {
#pragma unroll
            for (int ai = 0; ai < 2; ++ai) {
                const bf16_t* gp = G + (size_t)(row0 + ai * HALF) * GWD + sub * DM + col0;
                u32x4 gw[4][2], gn[4][2];
#pragma unroll
                for (int m = 0; m < 4; ++m)
#pragma unroll
                    for (int bj = 0; bj < 2; ++bj) { gw[m][bj] = *(const u32x4*)(gp + (size_t)(m * 16) * GWD + bj * HALF); gn[m][bj] = *(const u32x4*)(gp + (size_t)(m * 16) * GWD + DM + bj * HALF); }
#pragma unroll
                for (int m = 0; m < 4; ++m)
#pragma unroll
                    for (int bj = 0; bj < 2; ++bj) { const u32x4 a = gw[m][bj], n = gn[m][bj];
                        f32x4 s0 = {bf_lo(a.x), bf_hi(a.x), bf_lo(a.y), bf_hi(a.y)};
                        f32x4 s1 = {bf_lo(a.z), bf_hi(a.z), bf_lo(a.w), bf_hi(a.w)};
                        s0 *= (f32x4){__builtin_amdgcn_rcpf(bf_lo(n.x)), __builtin_amdgcn_rcpf(bf_hi(n.x)), __builtin_amdgcn_rcpf(bf_lo(n.y)), __builtin_amdgcn_rcpf(bf_hi(n.y))};
                        s1 *= (f32x4){__builtin_amdgcn_rcpf(bf_lo(n.z)), __builtin_amdgcn_rcpf(bf_hi(n.z)), __builtin_amdgcn_rcpf(bf_lo(n.w)), __builtin_amdgcn_rcpf(bf_hi(n.w))};
                        acc[ai][bj][m][0] *= s0; acc[ai][bj][m][1] *= s1; }
                asm volatile("" ::: "memory"); }
        } else {
#pragma unroll
            for (int ai = 0; ai < 2; ++ai) {
                const bf16_t* gp = G + (size_t)(row0 + ai * HALF) * GWD + sub * DM + col0;
                u32x4 gw[4][2];
#pragma unroll
                for (int m = 0; m < 4; ++m)
#pragma unroll
                    for (int bj = 0; bj < 2; ++bj) gw[m][bj] = *(const u32x4*)(gp + (size_t)(m * 16) * GWD + bj * HALF);
#pragma unroll
                for (int m = 0; m < 4; ++m)
#pragma unroll
                    for (int bj = 0; bj < 2; ++bj) { const u32x4 a = gw[m][bj];
                        const f32x4 s0 = {bf_lo(a.x), bf_hi(a.x), bf_lo(a.y), bf_hi(a.y)};
                        const f32x4 s1 = {bf_lo(a.z), bf_hi(a.z), bf_lo(a.w), bf_hi(a.w)};
                        const f32x4 v0 = acc[ai][bj][m][0] * s0, v1 = acc[ai][bj][m][1] * s1;
                        u32x4 w; w.x = cvt_pk_bf16(v0[0], v0[1]); w.y = cvt_pk_bf16(v0[2], v0[3]); w.z = cvt_pk_bf16(v1[0], v1[1]); w.w = cvt_pk_bf16(v1[2], v1[3]);
                        *(u32x4*)(OUT + (size_t)(row0 + ai * HALF + m * 16) * DM + col0 + bj * HALF) = w; }
                asm volatile("" ::: "memory"); }
        }
        return sub == 2;
    }
};
struct EpiBf16 {
    static constexpr bool PERM = true;
    bf16_t* O; int ldc;
    __device__ __forceinline__ bool operator()(f32x4 (&acc)[2][2][4][2], const Unit& u, int wr, int wc, int fr_, int fq) const {
        int fr = fr_; asm volatile("" : "+v"(fr));
        const int row0 = u.pm * BM + wr * 64 + fr, col0 = u.pn * BM + wc * 32 + 8 * fq;
#pragma unroll
        for (int ai = 0; ai < 2; ++ai)
#pragma unroll
            for (int m = 0; m < 4; ++m) { bf16_t* rowp = O + (size_t)(row0 + ai * HALF + m * 16) * ldc + col0;
#pragma unroll
                for (int bj = 0; bj < 2; ++bj) { const f32x4 v0 = acc[ai][bj][m][0], v1 = acc[ai][bj][m][1];
                    u32x4 w; w.x = cvt_pk_bf16(v0[0], v0[1]); w.y = cvt_pk_bf16(v0[2], v0[3]); w.z = cvt_pk_bf16(v1[0], v1[1]); w.w = cvt_pk_bf16(v1[2], v1[3]);
                    *(u32x4*)(rowp + bj * HALF) = w; } }
        return true;
    }
};
struct EpiRelu2Q {
    static constexpr bool PERM = true;
    bf16_t* O; int ldc; const float* rs; const float* sx; const float* cmax;
    __device__ __forceinline__ bool operator()(f32x4 (&acc)[2][2][4][2], const Unit& u, int wr, int wc, int fr_, int fq) const {
        int fr = fr_; asm volatile("" : "+v"(fr));
        const int row0 = u.pm * BM + wr * 64 + fr, col0 = u.pn * BM + wc * 32 + 8 * fq;
        f32x4 cw[2][2];
#pragma unroll
        for (int bj = 0; bj < 2; ++bj) { cw[bj][0] = *(const f32x4*)(cmax + col0 + bj * HALF) * (1.0f / 127.0f); cw[bj][1] = *(const f32x4*)(cmax + col0 + bj * HALF + 4) * (1.0f / 127.0f); }
        float rsa[2][4];
#pragma unroll
        for (int ai = 0; ai < 2; ++ai)
#pragma unroll
            for (int m = 0; m < 4; ++m) { const int row = row0 + ai * HALF + m * 16; rsa[ai][m] = rs[row] * sx[row]; }
#pragma unroll
        for (int ai = 0; ai < 2; ++ai)
#pragma unroll
            for (int m = 0; m < 4; ++m) { const int row = row0 + ai * HALF + m * 16; bf16_t* rowp = O + (size_t)row * ldc + col0; const float rsv = rsa[ai][m];
#pragma unroll
                for (int bj = 0; bj < 2; ++bj) { const v4i i0 = __builtin_bit_cast(v4i, acc[ai][bj][m][0]), i1 = __builtin_bit_cast(v4i, acc[ai][bj][m][1]);
                    f32x4 v0 = (f32x4){(float)i0[0], (float)i0[1], (float)i0[2], (float)i0[3]} * cw[bj][0] * rsv, v1 = (f32x4){(float)i1[0], (float)i1[1], (float)i1[2], (float)i1[3]} * cw[bj][1] * rsv;
#pragma unroll
                    for (int j = 0; j < 4; ++j) { const float a = fmaxf(v0[j], 0.f), b = fmaxf(v1[j], 0.f); v0[j] = a * a; v1[j] = b * b; }
                    u32x4 w; w.x = cvt_pk_bf16(v0[0], v0[1]); w.y = cvt_pk_bf16(v0[2], v0[3]); w.z = cvt_pk_bf16(v1[0], v1[1]); w.w = cvt_pk_bf16(v1[2], v1[3]);
                    *(u32x4*)(rowp + bj * HALF) = w; } }
        return true;
    }
};
struct EpiRelu2 {
    static constexpr bool PERM = true;
    bf16_t* O; int ldc; const float* rs;
    __device__ __forceinline__ bool operator()(f32x4 (&acc)[2][2][4][2], const Unit& u, int wr, int wc, int fr_, int fq) const {
        int fr = fr_; asm volatile("" : "+v"(fr));
        const int row0 = u.pm * BM + wr * 64 + fr, col0 = u.pn * BM + wc * 32 + 8 * fq;
#pragma unroll
        for (int ai = 0; ai < 2; ++ai)
#pragma unroll
            for (int m = 0; m < 4; ++m) { bf16_t* rowp = O + (size_t)(row0 + ai * HALF + m * 16) * ldc + col0; const float rsv = rs[row0 + ai * HALF + m * 16];
#pragma unroll
                for (int bj = 0; bj < 2; ++bj) { f32x4 v0 = acc[ai][bj][m][0], v1 = acc[ai][bj][m][1];
#pragma unroll
                    for (int j = 0; j < 4; ++j) { const float a = fmaxf(v0[j] * rsv, 0.f), b = fmaxf(v1[j] * rsv, 0.f); v0[j] = a * a; v1[j] = b * b; }
                    u32x4 w; w.x = cvt_pk_bf16(v0[0], v0[1]); w.y = cvt_pk_bf16(v0[2], v0[3]); w.z = cvt_pk_bf16(v1[0], v1[1]); w.w = cvt_pk_bf16(v1[2], v1[3]);
                    *(u32x4*)(rowp + bj * HALF) = w; } }
        return true;
    }
};

template <class Epi, class Sched, bool ALIGN_EPI = true, bool I8 = false>
__device__ __forceinline__ void gemm_phase(LAS unsigned char* lds, const Gemm g, const Sched& S, const Epi& E) {
    int tid_ = threadIdx.x; asm volatile("" : "+v"(tid_));
    const int tid = tid_, wid = __builtin_amdgcn_readfirstlane(tid >> 6), lane = tid & 63, wr = wid >> 2, wc = wid & 3, fr = lane & 15, fq = lane >> 4;
    const int K = g.K, PB = I8 ? K : 2 * K  , nt = PB / (BK * 2);
    unsigned voffA[2], voffB[2];
#pragma unroll
    for (int i = 0; i < 2; ++i) { int R, C; stage_rc(tid * 16 + i * 8192, R, C); const int Rb = Epi::PERM ? ((R & ~31) + perm32(R & 31)) : R;
        voffA[i] = (unsigned)(R * PB + C * 2); voffB[i] = (unsigned)(Rb * PB + C * 2); }
    const size_t kstep = (size_t)(BK * 2);
    const size_t hstep = (size_t)HALF * PB;
    const size_t tstep = 2 * hstep;
    const unsigned ldsw = (unsigned)wid * 1024u;
    const int aoff = lds_byte(wr * 64 + fr, fq * 8), boff = lds_byte(wc * 32 + fr, fq * 8);
#define PG8_SA(b, h) (((b) * 2 + (h)) * HTB)
#define PG8_SB(b, h) ((4 + (b) * 2 + (h)) * HTB)
#define PG8_STAGE(bufoff, gbase, voff) do { _Pragma("unroll") for (int _i = 0; _i < 2; ++_i) \
        __builtin_amdgcn_global_load_lds((const unsigned*)((const char*)(gbase) + (voff)[_i]), (LAS unsigned*)(lds + (bufoff) + ldsw + _i * 8192), 16, 0, 0); } while (0)
#define PG8_LDA(dst, b, h) do { _Pragma("unroll") for (int m = 0; m < 4; ++m) _Pragma("unroll") for (int k = 0; k < 2; ++k) dst[m][k] = *(const LAS bf16x8*)(lds + PG8_SA(b, h) + aoff + m * 2048 + k * 1024); } while (0)
#define PG8_LDB(dst, b, h) do { _Pragma("unroll") for (int n = 0; n < 2; ++n) _Pragma("unroll") for (int k = 0; k < 2; ++k) dst[n][k] = *(const LAS bf16x8*)(lds + PG8_SB(b, h) + boff + n * 2048 + k * 1024); } while (0)
#define PG8_MMA(ai, bj, At, Bt) do { __builtin_amdgcn_s_setprio(1); _Pragma("unroll") for (int m = 0; m < 4; ++m) _Pragma("unroll") for (int n = 0; n < 2; ++n) _Pragma("unroll") for (int k = 0; k < 2; ++k) \
        { if constexpr (I8) acc[ai][bj][m][n] = __builtin_bit_cast(f32x4, __builtin_amdgcn_mfma_i32_16x16x64_i8(__builtin_bit_cast(v4i, Bt[n][k]), __builtin_bit_cast(v4i, At[m][k]), __builtin_bit_cast(v4i, acc[ai][bj][m][n]), 0, 0, 0)); \
          else acc[ai][bj][m][n] = __builtin_amdgcn_mfma_f32_16x16x32_bf16(Bt[n][k], At[m][k], acc[ai][bj][m][n], 0, 0, 0); } __builtin_amdgcn_s_setprio(0); } while (0)
#define PG8_WAIT_V(n) asm volatile("s_waitcnt vmcnt(" #n ")" ::: "memory")
#define PG8_WAIT_L(n) asm volatile("s_waitcnt lgkmcnt(" #n ")" ::: "memory")
#define PG8_BAR __builtin_amdgcn_s_barrier()
#define PG8_SCHED __builtin_amdgcn_sched_barrier(0)
    Unit cur, nxt; int ui = 0;
    if (!S.next(0, cur)) return;
    f32x4 acc[2][2][4][2];
#pragma unroll
    for (int a = 0; a < 2; ++a)
#pragma unroll
        for (int b = 0; b < 2; ++b)
#pragma unroll
            for (int m = 0; m < 4; ++m)
#pragma unroll
                for (int n = 0; n < 2; ++n) acc[a][b][m][n] = (f32x4){0.f, 0.f, 0.f, 0.f};
    bf16x8 At[4][2], B0[2][2], B1[2][2];
    const char* cA = (const char*)g.A + (size_t)cur.ka * tstep; const char* cB = (const char*)g.Bt + (size_t)cur.kb * tstep;
    PG8_STAGE(PG8_SB(0, 0), cB, voffB); PG8_STAGE(PG8_SB(0, 1), cB + hstep, voffB); PG8_STAGE(PG8_SA(0, 0), cA, voffA); PG8_STAGE(PG8_SA(0, 1), cA + hstep, voffA);
    if (wr == 1) PG8_BAR;
    PG8_WAIT_V(2); PG8_BAR;
    PG8_STAGE(PG8_SB(1, 0), cB + kstep, voffB); PG8_STAGE(PG8_SA(1, 0), cA + kstep, voffA); PG8_STAGE(PG8_SB(1, 1), cB + hstep + kstep, voffB);
    PG8_WAIT_V(6); PG8_BAR;
    for (;;) {
        const bool has_next = S.next(ui + 1, nxt);
        const char* nA = has_next ? (const char*)g.A + (size_t)nxt.ka * tstep : cA; const char* nB = has_next ? (const char*)g.Bt + (size_t)nxt.kb * tstep : cB;
#pragma nounroll
        for (int t = 0; t < nt; t += 2) {
            const bool last = (t == nt - 2);
            const char* a1 = cA + (size_t)(t + 1) * kstep;
            const char* a2 = last ? nA : cA + (size_t)(t + 2) * kstep; const char* b2 = last ? nB : cB + (size_t)(t + 2) * kstep;
            const char* a3 = a2 + kstep; const char* b3 = b2 + kstep;
            PG8_LDB(B0, 0, 0); PG8_LDB(B1, 0, 1); PG8_SCHED; PG8_LDA(At, 0, 0); PG8_STAGE(PG8_SA(1, 1), a1 + hstep, voffA);
            PG8_WAIT_V(8); PG8_WAIT_L(0); PG8_BAR; PG8_MMA(0, 0, At, B0); PG8_MMA(0, 1, At, B1); PG8_BAR; PG8_SCHED;
            PG8_LDA(At, 0, 1); PG8_STAGE(PG8_SB(0, 0), b2, voffB); PG8_STAGE(PG8_SB(0, 1), b2 + hstep, voffB); PG8_STAGE(PG8_SA(0, 0), a2, voffA);
            PG8_WAIT_V(8); PG8_WAIT_L(0); PG8_BAR; PG8_MMA(1, 0, At, B0); PG8_MMA(1, 1, At, B1); PG8_BAR; PG8_SCHED;
            PG8_LDB(B0, 1, 0); PG8_LDB(B1, 1, 1); PG8_SCHED; PG8_LDA(At, 1, 0); PG8_STAGE(PG8_SA(0, 1), a2 + hstep, voffA);
            PG8_WAIT_V(8); PG8_WAIT_L(0); PG8_BAR; PG8_MMA(0, 0, At, B0); PG8_MMA(0, 1, At, B1); PG8_BAR; PG8_SCHED;
            PG8_LDA(At, 1, 1); PG8_STAGE(PG8_SB(1, 0), b3, voffB); PG8_STAGE(PG8_SB(1, 1), b3 + hstep, voffB); PG8_STAGE(PG8_SA(1, 0), a3, voffA);
            PG8_WAIT_V(8); PG8_WAIT_L(0); PG8_BAR; PG8_MMA(1, 0, At, B0); PG8_MMA(1, 1, At, B1); PG8_BAR; PG8_SCHED;
        }
        if constexpr (ALIGN_EPI) { if (wr == 0) PG8_BAR; }
        const bool reset = E(acc, cur, wr, wc, fr, fq);
        if (!has_next) break;
        if (reset) {
#pragma unroll
        for (int a = 0; a < 2; ++a)
#pragma unroll
            for (int b = 0; b < 2; ++b)
#pragma unroll
                for (int m = 0; m < 4; ++m)
#pragma unroll
                    for (int n = 0; n < 2; ++n) acc[a][b][m][n] = (f32x4){0.f, 0.f, 0.f, 0.f};
        }
        cur = nxt; cA = nA; cB = nB; ++ui;
        if constexpr (ALIGN_EPI) { if (wr == 1) PG8_BAR; }
    }
    PG8_WAIT_V(0);
    if constexpr (!ALIGN_EPI) { if (wr == 0) PG8_BAR; }
    PG8_BAR;
#undef PG8_SA
#undef PG8_SB
#undef PG8_STAGE
#undef PG8_LDA
#undef PG8_LDB
#undef PG8_MMA
#undef PG8_WAIT_V
#undef PG8_WAIT_L
#undef PG8_BAR
#undef PG8_SCHED
}
}

namespace att {
constexpr int D = 128, NW = 8, QBLK = 32, KVBLK = 64;
constexpr float SCALE = 0.088388347648318440f;
constexpr float THR = 8.f;
constexpr int LDQ = PWD, LDK = PWD, LDO = MWD;
constexpr int SHM_V = KVBLK * D * 2, SHM_K = KVBLK * D * 2;
constexpr int OST_PITCH = 272;
constexpr int OST_OFF = 2 * SHM_V + 2 * SHM_K + NW * 64 * 4;
constexpr int ATT_LDS = OST_OFF + NW * 32 * OST_PITCH;
#define KSWZ(row, colB) ((row) * 256 + ((colB) ^ (((row) & 7) << 4)))
#define SBAR() __builtin_amdgcn_sched_barrier(0)
__device__ __forceinline__ int crow(int r, int hi) { return (r & 3) + 8 * (r >> 2) + 4 * hi; }

template <bool MASKED>
__device__ __forceinline__ void partialSM(f32x16& p0, f32x16& p1, float& m_reg, float& mn, float& alpha, int mbase) {
  constexpr float C = SCALE * 1.4426950408889634f;
  if constexpr (MASKED) {
    const float ninf = -__builtin_inff();
#pragma unroll
    for (int r = 0; r < 16; ++r) { const int c = (r & 3) + 8 * (r >> 2);
      p0[r] = ((unsigned)(mbase - c) <= 256u) ? p0[r] : ninf;
      p1[r] = ((unsigned)(mbase - c - 32) <= 256u) ? p1[r] : ninf; }
  }
  float pmax = p0[0];
#pragma unroll
  for (int r = 1; r < 16; ++r) pmax = fmaxf(pmax, p0[r]);
#pragma unroll
  for (int r = 0; r < 16; ++r) pmax = fmaxf(pmax, p1[r]);
  { auto rr = __builtin_amdgcn_permlane32_swap(__float_as_uint(pmax), __float_as_uint(pmax), false, false);
    pmax = fmaxf(__uint_as_float(rr[0]), __uint_as_float(rr[1])); }
  if (__builtin_expect(__all(pmax - m_reg <= THR / SCALE), 1)) { mn = m_reg; alpha = 1.f; }
  else { mn = fmaxf(m_reg, pmax); alpha = __builtin_amdgcn_exp2f((m_reg - mn) * C); m_reg = mn; }
  float mnC = -mn * C;
#pragma unroll
  for (int r = 0; r < 16; ++r) p0[r] = fmaf(p0[r], C, mnC);
#pragma unroll
  for (int r = 0; r < 16; ++r) p1[r] = fmaf(p1[r], C, mnC);
#pragma unroll
  for (int r = 0; r < 16; ++r) p0[r] = __builtin_amdgcn_exp2f(p0[r]);
}
__device__ __forceinline__ void finishSM(f32x16& p0, f32x16& p1, float alpha, float& l_reg, bf16x8& pa0, bf16x8& pa1, bf16x8& pa2, bf16x8& pa3) {
#pragma unroll
  for (int r = 0; r < 16; ++r) p1[r] = __builtin_amdgcn_exp2f(p1[r]);
  float ps = 0;
#pragma unroll
  for (int r = 0; r < 16; ++r) ps += p0[r];
#pragma unroll
  for (int r = 0; r < 16; ++r) ps += p1[r];
  { auto rr = __builtin_amdgcn_permlane32_swap(__float_as_uint(ps), __float_as_uint(ps), false, false);
    ps = __uint_as_float(rr[0]) + __uint_as_float(rr[1]); }
  l_reg = l_reg * alpha + ps;
#define PK4(P, BASE, OUT) do { unsigned a0 = cvt_pk_bf16(P[BASE + 0], P[BASE + 1]), a1 = cvt_pk_bf16(P[BASE + 2], P[BASE + 3]);   \
    unsigned b0 = cvt_pk_bf16(P[BASE + 4], P[BASE + 5]), b1 = cvt_pk_bf16(P[BASE + 6], P[BASE + 7]);                              \
    auto r0 = __builtin_amdgcn_permlane32_swap(a0, b0, false, false); auto r1 = __builtin_amdgcn_permlane32_swap(a1, b1, false, false); \
    u32x4 w = {r0[0], r1[0], r0[1], r1[1]}; OUT = *reinterpret_cast<bf16x8*>(&w); } while (0)
  PK4(p0, 0, pa0); PK4(p0, 8, pa1); PK4(p1, 0, pa2); PK4(p1, 8, pa3);
#undef PK4
}
__device__ __forceinline__ void qkt(f32x16& p0, f32x16& p1, const bf16* Ks, const bf16x8* qr, int r32, int hi) {
  p0 = f32x16{}; p1 = f32x16{};
#pragma unroll
  for (int d0 = 0; d0 < 8; ++d0) { int cb = (d0 * 16 + hi * 8) * 2;
    bf16x8 b0 = *reinterpret_cast<const bf16x8*>((const char*)Ks + KSWZ(r32, cb));
    bf16x8 b1 = *reinterpret_cast<const bf16x8*>((const char*)Ks + KSWZ(32 + r32, cb));
    p0 = __builtin_amdgcn_mfma_f32_32x32x16_bf16(b0, qr[d0], p0, 0, 0, 0);
    p1 = __builtin_amdgcn_mfma_f32_32x32x16_bf16(b1, qr[d0], p1, 0, 0, 0); }
}
__device__ __forceinline__ int v_st(int k, int c) { const int kk = (k & ~0xC) | ((k & 4) << 1) | ((k & 8) >> 1); return ((kk >> 3) * 4 + (c >> 5)) * 512 + ((kk & 7) * 32 + (c & 31)) * 2; }
__device__ __forceinline__ int v_rd_base(int lane) { return ((lane & 3) << 3) | (((lane >> 2) & 3) << 6) | (((lane >> 4) & 1) << 5) | (((lane >> 5) & 1) << 8); }
constexpr int v_rd_off(int d0, int ks, int half) { return d0 * 512 + ks * 4096 + half * 2048; }
template <int OFF> __device__ __forceinline__ s16x4 tr_read(int vb) {
  s16x4 r; asm volatile("ds_read_b64_tr_b16 %0, %1 offset:%2" : "=&v"(r) : "v"(vb), "i"(OFF) : "memory"); return r;
}
template <int D0> __device__ __forceinline__ void pv_one(f32x16& od, int vb, bf16x8 pa0, bf16x8 pa1, bf16x8 pa2, bf16x8 pa3) {
  const s16x4 l0 = tr_read<v_rd_off(D0, 0, 0)>(vb), h0 = tr_read<v_rd_off(D0, 0, 1)>(vb), l1 = tr_read<v_rd_off(D0, 1, 0)>(vb), h1 = tr_read<v_rd_off(D0, 1, 1)>(vb);
  const s16x4 l2 = tr_read<v_rd_off(D0, 2, 0)>(vb), h2 = tr_read<v_rd_off(D0, 2, 1)>(vb), l3 = tr_read<v_rd_off(D0, 3, 0)>(vb), h3 = tr_read<v_rd_off(D0, 3, 1)>(vb);
  asm volatile("s_waitcnt lgkmcnt(0)" ::: "memory"); SBAR();
#define PK(L, H) (bf16x8){L[0], L[1], L[2], L[3], H[0], H[1], H[2], H[3]}
  od = __builtin_amdgcn_mfma_f32_32x32x16_bf16(pa0, PK(l0, h0), od, 0, 0, 0);
  od = __builtin_amdgcn_mfma_f32_32x32x16_bf16(pa1, PK(l1, h1), od, 0, 0, 0);
  od = __builtin_amdgcn_mfma_f32_32x32x16_bf16(pa2, PK(l2, h2), od, 0, 0, 0);
  od = __builtin_amdgcn_mfma_f32_32x32x16_bf16(pa3, PK(l3, h3), od, 0, 0, 0);
#undef PK
}
__device__ __forceinline__ void pv_d0(f32x16* o, int vb, bf16x8 pa0, bf16x8 pa1, bf16x8 pa2, bf16x8 pa3) {
#define PK(L, H) (bf16x8){L[0], L[1], L[2], L[3], H[0], H[1], H[2], H[3]}
#define PV_RD(D0, P, N) const s16x4 la##N = tr_read<v_rd_off(D0, 2 * (P), 0)>(vb), ha##N = tr_read<v_rd_off(D0, 2 * (P), 1)>(vb), lb##N = tr_read<v_rd_off(D0, 2 * (P) + 1, 0)>(vb), hb##N = tr_read<v_rd_off(D0, 2 * (P) + 1, 1)>(vb)
#define PV_MM2(D0, PA, PB, N) do { o[D0] = __builtin_amdgcn_mfma_f32_32x32x16_bf16(PA, PK(la##N, ha##N), o[D0], 0, 0, 0); o[D0] = __builtin_amdgcn_mfma_f32_32x32x16_bf16(PB, PK(lb##N, hb##N), o[D0], 0, 0, 0); } while (0)
#define PV_W4() do { asm volatile("s_waitcnt lgkmcnt(4)" ::: "memory"); SBAR(); } while (0)
  PV_RD(0, 0, 0); PV_RD(0, 1, 1);
  PV_W4(); PV_MM2(0, pa0, pa1, 0); SBAR(); PV_RD(1, 0, 2);
  PV_W4(); PV_MM2(0, pa2, pa3, 1); SBAR(); PV_RD(1, 1, 3);
  PV_W4(); PV_MM2(1, pa0, pa1, 2); SBAR(); PV_RD(2, 0, 4);
  PV_W4(); PV_MM2(1, pa2, pa3, 3); SBAR(); PV_RD(2, 1, 5);
  PV_W4(); PV_MM2(2, pa0, pa1, 4); SBAR(); PV_RD(3, 0, 6);
  PV_W4(); PV_MM2(2, pa2, pa3, 5); SBAR(); PV_RD(3, 1, 7);
  PV_W4(); PV_MM2(3, pa0, pa1, 6); SBAR();
  asm volatile("s_waitcnt lgkmcnt(0)" ::: "memory"); SBAR(); PV_MM2(3, pa2, pa3, 7);
#undef PV_W4
#undef PV_MM2
#undef PV_RD
#undef PK
}

constexpr float THR2 = THR * 1.4426950408889634f;
__device__ __forceinline__ void qkt_n(f32x16& p0, f32x16& p1, const bf16* Ks, const bf16x8* qr, const f32x16& negm, int r32, int hi) {
#pragma unroll
  for (int d0 = 0; d0 < 8; ++d0) { int cb = (d0 * 16 + hi * 8) * 2;
    bf16x8 b0 = *reinterpret_cast<const bf16x8*>((const char*)Ks + KSWZ(r32, cb));
    bf16x8 b1 = *reinterpret_cast<const bf16x8*>((const char*)Ks + KSWZ(32 + r32, cb));
    if (d0 == 0) { p0 = __builtin_amdgcn_mfma_f32_32x32x16_bf16(b0, qr[0], negm, 0, 0, 0); p1 = __builtin_amdgcn_mfma_f32_32x32x16_bf16(b1, qr[0], negm, 0, 0, 0); }
    else { p0 = __builtin_amdgcn_mfma_f32_32x32x16_bf16(b0, qr[d0], p0, 0, 0, 0); p1 = __builtin_amdgcn_mfma_f32_32x32x16_bf16(b1, qr[d0], p1, 0, 0, 0); } }
}
template <bool MASKED>
__device__ __forceinline__ void partialSM_n(f32x16& p0, f32x16& p1, float& m_reg, f32x16& negm, float& alpha, int mbase) {
  if constexpr (MASKED) {
    const float ninf = -__builtin_inff();
#pragma unroll
    for (int r = 0; r < 16; ++r) { const int c = (r & 3) + 8 * (r >> 2);
      p0[r] = ((unsigned)(mbase - c) <= 256u) ? p0[r] : ninf;
      p1[r] = ((unsigned)(mbase - c - 32) <= 256u) ? p1[r] : ninf; }
  }
  float pmax = p0[0];
#pragma unroll
  for (int r = 1; r < 16; ++r) pmax = fmaxf(pmax, p0[r]);
#pragma unroll
  for (int r = 0; r < 16; ++r) pmax = fmaxf(pmax, p1[r]);
  { auto rr = __builtin_amdgcn_permlane32_swap(__float_as_uint(pmax), __float_as_uint(pmax), false, false);
    pmax = fmaxf(__uint_as_float(rr[0]), __uint_as_float(rr[1])); }
  if (__builtin_expect(__all(pmax <= THR2), 1)) { alpha = 1.f; }
  else { const float sh = fmaxf(pmax, 0.f); alpha = __builtin_amdgcn_exp2f(-sh); m_reg += sh;
#pragma unroll
    for (int r = 0; r < 16; ++r) { p0[r] -= sh; p1[r] -= sh; negm[r] = -m_reg; } }
#pragma unroll
  for (int r = 0; r < 16; ++r) p0[r] = __builtin_amdgcn_exp2f(p0[r]);
}
template <int MODE, int SD>
__device__ __forceinline__ void attn_unit(const bf16* __restrict__ Qb, const bf16* __restrict__ Kh, const bf16* __restrict__ Vh, bf16* __restrict__ Ob, int NT, int dq0, const float* sinkp  , char* lds,
                                          const f32x2* __restrict__ tab  , const float* __restrict__ gq  ) {
  int tid_ = threadIdx.x; asm volatile("" : "+v"(tid_));
  const int tid = tid_, wid = tid >> 6, lane = tid & 63, r32 = lane & 31, hi = lane >> 5;
  bf16* V_lds = (bf16*)lds; bf16* K_lds = (bf16*)(lds + 2 * SHM_V);
  float* ws = (float*)(lds + 2 * SHM_V + 2 * SHM_K) + wid * 64; float* li_l = ws; float* al_l = ws + 32;
  const int wrow = MODE ? (wid >> 2) * QBLK : wid * QBLK, wcol = MODE ? (wid & 3) * D : 0;
  float m_reg = MODE ? sinkp[wid & 3] * (1.0f / SCALE) : 0.0f, l_reg = MODE ? 1.0f : 0.0f; f32x16 o[4] = {}; bf16x8 qr[8];
  f32x16 negm;
#pragma unroll
  for (int r = 0; r < 16; ++r) negm[r] = -m_reg;
  const bf16* Qw = Qb + (long)(wrow + r32) * LDQ + wcol + hi * 8;
#pragma unroll
  for (int d0 = 0; d0 < 8; ++d0) qr[d0] = *reinterpret_cast<const bf16x8*>(Qw + d0 * 16);
  const int sr = tid >> 4, sc = (tid & 15) * 8, vst0 = v_st(sr, sc), vst1 = v_st(32 + sr, sc);
  struct { bf16x8 vs0, vs1, ks0, ks1; } sr_[SD];
#define SLOAD(i, k0) do { sr_[i].vs0 = *reinterpret_cast<const bf16x8*>(&Vh[(long)((k0) + sr) * LDK + sc]); sr_[i].vs1 = *reinterpret_cast<const bf16x8*>(&Vh[(long)((k0) + 32 + sr) * LDK + sc]); \
    sr_[i].ks0 = *reinterpret_cast<const bf16x8*>(&Kh[(long)((k0) + sr) * LDK + sc]); sr_[i].ks1 = *reinterpret_cast<const bf16x8*>(&Kh[(long)((k0) + 32 + sr) * LDK + sc]); } while (0)
  SLOAD(0, 0);
  {
    float rstd = 1.f;
    if constexpr (MODE == 0) {
      float ss = 0.f;
#pragma unroll
      for (int d0 = 0; d0 < 8; ++d0) { const u32x4 w = *reinterpret_cast<const u32x4*>(&qr[d0]);
        const float a0 = bf_lo(w.x), a1 = bf_hi(w.x), a2 = bf_lo(w.y), a3 = bf_hi(w.y), a4 = bf_lo(w.z), a5 = bf_hi(w.z), a6 = bf_lo(w.w), a7 = bf_hi(w.w);
        ss += (a0 * a0 + a1 * a1) + (a2 * a2 + a3 * a3) + (a4 * a4 + a5 * a5) + (a6 * a6 + a7 * a7); }
      { auto rr = __builtin_amdgcn_permlane32_swap(__float_as_uint(ss), __float_as_uint(ss), false, false); ss = __uint_as_float(rr[0]) + __uint_as_float(rr[1]); }
      rstd = 1.0f / sqrtf(ss * (1.0f / D) + EPS);
    }
    const f32x4* tp = (const f32x4*)(tab + (wrow + r32) * 64 + hi * 8);
#pragma unroll
    for (int d0 = 0; d0 < 4; ++d0) {
      const u32x4 w1 = *reinterpret_cast<const u32x4*>(&qr[d0]), w2 = *reinterpret_cast<const u32x4*>(&qr[d0 + 4]);
      float x1[8] = {bf_lo(w1.x), bf_hi(w1.x), bf_lo(w1.y), bf_hi(w1.y), bf_lo(w1.z), bf_hi(w1.z), bf_lo(w1.w), bf_hi(w1.w)};
      float x2[8] = {bf_lo(w2.x), bf_hi(w2.x), bf_lo(w2.y), bf_hi(w2.y), bf_lo(w2.z), bf_hi(w2.z), bf_lo(w2.w), bf_hi(w2.w)};
      if constexpr (MODE == 0) {
        const f32x4 g1a = *(const f32x4*)(gq + d0 * 16 + hi * 8), g1b = *(const f32x4*)(gq + d0 * 16 + hi * 8 + 4), g2a = *(const f32x4*)(gq + 64 + d0 * 16 + hi * 8), g2b = *(const f32x4*)(gq + 64 + d0 * 16 + hi * 8 + 4);
        const float g1[8] = {g1a.x, g1a.y, g1a.z, g1a.w, g1b.x, g1b.y, g1b.z, g1b.w}, g2[8] = {g2a.x, g2a.y, g2a.z, g2a.w, g2b.x, g2b.y, g2b.z, g2b.w};
#pragma unroll
        for (int e = 0; e < 8; ++e) { x1[e] = x1[e] * rstd * g1[e]; x2[e] = x2[e] * rstd * g2[e]; }
      }
      float o1[8], o2[8];
#pragma unroll
      for (int e2 = 0; e2 < 4; ++e2) { const f32x4 cs = tp[d0 * 8 + e2];
        o1[2 * e2] = x1[2 * e2] * cs.x - x2[2 * e2] * cs.y; o2[2 * e2] = x2[2 * e2] * cs.x + x1[2 * e2] * cs.y;
        o1[2 * e2 + 1] = x1[2 * e2 + 1] * cs.z - x2[2 * e2 + 1] * cs.w; o2[2 * e2 + 1] = x2[2 * e2 + 1] * cs.z + x1[2 * e2 + 1] * cs.w; }
      if constexpr (MODE == 0) { constexpr float CQ = SCALE * 1.4426950408889634f;
#pragma unroll
        for (int e = 0; e < 8; ++e) { o1[e] *= CQ; o2[e] *= CQ; } }
      u32x4 p1, p2; p1.x = cvt_pk_bf16(o1[0], o1[1]); p1.y = cvt_pk_bf16(o1[2], o1[3]); p1.z = cvt_pk_bf16(o1[4], o1[5]); p1.w = cvt_pk_bf16(o1[6], o1[7]);
      p2.x = cvt_pk_bf16(o2[0], o2[1]); p2.y = cvt_pk_bf16(o2[2], o2[3]); p2.z = cvt_pk_bf16(o2[4], o2[5]); p2.w = cvt_pk_bf16(o2[6], o2[7]);
      qr[d0] = *reinterpret_cast<bf16x8*>(&p1); qr[d0 + 4] = *reinterpret_cast<bf16x8*>(&p2);
    }
  }
  const int vb0 = (int)(uintptr_t)V_lds + v_rd_base(lane);
  const int mb0 = dq0 + wrow + r32 + 128 - 4 * hi;
#define SWRITE(b, i) do { *(bf16x8*)((char*)V_lds + (b) * SHM_V + vst0) = sr_[i].vs0;          \
    *(bf16x8*)((char*)V_lds + (b) * SHM_V + vst1) = sr_[i].vs1; int kc = sc * 2;               \
    *(bf16x8*)((char*)K_lds + (b) * SHM_K + KSWZ(sr, kc)) = sr_[i].ks0;                       \
    *(bf16x8*)((char*)K_lds + (b) * SHM_K + KSWZ(32 + sr, kc)) = sr_[i].ks1; } while (0)
#define SWAIT() do { if constexpr (SD == 2) asm volatile("s_waitcnt vmcnt(4)" ::: "memory"); else asm volatile("s_waitcnt vmcnt(0)" ::: "memory"); } while (0)
#define RESC(a) do { if (__any((a) < 1.f)) { if (hi == 0) al_l[r32] = (a); asm volatile("s_waitcnt lgkmcnt(0)" ::: "memory"); \
    _Pragma("unroll") for (int d = 0; d < 4; ++d) _Pragma("unroll") for (int r = 0; r < 16; ++r) o[d][r] *= al_l[crow(r, hi)]; } } while (0)
#define PSM(P0, P1, MN, AL, J) do { if constexpr (MODE == 0) partialSM_n<false>(P0, P1, m_reg, negm, AL, 0); else partialSM<true>(P0, P1, m_reg, MN, AL, mb0 - 64 * (J)); } while (0)
#define QKT(P0, P1, KS) do { if constexpr (MODE == 0) qkt_n(P0, P1, KS, qr, negm, r32, hi); else qkt(P0, P1, KS, qr, r32, hi); } while (0)
  const int wq0 = dq0 + __builtin_amdgcn_readfirstlane(wrow);
#define NEED(T) (MODE == 0 || (64 * (T) <= wq0 + 31 + 128 && 64 * (T) + 63 >= wq0 - 128))
  f32x16 pA0, pA1, pB0, pB1; float mnA, mnB, alA, alB; bf16x8 pa0, pa1, pa2, pa3;
  constexpr int SE = 0, SO = SD - 1;
  asm volatile("s_waitcnt vmcnt(0)" ::: "memory"); SWRITE(0, SE); __syncthreads();
  alA = 1.f; alB = 1.f;
  if (NEED(0)) { QKT(pA0, pA1, K_lds); PSM(pA0, pA1, mnA, alA, 0); }
  SLOAD(SO, KVBLK); if constexpr (SD == 2) { if (2 < NT) SLOAD(SE, 2 * KVBLK); }
  SWAIT(); SWRITE(1, SO); __syncthreads();
  for (int j = 1; j + 1 < NT; j += 2) {
    const bool nB = NEED(j), nA0 = NEED(j - 1);
    SBAR(); if (nB) QKT(pB0, pB1, (bf16*)((char*)K_lds + SHM_K));
    if (nA0) finishSM(pA0, pA1, alA, l_reg, pa0, pa1, pa2, pa3); SBAR();
    SLOAD(SO, (j + SD) * KVBLK); SBAR();
    if (nA0) pv_d0(o, vb0, pa0, pa1, pa2, pa3); alB = 1.f; if (nB) PSM(pB0, pB1, mnB, alB, j);
    __syncthreads(); SWAIT(); SWRITE(0, SE);
    RESC(alB); __syncthreads();
    const bool nA1 = NEED(j + 1);
    SBAR(); if (nA1) QKT(pA0, pA1, K_lds);
    if (nB) finishSM(pB0, pB1, alB, l_reg, pa0, pa1, pa2, pa3); SBAR();
    if (SD == 1 || j + 3 < NT) SLOAD(SE, (j + 1 + SD) * KVBLK); SBAR();
    if (nB) pv_d0(o, vb0 + (int)SHM_V, pa0, pa1, pa2, pa3); alA = 1.f; if (nA1) PSM(pA0, pA1, mnA, alA, j + 1);
    __syncthreads(); SWAIT(); SWRITE(1, SO);
    RESC(alA); __syncthreads();
  }
  { const bool nB = NEED(NT - 1), nA0 = NEED(NT - 2);
  SBAR(); if (nB) QKT(pB0, pB1, (bf16*)((char*)K_lds + SHM_K));
  if (nA0) finishSM(pA0, pA1, alA, l_reg, pa0, pa1, pa2, pa3); SBAR();
  if (nA0) pv_d0(o, vb0, pa0, pa1, pa2, pa3); alB = 1.f; if (nB) PSM(pB0, pB1, mnB, alB, NT - 1);
  __syncthreads(); RESC(alB);
  if (nB) { finishSM(pB0, pB1, alB, l_reg, pa0, pa1, pa2, pa3); SBAR();
  pv_d0(o, vb0 + (int)SHM_V, pa0, pa1, pa2, pa3); } }
  if (hi == 0) li_l[r32] = l_reg; asm volatile("s_waitcnt lgkmcnt(0)" ::: "memory");
  float rli[16];
#pragma unroll
  for (int r = 0; r < 16; ++r) rli[r] = __builtin_amdgcn_rcpf(li_l[crow(r, hi)]);
  char* ost = lds + OST_OFF + wid * (32 * OST_PITCH);
#pragma unroll
  for (int r = 0; r < 16; ++r) { const int orow = crow(r, hi);
#pragma unroll
    for (int d0 = 0; d0 < 4; ++d0) { const float v = o[d0][r] * rli[r]; *(bf16*)(ost + orow * OST_PITCH + (d0 * 32 + r32) * 2) = (bf16)(cvt_pk_bf16(v, v) & 0xffffu); } }
  asm volatile("s_waitcnt lgkmcnt(0)" ::: "memory");
  bf16* Ow = Ob + (long)wrow * LDO + wcol;
#pragma unroll
  for (int i = 0; i < 8; ++i) { const int row = (lane >> 4) + 4 * i, cc = (lane & 15);
    const u32x4 w = *(const u32x4*)(ost + row * OST_PITCH + cc * 16);
    *(u32x4*)(Ow + (long)row * LDO + cc * 8) = w; }
  __syncthreads();
#undef SLOAD
#undef SWRITE
#undef SWAIT
#undef RESC
#undef PSM
#undef QKT
#undef NEED
}

__device__ __forceinline__ void qkt2(f32x16& p0, f32x16& p1, const char* Ks, const bf16x8* qr, int r32, int hi) {
  const int x = (r32 & 7) << 4;
  const char* ka = Ks + r32 * 256; const char* kb = Ks + (32 + r32) * 256;
#define KOFF(d0) ((((d0) * 32 + hi * 16)) ^ x)
  bf16x8 a0 = *reinterpret_cast<const bf16x8*>(ka + KOFF(0)), b0 = *reinterpret_cast<const bf16x8*>(kb + KOFF(0));
  bf16x8 a1 = *reinterpret_cast<const bf16x8*>(ka + KOFF(1)), b1 = *reinterpret_cast<const bf16x8*>(kb + KOFF(1));
  bf16x8 a2 = *reinterpret_cast<const bf16x8*>(ka + KOFF(2)), b2 = *reinterpret_cast<const bf16x8*>(kb + KOFF(2));
  bf16x8 a3 = *reinterpret_cast<const bf16x8*>(ka + KOFF(3)), b3 = *reinterpret_cast<const bf16x8*>(kb + KOFF(3));
  p0 = f32x16{}; p1 = f32x16{};
  SBAR();
  p0 = __builtin_amdgcn_mfma_f32_32x32x16_bf16(a0, qr[0], p0, 0, 0, 0); p1 = __builtin_amdgcn_mfma_f32_32x32x16_bf16(b0, qr[0], p1, 0, 0, 0);
  a0 = *reinterpret_cast<const bf16x8*>(ka + KOFF(4)); b0 = *reinterpret_cast<const bf16x8*>(kb + KOFF(4)); SBAR();
  p0 = __builtin_amdgcn_mfma_f32_32x32x16_bf16(a1, qr[1], p0, 0, 0, 0); p1 = __builtin_amdgcn_mfma_f32_32x32x16_bf16(b1, qr[1], p1, 0, 0, 0);
  a1 = *reinterpret_cast<const bf16x8*>(ka + KOFF(5)); b1 = *reinterpret_cast<const bf16x8*>(kb + KOFF(5)); SBAR();
  p0 = __builtin_amdgcn_mfma_f32_32x32x16_bf16(a2, qr[2], p0, 0, 0, 0); p1 = __builtin_amdgcn_mfma_f32_32x32x16_bf16(b2, qr[2], p1, 0, 0, 0);
  a2 = *reinterpret_cast<const bf16x8*>(ka + KOFF(6)); b2 = *reinterpret_cast<const bf16x8*>(kb + KOFF(6)); SBAR();
  p0 = __builtin_amdgcn_mfma_f32_32x32x16_bf16(a3, qr[3], p0, 0, 0, 0); p1 = __builtin_amdgcn_mfma_f32_32x32x16_bf16(b3, qr[3], p1, 0, 0, 0);
  a3 = *reinterpret_cast<const bf16x8*>(ka + KOFF(7)); b3 = *reinterpret_cast<const bf16x8*>(kb + KOFF(7)); SBAR();
  p0 = __builtin_amdgcn_mfma_f32_32x32x16_bf16(a0, qr[4], p0, 0, 0, 0); p1 = __builtin_amdgcn_mfma_f32_32x32x16_bf16(b0, qr[4], p1, 0, 0, 0); SBAR();
  p0 = __builtin_amdgcn_mfma_f32_32x32x16_bf16(a1, qr[5], p0, 0, 0, 0); p1 = __builtin_amdgcn_mfma_f32_32x32x16_bf16(b1, qr[5], p1, 0, 0, 0); SBAR();
  p0 = __builtin_amdgcn_mfma_f32_32x32x16_bf16(a2, qr[6], p0, 0, 0, 0); p1 = __builtin_amdgcn_mfma_f32_32x32x16_bf16(b2, qr[6], p1, 0, 0, 0); SBAR();
  p0 = __builtin_amdgcn_mfma_f32_32x32x16_bf16(a3, qr[7], p0, 0, 0, 0); p1 = __builtin_amdgcn_mfma_f32_32x32x16_bf16(b3, qr[7], p1, 0, 0, 0);
#undef KOFF
}
#define PV_RD(L, H, KS) do { L##0 = tr_read<v_rd_off(0, KS, 0)>(vb); H##0 = tr_read<v_rd_off(0, KS, 1)>(vb); L##1 = tr_read<v_rd_off(1, KS, 0)>(vb); H##1 = tr_read<v_rd_off(1, KS, 1)>(vb); \
    L##2 = tr_read<v_rd_off(2, KS, 0)>(vb); H##2 = tr_read<v_rd_off(2, KS, 1)>(vb); L##3 = tr_read<v_rd_off(3, KS, 0)>(vb); H##3 = tr_read<v_rd_off(3, KS, 1)>(vb); } while (0)
#define PV_PK(L, H) (bf16x8){L[0], L[1], L[2], L[3], H[0], H[1], H[2], H[3]}
#define PV_MM(PA, L, H) do { o[0] = __builtin_amdgcn_mfma_f32_32x32x16_bf16(PA, PV_PK(L##0, H##0), o[0], 0, 0, 0); o[1] = __builtin_amdgcn_mfma_f32_32x32x16_bf16(PA, PV_PK(L##1, H##1), o[1], 0, 0, 0); \
    o[2] = __builtin_amdgcn_mfma_f32_32x32x16_bf16(PA, PV_PK(L##2, H##2), o[2], 0, 0, 0); o[3] = __builtin_amdgcn_mfma_f32_32x32x16_bf16(PA, PV_PK(L##3, H##3), o[3], 0, 0, 0); } while (0)
__device__ __forceinline__ void pv2(f32x16* o, int vb, bf16x8 pa0, bf16x8 pa1, bf16x8 pa2, bf16x8 pa3) {
  s16x4 la0, la1, la2, la3, ha0, ha1, ha2, ha3, lb0, lb1, lb2, lb3, hb0, hb1, hb2, hb3;
  PV_RD(la, ha, 0); PV_RD(lb, hb, 1);
  asm volatile("s_waitcnt lgkmcnt(8)" ::: "memory"); SBAR(); PV_MM(pa0, la, ha); SBAR();
  PV_RD(la, ha, 2);
  asm volatile("s_waitcnt lgkmcnt(8)" ::: "memory"); SBAR(); PV_MM(pa1, lb, hb); SBAR();
  PV_RD(lb, hb, 3);
  asm volatile("s_waitcnt lgkmcnt(8)" ::: "memory"); SBAR(); PV_MM(pa2, la, ha); SBAR();
  asm volatile("s_waitcnt lgkmcnt(0)" ::: "memory"); SBAR(); PV_MM(pa3, lb, hb);
}
#undef PV_RD
#undef PV_PK
#undef PV_MM

constexpr int PP_K = 0, PP_V = 2 * SHM_K, PP_WS = 2 * SHM_K + 3 * SHM_V, PP_OST = 0;
static_assert(PP_WS + NW * 64 * 4 <= MISC_OFF && NW * 32 * OST_PITCH <= PP_WS, "attention LDS map");
__device__ __forceinline__ void pv_d0v(f32x16* o, int vb, bf16x8 pa0, bf16x8 pa1, bf16x8 pa2, bf16x8 pa3) { pv_d0(o, vb, pa0, pa1, pa2, pa3); }
template <int MODE>
__device__ __forceinline__ void attn_unit_pp(const bf16* __restrict__ Qb, const bf16* __restrict__ Kh, const bf16* __restrict__ Vh, bf16* __restrict__ Ob, int NT, int dq0, float sink, char* lds,
                                             const f32x2* __restrict__ tab, const float* __restrict__ gq) {
  int tid_ = threadIdx.x; asm volatile("" : "+v"(tid_));
  const int tid = tid_, wid = tid >> 6, lane = tid & 63, r32 = lane & 31, hi = lane >> 5, wr = __builtin_amdgcn_readfirstlane(wid >> 2);
  char* K_lds = lds + PP_K; char* V_lds = lds + PP_V;
  float* ws = (float*)(lds + PP_WS) + wid * 64; float* li_l = ws; float* al_l = ws + 32;
  float m_reg = MODE ? sink * (1.0f / SCALE) : -1e30f, l_reg = MODE ? 1.0f : 0.0f; f32x16 o[4] = {}; bf16x8 qr[8];
  const bf16* Qw = Qb + (long)(wid * QBLK + r32) * LDQ + hi * 8;
#pragma unroll
  for (int d0 = 0; d0 < 8; ++d0) qr[d0] = *reinterpret_cast<const bf16x8*>(Qw + d0 * 16);
  {
    float rstd = 1.f;
    if constexpr (MODE == 0) {
      float ss = 0.f;
#pragma unroll
      for (int d0 = 0; d0 < 8; ++d0) { const u32x4 w = *reinterpret_cast<const u32x4*>(&qr[d0]);
        const float a0 = bf_lo(w.x), a1 = bf_hi(w.x), a2 = bf_lo(w.y), a3 = bf_hi(w.y), a4 = bf_lo(w.z), a5 = bf_hi(w.z), a6 = bf_lo(w.w), a7 = bf_hi(w.w);
        ss += (a0 * a0 + a1 * a1) + (a2 * a2 + a3 * a3) + (a4 * a4 + a5 * a5) + (a6 * a6 + a7 * a7); }
      { auto rr = __builtin_amdgcn_permlane32_swap(__float_as_uint(ss), __float_as_uint(ss), false, false); ss = __uint_as_float(rr[0]) + __uint_as_float(rr[1]); }
      rstd = 1.0f / sqrtf(ss * (1.0f / D) + EPS);
    }
    const f32x4* tp = (const f32x4*)(tab + (wid * QBLK + r32) * 64 + hi * 8);
#pragma unroll
    for (int d0 = 0; d0 < 4; ++d0) {
      const u32x4 w1 = *reinterpret_cast<const u32x4*>(&qr[d0]), w2 = *reinterpret_cast<const u32x4*>(&qr[d0 + 4]);
      float x1[8] = {bf_lo(w1.x), bf_hi(w1.x), bf_lo(w1.y), bf_hi(w1.y), bf_lo(w1.z), bf_hi(w1.z), bf_lo(w1.w), bf_hi(w1.w)};
      float x2[8] = {bf_lo(w2.x), bf_hi(w2.x), bf_lo(w2.y), bf_hi(w2.y), bf_lo(w2.z), bf_hi(w2.z), bf_lo(w2.w), bf_hi(w2.w)};
      if constexpr (MODE == 0) {
        const f32x4 g1a = *(const f32x4*)(gq + d0 * 16 + hi * 8), g1b = *(const f32x4*)(gq + d0 * 16 + hi * 8 + 4), g2a = *(const f32x4*)(gq + 64 + d0 * 16 + hi * 8), g2b = *(const f32x4*)(gq + 64 + d0 * 16 + hi * 8 + 4);
        const float g1[8] = {g1a.x, g1a.y, g1a.z, g1a.w, g1b.x, g1b.y, g1b.z, g1b.w}, g2[8] = {g2a.x, g2a.y, g2a.z, g2a.w, g2b.x, g2b.y, g2b.z, g2b.w};
#pragma unroll
        for (int e = 0; e < 8; ++e) { x1[e] = x1[e] * rstd * g1[e]; x2[e] = x2[e] * rstd * g2[e]; }
      }
      float o1[8], o2[8];
#pragma unroll
      for (int e2 = 0; e2 < 4; ++e2) { const f32x4 cs = tp[d0 * 8 + e2];
        o1[2 * e2] = x1[2 * e2] * cs.x - x2[2 * e2] * cs.y; o2[2 * e2] = x2[2 * e2] * cs.x + x1[2 * e2] * cs.y;
        o1[2 * e2 + 1] = x1[2 * e2 + 1] * cs.z - x2[2 * e2 + 1] * cs.w; o2[2 * e2 + 1] = x2[2 * e2 + 1] * cs.z + x1[2 * e2 + 1] * cs.w; }
      u32x4 p1, p2; p1.x = cvt_pk_bf16(o1[0], o1[1]); p1.y = cvt_pk_bf16(o1[2], o1[3]); p1.z = cvt_pk_bf16(o1[4], o1[5]); p1.w = cvt_pk_bf16(o1[6], o1[7]);
      p2.x = cvt_pk_bf16(o2[0], o2[1]); p2.y = cvt_pk_bf16(o2[2], o2[3]); p2.z = cvt_pk_bf16(o2[4], o2[5]); p2.w = cvt_pk_bf16(o2[6], o2[7]);
      qr[d0] = *reinterpret_cast<bf16x8*>(&p1); qr[d0 + 4] = *reinterpret_cast<bf16x8*>(&p2);
    }
  }
  const int sr = tid >> 4, sc = (tid & 15) * 8, vst0 = v_st(sr, sc), vst1 = v_st(32 + sr, sc);
  const int vb0 = (int)(uintptr_t)V_lds + v_rd_base(lane);
  const int mb0 = dq0 + wid * QBLK + r32 + 128 - 4 * hi;
  struct { bf16x8 vs0, vs1, ks0, ks1; } sr_[2];
#define SLOAD(i, t) do { const long k0_ = (long)(t) * KVBLK; sr_[i].vs0 = *reinterpret_cast<const bf16x8*>(&Vh[(k0_ + sr) * LDK + sc]); sr_[i].vs1 = *reinterpret_cast<const bf16x8*>(&Vh[(k0_ + 32 + sr) * LDK + sc]); \
    sr_[i].ks0 = *reinterpret_cast<const bf16x8*>(&Kh[(k0_ + sr) * LDK + sc]); sr_[i].ks1 = *reinterpret_cast<const bf16x8*>(&Kh[(k0_ + 32 + sr) * LDK + sc]); } while (0)
#define SWRITE(i, kbuf, vbuf) do { *(bf16x8*)(V_lds + (vbuf) * SHM_V + vst0) = sr_[i].vs0; *(bf16x8*)(V_lds + (vbuf) * SHM_V + vst1) = sr_[i].vs1; const int kc = sc * 2; \
    *(bf16x8*)(K_lds + (kbuf) * SHM_K + KSWZ(sr, kc)) = sr_[i].ks0; *(bf16x8*)(K_lds + (kbuf) * SHM_K + KSWZ(32 + sr, kc)) = sr_[i].ks1; } while (0)
#define PPBAR() do { SBAR(); asm volatile("s_waitcnt lgkmcnt(0)" ::: "memory"); __builtin_amdgcn_s_barrier(); asm volatile("" ::: "memory"); SBAR(); } while (0)
#define RESC(a) do { if (__any((a) < 1.f)) { if (hi == 0) al_l[r32] = (a); asm volatile("s_waitcnt lgkmcnt(0)" ::: "memory"); \
    _Pragma("unroll") for (int d = 0; d < 4; ++d) _Pragma("unroll") for (int r = 0; r < 16; ++r) o[d][r] *= al_l[crow(r, hi)]; } } while (0)
  f32x16 p0, p1; bf16x8 pa0, pa1, pa2, pa3; float mn, al;
#define PPSTEP(j, SL) do { const int j_ = (j); \
    if (j_ + 2 < NT) { SWRITE(SL, (j_ + 2) & 1, (j_ + 2) % 3); if (j_ + 4 < NT) SLOAD(SL, j_ + 4); } \
    SBAR(); \
    if (j_ + 1 < NT) qkt2(p0, p1, K_lds + ((j_ + 1) & 1) * SHM_K, qr, r32, hi); \
    if (j_ >= 0) pv2(o, vb0 + (j_ % 3) * (int)SHM_V, pa0, pa1, pa2, pa3); \
    PPBAR(); \
    if (j_ + 1 < NT) { partialSM<MODE != 0>(p0, p1, m_reg, mn, al, mb0 - 64 * (j_ + 1)); RESC(al); finishSM(p0, p1, al, l_reg, pa0, pa1, pa2, pa3); } \
    PPBAR(); } while (0)
  SLOAD(0, 0); SWRITE(0, 0, 0); SLOAD(1, 1); SLOAD(0, 2);
  PPBAR();
  if (wr == 1) PPBAR();
  PPSTEP(-1, 1);
  for (int j = 0; j < NT; j += 2) { PPSTEP(j, 0); PPSTEP(j + 1, 1); }
  if (wr == 0) PPBAR();
  if (hi == 0) li_l[r32] = l_reg; asm volatile("s_waitcnt lgkmcnt(0)" ::: "memory");
  float rli[16];
#pragma unroll
  for (int r = 0; r < 16; ++r) rli[r] = __builtin_amdgcn_rcpf(li_l[crow(r, hi)]);
  char* ost = lds + PP_OST + wid * (32 * OST_PITCH);
#pragma unroll
  for (int r = 0; r < 16; ++r) { const int orow = crow(r, hi);
#pragma unroll
    for (int d0 = 0; d0 < 4; ++d0) { const float v = o[d0][r] * rli[r]; *(bf16*)(ost + orow * OST_PITCH + (d0 * 32 + r32) * 2) = (bf16)(cvt_pk_bf16(v, v) & 0xffffu); } }
  asm volatile("s_waitcnt lgkmcnt(0)" ::: "memory");
  bf16* Ow = Ob + (long)(wid * QBLK) * LDO;
#pragma unroll
  for (int i = 0; i < 8; ++i) { const int row = (lane >> 4) + 4 * i, cc = (lane & 15);
    const u32x4 w = *(const u32x4*)(ost + row * OST_PITCH + cc * 16);
    *(u32x4*)(Ow + (long)row * LDO + cc * 8) = w; }
  PPBAR();
#undef SLOAD
#undef SWRITE
#undef PPBAR
#undef RESC
#undef PPSTEP
}
}

#define XB_TMO      128
#define XB_XCNT(j)  (256  + 64 * (j))
#define XB_XSUB(j)  (1280 + 64 * (j))
#define XB_XGEN(j)  (2304 + 64 * (j))
#define XB_TOP      3328
#define XB_TOPGEN   3392
#define XCD_BAR_WORDS 3456
#define XB_SPIN_CAP (1u << 20)
__device__ __forceinline__ unsigned xb_ld(unsigned* p)              { return __hip_atomic_load(p, __ATOMIC_RELAXED, __HIP_MEMORY_SCOPE_AGENT); }
__device__ __forceinline__ unsigned xb_add(unsigned* p, unsigned v) { return __hip_atomic_fetch_add(p, v, __ATOMIC_RELAXED, __HIP_MEMORY_SCOPE_AGENT); }
__device__ __forceinline__ unsigned xb_xcc_id() { return (unsigned)__builtin_amdgcn_s_getreg((3 << 11) | 20) & 0xFu; }
#define XB_SPIN(cond, bar) do { unsigned _sp = 0; while (cond) { __builtin_amdgcn_s_sleep(1); \
    if ((++_sp & 255u) == 0u) { if (xb_ld(&(bar)[XB_TMO])) break; if (_sp > XB_SPIN_CAP) { atomicAdd(&(bar)[XB_TMO], 1u); break; } } } } while (0)
struct XcdBarrier { unsigned* bar; unsigned x; volatile LAS unsigned* st; };
__device__ __forceinline__ XcdBarrier xcd_barrier_post(unsigned* bar, volatile LAS unsigned* st) {
    XcdBarrier b; b.bar = bar; b.x = xb_xcc_id(); b.st = st;
    if (threadIdx.x == 0) (void)xb_add(&bar[XB_XCNT(b.x)], 1u);
    return b;
}
__device__ __forceinline__ void xcd_barrier_complete(unsigned* bar, unsigned x, unsigned& nloc, unsigned& nx) {
    const unsigned G = gridDim.x * gridDim.y * gridDim.z;
    unsigned sum, cnt, mine, sp = 0u;
    for (;;) {
        sum = 0u; cnt = 0u; mine = 0u;
#pragma unroll
        for (unsigned j = 0; j < 16; ++j) { const unsigned c = xb_ld(&bar[XB_XCNT(j)]); sum += c; cnt += (c > 0u) ? 1u : 0u; mine = (j == x) ? c : mine; }
        if (sum == G) break;
        __builtin_amdgcn_s_sleep(1);
        if ((++sp & 255u) == 0u) { if (xb_ld(&bar[XB_TMO])) break; if (sp > XB_SPIN_CAP) { atomicAdd(&bar[XB_TMO], 1u); break; } }
    }
    nloc = mine > 0u ? mine : 1u; nx = cnt > 0u ? cnt : 1u;
}
__device__ __forceinline__ void xcd_barrier(const XcdBarrier& b) {
    asm volatile("s_waitcnt vmcnt(0)" ::: "memory");
    __syncthreads();
    if (threadIdx.x == 0) {
        unsigned* bar = b.bar;
        __builtin_amdgcn_s_waitcnt(0);
        unsigned nloc = b.st[0], nx = b.st[1];
        if (nloc == 0u) { xcd_barrier_complete(bar, b.x, nloc, nx); b.st[0] = nloc; b.st[1] = nx; }
        const unsigned old = xb_add(&bar[XB_XSUB(b.x)], 1u);
        const unsigned gen = old / nloc;
        if (old + 1u == (gen + 1u) * nloc) {
            __builtin_amdgcn_fence(__ATOMIC_RELEASE, "agent");
            asm volatile("s_waitcnt vmcnt(0)" ::: "memory");
            const unsigned og = xb_add(&bar[XB_TOP], 1u);
            const unsigned tg = og / nx;
            if (og + 1u == (tg + 1u) * nx) xb_add(&bar[XB_TOPGEN], 1u);
            else XB_SPIN(xb_ld(&bar[XB_TOPGEN]) == tg, bar);
            __builtin_amdgcn_fence(__ATOMIC_ACQUIRE, "agent");
            xb_add(&bar[XB_XGEN(b.x)], 1u);
            asm volatile("s_waitcnt vmcnt(0)" ::: "memory");
        } else {
            XB_SPIN(xb_ld(&bar[XB_XGEN(b.x)]) == gen, bar);
            __builtin_amdgcn_fence(__ATOMIC_ACQUIRE, "agent");
            asm volatile("s_waitcnt vmcnt(0)" ::: "memory");
        }
    }
    __syncthreads();
}

__device__ __forceinline__ void transpose_item(const float* W, int K, int N, bf16* WT, LAS float* scr, int item, int lane, const float* gk = nullptr) {
    const int nblk = N / 32, kb = item / nblk, nb = item % nblk, k0 = 64 * kb, n0 = 32 * nb;
#pragma unroll
    for (int i = 0; i < 8; ++i) { const int kk = 8 * i + (lane >> 3), c4 = (lane & 7) * 4;
        const f32x4 v = *(const f32x4*)(W + (size_t)(k0 + kk) * N + n0 + c4); const float g = gk ? gk[k0 + kk] : 1.0f;
        LAS float* d = scr + kk * 33 + c4; d[0] = v.x * g; d[1] = v.y * g; d[2] = v.z * g; d[3] = v.w * g; }
    asm volatile("s_waitcnt lgkmcnt(0)" ::: "memory");
    const int c = lane & 7;
#pragma unroll
    for (int j = 0; j < 4; ++j) { const int n = (lane >> 3) + 8 * j; const LAS float* s = scr + (8 * c) * 33 + n;
        u32x4 o; o.x = cvt_pk_bf16(s[0 * 33], s[1 * 33]); o.y = cvt_pk_bf16(s[2 * 33], s[3 * 33]); o.z = cvt_pk_bf16(s[4 * 33], s[5 * 33]); o.w = cvt_pk_bf16(s[6 * 33], s[7 * 33]);
        *(u32x4*)(WT + (size_t)(n0 + n) * K + k0 + 8 * c) = o; }
    asm volatile("s_waitcnt lgkmcnt(0)" ::: "memory");
}

__device__ __forceinline__ void transpose_item_sub(const float* W, int K, int N, int NS, bf16* WT, LAS float* scr, int item, int lane, const float* gk, int ncol0 = 0) {
    const int nblk = NS / 32, kb = item / nblk, nb = item % nblk, k0 = 64 * kb, n0 = 32 * nb;
#pragma unroll
    for (int i = 0; i < 8; ++i) { const int kk = 8 * i + (lane >> 3), c4 = (lane & 7) * 4;
        const f32x4 v = *(const f32x4*)(W + (size_t)(k0 + kk) * N + ncol0 + n0 + c4); const float g = gk[k0 + kk];
        LAS float* d = scr + kk * 33 + c4; d[0] = v.x * g; d[1] = v.y * g; d[2] = v.z * g; d[3] = v.w * g; }
    asm volatile("s_waitcnt lgkmcnt(0)" ::: "memory");
    const int c = lane & 7;
#pragma unroll
    for (int j = 0; j < 4; ++j) { const int n = (lane >> 3) + 8 * j; const LAS float* s = scr + (8 * c) * 33 + n;
        u32x4 o; o.x = cvt_pk_bf16(s[0 * 33], s[1 * 33]); o.y = cvt_pk_bf16(s[2 * 33], s[3 * 33]); o.z = cvt_pk_bf16(s[4 * 33], s[5 * 33]); o.w = cvt_pk_bf16(s[6 * 33], s[7 * 33]);
        *(u32x4*)(WT + (size_t)(n0 + n) * K + k0 + 8 * c) = o; }
    asm volatile("s_waitcnt lgkmcnt(0)" ::: "memory");
}
__device__ __forceinline__ void colmax_item(const float* W, int N, int nq, int gs, int gl, unsigned* cmax, int item, int lane, const float* gk) {
    const int nblk = nq / 32, kb = item / nblk, nb = item % nblk, k0 = 64 * kb, n0 = 32 * nb, c4 = (lane & 7) * 4, ncol0 = (n0 >= gs) ? gl : 0;
    f32x4 mx = {0.f, 0.f, 0.f, 0.f};
#pragma unroll
    for (int i = 0; i < 8; ++i) { const int kk = 8 * i + (lane >> 3);
        const f32x4 v = *(const f32x4*)(W + (size_t)(k0 + kk) * N + ncol0 + n0 + c4) * gk[k0 + kk];
        mx.x = fmaxf(mx.x, fabsf(v.x)); mx.y = fmaxf(mx.y, fabsf(v.y)); mx.z = fmaxf(mx.z, fabsf(v.z)); mx.w = fmaxf(mx.w, fabsf(v.w)); }
#pragma unroll
    for (int o = 8; o < 64; o <<= 1) {
        mx.x = fmaxf(mx.x, __int_as_float(__builtin_amdgcn_ds_bpermute((lane ^ o) << 2, __float_as_int(mx.x)))); mx.y = fmaxf(mx.y, __int_as_float(__builtin_amdgcn_ds_bpermute((lane ^ o) << 2, __float_as_int(mx.y))));
        mx.z = fmaxf(mx.z, __int_as_float(__builtin_amdgcn_ds_bpermute((lane ^ o) << 2, __float_as_int(mx.z)))); mx.w = fmaxf(mx.w, __int_as_float(__builtin_amdgcn_ds_bpermute((lane ^ o) << 2, __float_as_int(mx.w)))); }
    if (lane < 8) { unsigned* p = cmax + n0 + c4;
        __hip_atomic_fetch_max(p + 0, __float_as_uint(mx.x), __ATOMIC_RELAXED, __HIP_MEMORY_SCOPE_AGENT); __hip_atomic_fetch_max(p + 1, __float_as_uint(mx.y), __ATOMIC_RELAXED, __HIP_MEMORY_SCOPE_AGENT);
        __hip_atomic_fetch_max(p + 2, __float_as_uint(mx.z), __ATOMIC_RELAXED, __HIP_MEMORY_SCOPE_AGENT); __hip_atomic_fetch_max(p + 3, __float_as_uint(mx.w), __ATOMIC_RELAXED, __HIP_MEMORY_SCOPE_AGENT); }
}
__device__ __forceinline__ unsigned pack_i8x4(float a, float b, float c, float d) {
    const int ia = (int)__builtin_rintf(a), ib = (int)__builtin_rintf(b), ic = (int)__builtin_rintf(c), id = (int)__builtin_rintf(d);
    return (unsigned)(ia & 0xff) | ((unsigned)(ib & 0xff) << 8) | ((unsigned)(ic & 0xff) << 16) | ((unsigned)id << 24);
}
__device__ __forceinline__ void transpose_item_q(const float* W, int K, int N, int nq, int gs, int gl, unsigned char* WQ, const float* cmax, LAS float* scr, int item, int lane, const float* gk) {
    const int nblk = nq / 32, kb = item / nblk, nb = item % nblk, k0 = 64 * kb, n0 = 32 * nb, ncol0 = (n0 >= gs) ? gl : 0;
#pragma unroll
    for (int i = 0; i < 8; ++i) { const int kk = 8 * i + (lane >> 3), c4 = (lane & 7) * 4;
        const f32x4 v = *(const f32x4*)(W + (size_t)(k0 + kk) * N + ncol0 + n0 + c4); const float g = gk[k0 + kk];
        LAS float* d = scr + kk * 33 + c4; d[0] = v.x * g; d[1] = v.y * g; d[2] = v.z * g; d[3] = v.w * g; }
    asm volatile("s_waitcnt lgkmcnt(0)" ::: "memory");
    const int c = lane & 7;
#pragma unroll
    for (int j = 0; j < 4; ++j) { const int n = (lane >> 3) + 8 * j; const LAS float* s = scr + (8 * c) * 33 + n;
        const float q = 127.0f / fmaxf(cmax[n0 + n], 1e-30f);
        *(u32x2*)(WQ + (size_t)(n0 + n) * K + k0 + 8 * c) = (u32x2){pack_i8x4(s[0 * 33] * q, s[1 * 33] * q, s[2 * 33] * q, s[3 * 33] * q), pack_i8x4(s[4 * 33] * q, s[5 * 33] * q, s[6 * 33] * q, s[7 * 33] * q)}; }
    asm volatile("s_waitcnt lgkmcnt(0)" ::: "memory");
}

struct Args { const float* in[21]; float* out; unsigned char* ws; int lo, hi; };

__device__ __forceinline__ const float* x_in_row(const float* xp, const float* xs, int row) {
    return row < NPROMPT_TOK ? xp + (size_t)row * DM : xs + (size_t)(row - NPROMPT_TOK) * DM;
}

__device__ __forceinline__ void phase_weights(const CAS Args* a, unsigned char* ws, int l, LAS unsigned char* lds, int gw, int NGW, int wave, int lane) {
    LAS float* scr = (LAS float*)(lds + wave * 16384);
    constexpr int I_IN = (DM / 64) * (XYW / 32), I_GQ = (DM / 64) * (I8W / 32), I_BR = (MWD / 64) * (DM / 32), I_OUT = (DM / 64) * (DM / 32), I_F1 = (DM / 64) * (FFD / 32), I_F2 = (FFD / 64) * (DM / 32), I_G = 32 * 8;
    constexpr int NITEMS = I_IN + I_GQ + 3 * I_BR + I_OUT + I_F1 + I_F2 + I_G;
    for (int it = gw; it < NITEMS; it += NGW) {
        int r = it;
        if (r < I_IN) { transpose_item_sub(a->in[6] + (size_t)l * DM * INW, DM, INW, XYW, (bf16*)(ws + WS_WIN), scr, r, lane, a->in[2] + (size_t)l * DM, QKVW); continue; } r -= I_IN;
        if (r < I_GQ) { colmax_item(a->in[6] + (size_t)l * DM * INW, INW, I8W, QKVW, XYW, (unsigned*)(ws + WS_CTL) + CW_CMAX + l * I8W, r, lane, a->in[2] + (size_t)l * DM); continue; } r -= I_GQ;
        if (r < 3 * I_BR) { const int b = r / I_BR; transpose_item(a->in[17] + ((size_t)l * 3 + b) * MWD * DM, MWD, DM, (bf16*)(ws + WS_WBR) + (size_t)b * DM * MWD, scr, r - b * I_BR, lane); continue; } r -= 3 * I_BR;
        if (r < I_OUT) { transpose_item(a->in[18] + (size_t)l * DM * DM, DM, DM, (bf16*)(ws + WS_WOUT), scr, r, lane); continue; } r -= I_OUT;
        if (r < I_F1) { colmax_item(a->in[19] + (size_t)l * DM * FFD, FFD, FFD, 1 << 30, 0, (unsigned*)(ws + WS_CTL) + CW_CMAX1 + l * FFD, r, lane, a->in[4] + (size_t)l * DM); continue; } r -= I_F1;
        if (r < I_F2) { transpose_item(a->in[20] + (size_t)l * FFD * DM, FFD, DM, (bf16*)(ws + WS_W2), scr, r, lane); continue; } r -= I_F2;
        { const int mi = r >> 3, sub = r & 7;
          const int gate = mi >> 4, dd = (mi >> 3) & 1, blk = mi & 7;
          const float* src = (gate ? a->in[14] : a->in[12]) + (((size_t)l * 2 + dd) * 8 + blk) * 16384;
          transpose_item(src, 128, 128, (bf16*)(ws + WS_WG) + ((size_t)(dd * 2 + gate) * 8 + blk) * 16384, scr, sub, lane); }
    }
}

__device__ __forceinline__ void entry_row(const float* xrow, bf16* xb, float* rs, int lane, unsigned char* xq, float* sx) {
    const f32x4* xr = (const f32x4*)xrow + lane;
    f32x4 v[8]; float s = 0.f;
#pragma unroll
    for (int j = 0; j < 8; ++j) { v[j] = xr[64 * j]; s += (v[j].x * v[j].x + v[j].y * v[j].y) + (v[j].z * v[j].z + v[j].w * v[j].w); }
    float am = 0.f;
#pragma unroll
    for (int j = 0; j < 8; ++j) am = fmaxf(fmaxf(am, fmaxf(fabsf(v[j].x), fabsf(v[j].y))), fmaxf(fabsf(v[j].z), fabsf(v[j].w)));
    am = fmaxf(wave_max(am, lane), 1e-30f); const float qs = 127.0f / am;
    u32x2* o8 = (u32x2*)xb + lane;
#pragma unroll
    for (int j = 0; j < 8; ++j) { u32x2 w; w.x = cvt_pk_bf16(v[j].x, v[j].y); w.y = cvt_pk_bf16(v[j].z, v[j].w); o8[64 * j] = w;
        ((unsigned*)xq)[64 * j + lane] = pack_i8x4(v[j].x * qs, v[j].y * qs, v[j].z * qs, v[j].w * qs); }
    const float tot = wave_sum(s, lane);
    if (lane == 0) { *rs = __builtin_amdgcn_rsqf(tot * (1.0f / DM) + EPS); *sx = am * (1.0f / 127.0f); }
}
template <bool LAST>
__device__ __forceinline__ void resid_norm_row(const u32x4 (&yw)[4], const u32x4 (&xw)[4], bf16* xrow, const float* g, float* rs, float* outrow, int lane, bf16* xdst = nullptr, unsigned char* xq = nullptr, float* sx = nullptr) {
    if (!xdst) xdst = xrow;
    float y[32], x[32]; float s = 0.f;
#pragma unroll
    for (int j = 0; j < 4; ++j) { const u32x4 w = yw[j];
        y[8 * j + 0] = bf_lo(w.x); y[8 * j + 1] = bf_hi(w.x); y[8 * j + 2] = bf_lo(w.y); y[8 * j + 3] = bf_hi(w.y); y[8 * j + 4] = bf_lo(w.z); y[8 * j + 5] = bf_hi(w.z); y[8 * j + 6] = bf_lo(w.w); y[8 * j + 7] = bf_hi(w.w); }
#pragma unroll
    for (int j = 0; j < 4; ++j) { const u32x4 w = xw[j];
        x[8 * j + 0] = bf_lo(w.x); x[8 * j + 1] = bf_hi(w.x); x[8 * j + 2] = bf_lo(w.y); x[8 * j + 3] = bf_hi(w.y); x[8 * j + 4] = bf_lo(w.z); x[8 * j + 5] = bf_hi(w.z); x[8 * j + 6] = bf_lo(w.w); x[8 * j + 7] = bf_hi(w.w); }
#pragma unroll
    for (int i = 0; i < 32; ++i) s += y[i] * y[i];
    const float rstd = __builtin_amdgcn_rsqf(wave_sum(s, lane) * (1.0f / DM) + EPS);
    float s2 = 0.f;
#pragma unroll
    for (int j = 0; j < 4; ++j) { const f32x4 g0 = ((const f32x4*)g)[2 * (64 * j + lane)], g1 = ((const f32x4*)g)[2 * (64 * j + lane) + 1];
        const float gg[8] = {g0.x, g0.y, g0.z, g0.w, g1.x, g1.y, g1.z, g1.w};
#pragma unroll
        for (int e = 0; e < 8; ++e) { const float v = x[8 * j + e] + y[8 * j + e] * rstd * gg[e]; x[8 * j + e] = v; s2 += v * v; } }
    if constexpr (LAST) {
#pragma unroll
        for (int j = 0; j < 4; ++j) { ((f32x4*)outrow)[2 * (64 * j + lane)] = (f32x4){x[8 * j], x[8 * j + 1], x[8 * j + 2], x[8 * j + 3]}; ((f32x4*)outrow)[2 * (64 * j + lane) + 1] = (f32x4){x[8 * j + 4], x[8 * j + 5], x[8 * j + 6], x[8 * j + 7]}; }
    } else {
#pragma unroll
        for (int j = 0; j < 4; ++j) { u32x4 w; w.x = cvt_pk_bf16(x[8 * j], x[8 * j + 1]); w.y = cvt_pk_bf16(x[8 * j + 2], x[8 * j + 3]); w.z = cvt_pk_bf16(x[8 * j + 4], x[8 * j + 5]); w.w = cvt_pk_bf16(x[8 * j + 6], x[8 * j + 7]);
            ((u32x4*)xdst)[64 * j + lane] = w; }
        const float r2 = __builtin_amdgcn_rsqf(wave_sum(s2, lane) * (1.0f / DM) + EPS);
        if (lane == 0) *rs = r2;
        if (xq) {
            float am = 0.f;
#pragma unroll
            for (int i = 0; i < 32; ++i) am = fmaxf(am, fabsf(x[i]));
            am = fmaxf(wave_max(am, lane), 1e-30f); const float qs = 127.0f / am;
#pragma unroll
            for (int j = 0; j < 4; ++j) ((u32x2*)xq)[64 * j + lane] = (u32x2){pack_i8x4(x[8 * j] * qs, x[8 * j + 1] * qs, x[8 * j + 2] * qs, x[8 * j + 3] * qs), pack_i8x4(x[8 * j + 4] * qs, x[8 * j + 5] * qs, x[8 * j + 6] * qs, x[8 * j + 7] * qs)};
            if (lane == 0) *sx = am * (1.0f / 127.0f);
        }
    }
}
__device__ __forceinline__ void load_row16(const bf16* row, u32x4 (&w)[4], int lane) {
#pragma unroll
    for (int j = 0; j < 4; ++j) w[j] = ((const u32x4*)row)[64 * j + lane];
}
template <bool LAST, bool QUANT>
__device__ __forceinline__ void resid_norm_rows(const bf16* Ysrc, bf16* X, const float* g, float* rsbase, float* outbase, unsigned char* xqbase, float* sxbase, int TC, int gw, int NGW, int lane) {
    int m = gw; if (m >= TC) return;
    u32x4 yw[4], xw[4]; load_row16(Ysrc + (size_t)m * DM, yw, lane); load_row16(X + (size_t)m * DM, xw, lane);
    for (; m < TC; m += NGW) {
        const int ml = (m + NGW < TC) ? m + NGW : m;
        u32x4 yn[4], xn[4]; load_row16(Ysrc + (size_t)ml * DM, yn, lane); load_row16(X + (size_t)ml * DM, xn, lane);
        if constexpr (LAST) resid_norm_row<true>(yw, xw, X + (size_t)m * DM, g, nullptr, outbase + (size_t)m * DM, lane);
        else if constexpr (QUANT) resid_norm_row<false>(yw, xw, X + (size_t)m * DM, g, rsbase + m, nullptr, lane, nullptr, xqbase + (size_t)m * DM, sxbase + m);
        else resid_norm_row<false>(yw, xw, X + (size_t)m * DM, g, rsbase + m, nullptr, lane);
#pragma unroll
        for (int j = 0; j < 4; ++j) { yw[j] = yn[j]; xw[j] = xn[j]; }
    }
}

__device__ __forceinline__ void krope_token2(bf16* prow0, int pos0, const f32x2* taba, const f32x2* tab1, const float* kn, int lane) {
    const int th = lane >> 5, head = (lane >> 3) & 3, c8 = (lane & 7) * 8; const bool isA = head < 2;
    bf16* p = prow0 + (size_t)th * PWD + (isA ? KA_OFF + head * HD : KB_OFF + (head - 2) * HD) + c8;
    const u32x4 w1 = *(const u32x4*)p, w2 = *(const u32x4*)(p + 64);
    float x1[8] = {bf_lo(w1.x), bf_hi(w1.x), bf_lo(w1.y), bf_hi(w1.y), bf_lo(w1.z), bf_hi(w1.z), bf_lo(w1.w), bf_hi(w1.w)};
    float x2[8] = {bf_lo(w2.x), bf_hi(w2.x), bf_lo(w2.y), bf_hi(w2.y), bf_lo(w2.z), bf_hi(w2.z), bf_lo(w2.w), bf_hi(w2.w)};
    float ss = 0.f;
#pragma unroll
    for (int e = 0; e < 8; ++e) ss += x1[e] * x1[e] + x2[e] * x2[e];
#pragma unroll
    for (int o = 1; o < 8; o <<= 1) ss += __int_as_float(__builtin_amdgcn_ds_bpermute((lane ^ o) << 2, __float_as_int(ss)));
    const float rstd = isA ? __builtin_amdgcn_rsqf(ss * (1.0f / HD) + EPS) : 1.0f;
    const f32x4* tp = (const f32x4*)((isA ? taba : tab1) + (size_t)(pos0 + th) * 64 + c8);
    const f32x4 ga = *(const f32x4*)(kn + c8), gb = *(const f32x4*)(kn + c8 + 4), gc = *(const f32x4*)(kn + 64 + c8), gd = *(const f32x4*)(kn + 64 + c8 + 4);
    const float g1[8] = {ga.x, ga.y, ga.z, ga.w, gb.x, gb.y, gb.z, gb.w}, g2[8] = {gc.x, gc.y, gc.z, gc.w, gd.x, gd.y, gd.z, gd.w};
    float o1[8], o2[8];
#pragma unroll
    for (int e2 = 0; e2 < 4; ++e2) { const f32x4 cs = tp[e2];
#pragma unroll
        for (int k = 0; k < 2; ++k) { const int e = 2 * e2 + k; const float c = k ? cs.z : cs.x, s = k ? cs.w : cs.y;
            const float y1 = x1[e] * rstd * (isA ? g1[e] : 1.0f), y2 = x2[e] * rstd * (isA ? g2[e] : 1.0f);
            o1[e] = y1 * c - y2 * s; o2[e] = y2 * c + y1 * s; } }
    u32x4 q1, q2; q1.x = cvt_pk_bf16(o1[0], o1[1]); q1.y = cvt_pk_bf16(o1[2], o1[3]); q1.z = cvt_pk_bf16(o1[4], o1[5]); q1.w = cvt_pk_bf16(o1[6], o1[7]);
    q2.x = cvt_pk_bf16(o2[0], o2[1]); q2.y = cvt_pk_bf16(o2[2], o2[3]); q2.z = cvt_pk_bf16(o2[4], o2[5]); q2.w = cvt_pk_bf16(o2[6], o2[7]);
    *(u32x4*)p = q1; *(u32x4*)(p + 64) = q2;
}
__device__ __forceinline__ void rope_tables(f32x2* tab1, f32x2* taba, int gtid, int nthr) {
    for (int i = gtid; i < SEQ * 64; i += nthr) {
        const int pos = i >> 6, j = i & 63;
        const double rev1 = (double)pos * ROPE_F1[j];
        const double reva = (double)(j < 32 ? (pos >> 6) : (pos & 63)) * ROPE_FA[j & 31];
        const float f1 = (float)(rev1 - __builtin_floor(rev1)), fa = (float)(reva - __builtin_floor(reva));
        tab1[i] = (f32x2){__builtin_amdgcn_cosf(f1), __builtin_amdgcn_sinf(f1)};
        taba[i] = (f32x2){__builtin_amdgcn_cosf(fa), __builtin_amdgcn_sinf(fa)};
    }
}

struct CParams { const float* conv_w; const float* conv_b; const float* gate_r_b; const float* gate_i_b; const float* lam; const bf16* WG; };
constexpr int CSPAN = 512, NSPAN = SEQ / CSPAN;
template <int PASS, int DIR>
__device__ __forceinline__ void c_sweep(LAS unsigned char* lds, const bf16* P, bf16* OC, const CParams& cp, f32x2* SUM, bf16* UB, int seq, int nb, int sp) {
    constexpr bool FIRST = (PASS == 1 && DIR == 0);
    constexpr int UP = 136;
    LAS bf16* U = (LAS bf16*)lds;
    LAS float* AD = (LAS float*)(lds + 32768);
    int tid_ = threadIdx.x; asm volatile("" : "+v"(tid_));
    const int tid = tid_, wave = tid >> 6, lane = tid & 63;
    const int t0 = tid >> 4, c8 = (tid & 15) * 8, cg8 = nb * 128 + c8;
    LAS float* CW = (LAS float*)(lds + 32768 + 65536);
    const int q = wave & 3, th = wave >> 2, r = lane & 31, h = lane >> 5;
    bf16x8 bfr[8], bfi[8];
    { const bf16* wrp = cp.WG + ((size_t)((DIR * 2 + 0) * 8 + nb) * 128 + 32 * q + r) * 128 + 8 * h;
      const bf16* wip = cp.WG + ((size_t)((DIR * 2 + 1) * 8 + nb) * 128 + 32 * q + r) * 128 + 8 * h;
#pragma unroll
      for (int ks = 0; ks < 8; ++ks) { bfr[ks] = *(const bf16x8*)(wrp + 16 * ks); bfi[ks] = *(const bf16x8*)(wip + 16 * ks); } }
    const int ch = 32 * q + r, cg = nb * 128 + ch;
    constexpr float L2E = 1.4426950408889634f;
    const float rbn = -L2E * cp.gate_r_b[DIR * MWD + cg], ibn = -L2E * cp.gate_i_b[DIR * MWD + cg], lam = cp.lam[DIR * MWD + cg];
    const float el = __builtin_amdgcn_exp2f(-L2E * lam);
    const float ls8 = -8.0f * (lam > 3.0f ? el * (1.0f - el * (0.5f - el * (1.0f / 3.0f))) : 0.6931471805599453f * __builtin_amdgcn_logf(1.0f + el));
    const f32x2 ls8e = {ls8 * L2E, ls8 * L2E}, ls82 = {2.0f * ls8, 2.0f * ls8}, rbn2 = {rbn, rbn}, ibn2 = {ibn, ibn};
    float hh = 0.f, pp = 1.f;
    if constexpr (PASS == 3) {
        if (tid < 128) {
            const f32x2* sb = SUM + ((size_t)(seq * NSPAN) * 2 + DIR) * MWD + nb * 128 + tid;
            f32x2 sv[NSPAN];
#pragma unroll
            for (int s = 0; s < NSPAN; ++s) sv[s] = sb[(size_t)s * 2 * MWD];
#pragma unroll
            for (int s = 0; s < NSPAN; ++s) { const int ss = DIR ? NSPAN - 1 - s : s; const bool use = DIR ? (ss > sp) : (ss < sp); hh = use ? sv[ss].x * hh + sv[ss].y : hh; }
        }
    }
    const size_t rowbase = (size_t)seq * SEQ + (size_t)sp * CSPAN;
    const int posbase = sp * CSPAN;
    u32x4 xw[2][4];
#define C_LOADX(tile) do { _Pragma("unroll") for (int hf = 0; hf < 2; ++hf) _Pragma("unroll") for (int j = 0; j < 4; ++j) { const int tt = posbase + (tile) * 64 + t0 + 32 * hf - 2 + j; \
        const int ttc = tt < 0 ? 0 : (tt >= SEQ ? SEQ - 1 : tt); const u32x4 xv = *(const u32x4*)(P + ((size_t)seq * SEQ + ttc) * PWD + XC_OFF + cg8); \
        const unsigned keep = (tt >= 0 && tt < SEQ) ? 0xffffffffu : 0u; xw[hf][j] = (u32x4){xv.x & keep, xv.y & keep, xv.z & keep, xv.w & keep}; } } while (0)
    u32x4 uw[2];
#define C_LOADU(tile) do { _Pragma("unroll") for (int hf = 0; hf < 2; ++hf) uw[hf] = *(const u32x4*)(UB + (rowbase + (tile) * 64 + t0 + 32 * hf) * MWD + cg8); } while (0)
    if constexpr (FIRST) C_LOADX(DIR ? 7 : 0); else C_LOADU(DIR ? 7 : 0);
    for (int i = tid; i < 5 * 128; i += 512) CW[i] = (i < 512) ? cp.conv_w[(i >> 7) * MWD + nb * 128 + (i & 127)] : cp.conv_b[nb * 128 + (i & 127)];
    __syncthreads();
    for (int it = 0; it < 8; ++it) {
        const int tile = DIR ? 7 - it : it;
        if constexpr (FIRST) {
#pragma unroll
        for (int hf = 0; hf < 2; ++hf) {
            float u8[8];
            { const f32x4 b0 = *(const LAS f32x4*)(CW + 512 + c8), b1 = *(const LAS f32x4*)(CW + 512 + c8 + 4); u8[0] = b0.x; u8[1] = b0.y; u8[2] = b0.z; u8[3] = b0.w; u8[4] = b1.x; u8[5] = b1.y; u8[6] = b1.z; u8[7] = b1.w; }
#pragma unroll
            for (int j = 0; j < 4; ++j) { const u32x4 x = xw[hf][j]; const f32x4 w0 = *(const LAS f32x4*)(CW + j * 128 + c8), w1 = *(const LAS f32x4*)(CW + j * 128 + c8 + 4);
                u8[0] += bf_lo(x.x) * w0.x; u8[1] += bf_hi(x.x) * w0.y; u8[2] += bf_lo(x.y) * w0.z; u8[3] += bf_hi(x.y) * w0.w;
                u8[4] += bf_lo(x.z) * w1.x; u8[5] += bf_hi(x.z) * w1.y; u8[6] += bf_lo(x.w) * w1.z; u8[7] += bf_hi(x.w) * w1.w; }
            u32x4 w; w.x = cvt_pk_bf16(u8[0], u8[1]); w.y = cvt_pk_bf16(u8[2], u8[3]); w.z = cvt_pk_bf16(u8[4], u8[5]); w.w = cvt_pk_bf16(u8[6], u8[7]);
            *(LAS u32x4*)(U + (t0 + 32 * hf) * UP + c8) = w;
            *(u32x4*)(UB + (rowbase + tile * 64 + t0 + 32 * hf) * MWD + cg8) = w;
        }
        } else {
#pragma unroll
        for (int hf = 0; hf < 2; ++hf) *(LAS u32x4*)(U + (t0 + 32 * hf) * UP + c8) = uw[hf];
        }
        if (it < 7) { if constexpr (FIRST) C_LOADX(DIR ? 6 - it : it + 1); else C_LOADU(DIR ? 6 - it : it + 1); }
        __syncthreads();
        {
            f32x16 accr = {}, acci = {};
#pragma unroll
            for (int ks = 0; ks < 8; ++ks) {
                const bf16x8 af = *(const LAS bf16x8*)(U + (32 * th + r) * UP + 16 * ks + 8 * h);
                accr = __builtin_amdgcn_mfma_f32_32x32x16_bf16(af, bfr[ks], accr, 0, 0, 0);
                acci = __builtin_amdgcn_mfma_f32_32x32x16_bf16(af, bfi[ks], acci, 0, 0, 0);
            }
            LAS float* pa = AD + ch; LAS float* pd = AD + 64 * 128 + ch;
#define C_PAIR(reg, AV, DR) do { const int tt = 32 * th + ((reg) & 3) + 8 * ((reg) >> 2) + 4 * h; \
                const f32x2 er = (f32x2){accr[reg], accr[(reg) + 1]} * (-L2E) + rbn2, ei = (f32x2){acci[reg], acci[(reg) + 1]} * (-L2E) + ibn2;       \
                f32x2 rr, ii; rr.x = __builtin_amdgcn_rcpf(1.0f + __builtin_amdgcn_exp2f(er.x)); rr.y = __builtin_amdgcn_rcpf(1.0f + __builtin_amdgcn_exp2f(er.y)); \
                ii.x = __builtin_amdgcn_rcpf(1.0f + __builtin_amdgcn_exp2f(ei.x)); ii.y = __builtin_amdgcn_rcpf(1.0f + __builtin_amdgcn_exp2f(ei.y)); \
                const f32x2 le = ls8e * rr, x2 = ls82 * rr;                                          \
                f32x2 av_; av_.x = __builtin_amdgcn_exp2f(le.x); av_.y = __builtin_amdgcn_exp2f(le.y); \
                const f32x2 pol = -x2 * (1.0f + x2 * (0.5f + x2 * ((1.0f / 6.0f) + x2 * ((1.0f / 24.0f) + x2 * (1.0f / 120.0f))))), dir = 1.0f - av_ * av_;     \
                f32x2 om; om.x = x2.x > -0.25f ? pol.x : dir.x; om.y = x2.y > -0.25f ? pol.y : dir.y; \
                const f32x2 uf = {bf2f(U[tt * UP + ch]), bf2f(U[(tt + 1) * UP + ch])}; \
                f32x2 sq; sq.x = __builtin_amdgcn_sqrtf(om.x); sq.y = __builtin_amdgcn_sqrtf(om.y); \
                AV = av_; DR = sq * (ii * uf); } while (0)
            if constexpr (PASS == 1) {
#pragma unroll
                for (int g4 = 0; g4 < 4; ++g4) { f32x2 a01, d01, a23, d23; C_PAIR(4 * g4, a01, d01); C_PAIR(4 * g4 + 2, a23, d23);
                    float dd;
                    if constexpr (DIR == 0) { dd = a01.y * d01.x + d01.y; dd = a23.x * dd + d23.x; dd = a23.y * dd + d23.y; }
                    else { dd = a23.x * d23.y + d23.x; dd = a01.y * dd + d01.y; dd = a01.x * dd + d01.x; }
                    const int G4 = 8 * th + 2 * g4 + h;
                    pa[G4 * 128] = (a01.x * a01.y) * (a23.x * a23.y); pd[G4 * 128] = dd; }
            } else {
#pragma unroll
                for (int reg = 0; reg < 16; reg += 2) { f32x2 av, dr; C_PAIR(reg, av, dr); const int tt = 32 * th + (reg & 3) + 8 * (reg >> 2) + 4 * h;
                    pa[tt * 128] = av.x; pa[(tt + 1) * 128] = av.y; pd[tt * 128] = dr.x; pd[(tt + 1) * 128] = dr.y; }
            }
#undef C_PAIR
        }
        u32x4 yw[2], ow[2];
        if constexpr (PASS == 3 && DIR == 1) {
#pragma unroll
            for (int hf = 0; hf < 2; ++hf) { const size_t row = rowbase + tile * 64 + t0 + 32 * hf; yw[hf] = *(const u32x4*)(P + row * PWD + YC_OFF + cg8); ow[hf] = *(const u32x4*)(OC + row * MWD + cg8); }
        }
        __syncthreads();
        if (tid < 128) {
            LAS float* pa = AD + tid; LAS float* pd = AD + 64 * 128 + tid;
            if constexpr (PASS == 1) {
                float av[16], dv[16];
#pragma unroll
                for (int s = 0; s < 16; ++s) { const int g = DIR ? 15 - s : s; av[s] = pa[g * 128]; dv[s] = pd[g * 128]; }
#pragma unroll
                for (int s = 0; s < 16; ++s) { hh = av[s] * hh + dv[s]; pp *= av[s]; }
            } else
#pragma unroll
            for (int s0 = 0; s0 < 64; s0 += 16) {
                float av[16], dv[16];
#pragma unroll
                for (int s = 0; s < 16; ++s) { const int t = DIR ? 63 - (s0 + s) : (s0 + s); av[s] = pa[t * 128]; dv[s] = pd[t * 128]; }
#pragma unroll
                for (int s = 0; s < 16; ++s) { hh = av[s] * hh + dv[s]; if constexpr (PASS == 1) pp *= av[s]; else dv[s] = hh; }
                if constexpr (PASS == 3) {
#pragma unroll
                    for (int s = 0; s < 16; ++s) { const int t = DIR ? 63 - (s0 + s) : (s0 + s); pa[t * 128] = dv[s]; } }
            }
        }
        if constexpr (PASS == 3) {
            __syncthreads();
#pragma unroll
            for (int hf = 0; hf < 2; ++hf) { const int t = t0 + 32 * hf; const size_t row = rowbase + tile * 64 + t;
                const LAS float* hp = AD + t * 128 + c8;
                float o[8];
                if constexpr (DIR == 0) {
#pragma unroll
                    for (int j = 0; j < 8; ++j) o[j] = hp[j];
                } else {
                    const u32x4 y4 = yw[hf], p4 = ow[hf];
                    const float y[8] = {bf_lo(y4.x), bf_hi(y4.x), bf_lo(y4.y), bf_hi(y4.y), bf_lo(y4.z), bf_hi(y4.z), bf_lo(y4.w), bf_hi(y4.w)};
                    const float hf0[8] = {bf_lo(p4.x), bf_hi(p4.x), bf_lo(p4.y), bf_hi(p4.y), bf_lo(p4.z), bf_hi(p4.z), bf_lo(p4.w), bf_hi(p4.w)};
#pragma unroll
                    for (int j = 0; j < 8; ++j) { const float z = 0.7978845608028654f * (y[j] + 0.044715f * y[j] * y[j] * y[j]);
                        o[j] = (hp[j] + hf0[j]) * (y[j] * fast_sigmoid(2.0f * z)); }
                }
                u32x4 w; w.x = cvt_pk_bf16(o[0], o[1]); w.y = cvt_pk_bf16(o[2], o[3]); w.z = cvt_pk_bf16(o[4], o[5]); w.w = cvt_pk_bf16(o[6], o[7]);
                *(u32x4*)(OC + row * MWD + cg8) = w; }
        }
    }
#undef C_LOADX
#undef C_LOADU
    if constexpr (PASS == 1) { if (tid < 128) SUM[((size_t)(seq * NSPAN + sp) * 2 + DIR) * MWD + nb * 128 + tid] = (f32x2){pp, hh}; }
    __syncthreads();
}

__global__ void __launch_bounds__(512, 2) mk_fwd(Args args) {
    extern __shared__ __attribute__((aligned(16))) unsigned char lds_raw[];
    LAS unsigned char* lds = (LAS unsigned char*)lds_raw;
    {
        volatile LAS unsigned* MISC = (volatile LAS unsigned*)(lds + MISC_OFF);
        for (int u = threadIdx.x; u < (LDS_BYTES - MISC_OFF) / 4; u += 512) MISC[u] = 0u;
        __syncthreads();
    }
#if MK_SINGLE
    XcdBarrier bar = xcd_barrier_post((unsigned*)(args.ws + WS_CTL) + CW_BAR, (volatile LAS unsigned*)(lds + MISC_OFF) + 8);
#define GRID_BAR() xcd_barrier(bar)
#else
#define GRID_BAR() do {} while (0)
#endif
    const int lo = args.lo, hi = args.hi;
    int step = 0; unsigned long long tacc = 0ull; (void)tacc;
#define RUN(k) (lo <= (k) && (k) < hi)
#define SEAM(k) do { if (RUN((k) + 1)) { const unsigned long long tb_ = (TSEL == 1) ? __builtin_amdgcn_s_memrealtime() : 0ull; GRID_BAR(); if (TSEL == 1) tacc += __builtin_amdgcn_s_memrealtime() - tb_; } } while (0)
#define PHASE_EXIT(id) do { if (TSEL == 2 + (id)) tacc += __builtin_amdgcn_s_memrealtime() - t_enter_; if (TSEL == 102 + (id)) tacc += (__builtin_amdgcn_s_memtime() - c_enter_) / 24ull; } while (0)
#define PHASE_ENTER() const unsigned long long t_enter_ = TSEL ? __builtin_amdgcn_s_memrealtime() : 0ull; (void)t_enter_; const unsigned long long c_enter_ = (TSEL >= 100) ? __builtin_amdgcn_s_memtime() : 0ull; (void)c_enter_; int tid = threadIdx.x; asm volatile("" : "+v"(tid)); int bx = blockIdx.x; asm volatile("" : "+s"(bx)); int G = gridDim.x; asm volatile("" : "+s"(G)); const int NGW = G * 8; (void)NGW; \
    const int lane = tid & 63, wave = __builtin_amdgcn_readfirstlane(tid >> 6), gw = bx * 8 + wave; \
    const CAS Args* ap = (const CAS Args*)__builtin_amdgcn_kernarg_segment_ptr(); asm volatile("" : "+s"(ap)); \
    unsigned char* ws = ap->ws; float* out = ap->out; (void)lane; (void)gw; (void)out; \
    bf16* const P = (bf16*)(ws + WS_P); bf16* const Y = (bf16*)(ws + WS_P); bf16* const GT = (bf16*)(ws + WS_G); bf16* const O = (bf16*)(ws + WS_O); bf16* const HID = (bf16*)(ws + WS_G); \
    (void)P; (void)Y; (void)GT; (void)O; (void)HID

    for (int l = 0; l < DEPTH; ++l) {
        { const int k = step++; if (RUN(k) && ((PH_MASK >> 0) & 1)) { PHASE_ENTER(); for (int rep_ = 0; rep_ < NREP(0); ++rep_) phase_weights(ap, ws, l, lds, gw, NGW, wave, lane);
            if (l == 0) {
                rope_tables((f32x2*)(ws + WS_TAB1), (f32x2*)(ws + WS_TABA), bx * 512 + tid, G * 512);
                for (int row = gw; row < NTOK; row += NGW) entry_row(x_in_row(ap->in[0], ap->in[1], row), (bf16*)(ws + WS_XB) + (size_t)row * DM, (float*)(ws + WS_RS) + row, lane, ws + WS_XQ + (size_t)row * DM, (float*)(ws + WS_SX) + row); }
            PHASE_EXIT(0); SEAM(k); } }
        { const int k = step++; if (RUN(k) && ((PH_MASK >> 0) & 1)) { PHASE_ENTER();
            LAS float* scr = (LAS float*)(lds + wave * 16384);
            for (int it = gw; it < (DM / 64) * (I8W / 32); it += NGW) transpose_item_q(ap->in[6] + (size_t)l * DM * INW, DM, INW, I8W, QKVW, XYW, ws + WS_WQ, (const float*)((unsigned*)(ws + WS_CTL) + CW_CMAX + l * I8W), scr, it, lane, ap->in[2] + (size_t)l * DM);
            for (int it = gw; it < (DM / 64) * (FFD / 32); it += NGW) transpose_item_q(ap->in[19] + (size_t)l * DM * FFD, DM, FFD, FFD, 1 << 30, 0, ws + WS_W1, (const float*)((unsigned*)(ws + WS_CTL) + CW_CMAX1 + l * FFD), scr, it, lane, ap->in[4] + (size_t)l * DM);
            SEAM(k); } }
        for (int c = 0; c < NCHUNK; ++c) {
            const int row0 = c ? 32768 : 0, nseq = c ? 2 : 4, TC = nseq * SEQ;
            #define XBC ((bf16*)(ws + WS_XB) + (size_t)row0 * DM)
            #define RSC ((float*)(ws + WS_RS) + (size_t)row0)
            #define MRG ((bf16*)(ws + WS_P + 128 * MiB))
            #define YF ((bf16*)(ws + WS_P + 160 * MiB))
            { const int k = step++; if (RUN(k) && ((PH_MASK >> 2) & 1)) { PHASE_ENTER();
                for (int rep_ = 0; rep_ < NREP(2); ++rep_) {
                if (bx & 1) {
                { pg8::Gemm g{(const bf16*)(ws + WS_XQ + (size_t)row0 * DM), (const bf16*)(ws + WS_WQ), DM}; pg8::StaticOrder S; S.init(TC, I8W, G, bx, WGM_G1);
                  pg8::EpiGateQ E{P, GT, RSC, (const float*)(ws + WS_SX) + row0, (const float*)((unsigned*)(ws + WS_CTL) + CW_CMAX + l * I8W)};
                  pg8::gemm_phase<pg8::EpiGateQ, pg8::StaticOrder, true, true>(lds, g, S, E); }
                { pg8::Gemm g{XBC, (bf16*)(ws + WS_WIN), DM}; pg8::StaticOrder S; S.init(TC, XYW, G, bx, WGM_G1); pg8::EpiXY E{P, RSC};
                  pg8::gemm_phase<pg8::EpiXY, pg8::StaticOrder>(lds, g, S, E); }
                } else {
                { pg8::Gemm g{XBC, (bf16*)(ws + WS_WIN), DM}; pg8::StaticOrder S; S.init(TC, XYW, G, bx, WGM_G1); pg8::EpiXY E{P, RSC};
                  pg8::gemm_phase<pg8::EpiXY, pg8::StaticOrder>(lds, g, S, E); }
                { pg8::Gemm g{(const bf16*)(ws + WS_XQ + (size_t)row0 * DM), (const bf16*)(ws + WS_WQ), DM}; pg8::StaticOrder S; S.init(TC, I8W, G, bx, WGM_G1);
                  pg8::EpiGateQ E{P, GT, RSC, (const float*)(ws + WS_SX) + row0, (const float*)((unsigned*)(ws + WS_CTL) + CW_CMAX + l * I8W)};
                  pg8::gemm_phase<pg8::EpiGateQ, pg8::StaticOrder, true, true>(lds, g, S, E); }
                }
                }
                PHASE_EXIT(2); SEAM(k); } }
            { const int k = step++; if (RUN(k) && ((PH_MASK >> 3) & 1)) { PHASE_ENTER();
                const float* kn = ap->in[8] + (size_t)l * HD;
                for (int m = 2 * gw; m < TC; m += 2 * NGW) krope_token2(P + (size_t)m * PWD, m & (SEQ - 1), (const f32x2*)(ws + WS_TABA), (const f32x2*)(ws + WS_TAB1), kn, lane);
                CParams cp{ap->in[10] + (size_t)l * 4 * MWD, ap->in[11] + (size_t)l * MWD, ap->in[13] + (size_t)l * 2 * MWD, ap->in[15] + (size_t)l * 2 * MWD, ap->in[16] + (size_t)l * 2 * MWD, (bf16*)(ws + WS_WG)};
                for (int rep_ = 0; rep_ < NREP(3); ++rep_) for (int u = bx; u < nseq * 8 * NSPAN; u += G) { const int sp = u & (NSPAN - 1), nb = (u >> 4) & 7, seq = u >> 7;
                    c_sweep<1, 0>(lds, P, nullptr, cp, (f32x2*)(ws + WS_SUM), (bf16*)(ws + WS_BRS), seq, nb, sp); c_sweep<1, 1>(lds, P, nullptr, cp, (f32x2*)(ws + WS_SUM), (bf16*)(ws + WS_BRS), seq, nb, sp); }
                PHASE_EXIT(3); SEAM(k); } }
            { const int k = step++; if (RUN(k) && ((PH_MASK >> 5) & 1)) {
                if (SUBMASK & 4) { PHASE_ENTER();
                CParams cp{ap->in[10] + (size_t)l * 4 * MWD, ap->in[11] + (size_t)l * MWD, ap->in[13] + (size_t)l * 2 * MWD, ap->in[15] + (size_t)l * 2 * MWD, ap->in[16] + (size_t)l * 2 * MWD, (bf16*)(ws + WS_WG)};
                for (int rep_ = 0; rep_ < NREP(14); ++rep_) for (int u = bx; u < nseq * 8 * NSPAN; u += G) { const int sp = u & (NSPAN - 1), nb = (u >> 4) & 7, seq = u >> 7;
                    c_sweep<3, 0>(lds, P, O + (size_t)2 * TC * MWD, cp, (f32x2*)(ws + WS_SUM), (bf16*)(ws + WS_BRS), seq, nb, sp); c_sweep<3, 1>(lds, P, O + (size_t)2 * TC * MWD, cp, (f32x2*)(ws + WS_SUM), (bf16*)(ws + WS_BRS), seq, nb, sp); } PHASE_EXIT(14); }
                if (SUBMASK & 1) { PHASE_ENTER(); const int xcd = bx & 7, rank = bx >> 3, nrank = G >> 3; for (int rep_ = 0; rep_ < NREP(12); ++rep_) for (int i = rank; i < 32 * nseq; i += nrank) {
                    const int uid = xcd * 32 * nseq + i, seq = uid >> 8, head = (uid >> 5) & 7, kvh = head >> 2, qb = uid & 31;
                    const bf16* Qb = P + (size_t)(seq * SEQ + qb * 256) * PWD + QA_OFF + head * HD;
                    const bf16* Kh = P + (size_t)(seq * SEQ) * PWD + KA_OFF + kvh * HD; const bf16* Vh = P + (size_t)(seq * SEQ) * PWD + VA_OFF + kvh * HD;
                    ATT_UNIT(0, SD_A)(Qb, Kh, Vh, O + (size_t)(seq * SEQ + qb * 256) * MWD + head * HD, SEQ / 64, 0, nullptr, (char*)lds_raw, (const f32x2*)(ws + WS_TABA) + qb * 256 * 64, ap->in[7] + (size_t)l * HD);
                } PHASE_EXIT(12); }
                if (SUBMASK & 2) { PHASE_ENTER(); const int xcd = bx & 7, rank = bx >> 3, nrank = G >> 3; for (int rep_ = 0; rep_ < NREP(13); ++rep_) for (int i = rank; i < 32 * nseq; i += nrank) {
                    const int uid = xcd * 32 * nseq + i, seq = uid >> 8, kvh = (uid >> 7) & 1, q0 = (uid & 127) * 64;
                    int k0 = q0 - 128 < 0 ? 0 : q0 - 128, k1 = q0 + 256 > SEQ ? SEQ : q0 + 256;
                    if (((k1 - k0) >> 6) & 1) { if (k1 < SEQ) k1 += 64; else k0 -= 64; }
                    const bf16* Qb = P + (size_t)(seq * SEQ + q0) * PWD + QB_OFF + kvh * 4 * HD;
                    const bf16* Kh = P + (size_t)(seq * SEQ + k0) * PWD + KB_OFF + kvh * HD; const bf16* Vh = P + (size_t)(seq * SEQ + k0) * PWD + VB_OFF + kvh * HD;
                    ATT_UNIT(1, SD_B)(Qb, Kh, Vh, O + (size_t)TC * MWD + (size_t)(seq * SEQ + q0) * MWD + kvh * 4 * HD, (k1 - k0) / 64, q0 - k0, ap->in[9] + l * 8 + kvh * 4, (char*)lds_raw, (const f32x2*)(ws + WS_TAB1) + q0 * 64, nullptr);
                } PHASE_EXIT(13); }
                SEAM(k); } }
            { const int k = step++; if (RUN(k) && ((PH_MASK >> 6) & 1)) { PHASE_ENTER();
                pg8::Gemm g{O, (bf16*)(ws + WS_WBR), MWD}; pg8::BranchOrder S; S.base.init(TC, DM, G, bx, WGM_G2); S.npanel = TC / 256;
                pg8::EpiBr E{GT, MRG};
                for (int rep_ = 0; rep_ < NREP(6); ++rep_) pg8::gemm_phase<pg8::EpiBr, pg8::BranchOrder>(lds, g, S, E);
                PHASE_EXIT(6); SEAM(k); } }
            { const int k = step++; if (RUN(k) && ((PH_MASK >> 7) & 1)) { PHASE_ENTER();
                pg8::Gemm g{MRG, (bf16*)(ws + WS_WOUT), DM}; pg8::StaticOrder S; S.init(TC, DM, G, bx, WGM_G3); pg8::EpiBf16 E{Y, DM};
                for (int rep_ = 0; rep_ < NREP(7); ++rep_) pg8::gemm_phase<pg8::EpiBf16, pg8::StaticOrder>(lds, g, S, E);
                PHASE_EXIT(7); SEAM(k); } }
            { const int k = step++; if (RUN(k) && ((PH_MASK >> 8) & 1)) { PHASE_ENTER();
                const float* g1 = ap->in[3] + (size_t)l * DM;
                resid_norm_rows<false, true>(Y, XBC, g1, RSC, nullptr, ws + WS_XQ + (size_t)row0 * DM, (float*)(ws + WS_SX) + row0, TC, gw, NGW, lane);
                PHASE_EXIT(8); SEAM(k); } }
            { const int k = step++; if (RUN(k) && ((PH_MASK >> 9) & 1)) { PHASE_ENTER();
                pg8::Gemm g{(const bf16*)(ws + WS_XQ + (size_t)row0 * DM), (const bf16*)(ws + WS_W1), DM}; pg8::StaticOrder S; S.init(TC, FFD, G, bx, WGM_G4);
                pg8::EpiRelu2Q E{HID, FFD, RSC, (const float*)(ws + WS_SX) + row0, (const float*)((unsigned*)(ws + WS_CTL) + CW_CMAX1 + l * FFD)};
                for (int rep_ = 0; rep_ < NREP(9); ++rep_) pg8::gemm_phase<pg8::EpiRelu2Q, pg8::StaticOrder, true, true>(lds, g, S, E);
                PHASE_EXIT(9); SEAM(k); } }
            { const int k = step++; if (RUN(k) && ((PH_MASK >> 10) & 1)) { PHASE_ENTER();
                pg8::Gemm g{HID, (bf16*)(ws + WS_W2), FFD}; pg8::StaticOrder S; S.init(TC, DM, G, bx, WGM_G5); pg8::EpiBf16 E{YF, DM};
                for (int rep_ = 0; rep_ < NREP(10); ++rep_) pg8::gemm_phase<pg8::EpiBf16, pg8::StaticOrder>(lds, g, S, E);
                PHASE_EXIT(10); SEAM(k); } }
            { const int k = step++; if (RUN(k) && ((PH_MASK >> 11) & 1)) { PHASE_ENTER();
                const float* g1 = ap->in[5] + (size_t)l * DM;
                if (l + 1 < DEPTH) resid_norm_rows<false, true>(YF, XBC, g1, RSC, nullptr, ws + WS_XQ + (size_t)row0 * DM, (float*)(ws + WS_SX) + row0, TC, gw, NGW, lane);
                else resid_norm_rows<true, false>(YF, XBC, g1, nullptr, out + (size_t)row0 * DM, nullptr, nullptr, TC, gw, NGW, lane);
                PHASE_EXIT(11);
                } }
        }
    }
#if TSEL && MK_SINGLE
    {
        unsigned long long* tw = (unsigned long long*)(args.ws + WS_CTL + 512 * 1024);
        xcd_barrier(bar);
        if (threadIdx.x == 0) __hip_atomic_fetch_add(tw, tacc, __ATOMIC_RELAXED, __HIP_MEMORY_SCOPE_AGENT);
        xcd_barrier(bar);
        const unsigned long long tot = __hip_atomic_load(tw, __ATOMIC_RELAXED, __HIP_MEMORY_SCOPE_AGENT) / gridDim.x;
        const unsigned long long t0 = __builtin_amdgcn_s_memrealtime();
        while (__builtin_amdgcn_s_memrealtime() - t0 < tot) __builtin_amdgcn_s_sleep(8);
    }
#endif
#undef RUN
#undef SEAM
}
constexpr int NSTEPS = DEPTH * (2 + NCHUNK * 9);

extern "C" void kernel_launch(void* const* d_in, const int* in_sizes, int n_in, void* d_out, int out_size, void* d_ws, size_t ws_size, hipStream_t stream) {
    static int grid = 0;
    if (grid == 0) {
        if (n_in != 21 || out_size != NTOK * DM || ws_size < WS_END) { fprintf(stderr, "kernel_launch: unexpected shapes (n_in %d out %d ws %zu)\n", n_in, out_size, ws_size); grid = -1; return; }
        int dev = 0, cus = 0, per_cu = 0;
        if (hipGetDevice(&dev) != hipSuccess || hipDeviceGetAttribute(&cus, hipDeviceAttributeMultiprocessorCount, dev) != hipSuccess) { grid = -1; return; }
        if (hipFuncSetAttribute((const void*)mk_fwd, hipFuncAttributeMaxDynamicSharedMemorySize, LDS_BYTES) != hipSuccess) { fprintf(stderr, "kernel_launch: hipFuncSetAttribute failed\n"); grid = -1; return; }
        if (hipOccupancyMaxActiveBlocksPerMultiprocessor(&per_cu, (const void*)mk_fwd, 512, LDS_BYTES) != hipSuccess || per_cu < 1) { fprintf(stderr, "kernel_launch: occupancy query says %d\n", per_cu); }
        (void)hipGetLastError();
        grid = cus;
    }
    if (grid < 0) return;
    if (hipMemsetAsync((char*)d_ws + WS_CTL, 0, CTL_ZERO_BYTES, stream) != hipSuccess) return;
    Args a{};
    for (int i = 0; i < 21; ++i) a.in[i] = (const float*)d_in[i];
    a.out = (float*)d_out; a.ws = (unsigned char*)d_ws;
#if MK_SINGLE
    a.lo = 0; a.hi = NSTEPS;
    hipLaunchKernelGGL(mk_fwd, dim3(grid), dim3(512), LDS_BYTES, stream, a);
#else
    for (int s = 0; s < NSTEPS; ++s) { a.lo = s; a.hi = s + 1; hipLaunchKernelGGL(mk_fwd, dim3(grid), dim3(512), LDS_BYTES, stream, a); }
#endif
    const hipError_t le = hipPeekAtLastError();
    if (le != hipSuccess) fprintf(stderr, "kernel_launch: launch failed: %s\n", hipGetErrorName(le));
}
```
